# Optimizing an MI355X kernel written in HIP

```python
import math
import jax
import jax.numpy as jnp
from jax import lax
import numpy as np

D_MODEL = 2048
BATCH = 1
SEQ = 8192
DEPTH = 2

F32 = jnp.float32
RET_HEADS = 4
RET_QK_DIM = 128
RET_V_DIM = 256
RET_CHUNK = 128
ROPE_BASE = 10000.0
GDN_HEADS = 8
GDN_DIM = 128
GDN_CHUNK = 64
CONV_WIDTH = 4
S5_CHANNELS = 1024
S5_GROUP = 16
S5_GROUPS = S5_CHANNELS // S5_GROUP
S5_STATE = 64
S5_STEP_MIN = 1e-3
S5_STEP_MAX = 1e-1
SSD_HEADS = 16
SSD_HEAD_DIM = 64
SSD_INNER = SSD_HEADS * SSD_HEAD_DIM
SSD_GROUPS = 2
SSD_STATE = 128
SSD_CHUNK = 128
DT_MIN = 1e-3
DT_MAX = 1e-1
D_FF = 4 * D_MODEL
N_BRANCH = 4
DEEPNORM_ALPHA = (2 * DEPTH) ** 0.25
DEEPNORM_BETA = (8 * DEPTH) ** -0.25
LN_EPS = 1e-5
RMS_EPS = 1e-6

RET_Q = RET_HEADS * RET_QK_DIM
RET_V = RET_HEADS * RET_V_DIM
GDN_W = GDN_HEADS * GDN_DIM
SSD_BC = SSD_GROUPS * SSD_STATE
SPLIT_SIZES = (
    RET_Q, RET_Q, RET_V, RET_V,
    GDN_W, GDN_W, GDN_W, GDN_W, GDN_HEADS, GDN_HEADS,
    S5_CHANNELS,
    SSD_INNER, SSD_INNER, SSD_BC, SSD_BC, SSD_HEADS,
    N_BRANCH * D_MODEL,
)
D_IN_PROJ = sum(SPLIT_SIZES)
SPLIT_POINTS = tuple(sum(SPLIT_SIZES[:i + 1]) for i in range(len(SPLIT_SIZES) - 1))

kernel_name = 'hybrid_gated_ret_gdn_s5_ssd_block'


def layer_norm(x, g, b):
    xf = x.astype(F32)
    mu = jnp.mean(xf, -1, keepdims=True)
    var = jnp.mean(jnp.square(xf - mu), -1, keepdims=True)
    return ((xf - mu) * lax.rsqrt(var + LN_EPS) * g.astype(F32) + b.astype(F32)).astype(x.dtype)


def rms_norm(x, w):
    xf = x.astype(F32)
    return xf * lax.rsqrt(jnp.mean(xf * xf, -1, keepdims=True) + RMS_EPS) * w.astype(F32)


def l2_norm(x):
    return x * lax.rsqrt(jnp.sum(x * x, -1, keepdims=True) + RMS_EPS)


def causal_conv(x, w):
    rhs = jnp.transpose(w).astype(x.dtype)[:, None, :]
    return lax.conv_general_dilated(x, rhs, window_strides=(1,), padding=[(CONV_WIDTH - 1, 0)],
                                    dimension_numbers=('NWC', 'WIO', 'NWC'),
                                    feature_group_count=x.shape[-1])


def rotary(x, positions):
    half = x.shape[-1] // 2
    inv = ROPE_BASE ** (-jnp.arange(half, dtype=F32) / half)
    ang = positions.astype(F32)[..., None] * inv
    cos = jnp.cos(ang)[:, :, None, :]
    sin = jnp.sin(ang)[:, :, None, :]
    x1, x2 = x[..., :half], x[..., half:]
    return jnp.concatenate([x1 * cos - x2 * sin, x1 * sin + x2 * cos], -1)


def chunk_decay_matrix(cum):
    c = cum.shape[-1]
    idx = jnp.arange(c)
    lower = idx[:, None] >= idx[None, :]
    diff = cum[..., :, None] - cum[..., None, :]
    return jnp.where(lower, jnp.exp(jnp.where(lower, diff, 0.0)), 0.0)


def retention(q, k, v, positions):
    bsz, t, h, dk = q.shape
    dv = v.shape[-1]
    c = RET_CHUNK
    n = t // c
    q = rotary(q.astype(F32), positions)
    k = rotary(k.astype(F32), positions) * dk ** -0.5
    v = v.astype(F32)
    log_g = jnp.log(1.0 - 2.0 ** (-5.0 - jnp.arange(h, dtype=F32)))
    idx = jnp.arange(c, dtype=F32)
    dmat = chunk_decay_matrix(idx[None, :] * log_g[:, None])
    q = q.reshape(bsz, n, c, h, dk)
    k = k.reshape(bsz, n, c, h, dk)
    v = v.reshape(bsz, n, c, h, dv)
    scores = jnp.einsum('bnihd,bnjhd->bnhij', q, k) * dmat
    inner = jnp.einsum('bnhij,bnjhe->bnihe', scores, v)
    k_decay = jnp.exp((c - 1.0 - idx)[:, None] * log_g[None, :])
    chunk_kv = jnp.einsum('bnjhd,jh,bnjhe->bnhde', k, k_decay, v)
    gamma_c = jnp.exp(c * log_g)[None, :, None, None]

    def step(r, kv):
        return r * gamma_c + kv, r

    _, r_prev = lax.scan(step, jnp.zeros((bsz, h, dk, dv), F32), jnp.moveaxis(chunk_kv, 1, 0))
    r_prev = jnp.moveaxis(r_prev, 0, 1)
    q_decay = jnp.exp((idx + 1.0)[:, None] * log_g[None, :])
    cross = jnp.einsum('bnihd,ih,bnhde->bnihe', q, q_decay, r_prev)
    return (inner + cross).reshape(bsz, t, h, dv)


def retention_mixer(rq, rk, rv, rg, positions):
    bsz, t, _ = rq.shape
    y = retention(rq.reshape(bsz, t, RET_HEADS, RET_QK_DIM), rk.reshape(bsz, t, RET_HEADS, RET_QK_DIM),
                  rv.reshape(bsz, t, RET_HEADS, RET_V_DIM), positions)
    mu = jnp.mean(y, -1, keepdims=True)
    var = jnp.mean(jnp.square(y - mu), -1, keepdims=True)
    y = ((y - mu) * lax.rsqrt(var + LN_EPS)).reshape(bsz, t, RET_V)
    return jax.nn.silu(rg.astype(F32)) * y


def gated_delta_rule(q, k, v, g, beta):
    bsz, t, h, dk = q.shape
    dv = v.shape[-1]
    c = GDN_CHUNK
    n = t // c
    q = (q * dk ** -0.5).reshape(bsz, n, c, h, dk)
    k = k.reshape(bsz, n, c, h, dk)
    v = v.reshape(bsz, n, c, h, dv)
    beta = beta.reshape(bsz, n, c, h)
    gcum = jnp.cumsum(g.reshape(bsz, n, c, h), axis=2)
    gamma = chunk_decay_matrix(jnp.swapaxes(gcum, 2, 3))
    idx = jnp.arange(c)
    strict = idx[:, None] > idx[None, :]
    kk = jnp.einsum('bnihd,bnjhd->bnhij', k, k)
    m = jnp.where(strict, jnp.swapaxes(beta, 2, 3)[..., :, None] * kk * gamma, 0.0)
    a_mat = m + jnp.eye(c, dtype=F32)
    rhs = jnp.concatenate([v * beta[..., None], k * (beta * jnp.exp(gcum))[..., None]], -1)
    rhs = jnp.swapaxes(rhs, 2, 3)
    sol = lax.linalg.triangular_solve(a_mat, rhs, left_side=True, lower=True, unit_diagonal=True)
    u = sol[..., :dv]
    w = sol[..., dv:]
    qk = jnp.einsum('bnihd,bnjhd->bnhij', q, k) * gamma
    q_dec = jnp.swapaxes(q * jnp.exp(gcum)[..., None], 2, 3)
    k_tail = jnp.swapaxes(k * jnp.exp(gcum[:, :, -1:, :] - gcum)[..., None], 2, 3)
    g_last = jnp.exp(gcum[:, :, -1, :])

    def step(s, xs):
        u_c, w_c, qk_c, qd_c, kt_c, gl_c = xs
        v_new = u_c - jnp.einsum('bhcd,bhde->bhce', w_c, s)
        o = jnp.einsum('bhcd,bhde->bhce', qd_c, s) + jnp.einsum('bhij,bhje->bhie', qk_c, v_new)
        s = s * gl_c[..., None, None] + jnp.einsum('bhcd,bhce->bhde', kt_c, v_new)
        return s, o

    xs = tuple(jnp.moveaxis(a, 1, 0) for a in (u, w, qk, q_dec, k_tail, g_last))
    _, o = lax.scan(step, jnp.zeros((bsz, h, dk, dv), F32), xs)
    o = jnp.swapaxes(jnp.moveaxis(o, 0, 1), 2, 3)
    return o.reshape(bsz, t, h, dv)


def gated_deltanet_mixer(dq, dk_, dv_, dz, da, db, conv_w, a_log, dt_bias, norm_w):
    bsz, t, _ = dq.shape
    qkv = jax.nn.silu(causal_conv(jnp.concatenate([dq, dk_, dv_], -1), conv_w).astype(F32))
    q, k, v = jnp.split(qkv, 3, axis=-1)
    heads = lambda a: a.reshape(bsz, t, GDN_HEADS, GDN_DIM)
    q = l2_norm(heads(q))
    k = l2_norm(heads(k))
    g = -jnp.exp(a_log.astype(F32)) * jax.nn.softplus(da.astype(F32) + dt_bias.astype(F32))
    beta = jax.nn.sigmoid(db.astype(F32))
    o = gated_delta_rule(q, k, heads(v), g, beta)
    o = rms_norm(o, norm_w) * jax.nn.silu(heads(dz).astype(F32))
    return o.reshape(bsz, t, GDN_W)


def s5_mixer(u, lam_re, lam_im, log_step, b_re, b_im, c_re, c_im, d_skip, glu_w, glu_b):
    bsz, t, _ = u.shape
    uf = u.astype(F32)
    ug = uf.reshape(bsz, t, S5_GROUPS, S5_GROUP)
    lre = lam_re.astype(F32)
    lim = lam_im.astype(F32)
    step = jnp.exp(log_step.astype(F32))[:, None]
    mag = jnp.exp(lre * step)
    ab_re = mag * jnp.cos(lim * step)
    ab_im = mag * jnp.sin(lim * step)
    den = lre * lre + lim * lim
    f_re = ((ab_re - 1.0) * lre + ab_im * lim) / den
    f_im = (ab_im * lre - (ab_re - 1.0) * lim) / den
    bb_re = f_re[..., None] * b_re.astype(F32) - f_im[..., None] * b_im.astype(F32)
    bb_im = f_re[..., None] * b_im.astype(F32) + f_im[..., None] * b_re.astype(F32)
    bu_re = jnp.einsum('btgc,gnc->btgn', ug, bb_re)
    bu_im = jnp.einsum('btgc,gnc->btgn', ug, bb_im)
    a_re = jnp.broadcast_to(ab_re, bu_re.shape)
    a_im = jnp.broadcast_to(ab_im, bu_im.shape)

    def combine(e1, e2):
        a1r, a1i, b1r, b1i = e1
        a2r, a2i, b2r, b2i = e2
        return (a2r * a1r - a2i * a1i, a2r * a1i + a2i * a1r,
                a2r * b1r - a2i * b1i + b2r, a2r * b1i + a2i * b1r + b2i)

    _, _, xr, xi = lax.associative_scan(combine, (a_re, a_im, bu_re, bu_im), axis=1)
    y = (jnp.einsum('gcn,btgn->btgc', c_re.astype(F32), xr)
         - jnp.einsum('gcn,btgn->btgc', c_im.astype(F32), xi))
    y = y.reshape(bsz, t, S5_CHANNELS) + d_skip.astype(F32) * uf
    y = jax.nn.gelu(y)
    return y * jax.nn.sigmoid(y @ glu_w.astype(F32) + glu_b.astype(F32))


def ssd_scan(x, dt, a, bm, cm):
    bsz, t, h, p = x.shape
    nst = bm.shape[-1]
    c = SSD_CHUNK
    n = t // c
    xdt = (x * dt[..., None]).reshape(bsz, n, c, h, p)
    acum = jnp.cumsum((dt * a).reshape(bsz, n, c, h), axis=2)
    bm = bm.reshape(bsz, n, c, h, nst)
    cm = cm.reshape(bsz, n, c, h, nst)
    lmat = chunk_decay_matrix(jnp.swapaxes(acum, 2, 3))
    scores = jnp.einsum('bnihs,bnjhs->bnhij', cm, bm) * lmat
    y_diag = jnp.einsum('bnhij,bnjhp->bnihp', scores, xdt)
    decay_states = jnp.exp(acum[:, :, -1:, :] - acum)
    states = jnp.einsum('bnjhs,bnjh,bnjhp->bnhps', bm, decay_states, xdt)
    chunk_decay = jnp.exp(acum[:, :, -1, :])

    def step(s, xs):
        st, dec = xs
        return s * dec[..., None, None] + st, s

    _, prev = lax.scan(step, jnp.zeros((bsz, h, p, nst), F32),
                       (jnp.moveaxis(states, 1, 0), jnp.moveaxis(chunk_decay, 1, 0)))
    prev = jnp.moveaxis(prev, 0, 1)
    y_off = jnp.einsum('bnihs,bnhps,bnih->bnihp', cm, prev, jnp.exp(acum))
    return (y_diag + y_off).reshape(bsz, t, h, p)


def mamba2_mixer(mz, mx, mb, mc, mdt, conv_w, conv_b, dt_bias, a_log, d_skip, norm_w):
    bsz, t, _ = mx.shape
    xbc = causal_conv(jnp.concatenate([mx, mb, mc], -1), conv_w) + conv_b
    xbc = jax.nn.silu(xbc.astype(F32))
    xs, bs, cs = jnp.split(xbc, [SSD_INNER, SSD_INNER + SSD_BC], axis=-1)
    xh = xs.reshape(bsz, t, SSD_HEADS, SSD_HEAD_DIM)
    rep = SSD_HEADS // SSD_GROUPS
    bh = jnp.repeat(bs.reshape(bsz, t, SSD_GROUPS, SSD_STATE), rep, axis=2)
    ch = jnp.repeat(cs.reshape(bsz, t, SSD_GROUPS, SSD_STATE), rep, axis=2)
    dt = jax.nn.softplus(mdt.astype(F32) + dt_bias.astype(F32))
    a = -jnp.exp(a_log.astype(F32))
    y = ssd_scan(xh, dt, a, bh, ch) + d_skip.astype(F32)[:, None] * xh
    y = y.reshape(bsz, t, SSD_INNER) * jax.nn.silu(mz.astype(F32))
    y = rms_norm(y.reshape(bsz, t, SSD_GROUPS, SSD_INNER // SSD_GROUPS),
                 norm_w.reshape(SSD_GROUPS, SSD_INNER // SSD_GROUPS))
    return y.reshape(bsz, t, SSD_INNER)


def setup_inputs(seed: int = 0) -> dict:
    key = jax.random.key(seed)
    keys = list(jax.random.split(key, 40))
    L = DEPTH

    def normal(shape, scale):
        return jax.random.normal(keys.pop(), shape, F32) * scale

    def uniform(shape, lo, hi):
        return jax.random.uniform(keys.pop(), shape, F32, lo, hi)

    def dt_bias(shape):
        dt = jnp.exp(uniform(shape, math.log(DT_MIN), math.log(DT_MAX)))
        return dt + jnp.log(-jnp.expm1(-dt))

    gain = lambda shape: 1.0 + normal(shape, 0.02)
    n_idx = jnp.arange(S5_STATE, dtype=F32)
    return {
        'x': normal((BATCH, SEQ, D_MODEL), 1.0),
        'positions': jnp.broadcast_to(jnp.arange(SEQ, dtype=jnp.int32)[None, :], (BATCH, SEQ)),
        'w_in': normal((L, D_MODEL, D_IN_PROJ), D_MODEL ** -0.5),
        'gdn_conv_w': normal((L, 3 * GDN_W, CONV_WIDTH), CONV_WIDTH ** -0.5),
        'gdn_a_log': jnp.log(uniform((L, GDN_HEADS), 1.0, 16.0)),
        'gdn_dt_bias': dt_bias((L, GDN_HEADS)),
        'gdn_norm_w': gain((L, GDN_DIM)),
        's5_lam_re': -0.5 * (1.0 + normal((L, S5_GROUPS, S5_STATE), 0.01)),
        's5_lam_im': jnp.broadcast_to(math.pi * n_idx, (L, S5_GROUPS, S5_STATE)),
        's5_log_step': uniform((L, S5_GROUPS), math.log(S5_STEP_MIN), math.log(S5_STEP_MAX)),
        's5_b_re': normal((L, S5_GROUPS, S5_STATE, S5_GROUP), (2 * S5_GROUP) ** -0.5),
        's5_b_im': normal((L, S5_GROUPS, S5_STATE, S5_GROUP), (2 * S5_GROUP) ** -0.5),
        's5_c_re': normal((L, S5_GROUPS, S5_GROUP, S5_STATE), S5_STATE ** -0.5),
        's5_c_im': normal((L, S5_GROUPS, S5_GROUP, S5_STATE), S5_STATE ** -0.5),
        's5_d': normal((L, S5_CHANNELS), 1.0),
        's5_glu_w': normal((L, S5_CHANNELS, S5_CHANNELS), S5_CHANNELS ** -0.5),
        's5_glu_b': normal((L, S5_CHANNELS), 0.01),
        'ssd_conv_w': normal((L, SSD_INNER + 2 * SSD_BC, CONV_WIDTH), CONV_WIDTH ** -0.5),
        'ssd_conv_b': normal((L, SSD_INNER + 2 * SSD_BC), 0.01),
        'ssd_dt_bias': dt_bias((L, SSD_HEADS)),
        'ssd_a_log': jnp.log(uniform((L, SSD_HEADS), 1.0, 16.0)),
        'ssd_d': gain((L, SSD_HEADS)),
        'ssd_norm_w': gain((L, SSD_INNER)),
        'w_branch_ret': normal((L, RET_V, D_MODEL), DEEPNORM_BETA * RET_V ** -0.5),
        'w_branch_gdn': normal((L, GDN_W, D_MODEL), DEEPNORM_BETA * GDN_W ** -0.5),
        'w_branch_s5': normal((L, S5_CHANNELS, D_MODEL), DEEPNORM_BETA * S5_CHANNELS ** -0.5),
        'w_branch_ssd': normal((L, SSD_INNER, D_MODEL), DEEPNORM_BETA * SSD_INNER ** -0.5),
        'w_out': normal((L, D_MODEL, D_MODEL), DEEPNORM_BETA * D_MODEL ** -0.5),
        'ln1_g': gain((L, D_MODEL)),
        'ln1_b': normal((L, D_MODEL), 0.02),
        'w_up': normal((L, D_MODEL, D_FF), DEEPNORM_BETA * D_MODEL ** -0.5),
        'w_down': normal((L, D_FF, D_MODEL), DEEPNORM_BETA * D_FF ** -0.5),
        'ln2_g': gain((L, D_MODEL)),
        'ln2_b': normal((L, D_MODEL), 0.02),
    }


def reference(x, positions, w_in, gdn_conv_w, gdn_a_log, gdn_dt_bias, gdn_norm_w,
              s5_lam_re, s5_lam_im, s5_log_step, s5_b_re, s5_b_im, s5_c_re, s5_c_im,
              s5_d, s5_glu_w, s5_glu_b, ssd_conv_w, ssd_conv_b, ssd_dt_bias, ssd_a_log,
              ssd_d, ssd_norm_w, w_branch_ret, w_branch_gdn, w_branch_s5, w_branch_ssd,
              w_out, ln1_g, ln1_b, w_up, w_down, ln2_g, ln2_b):
    bsz, t, _ = x.shape
    dt_ = x.dtype
    for l in range(DEPTH):
        proj = x @ w_in[l]
        (r_q, r_k, r_v, r_g, d_q, d_k, d_v, d_z, d_a, d_b, s_u,
         m_z, m_x, m_b, m_c, m_dt, gate_logits) = jnp.split(proj, SPLIT_POINTS, axis=-1)
        y_ret = retention_mixer(r_q, r_k, r_v, r_g, positions)
        y_gdn = gated_deltanet_mixer(d_q, d_k, d_v, d_z, d_a, d_b, gdn_conv_w[l], gdn_a_log[l],
                                     gdn_dt_bias[l], gdn_norm_w[l])
        y_s5 = s5_mixer(s_u, s5_lam_re[l], s5_lam_im[l], s5_log_step[l], s5_b_re[l], s5_b_im[l],
                        s5_c_re[l], s5_c_im[l], s5_d[l], s5_glu_w[l], s5_glu_b[l])
        y_ssd = mamba2_mixer(m_z, m_x, m_b, m_c, m_dt, ssd_conv_w[l], ssd_conv_b[l], ssd_dt_bias[l],
                             ssd_a_log[l], ssd_d[l], ssd_norm_w[l])
        gates = jax.nn.sigmoid(gate_logits.reshape(bsz, t, N_BRANCH, D_MODEL))
        merged = (gates[:, :, 0] * (y_ret.astype(dt_) @ w_branch_ret[l])
                  + gates[:, :, 1] * (y_gdn.astype(dt_) @ w_branch_gdn[l])
                  + gates[:, :, 2] * (y_s5.astype(dt_) @ w_branch_s5[l])
                  + gates[:, :, 3] * (y_ssd.astype(dt_) @ w_branch_ssd[l]))
        mix = merged @ w_out[l]
        x = layer_norm(DEEPNORM_ALPHA * x + mix, ln1_g[l], ln1_b[l])
        hid = jnp.square(jax.nn.relu(x @ w_up[l])) @ w_down[l]
        x = layer_norm(DEEPNORM_ALPHA * x + hid, ln2_g[l], ln2_b[l])
    return x
```

```cpp
#include <hip/hip_runtime.h>
#include <cstdio>
#include <cstdint>

#ifndef MK_N_LAUNCHES
#define MK_N_LAUNCHES 1
#endif

#define LAS __attribute__((address_space(3)))
#define GAS __attribute__((address_space(1)))
typedef unsigned short bf16_t;
typedef short bf16x8 __attribute__((ext_vector_type(8)));
typedef float f32x4 __attribute__((ext_vector_type(4)));
typedef float f32x2 __attribute__((ext_vector_type(2)));
typedef unsigned u32x4 __attribute__((ext_vector_type(4)));
typedef unsigned u32x2 __attribute__((ext_vector_type(2)));

constexpr int T = 8192, DM = 2048, NPROJ = 18976, NPP = 19200, DFF = 8192, NLAYER = 2;
constexpr int C_RQ = 0, C_RK = 512, C_RV = 1024, C_RG = 2048, C_DQ = 3072, C_DK = 4096, C_DV = 5120, C_DZ = 6144, C_DA = 7168, C_DB = 7176,
              C_SU = 7184, C_MZ = 8208, C_MX = 9232, C_MB = 10256, C_MC = 10512, C_MDT = 10768, C_GATE = 10784;
constexpr float LN_EPS = 1e-5f, RMS_EPS = 1e-6f, ALPHA = 1.41421356237f;

constexpr size_t MiB = 1u << 20;
constexpr size_t WS_CTL = 0, CTL_ZERO_BYTES = 1 * MiB;
constexpr size_t WT_IN = 0, WT_GLU = 75 * MiB, WT_BR = 77 * MiB, WT_OUT = 93 * MiB, WT_UP = 101 * MiB, WT_DOWN = 133 * MiB, WT_LAYER = 165 * MiB;
constexpr size_t WS_WT = 1 * MiB;
constexpr size_t WS_PROJ = WS_WT + 2 * WT_LAYER;
constexpr size_t WS_HID = WS_PROJ;
constexpr size_t WS_SMALL = WS_PROJ + 300 * MiB;
constexpr size_t WS_TRIG = WS_SMALL + 1 * MiB;
constexpr size_t WS_S5P = WS_TRIG + 4 * MiB;
constexpr size_t WS_YCAT = WS_S5P + 2 * MiB;
constexpr size_t WS_YS5 = WS_YCAT + 64 * MiB;
constexpr size_t WS_XB = WS_YS5 + 16 * MiB;
constexpr size_t WS_XR0 = WS_XB + 32 * MiB;
constexpr size_t WS_XR1 = WS_XR0 + 64 * MiB;
constexpr size_t WS_TMP = WS_XR1 + 64 * MiB;
constexpr size_t TM_KR = 0, TM_QR = 16 * MiB, TM_VR = 32 * MiB, TM_KS = 64 * MiB, TM_QS = 72 * MiB, TM_VS = 80 * MiB,
                 TM_KG = 112 * MiB, TM_QG = 144 * MiB, TM_VG = 176 * MiB, TM_SM = 208 * MiB, TM_END = 212 * MiB;
constexpr size_t TM_MERGED = 0, TM_PRE = 32 * MiB;
constexpr size_t WS_END = WS_TMP + TM_END;
constexpr size_t SM_DECR = 0, SM_KQR = 4 * T, SM_DECS = 8 * T, SM_KQS = 24 * T, SM_DECG = 26 * T, SM_BETG = 34 * T, SM_KQG = 42 * T;
constexpr int CW_BAR = 4096;

constexpr int RING_BYTES = 131072, LDSCTL_OFF = RING_BYTES, MISC_OFF = LDSCTL_OFF + 320, LDS_BYTES = 147456;

__device__ __forceinline__ unsigned f2bf(float f) { unsigned u = __builtin_bit_cast(unsigned, f); return (u + 0x7fffu + ((u >> 16) & 1u)) >> 16; }
__device__ __forceinline__ unsigned pk2(float lo, float hi) { return f2bf(lo) | (f2bf(hi) << 16); }
__device__ __forceinline__ float bf_lo(unsigned u) { return __builtin_bit_cast(float, u << 16); }
__device__ __forceinline__ float bf_hi(unsigned u) { return __builtin_bit_cast(float, u & 0xffff0000u); }
__device__ __forceinline__ float bf2f(bf16_t h) { return __builtin_bit_cast(float, (unsigned)h << 16); }
__device__ __forceinline__ float sigmoidf_(float x) { return 1.f / (1.f + __expf(-x)); }
__device__ __forceinline__ float siluf_(float x) { return x / (1.f + __expf(-x)); }
__device__ __forceinline__ float softplusf_(float x) { return x > 20.f ? x : log1pf(__expf(x)); }
__device__ __forceinline__ float wave_sum(float v) {
#pragma unroll
    for (int o = 1; o < 64; o <<= 1) v += __shfl_xor(v, o);
    return v;
}
__device__ __forceinline__ float half_sum(float v) {
#pragma unroll
    for (int o = 1; o < 32; o <<= 1) v += __shfl_xor(v, o);
    return v;
}
__device__ __forceinline__ void sincos_d(double x, double& s, double& c) {
    const double k = __builtin_rint(x * 0.63661977236758134308);
    double r = __builtin_fma(-k, 1.57079632679489655800e+00, x);
    r = __builtin_fma(-k, 6.12323399573676603587e-17, r);
    const double r2 = r * r;
    double sp = 1.58969099521155010221e-10;
    sp = __builtin_fma(sp, r2, -2.50507602534068634195e-08);
    sp = __builtin_fma(sp, r2, 2.75573137070700676789e-06);
    sp = __builtin_fma(sp, r2, -1.98412698298579493134e-04);
    sp = __builtin_fma(sp, r2, 8.33333333332248946124e-03);
    sp = __builtin_fma(sp, r2, -1.66666666666666324348e-01);
    const double sn = __builtin_fma(sp * r2, r, r);
    double cp = -1.13596475577881948265e-11;
    cp = __builtin_fma(cp, r2, 2.08757232129817482790e-09);
    cp = __builtin_fma(cp, r2, -2.75573143513906633035e-07);
    cp = __builtin_fma(cp, r2, 2.48015872894767294178e-05);
    cp = __builtin_fma(cp, r2, -1.38888888888741095749e-03);
    cp = __builtin_fma(cp, r2, 4.16666666666666019037e-02);
    const double cs = __builtin_fma(cp * r2, r2, __builtin_fma(-0.5, r2, 1.0));
    const long q = (long)k & 3;
    s = (q == 0) ? sn : (q == 1) ? cs : (q == 2) ? -sn : -cs;
    c = (q == 0) ? cs : (q == 1) ? -sn : (q == 2) ? -cs : sn;
}

namespace pg8 {
constexpr int BM = 256, BK = 64, HALF = 128, HTB = HALF * BK * 2, STAGE_BYTES = 8 * HTB, NXCD = 8, WGM = 8;
__host__ __device__ __forceinline__ int lds_byte(int r, int c) { const int st = (r >> 4) * 2 + (c >> 5), rr = r & 15, cc = c & 31, ob = rr * 64 + cc * 2; return st * 1024 + (ob ^ (((ob >> 9) & 1) << 5)); }
__host__ __device__ __forceinline__ void stage_rc(int b, int& R, int& C) { const int st = b / 1024, sb = b % 1024, swz = sb ^ (((sb >> 9) & 1) << 5); R = (st >> 1) * 16 + swz / 64; C = (st & 1) * 32 + (swz % 64) / 2; }
__host__ __device__ __forceinline__ int perm32(int rho) { const int n = rho >> 4, i = rho & 15; return 8 * (i >> 2) + 4 * n + (i & 3); }

struct Unit { int pm, pn, seg; };
struct Gemm { const bf16_t* A; const bf16_t* Bt; int M, N, K, lda, ldb; size_t segA, segB; };

__host__ __device__ __forceinline__ void tile_of(long L, int nM, int nN, int& pm, int& pn) {
    const int nwg = nM * nN; int wgid = (int)L;
    { const int q = nwg / NXCD, r = nwg % NXCD, xcd = wgid % NXCD, off = wgid / NXCD; wgid = (xcd < r ? xcd * (q + 1) : r * (q + 1) + (xcd - r) * q) + off; }
    const int nig = WGM * nN, gid = wgid / nig, fm = gid * WGM, gsz = (nM - fm) < WGM ? (nM - fm) : WGM;
    pm = fm + ((wgid % nig) % gsz); pn = (wgid % nig) / gsz;
}
struct StaticOrder {
    int nM, nN, nwg, G, c;
    __host__ __device__ void init(int M, int N, int G_, int c_) { nM = M / BM; nN = N / BM; nwg = nM * nN; G = G_; c = c_; }
    __host__ __device__ bool next(int i, Unit& u) const {
        const long L = (long)i * G + c; if (L >= nwg) return false;
        tile_of(L, nM, nN, u.pm, u.pn); u.seg = 0; return true;
    }
    __device__ __forceinline__ void a_ready(const Unit&) const {}
    __device__ __forceinline__ void done(const Unit&) const {}
};
template <int NSEG> struct SegOrder {
    int nM, nN, nwg, G, c;
    __host__ __device__ void init(int M, int N, int G_, int c_) { nM = M / BM; nN = N / BM; nwg = nM * nN; G = G_; c = c_; }
    __host__ __device__ bool next(int i, Unit& u) const {
        const long L = (long)(i / NSEG) * G + c; if (L >= nwg) return false;
        tile_of(L, nM, nN, u.pm, u.pn); u.seg = i % NSEG; return true;
    }
    __device__ __forceinline__ void a_ready(const Unit&) const {}
    __device__ __forceinline__ void done(const Unit&) const {}
};

__device__ __forceinline__ unsigned cvt_pk_bf16(float lo, float hi) { unsigned r; asm volatile("v_cvt_pk_bf16_f32 %0, %1, %2" : "=v"(r) : "v"(lo), "v"(hi)); return r; }


template <class Epi, class Sched, bool ALIGN_EPI = false, bool SP2 = false>
__device__ __forceinline__ void gemm_phase(LAS unsigned char* lds, const Gemm g, const Sched& S, const Epi& E) {
    int tid = threadIdx.x; asm volatile("" : "+v"(tid));
    const int wid = __builtin_amdgcn_readfirstlane(tid >> 6), lane = tid & 63, wr = wid >> 2, wc = wid & 3, fr = lane & 15, fq = lane >> 4;
    const int K = g.K, nt = K / BK;
    unsigned voffA[2], voffB[2];
#pragma unroll
    for (int i = 0; i < 2; ++i) { int R, C; stage_rc(tid * 16 + i * 8192, R, C); const int Rb = Epi::PERM ? ((R & ~31) + perm32(R & 31)) : R;
        voffA[i] = (unsigned)(R * g.lda + C) * 2u; voffB[i] = (unsigned)(Rb * g.ldb + C) * 2u; }
    const size_t kstep = (size_t)(BK * 2);
    const size_t hstepA = (size_t)HALF * g.lda * 2, hstepB = (size_t)HALF * g.ldb * 2;
    const size_t tstepA = 2 * hstepA, tstepB = 2 * hstepB;
    const unsigned ldsw = (unsigned)wid * 1024u;
    const int aoff = lds_byte(wr * 64 + fr, fq * 8), boff = lds_byte(wc * 32 + fr, fq * 8);
#define PG8_SA(b, h) (((b) * 2 + (h)) * HTB)
#define PG8_SB(b, h) ((4 + (b) * 2 + (h)) * HTB)
#define PG8_STAGE(bufoff, gbase, voff) do { _Pragma("unroll") for (int _i = 0; _i < 2; ++_i) \
        __builtin_amdgcn_global_load_lds((const unsigned*)((const char*)(gbase) + (voff)[_i]), (LAS unsigned*)(lds + (bufoff) + ldsw + _i * 8192), 16, 0, 0); } while (0)
#define PG8_LDA(dst, b, h) do { _Pragma("unroll") for (int m = 0; m < 4; ++m) _Pragma("unroll") for (int k = 0; k < 2; ++k) dst[m][k] = *(const LAS bf16x8*)(lds + PG8_SA(b, h) + aoff + m * 2048 + k * 1024); } while (0)
#define PG8_LDB(dst, b, h) do { _Pragma("unroll") for (int n = 0; n < 2; ++n) _Pragma("unroll") for (int k = 0; k < 2; ++k) dst[n][k] = *(const LAS bf16x8*)(lds + PG8_SB(b, h) + boff + n * 2048 + k * 1024); } while (0)
#define PG8_MMA(ai, bj, At, Bt) do { __builtin_amdgcn_s_setprio(1); _Pragma("unroll") for (int m = 0; m < 4; ++m) _Pragma("unroll") for (int n = 0; n < 2; ++n) _Pragma("unroll") for (int k = 0; k < 2; ++k) \
        acc[ai][bj][m][n] = __builtin_amdgcn_mfma_f32_16x16x32_bf16(Bt[n][k], At[m][k], acc[ai][bj][m][n], 0, 0, 0); __builtin_amdgcn_s_setprio(0); } while (0)
#define PG8_WAIT_V(n) asm volatile("s_waitcnt vmcnt(" #n ")" ::: "memory")
#define PG8_WAIT_L(n) asm volatile("s_waitcnt lgkmcnt(" #n ")" ::: "memory")
#define PG8_BAR __builtin_amdgcn_s_barrier()
#define PG8_SCHED __builtin_amdgcn_sched_barrier(0)
    Unit cur, nxt; int ui = 0;
    if (!S.next(0, cur)) return;
    f32x4 acc[2][2][4][2];
#pragma unroll
    for (int a = 0; a < 2; ++a)
#pragma unroll
        for (int b = 0; b < 2; ++b)
#pragma unroll
            for (int m = 0; m < 4; ++m)
#pragma unroll
                for (int n = 0; n < 2; ++n) acc[a][b][m][n] = (f32x4){0.f, 0.f, 0.f, 0.f};
    bf16x8 At[4][2], B0[2][2], B1[2][2];
    const char* cA = (const char*)g.A + (size_t)cur.seg * g.segA + (size_t)cur.pm * tstepA; const char* cB = (const char*)g.Bt + (size_t)cur.seg * g.segB + (size_t)cur.pn * tstepB;
    S.a_ready(cur);
    if constexpr (SP2) {
        PG8_STAGE(PG8_SB(0, 0), cB, voffB); PG8_STAGE(PG8_SB(0, 1), cB + hstepB, voffB); PG8_STAGE(PG8_SA(0, 0), cA, voffA); PG8_STAGE(PG8_SA(0, 1), cA + hstepA, voffA);
        if (wr == 1) PG8_BAR;
        PG8_WAIT_V(2); PG8_BAR;
        PG8_STAGE(PG8_SB(1, 0), cB + kstep, voffB); PG8_STAGE(PG8_SA(1, 0), cA + kstep, voffA); PG8_STAGE(PG8_SB(1, 1), cB + hstepB + kstep, voffB);
        PG8_WAIT_V(6); PG8_BAR;
    } else {
        PG8_STAGE(PG8_SB(0, 0), cB, voffB); PG8_STAGE(PG8_SA(0, 0), cA, voffA); PG8_STAGE(PG8_SB(0, 1), cB + hstepB, voffB); PG8_STAGE(PG8_SA(0, 1), cA + hstepA, voffA);
        if (wr == 1) PG8_BAR;
        PG8_WAIT_V(4); PG8_BAR;
        PG8_STAGE(PG8_SB(1, 0), cB + kstep, voffB); PG8_STAGE(PG8_SA(1, 0), cA + kstep, voffA); PG8_STAGE(PG8_SB(1, 1), cB + hstepB + kstep, voffB);
        PG8_WAIT_V(6); PG8_BAR;
    }
    for (;;) {
        const bool has_next = S.next(ui + 1, nxt);
        const char* nA = has_next ? (const char*)g.A + (size_t)nxt.seg * g.segA + (size_t)nxt.pm * tstepA : cA;
        const char* nB = has_next ? (const char*)g.Bt + (size_t)nxt.seg * g.segB + (size_t)nxt.pn * tstepB : cB;
        for (int t = 0; t < nt; t += 2) {
            const bool last = (t == nt - 2);
            const char* a1 = cA + (size_t)(t + 1) * kstep;
            const char* a2 = last ? nA : cA + (size_t)(t + 2) * kstep; const char* b2 = last ? nB : cB + (size_t)(t + 2) * kstep;
            const char* a3 = a2 + kstep; const char* b3 = b2 + kstep;
            if (last && has_next) S.a_ready(nxt);
            if constexpr (SP2) {
            PG8_LDB(B0, 0, 0); PG8_LDB(B1, 0, 1); PG8_SCHED; PG8_LDA(At, 0, 0); PG8_STAGE(PG8_SA(1, 1), a1 + hstepA, voffA);
            PG8_WAIT_V(8); PG8_WAIT_L(0); PG8_BAR; PG8_MMA(0, 0, At, B0); PG8_MMA(0, 1, At, B1); PG8_BAR; PG8_SCHED;
            PG8_LDA(At, 0, 1); PG8_STAGE(PG8_SB(0, 0), b2, voffB); PG8_STAGE(PG8_SB(0, 1), b2 + hstepB, voffB); PG8_STAGE(PG8_SA(0, 0), a2, voffA);
            PG8_WAIT_V(8); PG8_WAIT_L(0); PG8_BAR; PG8_MMA(1, 0, At, B0); PG8_MMA(1, 1, At, B1); PG8_BAR; PG8_SCHED;
            PG8_LDB(B0, 1, 0); PG8_LDB(B1, 1, 1); PG8_SCHED; PG8_LDA(At, 1, 0); PG8_STAGE(PG8_SA(0, 1), a2 + hstepA, voffA);
            PG8_WAIT_V(8); PG8_WAIT_L(0); PG8_BAR; PG8_MMA(0, 0, At, B0); PG8_MMA(0, 1, At, B1); PG8_BAR; PG8_SCHED;
            PG8_LDA(At, 1, 1); PG8_STAGE(PG8_SB(1, 0), b3, voffB); PG8_STAGE(PG8_SB(1, 1), b3 + hstepB, voffB); PG8_STAGE(PG8_SA(1, 0), a3, voffA);
            PG8_WAIT_V(8); PG8_WAIT_L(0); PG8_BAR; PG8_MMA(1, 0, At, B0); PG8_MMA(1, 1, At, B1); PG8_BAR; PG8_SCHED;
            } else {
            PG8_LDB(B0, 0, 0); PG8_SCHED; PG8_LDA(At, 0, 0); PG8_STAGE(PG8_SA(1, 1), a1 + hstepA, voffA);
            PG8_WAIT_L(8); PG8_BAR; PG8_WAIT_L(0); PG8_MMA(0, 0, At, B0); PG8_BAR; PG8_SCHED;
            PG8_LDB(B1, 0, 1); PG8_STAGE(PG8_SB(0, 0), b2, voffB);
            PG8_BAR; PG8_WAIT_L(0); PG8_MMA(0, 1, At, B1); PG8_BAR;
            PG8_LDA(At, 0, 1); PG8_STAGE(PG8_SA(0, 0), a2, voffA);
            PG8_BAR; PG8_WAIT_L(0); PG8_MMA(1, 0, At, B0); PG8_BAR; PG8_SCHED;
            PG8_STAGE(PG8_SB(0, 1), b2 + hstepB, voffB);
            PG8_WAIT_V(6); PG8_BAR; PG8_MMA(1, 1, At, B1); PG8_BAR;
            PG8_LDB(B0, 1, 0); PG8_SCHED; PG8_LDA(At, 1, 0); PG8_STAGE(PG8_SA(0, 1), a2 + hstepA, voffA);
            PG8_WAIT_L(8); PG8_BAR; PG8_WAIT_L(0); PG8_MMA(0, 0, At, B0); PG8_BAR; PG8_SCHED;
            PG8_LDB(B1, 1, 1); PG8_STAGE(PG8_SB(1, 0), b3, voffB);
            PG8_BAR; PG8_WAIT_L(0); PG8_MMA(0, 1, At, B1); PG8_BAR;
            PG8_LDA(At, 1, 1); PG8_STAGE(PG8_SA(1, 0), a3, voffA);
            PG8_BAR; PG8_WAIT_L(0); PG8_MMA(1, 0, At, B0); PG8_BAR; PG8_SCHED;
            PG8_STAGE(PG8_SB(1, 1), b3 + hstepB, voffB);
            PG8_WAIT_V(6); PG8_BAR; PG8_MMA(1, 1, At, B1); PG8_BAR;
            }
        }
        if constexpr (ALIGN_EPI) { if (wr == 0) PG8_BAR; }
        { int tz = threadIdx.x; asm volatile("" : "+v"(tz));
          const int l2 = tz & 63; E(acc, cur, wr, wc, l2 & 15, l2 >> 4, tz); }
        S.done(cur);
        if (!has_next) break;
#pragma unroll
        for (int a = 0; a < 2; ++a)
#pragma unroll
            for (int b = 0; b < 2; ++b)
#pragma unroll
                for (int m = 0; m < 4; ++m)
#pragma unroll
                    for (int n = 0; n < 2; ++n) acc[a][b][m][n] = (f32x4){0.f, 0.f, 0.f, 0.f};
        cur = nxt; cA = nA; cB = nB; ++ui;
        if constexpr (ALIGN_EPI) { if (wr == 1) PG8_BAR; }
    }
    PG8_WAIT_V(0);
    if constexpr (!ALIGN_EPI) { if (wr == 0) PG8_BAR; }
    PG8_BAR;
#undef PG8_SA
#undef PG8_SB
#undef PG8_STAGE
#undef PG8_LDA
#undef PG8_LDB
#undef PG8_MMA
#undef PG8_WAIT_V
#undef PG8_WAIT_L
#undef PG8_BAR
#undef PG8_SCHED
}

struct EpiProj {
    static constexpr bool PERM = true;
    bf16_t* O; float* small;
    __device__ __forceinline__ void operator()(const f32x4 (&acc)[2][2][4][2], const Unit& u, int wr, int wc, int fr, int fq, int tz) const {
        const int row0 = u.pm * BM + wr * 64 + fr, col0 = u.pn * BM + wc * 32 + 8 * fq;
#pragma unroll
        for (int ai = 0; ai < 2; ++ai)
#pragma unroll
            for (int m = 0; m < 4; ++m) { const int row = row0 + ai * HALF + m * 16; bf16_t* rowp = O + (size_t)row * NPP + col0;
#pragma unroll
                for (int bj = 0; bj < 2; ++bj) { const f32x4 v0 = acc[ai][bj][m][0], v1 = acc[ai][bj][m][1];
                    u32x4 w; w.x = cvt_pk_bf16(v0[0], v0[1]); w.y = cvt_pk_bf16(v0[2], v0[3]); w.z = cvt_pk_bf16(v1[0], v1[1]); w.w = cvt_pk_bf16(v1[2], v1[3]);
                    *(u32x4*)(rowp + bj * HALF) = w;
                    const int col = col0 + bj * HALF;
                    int si = -1; if (col == C_DA) si = 0; else if (col == C_DB) si = 8; else if (col == C_MDT) si = 16; else if (col == C_MDT + 8) si = 24;
                    if (si >= 0) { float* sp = small + (size_t)row * 32 + si; *(f32x4*)sp = v0; *(f32x4*)(sp + 4) = v1; } } }
    }
};
struct EpiGlu {
    static constexpr bool PERM = true;
    const bf16_t* Y; const float* bias; bf16_t* O;
    __device__ __forceinline__ void operator()(const f32x4 (&acc)[2][2][4][2], const Unit& u, int wr, int wc, int fr, int fq, int tz) const {
        const int row0 = u.pm * BM + wr * 64 + fr, col0 = u.pn * BM + wc * 32 + 8 * fq;
#pragma unroll
        for (int ai = 0; ai < 2; ++ai)
#pragma unroll
            for (int m = 0; m < 4; ++m) { const int row = row0 + ai * HALF + m * 16;
#pragma unroll
                for (int bj = 0; bj < 2; ++bj) { const int col = col0 + bj * HALF;
                    const f32x4 b0 = *(const f32x4*)(bias + col), b1 = *(const f32x4*)(bias + col + 4);
                    const u32x4 yw = *(const u32x4*)(Y + (size_t)row * 1024 + col);
                    const f32x4 v0 = acc[ai][bj][m][0] + b0, v1 = acc[ai][bj][m][1] + b1;
                    float o[8];
                    o[0] = bf_lo(yw.x) * sigmoidf_(v0[0]); o[1] = bf_hi(yw.x) * sigmoidf_(v0[1]); o[2] = bf_lo(yw.y) * sigmoidf_(v0[2]); o[3] = bf_hi(yw.y) * sigmoidf_(v0[3]);
                    o[4] = bf_lo(yw.z) * sigmoidf_(v1[0]); o[5] = bf_hi(yw.z) * sigmoidf_(v1[1]); o[6] = bf_lo(yw.w) * sigmoidf_(v1[2]); o[7] = bf_hi(yw.w) * sigmoidf_(v1[3]);
                    u32x4 w; w.x = cvt_pk_bf16(o[0], o[1]); w.y = cvt_pk_bf16(o[2], o[3]); w.z = cvt_pk_bf16(o[4], o[5]); w.w = cvt_pk_bf16(o[6], o[7]);
                    *(u32x4*)(O + (size_t)row * 4096 + 2048 + col) = w; asm volatile("" ::: "memory"); } }
    }
};
struct EpiMerge {
    static constexpr bool PERM = true;
    const bf16_t* proj; float* macc; bf16_t* O;
    __device__ __forceinline__ void operator()(const f32x4 (&acc)[2][2][4][2], const Unit& u, int wr, int wc, int fr, int fq, int tz) const {
        const int row0 = u.pm * BM + wr * 64 + fr, col0 = u.pn * BM + wc * 32 + 8 * fq;
        f32x4* sc = (f32x4*)(macc + (size_t)blockIdx.x * 65536) + tz;
#pragma unroll
        for (int ai = 0; ai < 2; ++ai)
#pragma unroll
            for (int m = 0; m < 4; ++m) { const int row = row0 + ai * HALF + m * 16;
#pragma unroll
                for (int bj = 0; bj < 2; ++bj) { const int col = col0 + bj * HALF;
                    const u32x4 gw = *(const u32x4*)(proj + (size_t)row * NPP + C_GATE + u.seg * 2048 + col);
                    f32x4 v0 = acc[ai][bj][m][0], v1 = acc[ai][bj][m][1];
                    v0[0] *= sigmoidf_(bf_lo(gw.x)); v0[1] *= sigmoidf_(bf_hi(gw.x)); v0[2] *= sigmoidf_(bf_lo(gw.y)); v0[3] *= sigmoidf_(bf_hi(gw.y));
                    v1[0] *= sigmoidf_(bf_lo(gw.z)); v1[1] *= sigmoidf_(bf_hi(gw.z)); v1[2] *= sigmoidf_(bf_lo(gw.w)); v1[3] *= sigmoidf_(bf_hi(gw.w));
                    const int idx = (((ai * 2 + bj) * 4 + m) * 2) * 512;
                    if (u.seg > 0) { v0 += sc[idx]; v1 += sc[idx + 512]; }
                    if (u.seg < 3) { sc[idx] = v0; sc[idx + 512] = v1; }
                    else { u32x4 w; w.x = cvt_pk_bf16(v0[0], v0[1]); w.y = cvt_pk_bf16(v0[2], v0[3]); w.z = cvt_pk_bf16(v1[0], v1[1]); w.w = cvt_pk_bf16(v1[2], v1[3]);
                        *(u32x4*)(O + (size_t)row * DM + col) = w; }
                    asm volatile("" ::: "memory"); } }
    }
};
struct EpiResid {
    static constexpr bool PERM = false;
    const float* xres; float* O;
    __device__ __forceinline__ void operator()(const f32x4 (&acc)[2][2][4][2], const Unit& u, int wr, int wc, int fr, int fq, int tz) const {
        const int row0 = u.pm * BM + wr * 64 + fr, col0 = u.pn * BM + wc * 32 + 4 * fq;
#pragma unroll
        for (int ai = 0; ai < 2; ++ai)
#pragma unroll
            for (int m = 0; m < 4; ++m) { const size_t ro = (size_t)(row0 + ai * HALF + m * 16) * DM + col0;
#pragma unroll
                for (int bj = 0; bj < 2; ++bj)
#pragma unroll
                    for (int n = 0; n < 2; ++n) { const f32x4 xr = *(const f32x4*)(xres + ro + bj * HALF + n * 16); *(f32x4*)(O + ro + bj * HALF + n * 16) = xr * ALPHA + acc[ai][bj][m][n]; } }
    }
};
struct EpiRelu2 {
    static constexpr bool PERM = true;
    bf16_t* O;
    __device__ __forceinline__ void operator()(const f32x4 (&acc)[2][2][4][2], const Unit& u, int wr, int wc, int fr, int fq, int tz) const {
        const int row0 = u.pm * BM + wr * 64 + fr, col0 = u.pn * BM + wc * 32 + 8 * fq;
#pragma unroll
        for (int ai = 0; ai < 2; ++ai)
#pragma unroll
            for (int m = 0; m < 4; ++m) { bf16_t* rowp = O + (size_t)(row0 + ai * HALF + m * 16) * DFF + col0;
#pragma unroll
                for (int bj = 0; bj < 2; ++bj) { f32x4 v0 = acc[ai][bj][m][0], v1 = acc[ai][bj][m][1];
#pragma unroll
                    for (int j = 0; j < 4; ++j) { const float a = fmaxf(v0[j], 0.f), b = fmaxf(v1[j], 0.f); v0[j] = a * a; v1[j] = b * b; }
                    u32x4 w; w.x = cvt_pk_bf16(v0[0], v0[1]); w.y = cvt_pk_bf16(v0[2], v0[3]); w.z = cvt_pk_bf16(v1[0], v1[1]); w.w = cvt_pk_bf16(v1[2], v1[3]);
                    *(u32x4*)(rowp + bj * HALF) = w; } }
    }
};
}

#define XB_TMO      128
#define XB_XCNT(j)  (256  + 64 * (j))
#define XB_XSUB(j)  (1280 + 64 * (j))
#define XB_XGEN(j)  (2304 + 64 * (j))
#define XB_TOP      3328
#define XB_TOPGEN   3392
#define XCD_BAR_WORDS 3456
#define XB_SPIN_CAP (1u << 18)
__device__ __forceinline__ unsigned xb_ld(unsigned* p)              { return __hip_atomic_load(p, __ATOMIC_RELAXED, __HIP_MEMORY_SCOPE_AGENT); }
__device__ __forceinline__ unsigned xb_add(unsigned* p, unsigned v) { return __hip_atomic_fetch_add(p, v, __ATOMIC_RELAXED, __HIP_MEMORY_SCOPE_AGENT); }
__device__ __forceinline__ unsigned xb_xcc_id() { return (unsigned)__builtin_amdgcn_s_getreg((3 << 11) | 20) & 0xFu; }
#define XB_SPIN(cond, bar) do { unsigned _sp = 0; while (cond) { __builtin_amdgcn_s_sleep(1); \
    if ((++_sp & 255u) == 0u) { if (xb_ld(&(bar)[XB_TMO])) break; if (_sp > XB_SPIN_CAP) { atomicAdd(&(bar)[XB_TMO], 1u); break; } } } } while (0)
struct XcdBarrier { unsigned* bar; unsigned x; volatile LAS unsigned* st; };
__device__ __forceinline__ XcdBarrier xcd_barrier_post(unsigned* bar, volatile LAS unsigned* st) {
    XcdBarrier b; b.bar = bar; b.x = xb_xcc_id(); b.st = st;
    if (threadIdx.x == 0) (void)xb_add(&bar[XB_XCNT(b.x)], 1u);
    return b;
}
__device__ __forceinline__ void xcd_barrier_complete(unsigned* bar, unsigned x, unsigned& nloc, unsigned& nx) {
    const unsigned G = gridDim.x * gridDim.y * gridDim.z;
    unsigned sum, cnt, mine, sp = 0u;
    for (;;) {
        sum = 0u; cnt = 0u; mine = 0u;
#pragma unroll
        for (unsigned j = 0; j < 16; ++j) { const unsigned c = xb_ld(&bar[XB_XCNT(j)]); sum += c; cnt += (c > 0u) ? 1u : 0u; mine = (j == x) ? c : mine; }
        if (sum == G) break;
        __builtin_amdgcn_s_sleep(1);
        if ((++sp & 255u) == 0u) { if (xb_ld(&bar[XB_TMO])) break; if (sp > XB_SPIN_CAP) { atomicAdd(&bar[XB_TMO], 1u); break; } }
    }
    nloc = mine > 0u ? mine : 1u; nx = cnt > 0u ? cnt : 1u;
}
__device__ __forceinline__ void xcd_barrier(const XcdBarrier& b) {
    asm volatile("s_waitcnt vmcnt(0)" ::: "memory");
    __syncthreads();
    if (threadIdx.x == 0) {
        unsigned* bar = b.bar;
        __builtin_amdgcn_s_waitcnt(0);
        unsigned nloc = b.st[0], nx = b.st[1];
        if (nloc == 0u) { xcd_barrier_complete(bar, b.x, nloc, nx); b.st[0] = nloc; b.st[1] = nx; }
        const unsigned old = xb_add(&bar[XB_XSUB(b.x)], 1u);
        const unsigned gen = old / nloc;
        if (old + 1u == (gen + 1u) * nloc) {
            __builtin_amdgcn_fence(__ATOMIC_RELEASE, "agent");
            asm volatile("s_waitcnt vmcnt(0)" ::: "memory");
            const unsigned og = xb_add(&bar[XB_TOP], 1u);
            const unsigned tg = og / nx;
            if (og + 1u == (tg + 1u) * nx) xb_add(&bar[XB_TOPGEN], 1u);
            else XB_SPIN(xb_ld(&bar[XB_TOPGEN]) == tg, bar);
            __builtin_amdgcn_fence(__ATOMIC_ACQUIRE, "agent");
            xb_add(&bar[XB_XGEN(b.x)], 1u);
            asm volatile("s_waitcnt vmcnt(0)" ::: "memory");
        } else {
            XB_SPIN(xb_ld(&bar[XB_XGEN(b.x)]) == gen, bar);
            __builtin_amdgcn_fence(__ATOMIC_ACQUIRE, "agent");
            asm volatile("s_waitcnt vmcnt(0)" ::: "memory");
        }
    }
    __syncthreads();
}

struct Args { const void* in[34]; float* out; unsigned char* ws; int ph_lo, ph_hi, li, pad; };
struct Frame {
    LAS unsigned char* lds;
    int tid, lane, wave, vcu, G;
    const void* const* in;
    unsigned char* ws;
    float* out;
};
__device__ __forceinline__ int opaque_tid() { int tz = threadIdx.x; asm volatile("" : "+v"(tz)); return tz; }
#define FIN(i) ((const float*)F.in[i])
#define WSP(type, off) ((type*)(F.ws + (off)))

__device__ __forceinline__ void p0_transpose_item(const float* W, int K, int N, bf16_t* WT, LAS float* scr, int item, int lane) {
    const int nblk = N / 32, kb = item / nblk, nb = item % nblk, k0 = 64 * kb, n0 = 32 * nb;
#pragma unroll 8
    for (int i = 0; i < 32; ++i) { const int kk = 2 * i + (lane >> 5); scr[kk * 33 + (lane & 31)] = W[(size_t)(k0 + kk) * N + n0 + (lane & 31)]; }
    asm volatile("s_waitcnt lgkmcnt(0)" ::: "memory");
    const int c = lane & 7;
#pragma unroll
    for (int j = 0; j < 4; ++j) { const int n = (lane >> 3) + 8 * j; const LAS float* s = scr + (8 * c) * 33 + n;
        u32x4 o; o.x = pk2(s[0 * 33], s[1 * 33]); o.y = pk2(s[2 * 33], s[3 * 33]); o.z = pk2(s[4 * 33], s[5 * 33]); o.w = pk2(s[6 * 33], s[7 * 33]);
        *(u32x4*)(WT + (size_t)(n0 + n) * K + k0 + 8 * c) = o; }
    asm volatile("s_waitcnt lgkmcnt(0)" ::: "memory");
}
__device__ __forceinline__ void p0_prologue(Frame& F) {
    LAS float* scr = (LAS float*)(F.lds + F.wave * 16384);
    const int gw = F.vcu * 8 + F.wave, NGW = F.G * 8; F.tid = opaque_tid(); F.lane = F.tid & 63;
    constexpr int I_IN = (DM / 64) * (NPROJ / 32), I_GLU = (1024 / 64) * (1024 / 32), I_BR = (1024 / 64) * (DM / 32), I_OUT = (DM / 64) * (DM / 32),
                  I_UP = (DM / 64) * (DFF / 32), I_DOWN = (DFF / 64) * (DM / 32), I_LAYER = I_IN + I_GLU + 4 * I_BR + I_OUT + I_UP + I_DOWN;
    for (int it = gw; it < NLAYER * I_LAYER; it += NGW) {
        const int l = it / I_LAYER; int r = it - l * I_LAYER;
        unsigned char* wt = F.ws + WS_WT + (size_t)l * WT_LAYER;
        if (r < I_IN) { p0_transpose_item(FIN(2) + (size_t)l * DM * NPROJ, DM, NPROJ, (bf16_t*)(wt + WT_IN), scr, r, F.lane); continue; } r -= I_IN;
        if (r < I_GLU) { p0_transpose_item(FIN(15) + (size_t)l * 1024 * 1024, 1024, 1024, (bf16_t*)(wt + WT_GLU), scr, r, F.lane); continue; } r -= I_GLU;
        if (r < I_BR) { p0_transpose_item(FIN(23) + (size_t)l * 1024 * DM, 1024, DM, (bf16_t*)(wt + WT_BR), scr, r, F.lane); continue; } r -= I_BR;
        if (r < I_BR) { p0_transpose_item(FIN(24) + (size_t)l * 1024 * DM, 1024, DM, (bf16_t*)(wt + WT_BR + 4 * MiB), scr, r, F.lane); continue; } r -= I_BR;
        if (r < I_BR) { p0_transpose_item(FIN(25) + (size_t)l * 1024 * DM, 1024, DM, (bf16_t*)(wt + WT_BR + 8 * MiB), scr, r, F.lane); continue; } r -= I_BR;
        if (r < I_BR) { p0_transpose_item(FIN(26) + (size_t)l * 1024 * DM, 1024, DM, (bf16_t*)(wt + WT_BR + 12 * MiB), scr, r, F.lane); continue; } r -= I_BR;
        if (r < I_OUT) { p0_transpose_item(FIN(27) + (size_t)l * DM * DM, DM, DM, (bf16_t*)(wt + WT_OUT), scr, r, F.lane); continue; } r -= I_OUT;
        if (r < I_UP) { p0_transpose_item(FIN(30) + (size_t)l * DM * DFF, DM, DFF, (bf16_t*)(wt + WT_UP), scr, r, F.lane); continue; } r -= I_UP;
        p0_transpose_item(FIN(31) + (size_t)l * DFF * DM, DFF, DM, (bf16_t*)(wt + WT_DOWN), scr, r, F.lane);
    }
    const int gt = F.vcu * 512 + F.tid, NGT = F.G * 512;
    for (int i = gt; i < NLAYER * (NPP - NPROJ) * DM / 8; i += NGT) { const int l = i / ((NPP - NPROJ) * DM / 8), r = i % ((NPP - NPROJ) * DM / 8);
        *(u32x4*)(F.ws + WS_WT + (size_t)l * WT_LAYER + WT_IN + (size_t)NPROJ * DM * 2 + (size_t)r * 16) = (u32x4){0u, 0u, 0u, 0u}; }
    { const int* pos = (const int*)F.in[1]; float* trig = WSP(float, WS_TRIG);
      for (int i = gt; i < T * 64; i += NGT) { const int t = i >> 6, j = i & 63;
          const double inv = exp2(-(double)j * (13.287712379549449 / 64.0));
          double s, c; sincos_d((double)pos[t] * inv, s, c);
          trig[(size_t)t * 128 + j] = (float)c; trig[(size_t)t * 128 + 64 + j] = (float)s; } }
    { const float* x = FIN(0); bf16_t* xb = WSP(bf16_t, WS_XB);
      for (int i = gt; i < T * DM / 4; i += NGT) { const f32x4 v = *(const f32x4*)(x + (size_t)i * 4); u32x2 w; w.x = pk2(v[0], v[1]); w.y = pk2(v[2], v[3]); *(u32x2*)(xb + (size_t)i * 4) = w; } }
    for (int i = gt; i < NLAYER * 4096; i += NGT) { const int l = i >> 12, gn = i & 4095, g = gn >> 6;
        const double lre = (double)FIN(7)[(size_t)l * 4096 + gn], lim = (double)FIN(8)[(size_t)l * 4096 + gn], step = exp((double)FIN(9)[l * 64 + g]);
        const double mag = exp(lre * step); double sn, cs; sincos_d(lim * step, sn, cs);
        const double are = mag * cs, aim = mag * sn, den = lre * lre + lim * lim;
        const double fre = ((are - 1.0) * lre + aim * lim) / den, fim = (aim * lre - (are - 1.0) * lim) / den;
        float* sp = (float*)(F.ws + WS_S5P + (size_t)l * MiB);
        sp[gn * 2] = (float)are; sp[gn * 2 + 1] = (float)aim;
        const float* bre = FIN(10) + ((size_t)l * 4096 + gn) * 16; const float* bim = FIN(11) + ((size_t)l * 4096 + gn) * 16;
        float* obre = sp + 16384 + (size_t)gn * 16; float* obim = sp + 16384 + 65536 + (size_t)gn * 16;
#pragma unroll
        for (int c = 0; c < 16; ++c) { const double br = bre[c], bi = bim[c]; obre[c] = (float)(fre * br - fim * bi); obim[c] = (float)(fre * bi + fim * br); } }
}

__device__ __forceinline__ float conv4(const bf16_t* proj, int t, int col, const f32x4 w) {
    float s = 0.f;
#pragma unroll
    for (int k = 0; k < 4; ++k) { const int tt = t - 3 + k; if (tt >= 0) s += w[k] * bf2f(proj[(size_t)tt * NPP + col]); }
    return s;
}
__device__ __forceinline__ void prep_phase(Frame& F, int layer) {
    const int gw = F.vcu * 8 + F.wave, NGW = F.G * 8, lane = opaque_tid() & 63;
    const bf16_t* proj = WSP(bf16_t, WS_PROJ); const float* small = WSP(float, WS_SMALL); const float* trig = WSP(float, WS_TRIG);
    unsigned char* tm = F.ws + WS_TMP; float* sm = (float*)(tm + TM_SM);
    float* Kr = (float*)(tm + TM_KR); float* Qr = (float*)(tm + TM_QR); float* Vr = (float*)(tm + TM_VR);
    float* Ks = (float*)(tm + TM_KS); float* Qs = (float*)(tm + TM_QS); float* Vs = (float*)(tm + TM_VS);
    float* Kg = (float*)(tm + TM_KG); float* Qg = (float*)(tm + TM_QG); float* Vg = (float*)(tm + TM_VG);
    const float* gcw = FIN(3) + (size_t)layer * 3072 * 4; const float* galog = FIN(4) + layer * 8; const float* gdtb = FIN(5) + layer * 8;
    const float* scw = FIN(17) + (size_t)layer * 1536 * 4; const float* scb = FIN(18) + layer * 1536; const float* sdtb = FIN(19) + layer * 16; const float* salog = FIN(20) + layer * 16;
    for (int t = gw; t < T; t += NGW) {
        const bf16_t* pr = proj + (size_t)t * NPP;
        { const float cs = trig[(size_t)t * 128 + lane], sn = trig[(size_t)t * 128 + 64 + lane];
#pragma unroll
          for (int h = 0; h < 4; ++h) {
              const float q1 = bf2f(pr[C_RQ + h * 128 + lane]), q2 = bf2f(pr[C_RQ + h * 128 + 64 + lane]);
              const float k1 = bf2f(pr[C_RK + h * 128 + lane]) * 0.08838834764831845f, k2 = bf2f(pr[C_RK + h * 128 + 64 + lane]) * 0.08838834764831845f;
              const float qa = q1 * cs - q2 * sn, qb = q1 * sn + q2 * cs, ka = k1 * cs - k2 * sn, kb = k1 * sn + k2 * cs;
              float* qo = Qr + ((size_t)t * 4 + h) * 128; float* ko = Kr + ((size_t)t * 4 + h) * 128;
              qo[lane] = qa; qo[64 + lane] = qb; ko[lane] = ka; ko[64 + lane] = kb;
              const float kq = wave_sum(qa * ka + qb * kb);
              if (lane == 0) { sm[SM_KQR + t * 4 + h] = kq; sm[SM_DECR + t * 4 + h] = 1.0f - exp2f(-5.0f - (float)h); } }
#pragma unroll
          for (int j = 0; j < 4; ++j) { const u32x2 w = *(const u32x2*)(pr + C_RV + j * 256 + lane * 4);
              *(f32x4*)(Vr + (size_t)t * 1024 + j * 256 + lane * 4) = (f32x4){bf_lo(w.x), bf_hi(w.x), bf_lo(w.y), bf_hi(w.y)}; } }
        for (int h = 0; h < 8; ++h) {
            float v[3][2];
#pragma unroll
            for (int p = 0; p < 3; ++p)
#pragma unroll
                for (int e = 0; e < 2; ++e) { const int c = p * 1024 + h * 128 + 2 * lane + e; v[p][e] = siluf_(conv4(proj, t, C_DQ + c, *(const f32x4*)(gcw + (size_t)c * 4))); }
            const float sq = wave_sum(v[0][0] * v[0][0] + v[0][1] * v[0][1]), sk = wave_sum(v[1][0] * v[1][0] + v[1][1] * v[1][1]), qk = wave_sum(v[0][0] * v[1][0] + v[0][1] * v[1][1]);
            const float rq = rsqrtf(sq + RMS_EPS) * 0.08838834764831845f, rk = rsqrtf(sk + RMS_EPS);
            *(f32x2*)(Qg + ((size_t)t * 8 + h) * 128 + 2 * lane) = (f32x2){v[0][0] * rq, v[0][1] * rq};
            *(f32x2*)(Kg + ((size_t)t * 8 + h) * 128 + 2 * lane) = (f32x2){v[1][0] * rk, v[1][1] * rk};
            *(f32x2*)(Vg + (size_t)t * 1024 + h * 128 + 2 * lane) = (f32x2){v[2][0], v[2][1]};
            if (lane == 0) { const float g = -__expf(galog[h]) * softplusf_(small[(size_t)t * 32 + h] + gdtb[h]);
                sm[SM_DECG + t * 8 + h] = __expf(g); sm[SM_BETG + t * 8 + h] = sigmoidf_(small[(size_t)t * 32 + 8 + h]); sm[SM_KQG + t * 8 + h] = qk * rq * rk; }
        }
        { float dtv = 0.f;
          if (lane < 16) { dtv = softplusf_(small[(size_t)t * 32 + 16 + lane] + sdtb[lane]); sm[SM_DECS + t * 16 + lane] = __expf(-dtv * __expf(salog[lane])); }
          float bv[2][2];
          for (int j = 0; j < 12; ++j) {
              float v[2];
#pragma unroll
              for (int e = 0; e < 2; ++e) { const int c = j * 128 + 2 * lane + e; v[e] = siluf_(conv4(proj, t, C_MX + c, *(const f32x4*)(scw + (size_t)c * 4)) + scb[c]); }
              if (j < 8) { const float dt = __shfl(dtv, 2 * j + (lane >> 5)); *(f32x2*)(Vs + (size_t)t * 1024 + j * 128 + 2 * lane) = (f32x2){v[0] * dt, v[1] * dt}; }
              else if (j < 10) { *(f32x2*)(Ks + ((size_t)t * 2 + (j - 8)) * 128 + 2 * lane) = (f32x2){v[0], v[1]}; bv[j - 8][0] = v[0]; bv[j - 8][1] = v[1]; }
              else { *(f32x2*)(Qs + ((size_t)t * 2 + (j - 10)) * 128 + 2 * lane) = (f32x2){v[0], v[1]};
                  const float kq = wave_sum(v[0] * bv[j - 10][0] + v[1] * bv[j - 10][1]); if (lane == 0) sm[SM_KQS + t * 2 + (j - 10)] = kq; }
          } }
    }
}

template <bool DELTA>
__device__ __forceinline__ void recur_unit(Frame& F, const float* Kp, const float* Qp, float* Vp, const float* decp, const float* betp, const float* kqp, int HK, int H, int E, int kdiv, int u) {
    LAS float* Kb = (LAS float*)(F.lds); LAS float* Qb = (LAS float*)(F.lds + 32768); LAS float* Vb = (LAS float*)(F.lds + 65536);
    LAS float* Ob = (LAS float*)(F.lds + 69632); LAS float* Sb = (LAS float*)(F.lds + 73728);
    const int tid = opaque_tid(), lane = tid & 63, li = lane & 31, cidx = 2 * F.wave + (lane >> 5);
    const int col0 = 16 * u, h = col0 / E, hk = h / kdiv;
    f32x4 kreg[4], qreg[4], vreg = {0.f, 0.f, 0.f, 0.f}; float s0 = 0.f, s1 = 0.f, s2 = 0.f;
#define REC_LOAD(b) do { _Pragma("unroll") for (int j = 0; j < 4; ++j) { const int idx = tid + 512 * j, tok = idx >> 5, d4 = idx & 31; const size_t go = ((size_t)((b) * 64 + tok) * HK + hk) * 128 + 4 * d4; \
            kreg[j] = *(const f32x4*)(Kp + go); qreg[j] = *(const f32x4*)(Qp + go); } \
        if (tid < 256) vreg = *(const f32x4*)(Vp + (size_t)((b) * 64 + (tid >> 2)) * 1024 + col0 + 4 * (tid & 3)); \
        else if (tid < 320) { const int tok = (b) * 64 + tid - 256; s0 = decp[(size_t)tok * H + h]; s1 = DELTA ? betp[(size_t)tok * H + h] : 0.f; s2 = kqp[(size_t)tok * HK + hk]; } } while (0)
    REC_LOAD(0);
    float S0 = 0.f, S1 = 0.f, S2 = 0.f, S3 = 0.f;
    for (int b = 0; b < T / 64; ++b) {
        __syncthreads();
#pragma unroll
        for (int j = 0; j < 4; ++j) { const int idx = tid + 512 * j; *(LAS f32x4*)(Kb + idx * 4) = kreg[j]; *(LAS f32x4*)(Qb + idx * 4) = qreg[j]; }
        if (tid < 256) *(LAS f32x4*)(Vb + tid * 4) = vreg;
        else if (tid < 320) { Sb[(tid - 256) * 4] = s0; Sb[(tid - 256) * 4 + 1] = s1; Sb[(tid - 256) * 4 + 2] = s2; }
        __syncthreads();
        if (b + 1 < T / 64) REC_LOAD(b + 1);
#pragma unroll 4
        for (int t = 0; t < 64; ++t) {
            const f32x4 k4 = *(const LAS f32x4*)(Kb + t * 128 + 4 * li), q4 = *(const LAS f32x4*)(Qb + t * 128 + 4 * li);
            const float dc = Sb[t * 4], bt = Sb[t * 4 + 1], kq = Sb[t * 4 + 2], v = Vb[t * 16 + cidx];
            float pk = k4[0] * S0 + k4[1] * S1 + k4[2] * S2 + k4[3] * S3, pq = q4[0] * S0 + q4[1] * S1 + q4[2] * S2 + q4[3] * S3;
            pq = half_sum(pq);
            float val = v;
            if (DELTA) { pk = half_sum(pk); val = bt * (v - dc * pk); }
            const float o = dc * pq + kq * val;
            S0 = dc * S0 + k4[0] * val; S1 = dc * S1 + k4[1] * val; S2 = dc * S2 + k4[2] * val; S3 = dc * S3 + k4[3] * val;
            if (li == 0) Ob[t * 16 + cidx] = o;
        }
        __syncthreads();
        if (tid < 256) *(f32x4*)(Vp + (size_t)(b * 64 + (tid >> 2)) * 1024 + col0 + 4 * (tid & 3)) = *(const LAS f32x4*)(Ob + tid * 4);
    }
#undef REC_LOAD
    __syncthreads();
}

__device__ __forceinline__ float gelu_tanh_(float y) { const float z = 0.7978845608028654f * (y + 0.044715f * y * y * y); const float th = 1.f - 2.f / (1.f + __expf(2.f * z)); return 0.5f * y * (1.f + th); }
__device__ __forceinline__ void s5_unit(Frame& F, int layer, int g) {
    const int lane = opaque_tid() & 63, w = F.wave;
    LAS float* Ub = (LAS float*)(F.lds + w * 4096);
    LAS float* Xb = (LAS float*)(F.lds + 32768 + w * 8704);
    LAS float* Ew = (LAS float*)(F.lds + 32768 + 8 * 8704);
    const bf16_t* proj = WSP(bf16_t, WS_PROJ); bf16_t* ys = WSP(bf16_t, WS_YS5);
    const float* sp = (const float*)(F.ws + WS_S5P + (size_t)layer * MiB);
    const int gn = g * 64 + lane;
    const float ar = sp[gn * 2], ai = sp[gn * 2 + 1];
    float bbr[16], bbi[16];
#pragma unroll
    for (int c4 = 0; c4 < 4; ++c4) { const f32x4 a = *(const f32x4*)(sp + 16384 + (size_t)gn * 16 + c4 * 4), b = *(const f32x4*)(sp + 16384 + 65536 + (size_t)gn * 16 + c4 * 4);
#pragma unroll
        for (int j = 0; j < 4; ++j) { bbr[c4 * 4 + j] = a[j]; bbi[c4 * 4 + j] = b[j]; } }
    const int t0 = w * 1024;
#define S5_LOADU(blk) do { const u32x4* up = (const u32x4*)(proj + (size_t)(t0 + (blk) * 64 + lane) * NPP + C_SU + g * 16); const u32x4 u0 = up[0], u1 = up[1]; \
        LAS f32x4* ud = (LAS f32x4*)(Ub + lane * 16); \
        ud[0] = (f32x4){bf_lo(u0.x), bf_hi(u0.x), bf_lo(u0.y), bf_hi(u0.y)}; ud[1] = (f32x4){bf_lo(u0.z), bf_hi(u0.z), bf_lo(u0.w), bf_hi(u0.w)}; \
        ud[2] = (f32x4){bf_lo(u1.x), bf_hi(u1.x), bf_lo(u1.y), bf_hi(u1.y)}; ud[3] = (f32x4){bf_lo(u1.z), bf_hi(u1.z), bf_lo(u1.w), bf_hi(u1.w)}; \
        asm volatile("s_waitcnt lgkmcnt(0)" ::: "memory"); } while (0)
#define S5_STEP(i) do { const LAS f32x4* ur = (const LAS f32x4*)(Ub + (i) * 16); float br = 0.f, bi = 0.f; \
        _Pragma("unroll") for (int c4 = 0; c4 < 4; ++c4) { const f32x4 uv = ur[c4]; _Pragma("unroll") for (int j = 0; j < 4; ++j) { br += uv[j] * bbr[c4 * 4 + j]; bi += uv[j] * bbi[c4 * 4 + j]; } } \
        const float nr = ar * xr - ai * xi + br, ni = ar * xi + ai * xr + bi; xr = nr; xi = ni; } while (0)
    float xr = 0.f, xi = 0.f;
    for (int blk = 0; blk < 16; ++blk) { S5_LOADU(blk);
#pragma unroll 4
        for (int i = 0; i < 64; ++i) S5_STEP(i);
        asm volatile("s_waitcnt lgkmcnt(0)" ::: "memory"); }
    Ew[(w * 64 + lane) * 2] = xr; Ew[(w * 64 + lane) * 2 + 1] = xi;
    __syncthreads();
    { float pr = ar, pi = ai;
#pragma unroll
      for (int s = 0; s < 10; ++s) { const float nr = pr * pr - pi * pi, ni = 2.f * pr * pi; pr = nr; pi = ni; }
      xr = 0.f; xi = 0.f;
      for (int v = 0; v < w; ++v) { const float er = Ew[(v * 64 + lane) * 2], ei = Ew[(v * 64 + lane) * 2 + 1]; const float nr = pr * xr - pi * xi + er, ni = pr * xi + pi * xr + ei; xr = nr; xi = ni; } }
    float cB[32];
    { const float* cre = FIN(12) + ((size_t)layer * 64 + g) * 1024; const float* cim = FIN(13) + ((size_t)layer * 64 + g) * 1024; const int c = lane & 15, q = lane >> 4;
#pragma unroll
      for (int kk = 0; kk < 32; ++kk) { const int np = 4 * kk + q; cB[kk] = (kk < 16) ? cre[c * 64 + np] : -cim[c * 64 + np - 64]; } }
    const float dsk = FIN(14)[layer * 1024 + g * 16 + (lane & 15)];
    for (int blk = 0; blk < 16; ++blk) { S5_LOADU(blk);
        for (int sb = 0; sb < 4; ++sb) {
#pragma unroll 4
            for (int i = 0; i < 16; ++i) { S5_STEP(sb * 16 + i); Xb[i * 130 + lane] = xr; Xb[i * 130 + 64 + lane] = xi; }
            asm volatile("s_waitcnt lgkmcnt(0)" ::: "memory");
            f32x4 acc = {0.f, 0.f, 0.f, 0.f};
#pragma unroll
            for (int kk = 0; kk < 32; ++kk) { const float a = Xb[(lane & 15) * 130 + 4 * kk + (lane >> 4)]; acc = __builtin_amdgcn_mfma_f32_16x16x4f32(a, cB[kk], acc, 0, 0, 0); }
#pragma unroll
            for (int r = 0; r < 4; ++r) { const int tl = sb * 16 + 4 * (lane >> 4) + r; const float y = acc[r] + dsk * Ub[tl * 16 + (lane & 15)];
                ys[(size_t)(t0 + blk * 64 + tl) * 1024 + g * 16 + (lane & 15)] = (bf16_t)f2bf(gelu_tanh_(y)); }
            asm volatile("s_waitcnt lgkmcnt(0)" ::: "memory");
        } }
#undef S5_LOADU
#undef S5_STEP
    __syncthreads();
}

__device__ __forceinline__ void mixer_phase(Frame& F, int layer) {
    unsigned char* tm = F.ws + WS_TMP; float* sm = (float*)(tm + TM_SM);
    for (int u = F.vcu; u < 256; u += F.G) {
        const int role = u >> 6, uu = u & 63;
        if (role == 0) recur_unit<false>(F, (const float*)(tm + TM_KR), (const float*)(tm + TM_QR), (float*)(tm + TM_VR), sm + SM_DECR, nullptr, sm + SM_KQR, 4, 4, 256, 1, uu);
        else if (role == 1) recur_unit<false>(F, (const float*)(tm + TM_KS), (const float*)(tm + TM_QS), (float*)(tm + TM_VS), sm + SM_DECS, nullptr, sm + SM_KQS, 2, 16, 64, 8, uu);
        else if (role == 2) recur_unit<true>(F, (const float*)(tm + TM_KG), (const float*)(tm + TM_QG), (float*)(tm + TM_VG), sm + SM_DECG, sm + SM_BETG, sm + SM_KQG, 8, 8, 128, 1, uu);
        else s5_unit(F, layer, uu);
    }
}

__device__ __forceinline__ void post_phase(Frame& F, int layer) {
    const int gw = F.vcu * 8 + F.wave, NGW = F.G * 8, lane = opaque_tid() & 63;
    const bf16_t* proj = WSP(bf16_t, WS_PROJ); bf16_t* ycat = WSP(bf16_t, WS_YCAT);
    unsigned char* tm = F.ws + WS_TMP;
    const float* Or = (const float*)(tm + TM_VR); const float* Os = (const float*)(tm + TM_VS); const float* Og = (const float*)(tm + TM_VG);
    const float* gnw = FIN(6) + layer * 128; const float* scw = FIN(17) + (size_t)layer * 1536 * 4; const float* scb = FIN(18) + layer * 1536;
    const float* sdk = FIN(21) + layer * 16; const float* snw = FIN(22) + layer * 1024;
    for (int t = gw; t < T; t += NGW) {
        const bf16_t* pr = proj + (size_t)t * NPP; bf16_t* yo = ycat + (size_t)t * 4096;
#pragma unroll
        for (int h = 0; h < 4; ++h) { f32x4 y = *(const f32x4*)(Or + (size_t)t * 1024 + h * 256 + 4 * lane);
            const float mu = wave_sum((y[0] + y[1]) + (y[2] + y[3])) * (1.f / 256.f); y = y - mu;
            const float rs = rsqrtf(wave_sum((y[0] * y[0] + y[1] * y[1]) + (y[2] * y[2] + y[3] * y[3])) * (1.f / 256.f) + LN_EPS);
            const u32x2 gw2 = *(const u32x2*)(pr + C_RG + h * 256 + 4 * lane);
            u32x2 o; o.x = pk2(y[0] * rs * siluf_(bf_lo(gw2.x)), y[1] * rs * siluf_(bf_hi(gw2.x))); o.y = pk2(y[2] * rs * siluf_(bf_lo(gw2.y)), y[3] * rs * siluf_(bf_hi(gw2.y)));
            *(u32x2*)(yo + h * 256 + 4 * lane) = o; }
#pragma unroll
        for (int h = 0; h < 8; ++h) { const f32x2 o = *(const f32x2*)(Og + (size_t)t * 1024 + h * 128 + 2 * lane);
            const float rs = rsqrtf(wave_sum(o[0] * o[0] + o[1] * o[1]) * (1.f / 128.f) + RMS_EPS);
            const unsigned zw = *(const unsigned*)(pr + C_DZ + h * 128 + 2 * lane); const f32x2 nw = *(const f32x2*)(gnw + 2 * lane);
            *(unsigned*)(yo + 1024 + h * 128 + 2 * lane) = pk2(o[0] * rs * nw[0] * siluf_(bf_lo(zw)), o[1] * rs * nw[1] * siluf_(bf_hi(zw))); }
        { float y[8][2]; float ss0 = 0.f, ss1 = 0.f;
#pragma unroll
          for (int j = 0; j < 8; ++j) { const f32x2 o = *(const f32x2*)(Os + (size_t)t * 1024 + j * 128 + 2 * lane); const float d = sdk[2 * j + (lane >> 5)];
              const unsigned zw = *(const unsigned*)(pr + C_MZ + j * 128 + 2 * lane);
#pragma unroll
              for (int e = 0; e < 2; ++e) { const int c = j * 128 + 2 * lane + e; const float xh = siluf_(conv4(proj, t, C_MX + c, *(const f32x4*)(scw + (size_t)c * 4)) + scb[c]);
                  y[j][e] = (o[e] + d * xh) * siluf_(e ? bf_hi(zw) : bf_lo(zw)); }
              const float s2 = y[j][0] * y[j][0] + y[j][1] * y[j][1]; if (j < 4) ss0 += s2; else ss1 += s2; }
          const float r0 = rsqrtf(wave_sum(ss0) * (1.f / 512.f) + RMS_EPS), r1 = rsqrtf(wave_sum(ss1) * (1.f / 512.f) + RMS_EPS);
#pragma unroll
          for (int j = 0; j < 8; ++j) { const float rs = j < 4 ? r0 : r1; const f32x2 nw = *(const f32x2*)(snw + j * 128 + 2 * lane);
              *(unsigned*)(yo + 3072 + j * 128 + 2 * lane) = pk2(y[j][0] * rs * nw[0], y[j][1] * rs * nw[1]); } }
    }
}

__device__ __forceinline__ void ln_phase(Frame& F, const float* in, const float* gam, const float* bet, float* outf, bf16_t* outb) {
    const int gw = F.vcu * 8 + F.wave, NGW = F.G * 8, lane = opaque_tid() & 63;
    for (int t = gw; t < T; t += NGW) {
        const f32x4* xr = (const f32x4*)(in + (size_t)t * DM) + lane;
        f32x4 v[8]; float s = 0.f;
#pragma unroll
        for (int j = 0; j < 8; ++j) { v[j] = xr[64 * j]; s += (v[j][0] + v[j][1]) + (v[j][2] + v[j][3]); }
        const float mean = wave_sum(s) * (1.f / DM); float s2 = 0.f;
#pragma unroll
        for (int j = 0; j < 8; ++j) { v[j] = v[j] - mean; s2 += (v[j][0] * v[j][0] + v[j][1] * v[j][1]) + (v[j][2] * v[j][2] + v[j][3] * v[j][3]); }
        const float rstd = rsqrtf(wave_sum(s2) * (1.f / DM) + LN_EPS);
#pragma unroll
        for (int j = 0; j < 8; ++j) { const f32x4 gm = *((const f32x4*)gam + lane + 64 * j), bt = *((const f32x4*)bet + lane + 64 * j);
            const f32x4 o = v[j] * rstd * gm + bt;
            *((f32x4*)(outf + (size_t)t * DM) + lane + 64 * j) = o;
            u32x2 w; w.x = pk2(o[0], o[1]); w.y = pk2(o[2], o[3]); *((u32x2*)(outb + (size_t)t * DM) + lane + 64 * j) = w; }
    }
}

constexpr int N_PHASES = 1 + 10 * NLAYER;
__global__ void __launch_bounds__(512, 2) mega(Args args) {
    extern __shared__ __attribute__((aligned(16))) unsigned char lds_raw[];
    Frame F;
    F.lds = (LAS unsigned char*)lds_raw;
    F.tid = threadIdx.x; F.lane = F.tid & 63; F.wave = __builtin_amdgcn_readfirstlane(F.tid >> 6);
    F.G = gridDim.x; { const int bx = blockIdx.x; F.vcu = (F.G % 8 == 0) ? (bx % 8) * (F.G / 8) + bx / 8 : bx; }
    F.in = args.in; F.ws = args.ws; F.out = args.out;
    for (int u = F.tid; u < (LDS_BYTES - LDSCTL_OFF) / 4; u += 512) ((LAS unsigned*)(F.lds + LDSCTL_OFF))[u] = 0u;
    __syncthreads();
    const int lo = args.ph_lo, hi = args.ph_hi;
    unsigned* barw = (unsigned*)(args.ws + WS_CTL) + CW_BAR + args.li * XCD_BAR_WORDS;
    XcdBarrier bar; bar.bar = barw; bar.x = 0; bar.st = nullptr;
    if (hi - lo > 1) bar = xcd_barrier_post(barw, (volatile LAS unsigned*)(F.lds + MISC_OFF) + 8);
#define IN(k) (lo <= (k) && (k) < hi)
#define SEAM(k) do { if ((k) + 1 < hi) xcd_barrier(bar); } while (0)

    if (IN(0)) { p0_prologue(F); SEAM(0); }

    for (int layer = 0; layer < NLAYER; ++layer) {
        const int pb = 1 + 10 * layer;
        unsigned char* wt = F.ws + WS_WT + (size_t)layer * WT_LAYER;
        const float* xcur = layer == 0 ? FIN(0) : WSP(float, WS_XR0);
        if (IN(pb + 0)) {
            pg8::Gemm g{WSP(bf16_t, WS_XB), (const bf16_t*)(wt + WT_IN), T, NPP, DM, DM, DM, 0, 0}; pg8::StaticOrder S; S.init(T, NPP, F.G, (int)blockIdx.x);
            pg8::EpiProj E{WSP(bf16_t, WS_PROJ), WSP(float, WS_SMALL)};
            pg8::gemm_phase<pg8::EpiProj, pg8::StaticOrder, true, true>(F.lds, g, S, E);
            SEAM(pb + 0);
        }
        if (IN(pb + 1)) { prep_phase(F, layer); SEAM(pb + 1); }
        if (IN(pb + 2)) { mixer_phase(F, layer); SEAM(pb + 2); }
        if (IN(pb + 3)) {
            pg8::Gemm g{WSP(bf16_t, WS_YS5), (const bf16_t*)(wt + WT_GLU), T, 1024, 1024, 1024, 1024, 0, 0}; pg8::StaticOrder S; S.init(T, 1024, F.G, (int)blockIdx.x);
            pg8::EpiGlu E{WSP(bf16_t, WS_YS5), FIN(16) + layer * 1024, WSP(bf16_t, WS_YCAT)};
            pg8::gemm_phase<pg8::EpiGlu, pg8::StaticOrder, true, true>(F.lds, g, S, E);
            post_phase(F, layer);
            SEAM(pb + 3);
        }
        if (IN(pb + 4)) {
            pg8::Gemm g{WSP(bf16_t, WS_YCAT), (const bf16_t*)(wt + WT_BR), T, DM, 1024, 4096, 1024, 2048, 4 * MiB}; pg8::SegOrder<4> S; S.init(T, DM, F.G, (int)blockIdx.x);
            pg8::EpiMerge E{WSP(bf16_t, WS_PROJ), (float*)(F.ws + WS_TMP + TM_PRE), (bf16_t*)(F.ws + WS_TMP + TM_MERGED)};
            pg8::gemm_phase<pg8::EpiMerge, pg8::SegOrder<4>, true, true>(F.lds, g, S, E);
            SEAM(pb + 4);
        }
        if (IN(pb + 5)) {
            pg8::Gemm g{(const bf16_t*)(F.ws + WS_TMP + TM_MERGED), (const bf16_t*)(wt + WT_OUT), T, DM, DM, DM, DM, 0, 0}; pg8::StaticOrder S; S.init(T, DM, F.G, (int)blockIdx.x);
            pg8::EpiResid E{xcur, (float*)(F.ws + WS_TMP + TM_PRE)};
            pg8::gemm_phase<pg8::EpiResid, pg8::StaticOrder, true, true>(F.lds, g, S, E);
            SEAM(pb + 5);
        }
        if (IN(pb + 6)) { ln_phase(F, (const float*)(F.ws + WS_TMP + TM_PRE), FIN(28) + layer * DM, FIN(29) + layer * DM, WSP(float, WS_XR1), WSP(bf16_t, WS_XB)); SEAM(pb + 6); }
        if (IN(pb + 7)) {
            pg8::Gemm g{WSP(bf16_t, WS_XB), (const bf16_t*)(wt + WT_UP), T, DFF, DM, DM, DM, 0, 0}; pg8::StaticOrder S; S.init(T, DFF, F.G, (int)blockIdx.x);
            pg8::EpiRelu2 E{WSP(bf16_t, WS_HID)};
            pg8::gemm_phase<pg8::EpiRelu2, pg8::StaticOrder, true, true>(F.lds, g, S, E);
            SEAM(pb + 7);
        }
        if (IN(pb + 8)) {
            pg8::Gemm g{WSP(bf16_t, WS_HID), (const bf16_t*)(wt + WT_DOWN), T, DM, DFF, DFF, DFF, 0, 0}; pg8::StaticOrder S; S.init(T, DM, F.G, (int)blockIdx.x);
            pg8::EpiResid E{WSP(float, WS_XR1), (float*)(F.ws + WS_TMP + TM_PRE)};
            pg8::gemm_phase<pg8::EpiResid, pg8::StaticOrder, true, true>(F.lds, g, S, E);
            SEAM(pb + 8);
        }
        if (IN(pb + 9)) { ln_phase(F, (const float*)(F.ws + WS_TMP + TM_PRE), FIN(32) + layer * DM, FIN(33) + layer * DM, layer == NLAYER - 1 ? F.out : WSP(float, WS_XR0), WSP(bf16_t, WS_XB)); SEAM(pb + 9); }
    }
#undef IN
#undef SEAM
}

extern "C" void kernel_launch(void* const* d_in, const int* in_sizes, int n_in, void* d_out, int out_size, void* d_ws, size_t ws_size, hipStream_t stream) {
    static int grid = 0;
    if (grid == 0) {
        if (n_in != 34 || out_size != T * DM || ws_size < WS_END) { fprintf(stderr, "kernel_launch: unexpected sizes (n_in %d, out %d, ws %zu need %zu)\n", n_in, out_size, ws_size, (size_t)WS_END); grid = -1; return; }
        int dev = 0, cus = 0, per_cu = 0;
        if (hipGetDevice(&dev) != hipSuccess || hipDeviceGetAttribute(&cus, hipDeviceAttributeMultiprocessorCount, dev) != hipSuccess) { grid = -1; return; }
        if (hipFuncSetAttribute((const void*)mega, hipFuncAttributeMaxDynamicSharedMemorySize, LDS_BYTES) != hipSuccess) { fprintf(stderr, "kernel_launch: hipFuncSetAttribute failed\n"); grid = -1; return; }
        if (hipOccupancyMaxActiveBlocksPerMultiprocessor(&per_cu, (const void*)mega, 512, LDS_BYTES) != hipSuccess || per_cu < 1) fprintf(stderr, "kernel_launch: occupancy query reports %d\n", per_cu);
        (void)hipGetLastError();
        grid = cus;
    }
    if (grid < 0) return;
    if (hipMemsetAsync((char*)d_ws + WS_CTL, 0, CTL_ZERO_BYTES, stream) != hipSuccess) return;
    Args a{};
    for (int i = 0; i < 34; ++i) a.in[i] = d_in[i];
    a.out = (float*)d_out; a.ws = (unsigned char*)d_ws;
#if MK_N_LAUNCHES == 1
    a.ph_lo = 0; a.ph_hi = N_PHASES; a.li = 0;
    hipLaunchKernelGGL(mega, dim3(grid), dim3(512), LDS_BYTES, stream, a);
#else
    for (int p = 0; p < N_PHASES; ++p) { a.ph_lo = p; a.ph_hi = p + 1; a.li = p; hipLaunchKernelGGL(mega, dim3(grid), dim3(512), LDS_BYTES, stream, a); }
#endif
}
```

```cpp
#include <hip/hip_runtime.h>
#include <cstdio>
#include <cstdint>

#ifndef MK_N_LAUNCHES
#define MK_N_LAUNCHES 1
#endif

#ifndef REPMASK
#define REPMASK 0
#endif
#define LAS __attribute__((address_space(3)))
#define GAS __attribute__((address_space(1)))
typedef unsigned short bf16_t;
typedef short bf16x8 __attribute__((ext_vector_type(8)));
typedef float f32x4 __attribute__((ext_vector_type(4)));
typedef float f32x2 __attribute__((ext_vector_type(2)));
typedef unsigned u32x4 __attribute__((ext_vector_type(4)));
typedef unsigned u32x2 __attribute__((ext_vector_type(2)));

constexpr int T = 8192, DM = 2048, NPROJ = 18976, NPP = 19200, DFF = 8192, NLAYER = 2;
constexpr int C_RQ = 0, C_RK = 512, C_RV = 1024, C_RG = 2048, C_DQ = 3072, C_DK = 4096, C_DV = 5120, C_DZ = 6144, C_DA = 7168, C_DB = 7176,
              C_SU = 7184, C_MZ = 8208, C_MX = 9232, C_MB = 10256, C_MC = 10512, C_MDT = 10768, C_GATE = 10784;
constexpr float LN_EPS = 1e-5f, RMS_EPS = 1e-6f, ALPHA = 1.41421356237f;

constexpr size_t MiB = 1u << 20;
constexpr size_t WS_CTL = 0, CTL_ZERO_BYTES = 1 * MiB;
constexpr size_t WT_IN = 0, WT_GLU = 75 * MiB, WT_BR = 77 * MiB, WT_OUT = 93 * MiB, WT_UP = 101 * MiB, WT_DOWN = 133 * MiB, WT_LAYER = 165 * MiB;
constexpr size_t WS_WT = 1 * MiB;
constexpr size_t WS_PROJ = WS_WT + 2 * WT_LAYER;
constexpr size_t WS_HID = WS_PROJ;
constexpr size_t WS_SMALL = WS_PROJ + 300 * MiB;
constexpr size_t WS_TRIG = WS_SMALL + 1 * MiB;
constexpr size_t WS_S5P = WS_TRIG + 4 * MiB;
constexpr size_t WS_YCAT = WS_S5P + 2 * MiB;
constexpr size_t WS_YS5 = WS_YCAT + 64 * MiB;
constexpr size_t WS_XB = WS_YS5 + 16 * MiB;
constexpr size_t WS_XR0 = WS_XB + 32 * MiB;
constexpr size_t WS_XR1 = WS_XR0 + 64 * MiB;
constexpr size_t WS_TMP = WS_XR1 + 64 * MiB;
constexpr size_t TM_KR = 0, TM_VR = 32 * MiB,
                 TM_SCB = 64 * MiB, TM_SSL = 72 * MiB, TM_SXD = 104 * MiB, TM_SXS = 120 * MiB, TM_SAC = 136 * MiB, TM_VS = 138 * MiB,
                 TM_KG = 170 * MiB, TM_VG = 242 * MiB, TM_SM = 274 * MiB, TM_END = 278 * MiB;
constexpr size_t TM_MERGED = 0, TM_PRE = 32 * MiB;
constexpr size_t WS_END = WS_TMP + TM_END;
constexpr int CW_BAR = 4096;

constexpr int RING_BYTES = 131072, LDSCTL_OFF = 155648, MISC_OFF = LDSCTL_OFF + 320, LDS_BYTES = 163840;

__device__ __forceinline__ unsigned f2bf(float f) { unsigned u = __builtin_bit_cast(unsigned, f); return (u + 0x7fffu + ((u >> 16) & 1u)) >> 16; }
__device__ __forceinline__ unsigned pk2(float lo, float hi) { return f2bf(lo) | (f2bf(hi) << 16); }
__device__ __forceinline__ float bf_lo(unsigned u) { return __builtin_bit_cast(float, u << 16); }
__device__ __forceinline__ float bf_hi(unsigned u) { return __builtin_bit_cast(float, u & 0xffff0000u); }
__device__ __forceinline__ float bf2f(bf16_t h) { return __builtin_bit_cast(float, (unsigned)h << 16); }
__device__ __forceinline__ float sigmoidf_(float x) { return 1.f / (1.f + __expf(-x)); }
__device__ __forceinline__ float siluf_(float x) { return x / (1.f + __expf(-x)); }
__device__ __forceinline__ float softplusf_(float x) { return x > 20.f ? x : log1pf(__expf(x)); }
__device__ __forceinline__ float wave_sum(float v) {
#pragma unroll
    for (int o = 1; o < 64; o <<= 1) v += __shfl_xor(v, o);
    return v;
}
__device__ __forceinline__ float half_sum(float v) {
#pragma unroll
    for (int o = 1; o < 32; o <<= 1) v += __shfl_xor(v, o);
    return v;
}
__device__ __forceinline__ void sincos_d(double x, double& s, double& c) {
    const double k = __builtin_rint(x * 0.63661977236758134308);
    double r = __builtin_fma(-k, 1.57079632679489655800e+00, x);
    r = __builtin_fma(-k, 6.12323399573676603587e-17, r);
    const double r2 = r * r;
    double sp = 1.58969099521155010221e-10;
    sp = __builtin_fma(sp, r2, -2.50507602534068634195e-08);
    sp = __builtin_fma(sp, r2, 2.75573137070700676789e-06);
    sp = __builtin_fma(sp, r2, -1.98412698298579493134e-04);
    sp = __builtin_fma(sp, r2, 8.33333333332248946124e-03);
    sp = __builtin_fma(sp, r2, -1.66666666666666324348e-01);
    const double sn = __builtin_fma(sp * r2, r, r);
    double cp = -1.13596475577881948265e-11;
    cp = __builtin_fma(cp, r2, 2.08757232129817482790e-09);
    cp = __builtin_fma(cp, r2, -2.75573143513906633035e-07);
    cp = __builtin_fma(cp, r2, 2.48015872894767294178e-05);
    cp = __builtin_fma(cp, r2, -1.38888888888741095749e-03);
    cp = __builtin_fma(cp, r2, 4.16666666666666019037e-02);
    const double cs = __builtin_fma(cp * r2, r2, __builtin_fma(-0.5, r2, 1.0));
    const long q = (long)k & 3;
    s = (q == 0) ? sn : (q == 1) ? cs : (q == 2) ? -sn : -cs;
    c = (q == 0) ? cs : (q == 1) ? -sn : (q == 2) ? -cs : sn;
}

namespace pg8 {
constexpr int BM = 256, BK = 64, HALF = 128, HTB = HALF * BK * 2, STAGE_BYTES = 8 * HTB, NXCD = 8, WGM = 8;
__host__ __device__ __forceinline__ int lds_byte(int r, int c) { const int st = (r >> 4) * 2 + (c >> 5), rr = r & 15, cc = c & 31, ob = rr * 64 + cc * 2; return st * 1024 + (ob ^ (((ob >> 9) & 1) << 5)); }
__host__ __device__ __forceinline__ void stage_rc(int b, int& R, int& C) { const int st = b / 1024, sb = b % 1024, swz = sb ^ (((sb >> 9) & 1) << 5); R = (st >> 1) * 16 + swz / 64; C = (st & 1) * 32 + (swz % 64) / 2; }
__host__ __device__ __forceinline__ int perm32(int rho) { const int n = rho >> 4, i = rho & 15; return 8 * (i >> 2) + 4 * n + (i & 3); }

struct Unit { int pm, pn, seg; };
struct Gemm { const bf16_t* A; const bf16_t* Bt; int M, N, K, lda, ldb; size_t segA, segB; };

__host__ __device__ __forceinline__ void tile_of(long L, int nM, int nN, int& pm, int& pn) {
    const int nwg = nM * nN; int wgid = (int)L;
    { const int q = nwg / NXCD, r = nwg % NXCD, xcd = wgid % NXCD, off = wgid / NXCD; wgid = (xcd < r ? xcd * (q + 1) : r * (q + 1) + (xcd - r) * q) + off; }
    const int nig = WGM * nN, gid = wgid / nig, fm = gid * WGM, gsz = (nM - fm) < WGM ? (nM - fm) : WGM;
    pm = fm + ((wgid % nig) % gsz); pn = (wgid % nig) / gsz;
}
struct StaticOrder {
    int nM, nN, nwg, G, c;
    __host__ __device__ void init(int M, int N, int G_, int c_) { nM = M / BM; nN = N / BM; nwg = nM * nN; G = G_; c = c_; }
    __host__ __device__ bool next(int i, Unit& u) const {
        const long L = (long)i * G + c; if (L >= nwg) return false;
        tile_of(L, nM, nN, u.pm, u.pn); u.seg = 0; return true;
    }
    __device__ __forceinline__ void a_ready(const Unit&) const {}
    __device__ __forceinline__ void done(const Unit&) const {}
};
template <int NSEG> struct SegOrder {
    int nM, nN, nwg, G, c;
    __host__ __device__ void init(int M, int N, int G_, int c_) { nM = M / BM; nN = N / BM; nwg = nM * nN; G = G_; c = c_; }
    __host__ __device__ bool next(int i, Unit& u) const {
        const long L = (long)(i / NSEG) * G + c; if (L >= nwg) return false;
        tile_of(L, nM, nN, u.pm, u.pn); u.seg = i % NSEG; return true;
    }
    __device__ __forceinline__ void a_ready(const Unit&) const {}
    __device__ __forceinline__ void done(const Unit&) const {}
};

__device__ __forceinline__ unsigned cvt_pk_bf16(float lo, float hi) { unsigned r; asm volatile("v_cvt_pk_bf16_f32 %0, %1, %2" : "=v"(r) : "v"(lo), "v"(hi)); return r; }


template <class Epi, class Sched, bool ALIGN_EPI = false, bool SP2 = false>
__device__ __forceinline__ void gemm_phase(LAS unsigned char* lds, const Gemm g, const Sched& S, const Epi& E) {
    int tid = threadIdx.x; asm volatile("" : "+v"(tid));
    const int wid = __builtin_amdgcn_readfirstlane(tid >> 6), lane = tid & 63, wr = wid >> 2, wc = wid & 3, fr = lane & 15, fq = lane >> 4;
    const int K = g.K, nt = K / BK;
    unsigned voffA[2], voffB[2];
#pragma unroll
    for (int i = 0; i < 2; ++i) { int R, C; stage_rc(tid * 16 + i * 8192, R, C); const int Rb = Epi::PERM ? ((R & ~31) + perm32(R & 31)) : R;
        voffA[i] = (unsigned)(R * g.lda + C) * 2u; voffB[i] = (unsigned)(Rb * g.ldb + C) * 2u; }
    const size_t kstep = (size_t)(BK * 2);
    const size_t hstepA = (size_t)HALF * g.lda * 2, hstepB = (size_t)HALF * g.ldb * 2;
    const size_t tstepA = 2 * hstepA, tstepB = 2 * hstepB;
    const unsigned ldsw = (unsigned)wid * 1024u;
    const int aoff = lds_byte(wr * 64 + fr, fq * 8), boff = lds_byte(wc * 32 + fr, fq * 8);
#define PG8_SA(b, h) (((b) * 2 + (h)) * HTB)
#define PG8_SB(b, h) ((4 + (b) * 2 + (h)) * HTB)
#define PG8_STAGE(bufoff, gbase, voff) do { _Pragma("unroll") for (int _i = 0; _i < 2; ++_i) \
        __builtin_amdgcn_global_load_lds((const unsigned*)((const char*)(gbase) + (voff)[_i]), (LAS unsigned*)(lds + (bufoff) + ldsw + _i * 8192), 16, 0, 0); } while (0)
#define PG8_LDA(dst, b, h) do { _Pragma("unroll") for (int m = 0; m < 4; ++m) _Pragma("unroll") for (int k = 0; k < 2; ++k) dst[m][k] = *(const LAS bf16x8*)(lds + PG8_SA(b, h) + aoff + m * 2048 + k * 1024); } while (0)
#define PG8_LDB(dst, b, h) do { _Pragma("unroll") for (int n = 0; n < 2; ++n) _Pragma("unroll") for (int k = 0; k < 2; ++k) dst[n][k] = *(const LAS bf16x8*)(lds + PG8_SB(b, h) + boff + n * 2048 + k * 1024); } while (0)
#define PG8_MMA(ai, bj, At, Bt) do { __builtin_amdgcn_s_setprio(1); _Pragma("unroll") for (int m = 0; m < 4; ++m) _Pragma("unroll") for (int n = 0; n < 2; ++n) _Pragma("unroll") for (int k = 0; k < 2; ++k) \
        acc[ai][bj][m][n] = __builtin_amdgcn_mfma_f32_16x16x32_bf16(Bt[n][k], At[m][k], acc[ai][bj][m][n], 0, 0, 0); __builtin_amdgcn_s_setprio(0); } while (0)
#define PG8_WAIT_V(n) asm volatile("s_waitcnt vmcnt(" #n ")" ::: "memory")
#define PG8_WAIT_L(n) asm volatile("s_waitcnt lgkmcnt(" #n ")" ::: "memory")
#define PG8_BAR __builtin_amdgcn_s_barrier()
#define PG8_SCHED __builtin_amdgcn_sched_barrier(0)
    Unit cur, nxt; int ui = 0;
    if (!S.next(0, cur)) return;
    f32x4 acc[2][2][4][2];
#pragma unroll
    for (int a = 0; a < 2; ++a)
#pragma unroll
        for (int b = 0; b < 2; ++b)
#pragma unroll
            for (int m = 0; m < 4; ++m)
#pragma unroll
                for (int n = 0; n < 2; ++n) acc[a][b][m][n] = (f32x4){0.f, 0.f, 0.f, 0.f};
    bf16x8 At[4][2], B0[2][2], B1[2][2];
    const char* cA = (const char*)g.A + (size_t)cur.seg * g.segA + (size_t)cur.pm * tstepA; const char* cB = (const char*)g.Bt + (size_t)cur.seg * g.segB + (size_t)cur.pn * tstepB;
    S.a_ready(cur);
    if constexpr (SP2) {
        PG8_STAGE(PG8_SB(0, 0), cB, voffB); PG8_STAGE(PG8_SB(0, 1), cB + hstepB, voffB); PG8_STAGE(PG8_SA(0, 0), cA, voffA); PG8_STAGE(PG8_SA(0, 1), cA + hstepA, voffA);
        if (wr == 1) PG8_BAR;
        PG8_WAIT_V(2); PG8_BAR;
        PG8_STAGE(PG8_SB(1, 0), cB + kstep, voffB); PG8_STAGE(PG8_SA(1, 0), cA + kstep, voffA); PG8_STAGE(PG8_SB(1, 1), cB + hstepB + kstep, voffB);
        PG8_WAIT_V(6); PG8_BAR;
    } else {
        PG8_STAGE(PG8_SB(0, 0), cB, voffB); PG8_STAGE(PG8_SA(0, 0), cA, voffA); PG8_STAGE(PG8_SB(0, 1), cB + hstepB, voffB); PG8_STAGE(PG8_SA(0, 1), cA + hstepA, voffA);
        if (wr == 1) PG8_BAR;
        PG8_WAIT_V(4); PG8_BAR;
        PG8_STAGE(PG8_SB(1, 0), cB + kstep, voffB); PG8_STAGE(PG8_SA(1, 0), cA + kstep, voffA); PG8_STAGE(PG8_SB(1, 1), cB + hstepB + kstep, voffB);
        PG8_WAIT_V(6); PG8_BAR;
    }
    for (;;) {
        const bool has_next = S.next(ui + 1, nxt);
        const char* nA = has_next ? (const char*)g.A + (size_t)nxt.seg * g.segA + (size_t)nxt.pm * tstepA : cA;
        const char* nB = has_next ? (const char*)g.Bt + (size_t)nxt.seg * g.segB + (size_t)nxt.pn * tstepB : cB;
        for (int t = 0; t < nt; t += 2) {
            const bool last = (t == nt - 2);
            const char* a1 = cA + (size_t)(t + 1) * kstep;
            const char* a2 = last ? nA : cA + (size_t)(t + 2) * kstep; const char* b2 = last ? nB : cB + (size_t)(t + 2) * kstep;
            const char* a3 = a2 + kstep; const char* b3 = b2 + kstep;
            if (last && has_next) S.a_ready(nxt);
            if constexpr (SP2) {
            PG8_LDB(B0, 0, 0); PG8_LDB(B1, 0, 1); PG8_SCHED; PG8_LDA(At, 0, 0); PG8_STAGE(PG8_SA(1, 1), a1 + hstepA, voffA);
            PG8_WAIT_V(8); PG8_WAIT_L(0); PG8_BAR; PG8_MMA(0, 0, At, B0); PG8_MMA(0, 1, At, B1); PG8_BAR; PG8_SCHED;
            PG8_LDA(At, 0, 1); PG8_STAGE(PG8_SB(0, 0), b2, voffB); PG8_STAGE(PG8_SB(0, 1), b2 + hstepB, voffB); PG8_STAGE(PG8_SA(0, 0), a2, voffA);
            PG8_WAIT_V(8); PG8_WAIT_L(0); PG8_BAR; PG8_MMA(1, 0, At, B0); PG8_MMA(1, 1, At, B1); PG8_BAR; PG8_SCHED;
            PG8_LDB(B0, 1, 0); PG8_LDB(B1, 1, 1); PG8_SCHED; PG8_LDA(At, 1, 0); PG8_STAGE(PG8_SA(0, 1), a2 + hstepA, voffA);
            PG8_WAIT_V(8); PG8_WAIT_L(0); PG8_BAR; PG8_MMA(0, 0, At, B0); PG8_MMA(0, 1, At, B1); PG8_BAR; PG8_SCHED;
            PG8_LDA(At, 1, 1); PG8_STAGE(PG8_SB(1, 0), b3, voffB); PG8_STAGE(PG8_SB(1, 1), b3 + hstepB, voffB); PG8_STAGE(PG8_SA(1, 0), a3, voffA);
            PG8_WAIT_V(8); PG8_WAIT_L(0); PG8_BAR; PG8_MMA(1, 0, At, B0); PG8_MMA(1, 1, At, B1); PG8_BAR; PG8_SCHED;
            } else {
            PG8_LDB(B0, 0, 0); PG8_SCHED; PG8_LDA(At, 0, 0); PG8_STAGE(PG8_SA(1, 1), a1 + hstepA, voffA);
            PG8_WAIT_L(8); PG8_BAR; PG8_WAIT_L(0); PG8_MMA(0, 0, At, B0); PG8_BAR; PG8_SCHED;
            PG8_LDB(B1, 0, 1); PG8_STAGE(PG8_SB(0, 0), b2, voffB);
            PG8_BAR; PG8_WAIT_L(0); PG8_MMA(0, 1, At, B1); PG8_BAR;
            PG8_LDA(At, 0, 1); PG8_STAGE(PG8_SA(0, 0), a2, voffA);
            PG8_BAR; PG8_WAIT_L(0); PG8_MMA(1, 0, At, B0); PG8_BAR; PG8_SCHED;
            PG8_STAGE(PG8_SB(0, 1), b2 + hstepB, voffB);
            PG8_WAIT_V(6); PG8_BAR; PG8_MMA(1, 1, At, B1); PG8_BAR;
            PG8_LDB(B0, 1, 0); PG8_SCHED; PG8_LDA(At, 1, 0); PG8_STAGE(PG8_SA(0, 1), a2 + hstepA, voffA);
            PG8_WAIT_L(8); PG8_BAR; PG8_WAIT_L(0); PG8_MMA(0, 0, At, B0); PG8_BAR; PG8_SCHED;
            PG8_LDB(B1, 1, 1); PG8_STAGE(PG8_SB(1, 0), b3, voffB);
            PG8_BAR; PG8_WAIT_L(0); PG8_MMA(0, 1, At, B1); PG8_BAR;
            PG8_LDA(At, 1, 1); PG8_STAGE(PG8_SA(1, 0), a3, voffA);
            PG8_BAR; PG8_WAIT_L(0); PG8_MMA(1, 0, At, B0); PG8_BAR; PG8_SCHED;
            PG8_STAGE(PG8_SB(1, 1), b3 + hstepB, voffB);
            PG8_WAIT_V(6); PG8_BAR; PG8_MMA(1, 1, At, B1); PG8_BAR;
            }
        }
        if constexpr (ALIGN_EPI) { if (wr == 0) PG8_BAR; }
        { int tz = threadIdx.x; asm volatile("" : "+v"(tz));
          const int l2 = tz & 63; E(acc, cur, wr, wc, l2 & 15, l2 >> 4, tz); }
        S.done(cur);
        if (!has_next) break;
#pragma unroll
        for (int a = 0; a < 2; ++a)
#pragma unroll
            for (int b = 0; b < 2; ++b)
#pragma unroll
                for (int m = 0; m < 4; ++m)
#pragma unroll
                    for (int n = 0; n < 2; ++n) acc[a][b][m][n] = (f32x4){0.f, 0.f, 0.f, 0.f};
        cur = nxt; cA = nA; cB = nB; ++ui;
        if constexpr (ALIGN_EPI) { if (wr == 1) PG8_BAR; }
    }
    PG8_WAIT_V(0);
    if constexpr (!ALIGN_EPI) { if (wr == 0) PG8_BAR; }
    PG8_BAR;
#undef PG8_SA
#undef PG8_SB
#undef PG8_STAGE
#undef PG8_LDA
#undef PG8_LDB
#undef PG8_MMA
#undef PG8_WAIT_V
#undef PG8_WAIT_L
#undef PG8_BAR
#undef PG8_SCHED
}

struct EpiProj {
    static constexpr bool PERM = true;
    bf16_t* O; float* small;
    __device__ __forceinline__ void operator()(const f32x4 (&acc)[2][2][4][2], const Unit& u, int wr, int wc, int fr, int fq, int tz) const {
        const int row0 = u.pm * BM + wr * 64 + fr, col0 = u.pn * BM + wc * 32 + 8 * fq;
#pragma unroll
        for (int ai = 0; ai < 2; ++ai)
#pragma unroll
            for (int m = 0; m < 4; ++m) { const int row = row0 + ai * HALF + m * 16; bf16_t* rowp = O + (size_t)row * NPP + col0;
#pragma unroll
                for (int bj = 0; bj < 2; ++bj) { const f32x4 v0 = acc[ai][bj][m][0], v1 = acc[ai][bj][m][1];
                    u32x4 w; w.x = cvt_pk_bf16(v0[0], v0[1]); w.y = cvt_pk_bf16(v0[2], v0[3]); w.z = cvt_pk_bf16(v1[0], v1[1]); w.w = cvt_pk_bf16(v1[2], v1[3]);
                    *(u32x4*)(rowp + bj * HALF) = w;
                    const int col = col0 + bj * HALF;
                    int si = -1; if (col == C_DA) si = 0; else if (col == C_DB) si = 8; else if (col == C_MDT) si = 16; else if (col == C_MDT + 8) si = 24;
                    if (si >= 0) { float* sp = small + (size_t)row * 32 + si; *(f32x4*)sp = v0; *(f32x4*)(sp + 4) = v1; } } }
    }
};
struct EpiGlu {
    static constexpr bool PERM = true;
    const bf16_t* Y; const float* bias; bf16_t* O;
    __device__ __forceinline__ void operator()(const f32x4 (&acc)[2][2][4][2], const Unit& u, int wr, int wc, int fr, int fq, int tz) const {
        const int row0 = u.pm * BM + wr * 64 + fr, col0 = u.pn * BM + wc * 32 + 8 * fq;
#pragma unroll
        for (int ai = 0; ai < 2; ++ai)
#pragma unroll
            for (int m = 0; m < 4; ++m) { const int row = row0 + ai * HALF + m * 16;
#pragma unroll
                for (int bj = 0; bj < 2; ++bj) { const int col = col0 + bj * HALF;
                    const f32x4 b0 = *(const f32x4*)(bias + col), b1 = *(const f32x4*)(bias + col + 4);
                    const u32x4 yw = *(const u32x4*)(Y + (size_t)row * 1024 + col);
                    const f32x4 v0 = acc[ai][bj][m][0] + b0, v1 = acc[ai][bj][m][1] + b1;
                    float o[8];
                    o[0] = bf_lo(yw.x) * sigmoidf_(v0[0]); o[1] = bf_hi(yw.x) * sigmoidf_(v0[1]); o[2] = bf_lo(yw.y) * sigmoidf_(v0[2]); o[3] = bf_hi(yw.y) * sigmoidf_(v0[3]);
                    o[4] = bf_lo(yw.z) * sigmoidf_(v1[0]); o[5] = bf_hi(yw.z) * sigmoidf_(v1[1]); o[6] = bf_lo(yw.w) * sigmoidf_(v1[2]); o[7] = bf_hi(yw.w) * sigmoidf_(v1[3]);
                    u32x4 w; w.x = cvt_pk_bf16(o[0], o[1]); w.y = cvt_pk_bf16(o[2], o[3]); w.z = cvt_pk_bf16(o[4], o[5]); w.w = cvt_pk_bf16(o[6], o[7]);
                    *(u32x4*)(O + (size_t)row * 4096 + 2048 + col) = w; asm volatile("" ::: "memory"); } }
    }
};
struct EpiMerge {
    static constexpr bool PERM = true;
    const bf16_t* proj; float* macc; bf16_t* O;
    __device__ __forceinline__ void operator()(const f32x4 (&acc)[2][2][4][2], const Unit& u, int wr, int wc, int fr, int fq, int tz) const {
        const int row0 = u.pm * BM + wr * 64 + fr, col0 = u.pn * BM + wc * 32 + 8 * fq;
        f32x4* sc = (f32x4*)(macc + (size_t)blockIdx.x * 65536) + tz;
#pragma unroll
        for (int ai = 0; ai < 2; ++ai)
#pragma unroll
            for (int m = 0; m < 4; ++m) { const int row = row0 + ai * HALF + m * 16;
#pragma unroll
                for (int bj = 0; bj < 2; ++bj) { const int col = col0 + bj * HALF;
                    const u32x4 gw = *(const u32x4*)(proj + (size_t)row * NPP + C_GATE + u.seg * 2048 + col);
                    f32x4 v0 = acc[ai][bj][m][0], v1 = acc[ai][bj][m][1];
                    v0[0] *= sigmoidf_(bf_lo(gw.x)); v0[1] *= sigmoidf_(bf_hi(gw.x)); v0[2] *= sigmoidf_(bf_lo(gw.y)); v0[3] *= sigmoidf_(bf_hi(gw.y));
                    v1[0] *= sigmoidf_(bf_lo(gw.z)); v1[1] *= sigmoidf_(bf_hi(gw.z)); v1[2] *= sigmoidf_(bf_lo(gw.w)); v1[3] *= sigmoidf_(bf_hi(gw.w));
                    const int idx = (((ai * 2 + bj) * 4 + m) * 2) * 512;
                    if (u.seg > 0) { v0 += sc[idx]; v1 += sc[idx + 512]; }
                    if (u.seg < 3) { sc[idx] = v0; sc[idx + 512] = v1; }
                    else { u32x4 w; w.x = cvt_pk_bf16(v0[0], v0[1]); w.y = cvt_pk_bf16(v0[2], v0[3]); w.z = cvt_pk_bf16(v1[0], v1[1]); w.w = cvt_pk_bf16(v1[2], v1[3]);
                        *(u32x4*)(O + (size_t)row * DM + col) = w; }
                    asm volatile("" ::: "memory"); } }
    }
};
struct EpiResid {
    static constexpr bool PERM = false;
    const float* xres; float* O;
    __device__ __forceinline__ void operator()(const f32x4 (&acc)[2][2][4][2], const Unit& u, int wr, int wc, int fr, int fq, int tz) const {
        const int row0 = u.pm * BM + wr * 64 + fr, col0 = u.pn * BM + wc * 32 + 4 * fq;
#pragma unroll
        for (int ai = 0; ai < 2; ++ai)
#pragma unroll
            for (int m = 0; m < 4; ++m) { const size_t ro = (size_t)(row0 + ai * HALF + m * 16) * DM + col0;
#pragma unroll
                for (int bj = 0; bj < 2; ++bj)
#pragma unroll
                    for (int n = 0; n < 2; ++n) { const f32x4 xr = *(const f32x4*)(xres + ro + bj * HALF + n * 16); *(f32x4*)(O + ro + bj * HALF + n * 16) = xr * ALPHA + acc[ai][bj][m][n]; } }
    }
};
struct EpiRelu2 {
    static constexpr bool PERM = true;
    bf16_t* O;
    __device__ __forceinline__ void operator()(const f32x4 (&acc)[2][2][4][2], const Unit& u, int wr, int wc, int fr, int fq, int tz) const {
        const int row0 = u.pm * BM + wr * 64 + fr, col0 = u.pn * BM + wc * 32 + 8 * fq;
#pragma unroll
        for (int ai = 0; ai < 2; ++ai)
#pragma unroll
            for (int m = 0; m < 4; ++m) { bf16_t* rowp = O + (size_t)(row0 + ai * HALF + m * 16) * DFF + col0;
#pragma unroll
                for (int bj = 0; bj < 2; ++bj) { f32x4 v0 = acc[ai][bj][m][0], v1 = acc[ai][bj][m][1];
#pragma unroll
                    for (int j = 0; j < 4; ++j) { const float a = fmaxf(v0[j], 0.f), b = fmaxf(v1[j], 0.f); v0[j] = a * a; v1[j] = b * b; }
                    u32x4 w; w.x = cvt_pk_bf16(v0[0], v0[1]); w.y = cvt_pk_bf16(v0[2], v0[3]); w.z = cvt_pk_bf16(v1[0], v1[1]); w.w = cvt_pk_bf16(v1[2], v1[3]);
                    *(u32x4*)(rowp + bj * HALF) = w; } }
    }
};
}

#define XB_TMO      128
#define XB_XCNT(j)  (256  + 64 * (j))
#define XB_XSUB(j)  (1280 + 64 * (j))
#define XB_XGEN(j)  (2304 + 64 * (j))
#define XB_TOP      3328
#define XB_TOPGEN   3392
#define XCD_BAR_WORDS 3456
#define XB_SPIN_CAP (1u << 18)
__device__ __forceinline__ unsigned xb_ld(unsigned* p)              { return __hip_atomic_load(p, __ATOMIC_RELAXED, __HIP_MEMORY_SCOPE_AGENT); }
__device__ __forceinline__ unsigned xb_add(unsigned* p, unsigned v) { return __hip_atomic_fetch_add(p, v, __ATOMIC_RELAXED, __HIP_MEMORY_SCOPE_AGENT); }
__device__ __forceinline__ unsigned xb_xcc_id() { return (unsigned)__builtin_amdgcn_s_getreg((3 << 11) | 20) & 0xFu; }
#define XB_SPIN(cond, bar) do { unsigned _sp = 0; while (cond) { __builtin_amdgcn_s_sleep(1); \
    if ((++_sp & 255u) == 0u) { if (xb_ld(&(bar)[XB_TMO])) break; if (_sp > XB_SPIN_CAP) { atomicAdd(&(bar)[XB_TMO], 1u); break; } } } } while (0)
struct XcdBarrier { unsigned* bar; unsigned x; volatile LAS unsigned* st; };
__device__ __forceinline__ XcdBarrier xcd_barrier_post(unsigned* bar, volatile LAS unsigned* st) {
    XcdBarrier b; b.bar = bar; b.x = xb_xcc_id(); b.st = st;
    if (threadIdx.x == 0) (void)xb_add(&bar[XB_XCNT(b.x)], 1u);
    return b;
}
__device__ __forceinline__ void xcd_barrier_complete(unsigned* bar, unsigned x, unsigned& nloc, unsigned& nx) {
    const unsigned G = gridDim.x * gridDim.y * gridDim.z;
    unsigned sum, cnt, mine, sp = 0u;
    for (;;) {
        sum = 0u; cnt = 0u; mine = 0u;
#pragma unroll
        for (unsigned j = 0; j < 16; ++j) { const unsigned c = xb_ld(&bar[XB_XCNT(j)]); sum += c; cnt += (c > 0u) ? 1u : 0u; mine = (j == x) ? c : mine; }
        if (sum == G) break;
        __builtin_amdgcn_s_sleep(1);
        if ((++sp & 255u) == 0u) { if (xb_ld(&bar[XB_TMO])) break; if (sp > XB_SPIN_CAP) { atomicAdd(&bar[XB_TMO], 1u); break; } }
    }
    nloc = mine > 0u ? mine : 1u; nx = cnt > 0u ? cnt : 1u;
}
__device__ __forceinline__ void xcd_barrier(const XcdBarrier& b) {
    asm volatile("s_waitcnt vmcnt(0)" ::: "memory");
    __syncthreads();
    if (threadIdx.x == 0) {
        unsigned* bar = b.bar;
        __builtin_amdgcn_s_waitcnt(0);
        unsigned nloc = b.st[0], nx = b.st[1];
        if (nloc == 0u) { xcd_barrier_complete(bar, b.x, nloc, nx); b.st[0] = nloc; b.st[1] = nx; }
        const unsigned old = xb_add(&bar[XB_XSUB(b.x)], 1u);
        const unsigned gen = old / nloc;
        if (old + 1u == (gen + 1u) * nloc) {
            __builtin_amdgcn_fence(__ATOMIC_RELEASE, "agent");
            asm volatile("s_waitcnt vmcnt(0)" ::: "memory");
            const unsigned og = xb_add(&bar[XB_TOP], 1u);
            const unsigned tg = og / nx;
            if (og + 1u == (tg + 1u) * nx) xb_add(&bar[XB_TOPGEN], 1u);
            else XB_SPIN(xb_ld(&bar[XB_TOPGEN]) == tg, bar);
            __builtin_amdgcn_fence(__ATOMIC_ACQUIRE, "agent");
            xb_add(&bar[XB_XGEN(b.x)], 1u);
            asm volatile("s_waitcnt vmcnt(0)" ::: "memory");
        } else {
            XB_SPIN(xb_ld(&bar[XB_XGEN(b.x)]) == gen, bar);
            __builtin_amdgcn_fence(__ATOMIC_ACQUIRE, "agent");
            asm volatile("s_waitcnt vmcnt(0)" ::: "memory");
        }
    }
    __syncthreads();
}

struct Args { const void* in[34]; float* out; unsigned char* ws; int ph_lo, ph_hi, li, pad; };
struct Frame {
    LAS unsigned char* lds;
    int tid, lane, wave, vcu, G;
    const void* const* in;
    unsigned char* ws;
    float* out;
};
__device__ __forceinline__ int opaque_tid() { int tz = threadIdx.x; asm volatile("" : "+v"(tz)); return tz; }
#define FIN(i) ((const float*)F.in[i])
#define WSP(type, off) ((type*)(F.ws + (off)))

__device__ __forceinline__ void p0_transpose_item(const float* W, int K, int N, bf16_t* WT, LAS float* scr, int item, int lane) {
    const int nblk = N / 32, kb = item / nblk, nb = item % nblk, k0 = 64 * kb, n0 = 32 * nb;
#pragma unroll 8
    for (int i = 0; i < 32; ++i) { const int kk = 2 * i + (lane >> 5); scr[kk * 33 + (lane & 31)] = W[(size_t)(k0 + kk) * N + n0 + (lane & 31)]; }
    asm volatile("s_waitcnt lgkmcnt(0)" ::: "memory");
    const int c = lane & 7;
#pragma unroll
    for (int j = 0; j < 4; ++j) { const int n = (lane >> 3) + 8 * j; const LAS float* s = scr + (8 * c) * 33 + n;
        u32x4 o; o.x = pk2(s[0 * 33], s[1 * 33]); o.y = pk2(s[2 * 33], s[3 * 33]); o.z = pk2(s[4 * 33], s[5 * 33]); o.w = pk2(s[6 * 33], s[7 * 33]);
        *(u32x4*)(WT + (size_t)(n0 + n) * K + k0 + 8 * c) = o; }
    asm volatile("s_waitcnt lgkmcnt(0)" ::: "memory");
}
__device__ __forceinline__ void p0_prologue(Frame& F) {
    LAS float* scr = (LAS float*)(F.lds + F.wave * 16384);
    const int gw = F.vcu * 8 + F.wave, NGW = F.G * 8; F.tid = opaque_tid(); F.lane = F.tid & 63;
    constexpr int I_IN = (DM / 64) * (NPROJ / 32), I_GLU = (1024 / 64) * (1024 / 32), I_BR = (1024 / 64) * (DM / 32), I_OUT = (DM / 64) * (DM / 32),
                  I_UP = (DM / 64) * (DFF / 32), I_DOWN = (DFF / 64) * (DM / 32), I_LAYER = I_IN + I_GLU + 4 * I_BR + I_OUT + I_UP + I_DOWN;
    for (int it = gw; it < NLAYER * I_LAYER; it += NGW) {
        const int l = it / I_LAYER; int r = it - l * I_LAYER;
        unsigned char* wt = F.ws + WS_WT + (size_t)l * WT_LAYER;
        if (r < I_IN) { p0_transpose_item(FIN(2) + (size_t)l * DM * NPROJ, DM, NPROJ, (bf16_t*)(wt + WT_IN), scr, r, F.lane); continue; } r -= I_IN;
        if (r < I_GLU) { p0_transpose_item(FIN(15) + (size_t)l * 1024 * 1024, 1024, 1024, (bf16_t*)(wt + WT_GLU), scr, r, F.lane); continue; } r -= I_GLU;
        if (r < I_BR) { p0_transpose_item(FIN(23) + (size_t)l * 1024 * DM, 1024, DM, (bf16_t*)(wt + WT_BR), scr, r, F.lane); continue; } r -= I_BR;
        if (r < I_BR) { p0_transpose_item(FIN(24) + (size_t)l * 1024 * DM, 1024, DM, (bf16_t*)(wt + WT_BR + 4 * MiB), scr, r, F.lane); continue; } r -= I_BR;
        if (r < I_BR) { p0_transpose_item(FIN(25) + (size_t)l * 1024 * DM, 1024, DM, (bf16_t*)(wt + WT_BR + 8 * MiB), scr, r, F.lane); continue; } r -= I_BR;
        if (r < I_BR) { p0_transpose_item(FIN(26) + (size_t)l * 1024 * DM, 1024, DM, (bf16_t*)(wt + WT_BR + 12 * MiB), scr, r, F.lane); continue; } r -= I_BR;
        if (r < I_OUT) { p0_transpose_item(FIN(27) + (size_t)l * DM * DM, DM, DM, (bf16_t*)(wt + WT_OUT), scr, r, F.lane); continue; } r -= I_OUT;
        if (r < I_UP) { p0_transpose_item(FIN(30) + (size_t)l * DM * DFF, DM, DFF, (bf16_t*)(wt + WT_UP), scr, r, F.lane); continue; } r -= I_UP;
        p0_transpose_item(FIN(31) + (size_t)l * DFF * DM, DFF, DM, (bf16_t*)(wt + WT_DOWN), scr, r, F.lane);
    }
    const int gt = F.vcu * 512 + F.tid, NGT = F.G * 512;
    for (int i = gt; i < NLAYER * (NPP - NPROJ) * DM / 8; i += NGT) { const int l = i / ((NPP - NPROJ) * DM / 8), r = i % ((NPP - NPROJ) * DM / 8);
        *(u32x4*)(F.ws + WS_WT + (size_t)l * WT_LAYER + WT_IN + (size_t)NPROJ * DM * 2 + (size_t)r * 16) = (u32x4){0u, 0u, 0u, 0u}; }
    { const int* pos = (const int*)F.in[1]; float* trig = WSP(float, WS_TRIG);
      for (int i = gt; i < T * 64; i += NGT) { const int t = i >> 6, j = i & 63;
          const double inv = exp2(-(double)j * (13.287712379549449 / 64.0));
          double s, c; sincos_d((double)pos[t] * inv, s, c);
          trig[(size_t)t * 128 + j] = (float)c; trig[(size_t)t * 128 + 64 + j] = (float)s; } }
    { const float* x = FIN(0); bf16_t* xb = WSP(bf16_t, WS_XB);
      for (int i = gt; i < T * DM / 4; i += NGT) { const f32x4 v = *(const f32x4*)(x + (size_t)i * 4); u32x2 w; w.x = pk2(v[0], v[1]); w.y = pk2(v[2], v[3]); *(u32x2*)(xb + (size_t)i * 4) = w; } }
    for (int i = gt; i < NLAYER * 4096; i += NGT) { const int l = i >> 12, gn = i & 4095, g = gn >> 6;
        const double lre = (double)FIN(7)[(size_t)l * 4096 + gn], lim = (double)FIN(8)[(size_t)l * 4096 + gn], step = exp((double)FIN(9)[l * 64 + g]);
        const double mag = exp(lre * step); double sn, cs; sincos_d(lim * step, sn, cs);
        const double are = mag * cs, aim = mag * sn, den = lre * lre + lim * lim;
        const double fre = ((are - 1.0) * lre + aim * lim) / den, fim = (aim * lre - (are - 1.0) * lim) / den;
        float* sp = (float*)(F.ws + WS_S5P + (size_t)l * MiB);
        sp[gn * 2] = (float)are; sp[gn * 2 + 1] = (float)aim;
        const float* bre = FIN(10) + ((size_t)l * 4096 + gn) * 16; const float* bim = FIN(11) + ((size_t)l * 4096 + gn) * 16;
        float* obre = sp + 16384 + (size_t)gn * 16; float* obim = sp + 16384 + 65536 + (size_t)gn * 16;
#pragma unroll
        for (int c = 0; c < 16; ++c) { const double br = bre[c], bi = bim[c]; obre[c] = (float)(fre * br - fim * bi); obim[c] = (float)(fre * bi + fim * br); } }
}

__device__ __forceinline__ float gelu_tanh_(float y) { const float z = 0.7978845608028654f * (y + 0.044715f * y * y * y); const float th = 1.f - 2.f / (1.f + __expf(2.f * z)); return 0.5f * y * (1.f + th); }
__device__ __forceinline__ void s5_unit(Frame& F, int layer, int g) {
    const int lane = opaque_tid() & 63, w = F.wave;
    LAS float* Ub = (LAS float*)(F.lds + w * 4096);
    LAS float* Xb = (LAS float*)(F.lds + 32768 + w * 8704);
    LAS float* Ew = (LAS float*)(F.lds + 32768 + 8 * 8704);
    const bf16_t* proj = WSP(bf16_t, WS_PROJ); bf16_t* ys = WSP(bf16_t, WS_YS5);
    const float* sp = (const float*)(F.ws + WS_S5P + (size_t)layer * MiB);
    const int gn = g * 64 + lane;
    const float ar = sp[gn * 2], ai = sp[gn * 2 + 1];
    float bbr[16], bbi[16];
#pragma unroll
    for (int c4 = 0; c4 < 4; ++c4) { const f32x4 a = *(const f32x4*)(sp + 16384 + (size_t)gn * 16 + c4 * 4), b = *(const f32x4*)(sp + 16384 + 65536 + (size_t)gn * 16 + c4 * 4);
#pragma unroll
        for (int j = 0; j < 4; ++j) { bbr[c4 * 4 + j] = a[j]; bbi[c4 * 4 + j] = b[j]; } }
    const int t0 = w * 1024;
#define S5_LOADU(blk) do { const u32x4* up = (const u32x4*)(proj + (size_t)(t0 + (blk) * 64 + lane) * NPP + C_SU + g * 16); const u32x4 u0 = up[0], u1 = up[1]; \
        LAS f32x4* ud = (LAS f32x4*)(Ub + lane * 16); \
        ud[0] = (f32x4){bf_lo(u0.x), bf_hi(u0.x), bf_lo(u0.y), bf_hi(u0.y)}; ud[1] = (f32x4){bf_lo(u0.z), bf_hi(u0.z), bf_lo(u0.w), bf_hi(u0.w)}; \
        ud[2] = (f32x4){bf_lo(u1.x), bf_hi(u1.x), bf_lo(u1.y), bf_hi(u1.y)}; ud[3] = (f32x4){bf_lo(u1.z), bf_hi(u1.z), bf_lo(u1.w), bf_hi(u1.w)}; \
        asm volatile("s_waitcnt lgkmcnt(0)" ::: "memory"); } while (0)
#define S5_STEP(i) do { const LAS f32x4* ur = (const LAS f32x4*)(Ub + (i) * 16); float br = 0.f, bi = 0.f; \
        _Pragma("unroll") for (int c4 = 0; c4 < 4; ++c4) { const f32x4 uv = ur[c4]; _Pragma("unroll") for (int j = 0; j < 4; ++j) { br += uv[j] * bbr[c4 * 4 + j]; bi += uv[j] * bbi[c4 * 4 + j]; } } \
        const float nr = ar * xr - ai * xi + br, ni = ar * xi + ai * xr + bi; xr = nr; xi = ni; } while (0)
    float xr = 0.f, xi = 0.f;
    for (int blk = 0; blk < 16; ++blk) { S5_LOADU(blk);
#pragma unroll 4
        for (int i = 0; i < 64; ++i) S5_STEP(i);
        asm volatile("s_waitcnt lgkmcnt(0)" ::: "memory"); }
    Ew[(w * 64 + lane) * 2] = xr; Ew[(w * 64 + lane) * 2 + 1] = xi;
    __syncthreads();
    { float pr = ar, pi = ai;
#pragma unroll
      for (int s = 0; s < 10; ++s) { const float nr = pr * pr - pi * pi, ni = 2.f * pr * pi; pr = nr; pi = ni; }
      xr = 0.f; xi = 0.f;
      for (int v = 0; v < w; ++v) { const float er = Ew[(v * 64 + lane) * 2], ei = Ew[(v * 64 + lane) * 2 + 1]; const float nr = pr * xr - pi * xi + er, ni = pr * xi + pi * xr + ei; xr = nr; xi = ni; } }
    float cB[32];
    { const float* cre = FIN(12) + ((size_t)layer * 64 + g) * 1024; const float* cim = FIN(13) + ((size_t)layer * 64 + g) * 1024; const int c = lane & 15, q = lane >> 4;
#pragma unroll
      for (int kk = 0; kk < 32; ++kk) { const int np = 4 * kk + q; cB[kk] = (kk < 16) ? cre[c * 64 + np] : -cim[c * 64 + np - 64]; } }
    const float dsk = FIN(14)[layer * 1024 + g * 16 + (lane & 15)];
    for (int blk = 0; blk < 16; ++blk) { S5_LOADU(blk);
        for (int sb = 0; sb < 4; ++sb) {
#pragma unroll 4
            for (int i = 0; i < 16; ++i) { S5_STEP(sb * 16 + i); Xb[i * 130 + lane] = xr; Xb[i * 130 + 64 + lane] = xi; }
            asm volatile("s_waitcnt lgkmcnt(0)" ::: "memory");
            f32x4 acc = {0.f, 0.f, 0.f, 0.f};
#pragma unroll
            for (int kk = 0; kk < 32; ++kk) { const float a = Xb[(lane & 15) * 130 + 4 * kk + (lane >> 4)]; acc = __builtin_amdgcn_mfma_f32_16x16x4f32(a, cB[kk], acc, 0, 0, 0); }
#pragma unroll
            for (int r = 0; r < 4; ++r) { const int tl = sb * 16 + 4 * (lane >> 4) + r; const float y = acc[r] + dsk * Ub[tl * 16 + (lane & 15)];
                ys[(size_t)(t0 + blk * 64 + tl) * 1024 + g * 16 + (lane & 15)] = (bf16_t)f2bf(gelu_tanh_(y)); }
            asm volatile("s_waitcnt lgkmcnt(0)" ::: "memory");
        } }
#undef S5_LOADU
#undef S5_STEP
    __syncthreads();
}


constexpr int LDP = 136;
__device__ __forceinline__ bf16x8 ldsfrag(const LAS bf16_t* base, int pitch, int row, int kk, int q) { return *(const LAS bf16x8*)(base + row * pitch + kk * 32 + 8 * q); }
__device__ __forceinline__ bf16x8 glbfrag(const bf16_t* base, int pitch, int row, int kk, int q) { return *(const bf16x8*)(base + (size_t)row * pitch + kk * 32 + 8 * q); }
#define MFMA16(a, b, c) __builtin_amdgcn_mfma_f32_16x16x32_bf16((a), (b), (c), 0, 0, 0)

constexpr size_t RET_BLK = 3 * 16384;
__device__ __forceinline__ void ret_pre_unit(Frame& F, int n, int h) {
    const int tid = opaque_tid(), lane = tid & 63, w = F.wave, r16 = lane & 15, q = lane >> 4;
    LAS bf16_t* Qs = (LAS bf16_t*)(F.lds); LAS bf16_t* Ks = (LAS bf16_t*)(F.lds + 128 * LDP * 2);
    const bf16_t* proj = WSP(bf16_t, WS_PROJ); const float* trig = WSP(float, WS_TRIG);
    bf16_t* blk = (bf16_t*)(F.ws + WS_TMP + TM_KR) + (size_t)(n * 4 + h) * RET_BLK;
    { const int tok = tid >> 2, qt = tid & 3; const size_t t = (size_t)n * 128 + tok;
      const bf16_t* pq = proj + t * NPP + C_RQ + h * 128 + 16 * qt; const bf16_t* pk = proj + t * NPP + C_RK + h * 128 + 16 * qt;
      const float* tc = trig + t * 128 + 16 * qt;
      float cs[16], sn[16];
#pragma unroll
      for (int i = 0; i < 4; ++i) { const f32x4 c4 = *(const f32x4*)(tc + 4 * i), s4 = *(const f32x4*)(tc + 64 + 4 * i);
#pragma unroll
          for (int j = 0; j < 4; ++j) { cs[4 * i + j] = c4[j]; sn[4 * i + j] = s4[j]; } }
#pragma unroll
      for (int isk = 0; isk < 2; ++isk) {
          const bf16_t* p = isk ? pk : pq; const float sc = isk ? 0.08838834764831845f : 1.0f;
          const u32x4 a0 = *(const u32x4*)p, a1 = *(const u32x4*)(p + 8), b0 = *(const u32x4*)(p + 64), b1 = *(const u32x4*)(p + 72);
          float x1[16], x2[16];
#pragma unroll
          for (int j = 0; j < 4; ++j) { x1[2 * j] = bf_lo(a0[j]); x1[2 * j + 1] = bf_hi(a0[j]); x1[8 + 2 * j] = bf_lo(a1[j]); x1[8 + 2 * j + 1] = bf_hi(a1[j]);
              x2[2 * j] = bf_lo(b0[j]); x2[2 * j + 1] = bf_hi(b0[j]); x2[8 + 2 * j] = bf_lo(b1[j]); x2[8 + 2 * j + 1] = bf_hi(b1[j]); }
          u32x4 o1[2], o2[2];
#pragma unroll
          for (int j = 0; j < 8; ++j) { const float ya = (x1[2 * j] * cs[2 * j] - x2[2 * j] * sn[2 * j]) * sc, yb = (x1[2 * j + 1] * cs[2 * j + 1] - x2[2 * j + 1] * sn[2 * j + 1]) * sc;
              const float za = (x1[2 * j] * sn[2 * j] + x2[2 * j] * cs[2 * j]) * sc, zb = (x1[2 * j + 1] * sn[2 * j + 1] + x2[2 * j + 1] * cs[2 * j + 1]) * sc;
              o1[j >> 2][j & 3] = pk2(ya, yb); o2[j >> 2][j & 3] = pk2(za, zb); }
          LAS bf16_t* ls = (isk ? Ks : Qs) + tok * LDP + 16 * qt;
          *(LAS u32x4*)ls = o1[0]; *(LAS u32x4*)(ls + 8) = o1[1]; *(LAS u32x4*)(ls + 64) = o2[0]; *(LAS u32x4*)(ls + 72) = o2[1];
          if (!isk) { bf16_t* g = blk + tok * 128 + 16 * qt; *(u32x4*)g = o1[0]; *(u32x4*)(g + 8) = o1[1]; *(u32x4*)(g + 64) = o2[0]; *(u32x4*)(g + 72) = o2[1]; } } }
    __syncthreads();
    { const int d = tid >> 2, jq = tid & 3; bf16_t* g = blk + 2 * 16384 + d * 128 + 32 * jq;
#pragma unroll
      for (int c = 0; c < 4; ++c) { u32x4 o;
#pragma unroll
          for (int j = 0; j < 4; ++j) { const unsigned lo = Ks[(32 * jq + 8 * c + 2 * j) * LDP + d], hi = Ks[(32 * jq + 8 * c + 2 * j + 1) * LDP + d]; o[j] = lo | (hi << 16); }
          *(u32x4*)(g + 8 * c) = o; } }
    { const float lg = log2f(1.0f - exp2f(-5.0f - (float)h)); const int i = 16 * w + r16;
      bf16x8 bq[4];
#pragma unroll
      for (int kk = 0; kk < 4; ++kk) bq[kk] = ldsfrag(Qs, LDP, 16 * w + r16, kk, q);
      bf16_t* g = blk + 16384 + i * 128;
      for (int jt = 0; jt < 8; ++jt) {
          u32x2 o = {0u, 0u};
          if (jt <= w) { f32x4 acc = {0.f, 0.f, 0.f, 0.f};
#pragma unroll
              for (int kk = 0; kk < 4; ++kk) acc = MFMA16(ldsfrag(Ks, LDP, 16 * jt + r16, kk, q), bq[kk], acc);
              float v[4];
#pragma unroll
              for (int r = 0; r < 4; ++r) { const int j = 16 * jt + 4 * q + r; v[r] = (j <= i) ? acc[r] * exp2f((float)(i - j) * lg) : 0.f; }
              o.x = pk2(v[0], v[1]); o.y = pk2(v[2], v[3]); }
          *(u32x2*)(g + 16 * jt + 4 * q) = o; } }
    __syncthreads();
}

__device__ __forceinline__ void ret_seq_unit(Frame& F, int u) {
    const int tid = opaque_tid(), lane = tid & 63, w = F.wave, r16 = lane & 15, q = lane >> 4;
    const int h = u >> 4, e0 = (u & 15) * 16;
    LAS bf16_t* Rt = (LAS bf16_t*)(F.lds); LAS bf16_t* Vt = (LAS bf16_t*)(F.lds + 2 * 16 * LDP * 2); LAS bf16_t* Vd = (LAS bf16_t*)(F.lds + 4 * 16 * LDP * 2);
    const bf16_t* proj = WSP(bf16_t, WS_PROJ); float* O = (float*)(F.ws + WS_TMP + TM_VR);
    const bf16_t* blk0 = (const bf16_t*)(F.ws + WS_TMP + TM_KR) + (size_t)h * RET_BLK;
    const float lg = log2f(1.0f - exp2f(-5.0f - (float)h)), g128 = exp2f(128.f * lg);
    float rsc[4];
#pragma unroll
    for (int r = 0; r < 4; ++r) rsc[r] = exp2f((float)(16 * w + 4 * q + r + 1) * lg);
    const int vj = tid >> 1, vh = tid & 1; const float vdec = exp2f((float)(127 - vj) * lg);
    u32x4 vreg = {0u, 0u, 0u, 0u};
#define RET_LOADV(c) do { if (tid < 256) vreg = *(const u32x4*)(proj + (size_t)((c) * 128 + vj) * NPP + C_RV + h * 256 + e0 + 8 * vh); } while (0)
#define RET_STOREV(b) do { if (tid < 256) { LAS bf16_t* vt = Vt + (b) * 16 * LDP + (8 * vh) * LDP + vj; LAS bf16_t* vd = Vd + (b) * 16 * LDP + (8 * vh) * LDP + vj; \
        _Pragma("unroll") for (int j = 0; j < 4; ++j) { const float lo = bf_lo(vreg[j]), hi = bf_hi(vreg[j]); vt[(2 * j) * LDP] = (bf16_t)(vreg[j] & 0xffffu); vt[(2 * j + 1) * LDP] = (bf16_t)(vreg[j] >> 16); \
            vd[(2 * j) * LDP] = (bf16_t)f2bf(lo * vdec); vd[(2 * j + 1) * LDP] = (bf16_t)f2bf(hi * vdec); } } } while (0)
#define RET_LOADF(FR, c) do { const bf16_t* bk = blk0 + (size_t)(c) * 4 * RET_BLK; _Pragma("unroll") for (int kk = 0; kk < 4; ++kk) { \
        FR[kk] = glbfrag(bk, 128, 16 * w + r16, kk, q); FR[4 + kk] = glbfrag(bk + 16384, 128, 16 * w + r16, kk, q); FR[8 + kk] = glbfrag(bk + 32768, 128, 16 * w + r16, kk, q); } } while (0)
    for (int i = tid; i < 16 * LDP; i += 512) Rt[i] = 0;
    RET_LOADV(0); RET_STOREV(0);
    bf16x8 fa[12], fb[12];
    RET_LOADF(fa, 0);
    f32x4 R = {0.f, 0.f, 0.f, 0.f};
    __syncthreads();
#define RET_CHUNK(c, CUR, NXT) do { const int b = (c) & 1; \
        if ((c) + 1 < T / 128) { RET_LOADF(NXT, (c) + 1); RET_LOADV((c) + 1); } \
        f32x4 a1 = {0.f, 0.f, 0.f, 0.f}, a2 = {0.f, 0.f, 0.f, 0.f}; f32x4 ra = R * g128; \
        _Pragma("unroll") for (int kk = 0; kk < 4; ++kk) { const bf16x8 bR = ldsfrag(Rt + b * 16 * LDP, LDP, r16, kk, q), bV = ldsfrag(Vt + b * 16 * LDP, LDP, r16, kk, q), bD = ldsfrag(Vd + b * 16 * LDP, LDP, r16, kk, q); \
            a1 = MFMA16(CUR[kk], bR, a1); a2 = MFMA16(CUR[4 + kk], bV, a2); ra = MFMA16(CUR[8 + kk], bD, ra); } \
        R = ra; \
        _Pragma("unroll") for (int r = 0; r < 4; ++r) O[(size_t)((c) * 128 + 16 * w + 4 * q + r) * 1024 + h * 256 + e0 + r16] = rsc[r] * a1[r] + a2[r]; \
        { u32x2 o; o.x = pk2(R[0], R[1]); o.y = pk2(R[2], R[3]); *(LAS u32x2*)(Rt + (b ^ 1) * 16 * LDP + r16 * LDP + 16 * w + 4 * q) = o; } \
        if ((c) + 1 < T / 128) RET_STOREV(b ^ 1); \
        __syncthreads(); } while (0)
    for (int c = 0; c < T / 128; c += 2) { RET_CHUNK(c, fa, fb); RET_CHUNK(c + 1, fb, fa); }
#undef RET_CHUNK
#undef RET_LOADF
#undef RET_LOADV
#undef RET_STOREV
}


__device__ __forceinline__ void ssd_pre_unit(Frame& F, int layer, int n, int g) {
    const int tid = opaque_tid(), lane = tid & 63, w = F.wave, r16 = lane & 15, q = lane >> 4;
    LAS bf16_t* Cs = (LAS bf16_t*)(F.lds); LAS bf16_t* Bs = (LAS bf16_t*)(F.lds + 128 * LDP * 2);
    LAS float* Ac = (LAS float*)(F.lds + 2 * 128 * LDP * 2); LAS float* Dt = Ac + 8 * 128;
    const bf16_t* proj = WSP(bf16_t, WS_PROJ); const float* small = WSP(float, WS_SMALL);
    unsigned char* tm = F.ws + WS_TMP;
    float* acum = (float*)(tm + TM_SAC); bf16_t* XS = (bf16_t*)(tm + TM_SXS); bf16_t* XD = (bf16_t*)(tm + TM_SXD);
    bf16_t* cb = (bf16_t*)(tm + TM_SCB) + (size_t)(n * 2 + g) * 32768; bf16_t* sl = (bf16_t*)(tm + TM_SSL) + (size_t)(n * 16 + 8 * g) * 16384;
    const float* scw = FIN(17) + (size_t)layer * 1536 * 4; const float* scb = FIN(18) + layer * 1536; const float* sdtb = FIN(19) + layer * 16; const float* salog = FIN(20) + layer * 16;
    const int t0 = n * 128;
    { const int hh = 8 * g + w; const float a = -__expf(salog[hh]);
      const float dt0 = softplusf_(small[(size_t)(t0 + 2 * lane) * 32 + 16 + hh] + sdtb[hh]), dt1 = softplusf_(small[(size_t)(t0 + 2 * lane + 1) * 32 + 16 + hh] + sdtb[hh]);
      const float v0 = dt0 * a, v1 = dt1 * a, s = v0 + v1; float incl = s;
#pragma unroll
      for (int o = 1; o < 64; o <<= 1) { const float tmp = __shfl_up(incl, o); if (lane >= o) incl += tmp; }
      const float excl = incl - s;
      Ac[w * 128 + 2 * lane] = excl + v0; Ac[w * 128 + 2 * lane + 1] = excl + s; Dt[w * 128 + 2 * lane] = dt0; Dt[w * 128 + 2 * lane + 1] = dt1;
      acum[(size_t)(t0 + 2 * lane) * 16 + hh] = excl + v0; acum[(size_t)(t0 + 2 * lane + 1) * 16 + hh] = excl + s; }
    __syncthreads();
    { const int cp = tid & 127, tq = tid >> 7;
#pragma unroll
      for (int m = 0; m < 3; ++m) {
          const int ch = (m < 2) ? g * 512 + m * 256 + 2 * cp : (cp < 64 ? 1024 + g * 128 + 2 * cp : 1280 + g * 128 + 2 * (cp - 64));
          const f32x4 w0 = *(const f32x4*)(scw + (size_t)ch * 4), w1 = *(const f32x4*)(scw + (size_t)ch * 4 + 4); const float b0 = scb[ch], b1 = scb[ch + 1];
          const bf16_t* pc = proj + C_MX + ch; const int tb = t0 + 32 * tq;
          unsigned x0 = (tb - 3 >= 0) ? *(const unsigned*)(pc + (size_t)(tb - 3) * NPP) : 0u, x1 = (tb - 2 >= 0) ? *(const unsigned*)(pc + (size_t)(tb - 2) * NPP) : 0u, x2 = (tb - 1 >= 0) ? *(const unsigned*)(pc + (size_t)(tb - 1) * NPP) : 0u;
#pragma unroll 4
          for (int i = 0; i < 32; ++i) { const unsigned x3 = *(const unsigned*)(pc + (size_t)(tb + i) * NPP);
              const float ya = siluf_(w0[0] * bf_lo(x0) + w0[1] * bf_lo(x1) + w0[2] * bf_lo(x2) + w0[3] * bf_lo(x3) + b0);
              const float yb = siluf_(w1[0] * bf_hi(x0) + w1[1] * bf_hi(x1) + w1[2] * bf_hi(x2) + w1[3] * bf_hi(x3) + b1);
              x0 = x1; x1 = x2; x2 = x3;
              if (m < 2) { const float dt = Dt[(m * 4 + (cp >> 5)) * 128 + 32 * tq + i]; const size_t go = (size_t)(tb + i) * 1024 + g * 512 + m * 256 + 2 * cp;
                  *(unsigned*)(XS + go) = pk2(ya, yb); *(unsigned*)(XD + go) = pk2(ya * dt, yb * dt); }
              else if (cp < 64) *(LAS unsigned*)(Bs + (32 * tq + i) * LDP + 2 * cp) = pk2(ya, yb);
              else *(LAS unsigned*)(Cs + (32 * tq + i) * LDP + 2 * (cp - 64)) = pk2(ya, yb); } } }
    __syncthreads();
#pragma unroll
    for (int k = 0; k < 4; ++k) { const int idx = tid + 512 * k, row = idx >> 4, c8 = idx & 15; *(u32x4*)(cb + row * 128 + 8 * c8) = *(const LAS u32x4*)(Cs + row * LDP + 8 * c8); }
    { const int d = tid >> 2, jq = tid & 3; bf16_t* gp = cb + 16384 + d * 128 + 32 * jq;
#pragma unroll
      for (int c = 0; c < 4; ++c) { u32x4 o;
#pragma unroll
          for (int j = 0; j < 4; ++j) { const unsigned lo = Bs[(32 * jq + 8 * c + 2 * j) * LDP + d], hi = Bs[(32 * jq + 8 * c + 2 * j + 1) * LDP + d]; o[j] = lo | (hi << 16); }
          *(u32x4*)(gp + 8 * c) = o; } }
    { const int i = 16 * w + r16; bf16x8 bq[4];
#pragma unroll
      for (int kk = 0; kk < 4; ++kk) bq[kk] = ldsfrag(Cs, LDP, i, kk, q);
      float ai[8];
#pragma unroll
      for (int hh = 0; hh < 8; ++hh) ai[hh] = Ac[hh * 128 + i];
      for (int jt = 0; jt < 8; ++jt) {
          f32x4 acc = {0.f, 0.f, 0.f, 0.f};
          if (jt <= w) {
#pragma unroll
              for (int kk = 0; kk < 4; ++kk) acc = MFMA16(ldsfrag(Bs, LDP, 16 * jt + r16, kk, q), bq[kk], acc); }
#pragma unroll
          for (int hh = 0; hh < 8; ++hh) { u32x2 o = {0u, 0u};
              if (jt <= w) { const f32x4 aj = *(const LAS f32x4*)(Ac + hh * 128 + 16 * jt + 4 * q); float v[4];
#pragma unroll
                  for (int r = 0; r < 4; ++r) { const int j = 16 * jt + 4 * q + r; v[r] = (j <= i) ? acc[r] * __expf(ai[hh] - aj[r]) : 0.f; }
                  o.x = pk2(v[0], v[1]); o.y = pk2(v[2], v[3]); }
              *(u32x2*)(sl + (size_t)hh * 16384 + i * 128 + 16 * jt + 4 * q) = o; } } }
    __syncthreads();
}

__device__ __forceinline__ void ssd_seq_unit(Frame& F, int u) {
    const int tid = opaque_tid(), lane = tid & 63, w = F.wave, r16 = lane & 15, q = lane >> 4;
    const int h = u >> 2, p0 = (u & 3) * 16, g = h >> 3;
    LAS bf16_t* St = (LAS bf16_t*)(F.lds); LAS bf16_t* Vt = (LAS bf16_t*)(F.lds + 2 * 16 * LDP * 2); LAS bf16_t* Vd = (LAS bf16_t*)(F.lds + 4 * 16 * LDP * 2);
    unsigned char* tm = F.ws + WS_TMP;
    const float* acum = (const float*)(tm + TM_SAC); const bf16_t* XD = (const bf16_t*)(tm + TM_SXD); float* O = (float*)(tm + TM_VS);
    const bf16_t* cb0 = (const bf16_t*)(tm + TM_SCB) + (size_t)g * 32768; const bf16_t* sl0 = (const bf16_t*)(tm + TM_SSL) + (size_t)h * 16384;
    const int vj = tid >> 1, vh = tid & 1;
    u32x4 vreg = {0u, 0u, 0u, 0u}; float vdn = 0.f;
#define SSD_LOADV(c) do { if (tid < 256) { vreg = *(const u32x4*)(XD + (size_t)((c) * 128 + vj) * 1024 + h * 64 + p0 + 8 * vh); \
        vdn = __expf(acum[(size_t)((c) * 128 + 127) * 16 + h] - acum[(size_t)((c) * 128 + vj) * 16 + h]); } } while (0)
#define SSD_STOREV(b) do { if (tid < 256) { LAS bf16_t* vt = Vt + (b) * 16 * LDP + (8 * vh) * LDP + vj; LAS bf16_t* vd = Vd + (b) * 16 * LDP + (8 * vh) * LDP + vj; \
        _Pragma("unroll") for (int j = 0; j < 4; ++j) { const float lo = bf_lo(vreg[j]), hi = bf_hi(vreg[j]); vt[(2 * j) * LDP] = (bf16_t)(vreg[j] & 0xffffu); vt[(2 * j + 1) * LDP] = (bf16_t)(vreg[j] >> 16); \
            vd[(2 * j) * LDP] = (bf16_t)f2bf(lo * vdn); vd[(2 * j + 1) * LDP] = (bf16_t)f2bf(hi * vdn); } } } while (0)
#define SSD_LOADF(FR, AR, c) do { const bf16_t* bc = cb0 + (size_t)(c) * 2 * 32768; const bf16_t* bs = sl0 + (size_t)(c) * 16 * 16384; _Pragma("unroll") for (int kk = 0; kk < 4; ++kk) { \
        FR[kk] = glbfrag(bc, 128, 16 * w + r16, kk, q); FR[4 + kk] = glbfrag(bs, 128, 16 * w + r16, kk, q); FR[8 + kk] = glbfrag(bc + 16384, 128, 16 * w + r16, kk, q); } \
        _Pragma("unroll") for (int r = 0; r < 4; ++r) AR[r] = acum[(size_t)((c) * 128 + 16 * w + 4 * q + r) * 16 + h]; AR[4] = acum[(size_t)((c) * 128 + 127) * 16 + h]; } while (0)
    for (int i = tid; i < 16 * LDP; i += 512) St[i] = 0;
    SSD_LOADV(0); SSD_STOREV(0);
    bf16x8 fa[12], fb[12]; float aa[5], ab[5];
    SSD_LOADF(fa, aa, 0);
    f32x4 S = {0.f, 0.f, 0.f, 0.f};
    __syncthreads();
#define SSD_CHUNK(c, CUR, NXT, ACUR, ANXT) do { const int b = (c) & 1; \
        if ((c) + 1 < T / 128) { SSD_LOADF(NXT, ANXT, (c) + 1); SSD_LOADV((c) + 1); } \
        f32x4 a1 = {0.f, 0.f, 0.f, 0.f}, a2 = {0.f, 0.f, 0.f, 0.f}; f32x4 sa = S * __expf(ACUR[4]); \
        _Pragma("unroll") for (int kk = 0; kk < 4; ++kk) { const bf16x8 bS = ldsfrag(St + b * 16 * LDP, LDP, r16, kk, q), bV = ldsfrag(Vt + b * 16 * LDP, LDP, r16, kk, q), bD = ldsfrag(Vd + b * 16 * LDP, LDP, r16, kk, q); \
            a1 = MFMA16(CUR[kk], bS, a1); a2 = MFMA16(CUR[4 + kk], bV, a2); sa = MFMA16(CUR[8 + kk], bD, sa); } \
        S = sa; \
        _Pragma("unroll") for (int r = 0; r < 4; ++r) O[(size_t)((c) * 128 + 16 * w + 4 * q + r) * 1024 + h * 64 + p0 + r16] = __expf(ACUR[r]) * a1[r] + a2[r]; \
        { u32x2 o; o.x = pk2(S[0], S[1]); o.y = pk2(S[2], S[3]); *(LAS u32x2*)(St + (b ^ 1) * 16 * LDP + r16 * LDP + 16 * w + 4 * q) = o; } \
        if ((c) + 1 < T / 128) SSD_STOREV(b ^ 1); \
        __syncthreads(); } while (0)
    for (int c = 0; c < T / 128; c += 2) { SSD_CHUNK(c, fa, fb, aa, ab); SSD_CHUNK(c + 1, fb, fa, ab, aa); }
#undef SSD_CHUNK
#undef SSD_LOADF
#undef SSD_LOADV
#undef SSD_STOREV
}


constexpr size_t GDN_BLK = 36864;
__device__ __forceinline__ void gdn_pre_unit(Frame& F, int layer, int n, int h) {
    const int tid = opaque_tid(), lane = tid & 63, w = F.wave, r16 = lane & 15, q = lane >> 4;
    LAS bf16_t* Qs = (LAS bf16_t*)(F.lds); LAS bf16_t* Ks = (LAS bf16_t*)(F.lds + 17408); LAS bf16_t* Kd = (LAS bf16_t*)(F.lds + 34816);
    LAS float* Mm = (LAS float*)(F.lds + 52224); LAS float* Rr = (LAS float*)(F.lds + 69632); LAS float* gc = (LAS float*)(F.lds + 135168); LAS float* be = gc + 64;
    LAS bf16_t* Ws = Qs;
    const bf16_t* proj = WSP(bf16_t, WS_PROJ); const float* small = WSP(float, WS_SMALL);
    unsigned char* tm = F.ws + WS_TMP;
    bf16_t* blk = (bf16_t*)(tm + TM_KG) + (size_t)(n * 8 + h) * GDN_BLK;
    const float* gcw = FIN(3) + (size_t)layer * 3072 * 4; const float* galog = FIN(4) + layer * 8; const float* gdtb = FIN(5) + layer * 8;
    const int t0 = n * 64;
    if (w == 0) { const float g = -__expf(galog[h]) * softplusf_(small[(size_t)(t0 + lane) * 32 + h] + gdtb[h]); float incl = g;
#pragma unroll
        for (int o = 1; o < 64; o <<= 1) { const float tmp = __shfl_up(incl, o); if (lane >= o) incl += tmp; }
        gc[lane] = incl; be[lane] = sigmoidf_(small[(size_t)(t0 + lane) * 32 + 8 + h]);
        if (lane == 63) ((float*)(tm + TM_SM))[n * 8 + h] = __expf(incl); }
    __syncthreads();
    { f32x4 wt[3][2];
#pragma unroll
      for (int p = 0; p < 3; ++p)
#pragma unroll
          for (int e = 0; e < 2; ++e) wt[p][e] = *(const f32x4*)(gcw + (size_t)(p * 1024 + h * 128 + 2 * lane + e) * 4);
      const bf16_t* pc = proj + C_DQ + h * 128 + 2 * lane; const int tb = t0 + 8 * w;
      unsigned x[3][4];
#pragma unroll
      for (int p = 0; p < 3; ++p)
#pragma unroll
          for (int k = 0; k < 3; ++k) x[p][k] = (tb - 3 + k >= 0) ? *(const unsigned*)(pc + (size_t)(tb - 3 + k) * NPP + p * 1024) : 0u;
      const float gl63 = gc[63];
#pragma unroll
      for (int i = 0; i < 8; ++i) { const int tok = 8 * w + i; float v[3][2];
#pragma unroll
          for (int p = 0; p < 3; ++p) { x[p][3] = *(const unsigned*)(pc + (size_t)(tb + i) * NPP + p * 1024);
              v[p][0] = siluf_(wt[p][0][0] * bf_lo(x[p][0]) + wt[p][0][1] * bf_lo(x[p][1]) + wt[p][0][2] * bf_lo(x[p][2]) + wt[p][0][3] * bf_lo(x[p][3]));
              v[p][1] = siluf_(wt[p][1][0] * bf_hi(x[p][0]) + wt[p][1][1] * bf_hi(x[p][1]) + wt[p][1][2] * bf_hi(x[p][2]) + wt[p][1][3] * bf_hi(x[p][3]));
              x[p][0] = x[p][1]; x[p][1] = x[p][2]; x[p][2] = x[p][3]; }
          const float sq = wave_sum(v[0][0] * v[0][0] + v[0][1] * v[0][1]), sk = wave_sum(v[1][0] * v[1][0] + v[1][1] * v[1][1]);
          const float rq = rsqrtf(sq + RMS_EPS) * 0.08838834764831845f, rk = rsqrtf(sk + RMS_EPS);
          const float gci = gc[tok], bei = be[tok], eg = __expf(gci), et = __expf(gl63 - gci);
          const float q0 = v[0][0] * rq, q1 = v[0][1] * rq, k0 = v[1][0] * rk, k1 = v[1][1] * rk;
          *(LAS unsigned*)(Qs + tok * LDP + 2 * lane) = pk2(q0, q1); *(LAS unsigned*)(Ks + tok * LDP + 2 * lane) = pk2(k0, k1); *(LAS unsigned*)(Kd + tok * LDP + 2 * lane) = pk2(k0 * et, k1 * et);
          *(LAS f32x2*)(Rr + tok * 256 + 2 * lane) = (f32x2){bei * v[2][0], bei * v[2][1]}; *(LAS f32x2*)(Rr + tok * 256 + 128 + 2 * lane) = (f32x2){bei * eg * k0, bei * eg * k1};
          *(unsigned*)(blk + 16384 + tok * 128 + 2 * lane) = pk2(q0 * eg, q1 * eg); } }
    __syncthreads();
    if (w < 4) { bf16x8 aK[4];
#pragma unroll
        for (int kk = 0; kk < 4; ++kk) aK[kk] = ldsfrag(Ks, LDP, 16 * w + r16, kk, q);
        for (int jt = 0; jt <= w; ++jt) { f32x4 acc = {0.f, 0.f, 0.f, 0.f};
#pragma unroll
            for (int kk = 0; kk < 4; ++kk) acc = MFMA16(aK[kk], ldsfrag(Ks, LDP, 16 * jt + r16, kk, q), acc);
            const int j = 16 * jt + r16; const float gj = gc[j];
#pragma unroll
            for (int r = 0; r < 4; ++r) { const int i = 16 * w + 4 * q + r; Mm[i * 68 + j] = (j < i) ? be[i] * acc[r] * __expf(gc[i] - gj) : 0.f; } } }
    else { const int wq = w - 4, i = 16 * wq + r16; bf16x8 bQ[4];
#pragma unroll
        for (int kk = 0; kk < 4; ++kk) bQ[kk] = ldsfrag(Qs, LDP, i, kk, q);
        const float gi = gc[i];
        for (int jt = 0; jt < 4; ++jt) { u32x2 o = {0u, 0u};
            if (jt <= wq) { f32x4 acc = {0.f, 0.f, 0.f, 0.f};
#pragma unroll
                for (int kk = 0; kk < 4; ++kk) acc = MFMA16(ldsfrag(Ks, LDP, 16 * jt + r16, kk, q), bQ[kk], acc);
                float v[4];
#pragma unroll
                for (int r = 0; r < 4; ++r) { const int j = 16 * jt + 4 * q + r; v[r] = (j <= i) ? acc[r] * __expf(gi - gc[j]) : 0.f; }
                o.x = pk2(v[0], v[1]); o.y = pk2(v[2], v[3]); }
            *(u32x2*)(blk + 24576 + i * 64 + 16 * jt + 4 * q) = o; } }
    { const int d = tid >> 2, jq = tid & 3; bf16_t* gp = blk + 28672 + d * 64 + 16 * jq;
#pragma unroll
      for (int c = 0; c < 2; ++c) { u32x4 o;
#pragma unroll
          for (int j = 0; j < 4; ++j) { const unsigned lo = Kd[(16 * jq + 8 * c + 2 * j) * LDP + d], hi = Kd[(16 * jq + 8 * c + 2 * j + 1) * LDP + d]; o[j] = lo | (hi << 16); }
          *(u32x4*)(gp + 8 * c) = o; } }
    __syncthreads();
    if (tid < 256) { float x[64];
#pragma unroll
        for (int i = 0; i < 64; ++i) x[i] = 0.f;
#pragma unroll
        for (int i = 0; i < 64; ++i) { float s = Rr[i * 256 + tid];
#pragma unroll
            for (int j4 = 0; j4 < (i + 3) / 4; ++j4) { const f32x4 m4 = *(const LAS f32x4*)(Mm + i * 68 + 4 * j4); s -= m4[0] * x[4 * j4] + m4[1] * x[4 * j4 + 1] + m4[2] * x[4 * j4 + 2] + m4[3] * x[4 * j4 + 3]; }
            x[i] = s; }
        if (tid < 128) { bf16_t* gp = blk + 8192 + tid * 64;
#pragma unroll
            for (int c = 0; c < 8; ++c) { u32x4 o; o.x = pk2(x[8 * c], x[8 * c + 1]); o.y = pk2(x[8 * c + 2], x[8 * c + 3]); o.z = pk2(x[8 * c + 4], x[8 * c + 5]); o.w = pk2(x[8 * c + 6], x[8 * c + 7]); *(u32x4*)(gp + 8 * c) = o; } }
        else {
#pragma unroll
            for (int i = 0; i < 64; ++i) Ws[i * LDP + tid - 128] = (bf16_t)f2bf(x[i]); } }
    __syncthreads();
#pragma unroll
    for (int k = 0; k < 2; ++k) { const int idx = tid + 512 * k, row = idx >> 4, c8 = idx & 15; *(u32x4*)(blk + row * 128 + 8 * c8) = *(const LAS u32x4*)(Ws + row * LDP + 8 * c8); }
    __syncthreads();
}

__device__ __forceinline__ void gdn_seq_unit(Frame& F, int u) {
    const int tid = opaque_tid(), lane = tid & 63, w = F.wave, r16 = lane & 15, q = lane >> 4;
    const int h = u >> 3, e0 = (u & 7) * 16, mt = w & 3; const bool lo = w < 4;
    LAS bf16_t* St = (LAS bf16_t*)(F.lds); LAS bf16_t* Vt = (LAS bf16_t*)(F.lds + 16 * LDP * 2);
    unsigned char* tm = F.ws + WS_TMP; float* O = (float*)(tm + TM_VG);
    const bf16_t* blk0 = (const bf16_t*)(tm + TM_KG) + (size_t)h * GDN_BLK;
    const float* glp = (const float*)(tm + TM_SM) + h + (lane & 0);
    const int p0off = lo ? 0 : 16384;
#define GDN_LOADF(FR, UU, GG, c) do { const bf16_t* bk = blk0 + (size_t)(c) * 8 * GDN_BLK; _Pragma("unroll") for (int kk = 0; kk < 4; ++kk) FR[kk] = glbfrag(bk + p0off, 128, 16 * mt + r16, kk, q); \
        _Pragma("unroll") for (int kk = 0; kk < 2; ++kk) { FR[4 + kk] = glbfrag(bk + 28672, 64, 16 * w + r16, kk, q); FR[6 + kk] = glbfrag(bk + 24576, 64, 16 * mt + r16, kk, q); } \
        UU = *(const u32x2*)(bk + 8192 + (e0 + r16) * 64 + 16 * mt + 4 * q); GG = glp[(c) * 8]; } while (0)
    for (int i = tid; i < 16 * LDP; i += 512) St[i] = 0;
    bf16x8 fa[8], fb[8]; u32x2 ua, ub; float ga, gb;
    GDN_LOADF(fa, ua, ga, 0);
    f32x4 S = {0.f, 0.f, 0.f, 0.f};
    __syncthreads();
#define GDN_CHUNK(c, CUR, UC, GC, NXT, UN, GN) do { \
        if ((c) + 1 < T / 64) GDN_LOADF(NXT, UN, GN, (c) + 1); \
        f32x4 a0 = {0.f, 0.f, 0.f, 0.f}; \
        _Pragma("unroll") for (int kk = 0; kk < 4; ++kk) a0 = MFMA16(CUR[kk], ldsfrag(St, LDP, r16, kk, q), a0); \
        if (lo) { u32x2 o; o.x = pk2(bf_lo(UC.x) - a0[0], bf_hi(UC.x) - a0[1]); o.y = pk2(bf_lo(UC.y) - a0[2], bf_hi(UC.y) - a0[3]); *(LAS u32x2*)(Vt + r16 * 72 + 16 * mt + 4 * q) = o; } \
        __syncthreads(); \
        const bf16x8 bV0 = ldsfrag(Vt, 72, r16, 0, q), bV1 = ldsfrag(Vt, 72, r16, 1, q); \
        if (!lo) { a0 = MFMA16(CUR[6], bV0, a0); a0 = MFMA16(CUR[7], bV1, a0); \
            _Pragma("unroll") for (int r = 0; r < 4; ++r) O[(size_t)((c) * 64 + 16 * mt + 4 * q + r) * 1024 + h * 128 + e0 + r16] = a0[r]; } \
        f32x4 sa = S * GC; sa = MFMA16(CUR[4], bV0, sa); sa = MFMA16(CUR[5], bV1, sa); S = sa; \
        { u32x2 o; o.x = pk2(S[0], S[1]); o.y = pk2(S[2], S[3]); *(LAS u32x2*)(St + r16 * LDP + 16 * w + 4 * q) = o; } \
        __syncthreads(); } while (0)
    for (int c = 0; c < T / 64; c += 2) { GDN_CHUNK(c, fa, ua, ga, fb, ub, gb); GDN_CHUNK(c + 1, fb, ub, gb, fa, ua, ga); }
#undef GDN_CHUNK
#undef GDN_LOADF
}

__device__ __forceinline__ void mixer_phase(Frame& F, int layer) {
    for (int u = F.vcu; u < 256; u += F.G) {
        if (u < 64) gdn_seq_unit(F, u);
        else if (u < 128) s5_unit(F, layer, u - 64);
        else if (u < 192) ret_seq_unit(F, u - 128);
        else ssd_seq_unit(F, u - 192);
    }
}
__device__ __forceinline__ void pre_phase(Frame& F, int layer) {
    for (int u = F.vcu; u < 1408; u += F.G) {
        if (u < 1024) gdn_pre_unit(F, layer, u >> 3, u & 7);
        else if (u < 1152) ssd_pre_unit(F, layer, (u - 1024) >> 1, (u - 1024) & 1);
        else ret_pre_unit(F, (u - 1152) >> 2, (u - 1152) & 3);
    }
}

__device__ __forceinline__ void post_phase(Frame& F, int layer) {
    const int gw = F.vcu * 8 + F.wave, NGW = F.G * 8, lane = opaque_tid() & 63;
    const bf16_t* proj = WSP(bf16_t, WS_PROJ); bf16_t* ycat = WSP(bf16_t, WS_YCAT);
    unsigned char* tm = F.ws + WS_TMP;
    const float* Or = (const float*)(tm + TM_VR); const float* Os = (const float*)(tm + TM_VS); const float* Og = (const float*)(tm + TM_VG);
    const float* gnw = FIN(6) + layer * 128; const bf16_t* XS = (const bf16_t*)(tm + TM_SXS);
    const float* sdk = FIN(21) + layer * 16; const float* snw = FIN(22) + layer * 1024;
    for (int t = gw; t < T; t += NGW) {
        const bf16_t* pr = proj + (size_t)t * NPP; bf16_t* yo = ycat + (size_t)t * 4096;
#pragma unroll
        for (int h = 0; h < 4; ++h) { f32x4 y = *(const f32x4*)(Or + (size_t)t * 1024 + h * 256 + 4 * lane);
            const float mu = wave_sum((y[0] + y[1]) + (y[2] + y[3])) * (1.f / 256.f); y = y - mu;
            const float rs = rsqrtf(wave_sum((y[0] * y[0] + y[1] * y[1]) + (y[2] * y[2] + y[3] * y[3])) * (1.f / 256.f) + LN_EPS);
            const u32x2 gw2 = *(const u32x2*)(pr + C_RG + h * 256 + 4 * lane);
            u32x2 o; o.x = pk2(y[0] * rs * siluf_(bf_lo(gw2.x)), y[1] * rs * siluf_(bf_hi(gw2.x))); o.y = pk2(y[2] * rs * siluf_(bf_lo(gw2.y)), y[3] * rs * siluf_(bf_hi(gw2.y)));
            *(u32x2*)(yo + h * 256 + 4 * lane) = o; }
#pragma unroll
        for (int h = 0; h < 8; ++h) { const f32x2 o = *(const f32x2*)(Og + (size_t)t * 1024 + h * 128 + 2 * lane);
            const float rs = rsqrtf(wave_sum(o[0] * o[0] + o[1] * o[1]) * (1.f / 128.f) + RMS_EPS);
            const unsigned zw = *(const unsigned*)(pr + C_DZ + h * 128 + 2 * lane); const f32x2 nw = *(const f32x2*)(gnw + 2 * lane);
            *(unsigned*)(yo + 1024 + h * 128 + 2 * lane) = pk2(o[0] * rs * nw[0] * siluf_(bf_lo(zw)), o[1] * rs * nw[1] * siluf_(bf_hi(zw))); }
        { float y[8][2]; float ss0 = 0.f, ss1 = 0.f;
#pragma unroll
          for (int j = 0; j < 8; ++j) { const f32x2 o = *(const f32x2*)(Os + (size_t)t * 1024 + j * 128 + 2 * lane); const float d = sdk[2 * j + (lane >> 5)];
              const unsigned zw = *(const unsigned*)(pr + C_MZ + j * 128 + 2 * lane);
              const unsigned xw = *(const unsigned*)(XS + (size_t)t * 1024 + j * 128 + 2 * lane);
              y[j][0] = (o[0] + d * bf_lo(xw)) * siluf_(bf_lo(zw)); y[j][1] = (o[1] + d * bf_hi(xw)) * siluf_(bf_hi(zw));
              const float s2 = y[j][0] * y[j][0] + y[j][1] * y[j][1]; if (j < 4) ss0 += s2; else ss1 += s2; }
          const float r0 = rsqrtf(wave_sum(ss0) * (1.f / 512.f) + RMS_EPS), r1 = rsqrtf(wave_sum(ss1) * (1.f / 512.f) + RMS_EPS);
#pragma unroll
          for (int j = 0; j < 8; ++j) { const float rs = j < 4 ? r0 : r1; const f32x2 nw = *(const f32x2*)(snw + j * 128 + 2 * lane);
              *(unsigned*)(yo + 3072 + j * 128 + 2 * lane) = pk2(y[j][0] * rs * nw[0], y[j][1] * rs * nw[1]); } }
    }
}

__device__ __forceinline__ void ln_phase(Frame& F, const float* in, const float* gam, const float* bet, float* outf, bf16_t* outb) {
    const int gw = F.vcu * 8 + F.wave, NGW = F.G * 8, lane = opaque_tid() & 63;
    for (int t = gw; t < T; t += NGW) {
        const f32x4* xr = (const f32x4*)(in + (size_t)t * DM) + lane;
        f32x4 v[8]; float s = 0.f;
#pragma unroll
        for (int j = 0; j < 8; ++j) { v[j] = xr[64 * j]; s += (v[j][0] + v[j][1]) + (v[j][2] + v[j][3]); }
        const float mean = wave_sum(s) * (1.f / DM); float s2 = 0.f;
#pragma unroll
        for (int j = 0; j < 8; ++j) { v[j] = v[j] - mean; s2 += (v[j][0] * v[j][0] + v[j][1] * v[j][1]) + (v[j][2] * v[j][2] + v[j][3] * v[j][3]); }
        const float rstd = rsqrtf(wave_sum(s2) * (1.f / DM) + LN_EPS);
#pragma unroll
        for (int j = 0; j < 8; ++j) { const f32x4 gm = *((const f32x4*)gam + lane + 64 * j), bt = *((const f32x4*)bet + lane + 64 * j);
            const f32x4 o = v[j] * rstd * gm + bt;
            *((f32x4*)(outf + (size_t)t * DM) + lane + 64 * j) = o;
            u32x2 w; w.x = pk2(o[0], o[1]); w.y = pk2(o[2], o[3]); *((u32x2*)(outb + (size_t)t * DM) + lane + 64 * j) = w; }
    }
}

constexpr int N_PHASES = 1 + 10 * NLAYER;
__global__ void __launch_bounds__(512, 2) mega(Args args) {
    extern __shared__ __attribute__((aligned(16))) unsigned char lds_raw[];
    Frame F;
    F.lds = (LAS unsigned char*)lds_raw;
    F.tid = threadIdx.x; F.lane = F.tid & 63; F.wave = __builtin_amdgcn_readfirstlane(F.tid >> 6);
    F.G = gridDim.x; { const int bx = blockIdx.x; F.vcu = (F.G % 8 == 0) ? (bx % 8) * (F.G / 8) + bx / 8 : bx; }
    F.in = args.in; F.ws = args.ws; F.out = args.out;
    for (int u = F.tid; u < (LDS_BYTES - LDSCTL_OFF) / 4; u += 512) ((LAS unsigned*)(F.lds + LDSCTL_OFF))[u] = 0u;
    __syncthreads();
    const int lo = args.ph_lo, hi = args.ph_hi;
    unsigned* barw = (unsigned*)(args.ws + WS_CTL) + CW_BAR + args.li * XCD_BAR_WORDS;
    XcdBarrier bar; bar.bar = barw; bar.x = 0; bar.st = nullptr;
    if (hi - lo > 1) bar = xcd_barrier_post(barw, (volatile LAS unsigned*)(F.lds + MISC_OFF) + 8);
#define IN(k) (lo <= (k) && (k) < hi)
#define SEAM(k) do { if ((k) + 1 < hi) xcd_barrier(bar); } while (0)

    if (IN(0)) { p0_prologue(F); if (REPMASK & 1) { xcd_barrier(bar); p0_prologue(F); } SEAM(0); }

    for (int layer = 0; layer < NLAYER; ++layer) {
        const int pb = 1 + 10 * layer;
        unsigned char* wt = F.ws + WS_WT + (size_t)layer * WT_LAYER;
        const float* xcur = layer == 0 ? FIN(0) : WSP(float, WS_XR0);
#define B_INPROJ do { pg8::Gemm g{WSP(bf16_t, WS_XB), (const bf16_t*)(wt + WT_IN), T, NPP, DM, DM, DM, 0, 0}; pg8::StaticOrder S; S.init(T, NPP, F.G, (int)blockIdx.x); \
            pg8::EpiProj E{WSP(bf16_t, WS_PROJ), WSP(float, WS_SMALL)}; pg8::gemm_phase<pg8::EpiProj, pg8::StaticOrder, true, true>(F.lds, g, S, E); } while (0)
#define B_PREP pre_phase(F, layer)
#define B_MIX mixer_phase(F, layer)
#define B_GLUPOST do { pg8::Gemm g{WSP(bf16_t, WS_YS5), (const bf16_t*)(wt + WT_GLU), T, 1024, 1024, 1024, 1024, 0, 0}; pg8::StaticOrder S; S.init(T, 1024, F.G, (int)blockIdx.x); \
            pg8::EpiGlu E{WSP(bf16_t, WS_YS5), FIN(16) + layer * 1024, WSP(bf16_t, WS_YCAT)}; pg8::gemm_phase<pg8::EpiGlu, pg8::StaticOrder, true, true>(F.lds, g, S, E); post_phase(F, layer); } while (0)
#define B_MERGE do { pg8::Gemm g{WSP(bf16_t, WS_YCAT), (const bf16_t*)(wt + WT_BR), T, DM, 1024, 4096, 1024, 2048, 4 * MiB}; pg8::SegOrder<4> S; S.init(T, DM, F.G, (int)blockIdx.x); \
            pg8::EpiMerge E{WSP(bf16_t, WS_PROJ), (float*)(F.ws + WS_TMP + TM_PRE), (bf16_t*)(F.ws + WS_TMP + TM_MERGED)}; pg8::gemm_phase<pg8::EpiMerge, pg8::SegOrder<4>, true, true>(F.lds, g, S, E); } while (0)
#define B_WOUT do { pg8::Gemm g{(const bf16_t*)(F.ws + WS_TMP + TM_MERGED), (const bf16_t*)(wt + WT_OUT), T, DM, DM, DM, DM, 0, 0}; pg8::StaticOrder S; S.init(T, DM, F.G, (int)blockIdx.x); \
            pg8::EpiResid E{xcur, (float*)(F.ws + WS_TMP + TM_PRE)}; pg8::gemm_phase<pg8::EpiResid, pg8::StaticOrder, true, true>(F.lds, g, S, E); } while (0)
#define B_LN1 ln_phase(F, (const float*)(F.ws + WS_TMP + TM_PRE), FIN(28) + layer * DM, FIN(29) + layer * DM, WSP(float, WS_XR1), WSP(bf16_t, WS_XB))
#define B_UP do { pg8::Gemm g{WSP(bf16_t, WS_XB), (const bf16_t*)(wt + WT_UP), T, DFF, DM, DM, DM, 0, 0}; pg8::StaticOrder S; S.init(T, DFF, F.G, (int)blockIdx.x); \
            pg8::EpiRelu2 E{WSP(bf16_t, WS_HID)}; pg8::gemm_phase<pg8::EpiRelu2, pg8::StaticOrder, true, true>(F.lds, g, S, E); } while (0)
#define B_DOWN do { pg8::Gemm g{WSP(bf16_t, WS_HID), (const bf16_t*)(wt + WT_DOWN), T, DM, DFF, DFF, DFF, 0, 0}; pg8::StaticOrder S; S.init(T, DM, F.G, (int)blockIdx.x); \
            pg8::EpiResid E{WSP(float, WS_XR1), (float*)(F.ws + WS_TMP + TM_PRE)}; pg8::gemm_phase<pg8::EpiResid, pg8::StaticOrder, true, true>(F.lds, g, S, E); } while (0)
#define B_LN2 ln_phase(F, (const float*)(F.ws + WS_TMP + TM_PRE), FIN(32) + layer * DM, FIN(33) + layer * DM, layer == NLAYER - 1 ? F.out : WSP(float, WS_XR0), WSP(bf16_t, WS_XB))
#define PH(k, body) do { if (IN(pb + (k))) { body; if ((REPMASK >> ((k) + 1)) & 1) { xcd_barrier(bar); body; } SEAM(pb + (k)); } } while (0)
        PH(0, B_INPROJ);
        PH(1, B_PREP);
        if (IN(pb + 2)) { B_MIX; if ((REPMASK >> 3) & 1) { xcd_barrier(bar); B_PREP; xcd_barrier(bar); B_MIX; } SEAM(pb + 2); }
        PH(3, B_GLUPOST);
        PH(4, B_MERGE);
        PH(5, B_WOUT);
        PH(6, B_LN1);
        PH(7, B_UP);
        PH(8, B_DOWN);
        PH(9, B_LN2);
    }
#undef IN
#undef SEAM
}

extern "C" void kernel_launch(void* const* d_in, const int* in_sizes, int n_in, void* d_out, int out_size, void* d_ws, size_t ws_size, hipStream_t stream) {
    static int grid = 0;
    if (grid == 0) {
        if (n_in != 34 || out_size != T * DM || ws_size < WS_END) { fprintf(stderr, "kernel_launch: unexpected sizes (n_in %d, out %d, ws %zu need %zu)\n", n_in, out_size, ws_size, (size_t)WS_END); grid = -1; return; }
        int dev = 0, cus = 0, per_cu = 0;
        if (hipGetDevice(&dev) != hipSuccess || hipDeviceGetAttribute(&cus, hipDeviceAttributeMultiprocessorCount, dev) != hipSuccess) { grid = -1; return; }
        if (hipFuncSetAttribute((const void*)mega, hipFuncAttributeMaxDynamicSharedMemorySize, LDS_BYTES) != hipSuccess) { fprintf(stderr, "kernel_launch: hipFuncSetAttribute failed\n"); grid = -1; return; }
        if (hipOccupancyMaxActiveBlocksPerMultiprocessor(&per_cu, (const void*)mega, 512, LDS_BYTES) != hipSuccess || per_cu < 1) fprintf(stderr, "kernel_launch: occupancy query reports %d\n", per_cu);
        (void)hipGetLastError();
        grid = cus;
    }
    if (grid < 0) return;
    if (hipMemsetAsync((char*)d_ws + WS_CTL, 0, CTL_ZERO_BYTES, stream) != hipSuccess) return;
    Args a{};
    for (int i = 0; i < 34; ++i) a.in[i] = d_in[i];
    a.out = (float*)d_out; a.ws = (unsigned char*)d_ws;
#if MK_N_LAUNCHES == 1
    a.ph_lo = 0; a.ph_hi = N_PHASES; a.li = 0;
    hipLaunchKernelGGL(mega, dim3(grid), dim3(512), LDS_BYTES, stream, a);
#else
    for (int p = 0; p < N_PHASES; ++p) { a.ph_lo = p; a.ph_hi = p + 1; a.li = p; hipLaunchKernelGGL(mega, dim3(grid), dim3(512), LDS_BYTES, stream, a); }
#endif
}
```

```cpp
#include <hip/hip_runtime.h>
#include <cstdio>
#include <cstdint>

#ifndef MK_N_LAUNCHES
#define MK_N_LAUNCHES 1
#endif

#ifndef MIXREP
#define MIXREP 0
#endif
#ifndef REPMASK
#define REPMASK 0
#endif
#define LAS __attribute__((address_space(3)))
#define GAS __attribute__((address_space(1)))
typedef unsigned short bf16_t;
typedef short bf16x8 __attribute__((ext_vector_type(8)));
typedef float f32x4 __attribute__((ext_vector_type(4)));
typedef float f32x2 __attribute__((ext_vector_type(2)));
typedef unsigned u32x4 __attribute__((ext_vector_type(4)));
typedef unsigned u32x2 __attribute__((ext_vector_type(2)));

constexpr int T = 8192, DM = 2048, NPROJ = 18976, NPP = 19200, NP_MAIN = 18432, DFF = 8192, NLAYER = 2;
constexpr int C_RQ = 0, C_RK = 512, C_RV = 1024, C_RG = 2048, C_DQ = 3072, C_DK = 4096, C_DV = 5120, C_DZ = 6144, C_DA = 7168, C_DB = 7176,
              C_SU = 7184, C_MZ = 8208, C_MX = 9232, C_MB = 10256, C_MC = 10512, C_MDT = 10768, C_GATE = 10784;
constexpr float LN_EPS = 1e-5f, RMS_EPS = 1e-6f, ALPHA = 1.41421356237f;

constexpr size_t MiB = 1u << 20;
constexpr size_t WS_CTL = 0, CTL_ZERO_BYTES = 1 * MiB;
constexpr size_t WT_IN = 0, WT_GLU = 75 * MiB, WT_BR = 77 * MiB, WT_OUT = 93 * MiB, WT_UP = 101 * MiB, WT_DOWN = 133 * MiB, WT_LAYER = 165 * MiB;
constexpr size_t WS_WT = 1 * MiB;
constexpr size_t WS_PROJ = WS_WT + 2 * WT_LAYER;
constexpr size_t WS_HID = WS_PROJ;
constexpr size_t WS_SMALL = WS_PROJ + 300 * MiB;
constexpr size_t WS_TRIG = WS_SMALL + 1 * MiB;
constexpr size_t WS_S5P = WS_TRIG + 4 * MiB;
constexpr size_t WS_YCAT = WS_S5P + 2 * MiB;
constexpr size_t WS_YS5 = WS_YCAT + 64 * MiB;
constexpr size_t WS_XB = WS_YS5 + 16 * MiB;
constexpr size_t WS_XR0 = WS_XB + 32 * MiB;
constexpr size_t WS_XR1 = WS_XR0 + 64 * MiB;
constexpr size_t WS_TMP = WS_XR1 + 64 * MiB;
constexpr size_t TM_KR = 0, TM_VR = 32 * MiB,
                 TM_SCB = 64 * MiB, TM_SSL = 72 * MiB, TM_SXD = 104 * MiB, TM_SXS = 120 * MiB, TM_SAC = 136 * MiB, TM_VS = 138 * MiB,
                 TM_KG = 170 * MiB, TM_VG = 242 * MiB, TM_SM = 274 * MiB, TM_END = 278 * MiB;
constexpr size_t TM_MERGED = 0, TM_PRE = 32 * MiB;
constexpr size_t WS_END = WS_TMP + TM_END;
constexpr int CW_BAR = 4096;

constexpr int RING_BYTES = 131072, LDSCTL_OFF = 155648, MISC_OFF = LDSCTL_OFF + 320, LDS_BYTES = 163840;

__device__ __forceinline__ unsigned f2bf(float f) { unsigned u = __builtin_bit_cast(unsigned, f); return (u + 0x7fffu + ((u >> 16) & 1u)) >> 16; }
__device__ __forceinline__ unsigned pk2(float lo, float hi) { return f2bf(lo) | (f2bf(hi) << 16); }
__device__ __forceinline__ float bf_lo(unsigned u) { return __builtin_bit_cast(float, u << 16); }
__device__ __forceinline__ float bf_hi(unsigned u) { return __builtin_bit_cast(float, u & 0xffff0000u); }
__device__ __forceinline__ float bf2f(bf16_t h) { return __builtin_bit_cast(float, (unsigned)h << 16); }
__device__ __forceinline__ float sigmoidf_(float x) { return 1.f / (1.f + __expf(-x)); }
__device__ __forceinline__ float siluf_(float x) { return x / (1.f + __expf(-x)); }
__device__ __forceinline__ float softplusf_(float x) { return x > 20.f ? x : log1pf(__expf(x)); }
template <int CTRL> __device__ __forceinline__ float dppf(float v) { return __builtin_bit_cast(float, __builtin_amdgcn_update_dpp(0, __builtin_bit_cast(int, v), CTRL, 0xF, 0xF, true)); }
__device__ __forceinline__ float row_sum16(float v) {
    v += dppf<0xB1>(v); v += dppf<0x4E>(v); v += dppf<0x141>(v); v += dppf<0x140>(v); return v;
}
__device__ __forceinline__ float wave_sum(float v) { v = row_sum16(v); v += __shfl_xor(v, 16); v += __shfl_xor(v, 32); return v; }
__device__ __forceinline__ void sincos_d(double x, double& s, double& c) {
    const double k = __builtin_rint(x * 0.63661977236758134308);
    double r = __builtin_fma(-k, 1.57079632679489655800e+00, x);
    r = __builtin_fma(-k, 6.12323399573676603587e-17, r);
    const double r2 = r * r;
    double sp = 1.58969099521155010221e-10;
    sp = __builtin_fma(sp, r2, -2.50507602534068634195e-08);
    sp = __builtin_fma(sp, r2, 2.75573137070700676789e-06);
    sp = __builtin_fma(sp, r2, -1.98412698298579493134e-04);
    sp = __builtin_fma(sp, r2, 8.33333333332248946124e-03);
    sp = __builtin_fma(sp, r2, -1.66666666666666324348e-01);
    const double sn = __builtin_fma(sp * r2, r, r);
    double cp = -1.13596475577881948265e-11;
    cp = __builtin_fma(cp, r2, 2.08757232129817482790e-09);
    cp = __builtin_fma(cp, r2, -2.75573143513906633035e-07);
    cp = __builtin_fma(cp, r2, 2.48015872894767294178e-05);
    cp = __builtin_fma(cp, r2, -1.38888888888741095749e-03);
    cp = __builtin_fma(cp, r2, 4.16666666666666019037e-02);
    const double cs = __builtin_fma(cp * r2, r2, __builtin_fma(-0.5, r2, 1.0));
    const long q = (long)k & 3;
    s = (q == 0) ? sn : (q == 1) ? cs : (q == 2) ? -sn : -cs;
    c = (q == 0) ? cs : (q == 1) ? -sn : (q == 2) ? -cs : sn;
}

namespace pg8 {
constexpr int BM = 256, BK = 64, HALF = 128, HTB = HALF * BK * 2, STAGE_BYTES = 8 * HTB, NXCD = 8, WGM = 8;
__host__ __device__ __forceinline__ int lds_byte(int r, int c) { const int st = (r >> 4) * 2 + (c >> 5), rr = r & 15, cc = c & 31, ob = rr * 64 + cc * 2; return st * 1024 + (ob ^ (((ob >> 9) & 1) << 5)); }
__host__ __device__ __forceinline__ void stage_rc(int b, int& R, int& C) { const int st = b / 1024, sb = b % 1024, swz = sb ^ (((sb >> 9) & 1) << 5); R = (st >> 1) * 16 + swz / 64; C = (st & 1) * 32 + (swz % 64) / 2; }
__host__ __device__ __forceinline__ int perm32(int rho) { const int n = rho >> 4, i = rho & 15; return 8 * (i >> 2) + 4 * n + (i & 3); }

struct Unit { int pm, pn, seg; };
struct Gemm { const bf16_t* A; const bf16_t* Bt; int M, N, K, lda, ldb; size_t segA, segB; };

__host__ __device__ __forceinline__ void tile_of(long L, int nM, int nN, int& pm, int& pn) {
    const int nwg = nM * nN; int wgid = (int)L;
    { const int q = nwg / NXCD, r = nwg % NXCD, xcd = wgid % NXCD, off = wgid / NXCD; wgid = (xcd < r ? xcd * (q + 1) : r * (q + 1) + (xcd - r) * q) + off; }
    const int nig = WGM * nN, gid = wgid / nig, fm = gid * WGM, gsz = (nM - fm) < WGM ? (nM - fm) : WGM;
    pm = fm + ((wgid % nig) % gsz); pn = (wgid % nig) / gsz;
}
struct StaticOrder {
    int nM, nN, nwg, G, c;
    __host__ __device__ void init(int M, int N, int G_, int c_) { nM = M / BM; nN = N / BM; nwg = nM * nN; G = G_; c = c_; }
    __host__ __device__ bool next(int i, Unit& u) const {
        const long L = (long)i * G + c; if (L >= nwg) return false;
        tile_of(L, nM, nN, u.pm, u.pn); u.seg = 0; return true;
    }
    __device__ __forceinline__ void a_ready(const Unit&) const {}
    __device__ __forceinline__ void done(const Unit&) const {}
};
template <int NSEG> struct SegOrder {
    int nM, nN, nwg, G, c;
    __host__ __device__ void init(int M, int N, int G_, int c_) { nM = M / BM; nN = N / BM; nwg = nM * nN; G = G_; c = c_; }
    __host__ __device__ bool next(int i, Unit& u) const {
        const long L = (long)(i / NSEG) * G + c; if (L >= nwg) return false;
        tile_of(L, nM, nN, u.pm, u.pn); u.seg = i % NSEG; return true;
    }
    __device__ __forceinline__ void a_ready(const Unit&) const {}
    __device__ __forceinline__ void done(const Unit&) const {}
};

struct DeferOrder {
    int nM, nunits, G, c;
    __host__ __device__ void init(int M, int N, int G_, int c_) { nM = M / BM; nunits = nM * (N / BM); G = G_; c = c_; }
    __host__ __device__ bool next(int i, Unit& u) const { const long L = (long)i * G + c; if (L >= nunits) return false; u.pm = (int)(L % nM); u.pn = (int)(L / nM); u.seg = 0; return true; }
    __device__ __forceinline__ void a_ready(const Unit&) const {}
    __device__ __forceinline__ void done(const Unit&) const {}
};
__device__ __forceinline__ unsigned cvt_pk_bf16(float lo, float hi) { unsigned r; asm volatile("v_cvt_pk_bf16_f32 %0, %1, %2" : "=v"(r) : "v"(lo), "v"(hi)); return r; }


template <class Epi, class Sched, bool ALIGN_EPI = false, bool SP2 = false>
__device__ __forceinline__ void gemm_phase(LAS unsigned char* lds, const Gemm g, const Sched& S, const Epi& E) {
    int tid = threadIdx.x; asm volatile("" : "+v"(tid));
    const int wid = __builtin_amdgcn_readfirstlane(tid >> 6), lane = tid & 63, wr = wid >> 2, wc = wid & 3, fr = lane & 15, fq = lane >> 4;
    const int K = g.K, nt = K / BK;
    unsigned voffA[2], voffB[2];
#pragma unroll
    for (int i = 0; i < 2; ++i) { int R, C; stage_rc(tid * 16 + i * 8192, R, C); const int Rb = Epi::PERM ? ((R & ~31) + perm32(R & 31)) : R;
        voffA[i] = (unsigned)(R * g.lda + C) * 2u; voffB[i] = (unsigned)(Rb * g.ldb + C) * 2u; }
    const size_t kstep = (size_t)(BK * 2);
    const size_t hstepA = (size_t)HALF * g.lda * 2, hstepB = (size_t)HALF * g.ldb * 2;
    const size_t tstepA = 2 * hstepA, tstepB = 2 * hstepB;
    const unsigned ldsw = (unsigned)wid * 1024u;
    const int aoff = lds_byte(wr * 64 + fr, fq * 8), boff = lds_byte(wc * 32 + fr, fq * 8);
#define PG8_SA(b, h) (((b) * 2 + (h)) * HTB)
#define PG8_SB(b, h) ((4 + (b) * 2 + (h)) * HTB)
#define PG8_STAGE(bufoff, gbase, voff) do { _Pragma("unroll") for (int _i = 0; _i < 2; ++_i) \
        __builtin_amdgcn_global_load_lds((const unsigned*)((const char*)(gbase) + (voff)[_i]), (LAS unsigned*)(lds + (bufoff) + ldsw + _i * 8192), 16, 0, 0); } while (0)
#define PG8_LDA(dst, b, h) do { _Pragma("unroll") for (int m = 0; m < 4; ++m) _Pragma("unroll") for (int k = 0; k < 2; ++k) dst[m][k] = *(const LAS bf16x8*)(lds + PG8_SA(b, h) + aoff + m * 2048 + k * 1024); } while (0)
#define PG8_LDB(dst, b, h) do { _Pragma("unroll") for (int n = 0; n < 2; ++n) _Pragma("unroll") for (int k = 0; k < 2; ++k) dst[n][k] = *(const LAS bf16x8*)(lds + PG8_SB(b, h) + boff + n * 2048 + k * 1024); } while (0)
#define PG8_MMA(ai, bj, At, Bt) do { __builtin_amdgcn_s_setprio(1); _Pragma("unroll") for (int m = 0; m < 4; ++m) _Pragma("unroll") for (int n = 0; n < 2; ++n) _Pragma("unroll") for (int k = 0; k < 2; ++k) \
        acc[ai][bj][m][n] = __builtin_amdgcn_mfma_f32_16x16x32_bf16(Bt[n][k], At[m][k], acc[ai][bj][m][n], 0, 0, 0); __builtin_amdgcn_s_setprio(0); } while (0)
#define PG8_WAIT_V(n) asm volatile("s_waitcnt vmcnt(" #n ")" ::: "memory")
#define PG8_WAIT_L(n) asm volatile("s_waitcnt lgkmcnt(" #n ")" ::: "memory")
#define PG8_BAR __builtin_amdgcn_s_barrier()
#define PG8_SCHED __builtin_amdgcn_sched_barrier(0)
    Unit cur, nxt; int ui = 0;
    if (!S.next(0, cur)) return;
    f32x4 acc[2][2][4][2];
#pragma unroll
    for (int a = 0; a < 2; ++a)
#pragma unroll
        for (int b = 0; b < 2; ++b)
#pragma unroll
            for (int m = 0; m < 4; ++m)
#pragma unroll
                for (int n = 0; n < 2; ++n) acc[a][b][m][n] = (f32x4){0.f, 0.f, 0.f, 0.f};
    bf16x8 At[4][2], B0[2][2], B1[2][2];
    const char* cA = (const char*)g.A + (size_t)cur.seg * g.segA + (size_t)cur.pm * tstepA; const char* cB = (const char*)g.Bt + (size_t)cur.seg * g.segB + (size_t)cur.pn * tstepB;
    S.a_ready(cur);
    if constexpr (SP2) {
        PG8_STAGE(PG8_SB(0, 0), cB, voffB); PG8_STAGE(PG8_SB(0, 1), cB + hstepB, voffB); PG8_STAGE(PG8_SA(0, 0), cA, voffA); PG8_STAGE(PG8_SA(0, 1), cA + hstepA, voffA);
        if (wr == 1) PG8_BAR;
        PG8_WAIT_V(2); PG8_BAR;
        PG8_STAGE(PG8_SB(1, 0), cB + kstep, voffB); PG8_STAGE(PG8_SA(1, 0), cA + kstep, voffA); PG8_STAGE(PG8_SB(1, 1), cB + hstepB + kstep, voffB);
        PG8_WAIT_V(6); PG8_BAR;
    } else {
        PG8_STAGE(PG8_SB(0, 0), cB, voffB); PG8_STAGE(PG8_SA(0, 0), cA, voffA); PG8_STAGE(PG8_SB(0, 1), cB + hstepB, voffB); PG8_STAGE(PG8_SA(0, 1), cA + hstepA, voffA);
        if (wr == 1) PG8_BAR;
        PG8_WAIT_V(4); PG8_BAR;
        PG8_STAGE(PG8_SB(1, 0), cB + kstep, voffB); PG8_STAGE(PG8_SA(1, 0), cA + kstep, voffA); PG8_STAGE(PG8_SB(1, 1), cB + hstepB + kstep, voffB);
        PG8_WAIT_V(6); PG8_BAR;
    }
    for (;;) {
        const bool has_next = S.next(ui + 1, nxt);
        const char* nA = has_next ? (const char*)g.A + (size_t)nxt.seg * g.segA + (size_t)nxt.pm * tstepA : cA;
        const char* nB = has_next ? (const char*)g.Bt + (size_t)nxt.seg * g.segB + (size_t)nxt.pn * tstepB : cB;
        for (int t = 0; t < nt; t += 2) {
            const bool last = (t == nt - 2);
            const char* a1 = cA + (size_t)(t + 1) * kstep;
            const char* a2 = last ? nA : cA + (size_t)(t + 2) * kstep; const char* b2 = last ? nB : cB + (size_t)(t + 2) * kstep;
            const char* a3 = a2 + kstep; const char* b3 = b2 + kstep;
            if (last && has_next) S.a_ready(nxt);
            if constexpr (SP2) {
            PG8_LDB(B0, 0, 0); PG8_LDB(B1, 0, 1); PG8_SCHED; PG8_LDA(At, 0, 0); PG8_STAGE(PG8_SA(1, 1), a1 + hstepA, voffA);
            PG8_WAIT_V(8); PG8_WAIT_L(0); PG8_BAR; PG8_MMA(0, 0, At, B0); PG8_MMA(0, 1, At, B1); PG8_BAR; PG8_SCHED;
            PG8_LDA(At, 0, 1); PG8_STAGE(PG8_SB(0, 0), b2, voffB); PG8_STAGE(PG8_SB(0, 1), b2 + hstepB, voffB); PG8_STAGE(PG8_SA(0, 0), a2, voffA);
            PG8_WAIT_V(8); PG8_WAIT_L(0); PG8_BAR; PG8_MMA(1, 0, At, B0); PG8_MMA(1, 1, At, B1); PG8_BAR; PG8_SCHED;
            PG8_LDB(B0, 1, 0); PG8_LDB(B1, 1, 1); PG8_SCHED; PG8_LDA(At, 1, 0); PG8_STAGE(PG8_SA(0, 1), a2 + hstepA, voffA);
            PG8_WAIT_V(8); PG8_WAIT_L(0); PG8_BAR; PG8_MMA(0, 0, At, B0); PG8_MMA(0, 1, At, B1); PG8_BAR; PG8_SCHED;
            PG8_LDA(At, 1, 1); PG8_STAGE(PG8_SB(1, 0), b3, voffB); PG8_STAGE(PG8_SB(1, 1), b3 + hstepB, voffB); PG8_STAGE(PG8_SA(1, 0), a3, voffA);
            PG8_WAIT_V(8); PG8_WAIT_L(0); PG8_BAR; PG8_MMA(1, 0, At, B0); PG8_MMA(1, 1, At, B1); PG8_BAR; PG8_SCHED;
            } else {
            PG8_LDB(B0, 0, 0); PG8_SCHED; PG8_LDA(At, 0, 0); PG8_STAGE(PG8_SA(1, 1), a1 + hstepA, voffA);
            PG8_WAIT_L(8); PG8_BAR; PG8_WAIT_L(0); PG8_MMA(0, 0, At, B0); PG8_BAR; PG8_SCHED;
            PG8_LDB(B1, 0, 1); PG8_STAGE(PG8_SB(0, 0), b2, voffB);
            PG8_BAR; PG8_WAIT_L(0); PG8_MMA(0, 1, At, B1); PG8_BAR;
            PG8_LDA(At, 0, 1); PG8_STAGE(PG8_SA(0, 0), a2, voffA);
            PG8_BAR; PG8_WAIT_L(0); PG8_MMA(1, 0, At, B0); PG8_BAR; PG8_SCHED;
            PG8_STAGE(PG8_SB(0, 1), b2 + hstepB, voffB);
            PG8_WAIT_V(6); PG8_BAR; PG8_MMA(1, 1, At, B1); PG8_BAR;
            PG8_LDB(B0, 1, 0); PG8_SCHED; PG8_LDA(At, 1, 0); PG8_STAGE(PG8_SA(0, 1), a2 + hstepA, voffA);
            PG8_WAIT_L(8); PG8_BAR; PG8_WAIT_L(0); PG8_MMA(0, 0, At, B0); PG8_BAR; PG8_SCHED;
            PG8_LDB(B1, 1, 1); PG8_STAGE(PG8_SB(1, 0), b3, voffB);
            PG8_BAR; PG8_WAIT_L(0); PG8_MMA(0, 1, At, B1); PG8_BAR;
            PG8_LDA(At, 1, 1); PG8_STAGE(PG8_SA(1, 0), a3, voffA);
            PG8_BAR; PG8_WAIT_L(0); PG8_MMA(1, 0, At, B0); PG8_BAR; PG8_SCHED;
            PG8_STAGE(PG8_SB(1, 1), b3 + hstepB, voffB);
            PG8_WAIT_V(6); PG8_BAR; PG8_MMA(1, 1, At, B1); PG8_BAR;
            }
        }
        if constexpr (ALIGN_EPI) { if (wr == 0) PG8_BAR; }
        { int tz = threadIdx.x; asm volatile("" : "+v"(tz));
          const int l2 = tz & 63; E(acc, cur, wr, wc, l2 & 15, l2 >> 4, tz); }
        S.done(cur);
        if (!has_next) break;
#pragma unroll
        for (int a = 0; a < 2; ++a)
#pragma unroll
            for (int b = 0; b < 2; ++b)
#pragma unroll
                for (int m = 0; m < 4; ++m)
#pragma unroll
                    for (int n = 0; n < 2; ++n) acc[a][b][m][n] = (f32x4){0.f, 0.f, 0.f, 0.f};
        cur = nxt; cA = nA; cB = nB; ++ui;
        if constexpr (ALIGN_EPI) { if (wr == 1) PG8_BAR; }
    }
    PG8_WAIT_V(0);
    if constexpr (!ALIGN_EPI) { if (wr == 0) PG8_BAR; }
    PG8_BAR;
#undef PG8_SA
#undef PG8_SB
#undef PG8_STAGE
#undef PG8_LDA
#undef PG8_LDB
#undef PG8_MMA
#undef PG8_WAIT_V
#undef PG8_WAIT_L
#undef PG8_BAR
#undef PG8_SCHED
}

struct EpiProj {
    static constexpr bool PERM = true;
    bf16_t* O; float* small;
    __device__ __forceinline__ void operator()(const f32x4 (&acc)[2][2][4][2], const Unit& u, int wr, int wc, int fr, int fq, int tz) const {
        const int row0 = u.pm * BM + wr * 64 + fr, col0 = u.pn * BM + wc * 32 + 8 * fq;
#pragma unroll
        for (int ai = 0; ai < 2; ++ai)
#pragma unroll
            for (int m = 0; m < 4; ++m) { const int row = row0 + ai * HALF + m * 16; bf16_t* rowp = O + (size_t)row * NPP + col0;
#pragma unroll
                for (int bj = 0; bj < 2; ++bj) { const f32x4 v0 = acc[ai][bj][m][0], v1 = acc[ai][bj][m][1];
                    u32x4 w; w.x = cvt_pk_bf16(v0[0], v0[1]); w.y = cvt_pk_bf16(v0[2], v0[3]); w.z = cvt_pk_bf16(v1[0], v1[1]); w.w = cvt_pk_bf16(v1[2], v1[3]);
                    *(u32x4*)(rowp + bj * HALF) = w;
                    const int col = col0 + bj * HALF;
                    int si = -1; if (col == C_DA) si = 0; else if (col == C_DB) si = 8; else if (col == C_MDT) si = 16; else if (col == C_MDT + 8) si = 24;
                    if (si >= 0) { float* sp = small + (size_t)row * 32 + si; *(f32x4*)sp = v0; *(f32x4*)(sp + 4) = v1; } } }
    }
};
struct EpiGlu {
    static constexpr bool PERM = true;
    const bf16_t* Y; const float* bias; bf16_t* O;
    __device__ __forceinline__ void operator()(const f32x4 (&acc)[2][2][4][2], const Unit& u, int wr, int wc, int fr, int fq, int tz) const {
        const int row0 = u.pm * BM + wr * 64 + fr, col0 = u.pn * BM + wc * 32 + 8 * fq;
#pragma unroll
        for (int ai = 0; ai < 2; ++ai)
#pragma unroll
            for (int m = 0; m < 4; ++m) { const int row = row0 + ai * HALF + m * 16;
#pragma unroll
                for (int bj = 0; bj < 2; ++bj) { const int col = col0 + bj * HALF;
                    const f32x4 b0 = *(const f32x4*)(bias + col), b1 = *(const f32x4*)(bias + col + 4);
                    const u32x4 yw = *(const u32x4*)(Y + (size_t)row * 1024 + col);
                    const f32x4 v0 = acc[ai][bj][m][0] + b0, v1 = acc[ai][bj][m][1] + b1;
                    float o[8];
                    o[0] = bf_lo(yw.x) * sigmoidf_(v0[0]); o[1] = bf_hi(yw.x) * sigmoidf_(v0[1]); o[2] = bf_lo(yw.y) * sigmoidf_(v0[2]); o[3] = bf_hi(yw.y) * sigmoidf_(v0[3]);
                    o[4] = bf_lo(yw.z) * sigmoidf_(v1[0]); o[5] = bf_hi(yw.z) * sigmoidf_(v1[1]); o[6] = bf_lo(yw.w) * sigmoidf_(v1[2]); o[7] = bf_hi(yw.w) * sigmoidf_(v1[3]);
                    u32x4 w; w.x = cvt_pk_bf16(o[0], o[1]); w.y = cvt_pk_bf16(o[2], o[3]); w.z = cvt_pk_bf16(o[4], o[5]); w.w = cvt_pk_bf16(o[6], o[7]);
                    *(u32x4*)(O + (size_t)row * 4096 + 2048 + col) = w; asm volatile("" ::: "memory"); } }
    }
};
struct EpiMerge {
    static constexpr bool PERM = true;
    const bf16_t* proj; float* macc; bf16_t* O;
    __device__ __forceinline__ void operator()(const f32x4 (&acc)[2][2][4][2], const Unit& u, int wr, int wc, int fr, int fq, int tz) const {
        const int row0 = u.pm * BM + wr * 64 + fr, col0 = u.pn * BM + wc * 32 + 8 * fq;
        f32x4* sc = (f32x4*)(macc + (size_t)blockIdx.x * 65536) + tz;
#pragma unroll
        for (int ai = 0; ai < 2; ++ai)
#pragma unroll
            for (int m = 0; m < 4; ++m) { const int row = row0 + ai * HALF + m * 16;
#pragma unroll
                for (int bj = 0; bj < 2; ++bj) { const int col = col0 + bj * HALF;
                    const u32x4 gw = *(const u32x4*)(proj + (size_t)row * NPP + C_GATE + u.seg * 2048 + col);
                    f32x4 v0 = acc[ai][bj][m][0], v1 = acc[ai][bj][m][1];
                    v0[0] *= sigmoidf_(bf_lo(gw.x)); v0[1] *= sigmoidf_(bf_hi(gw.x)); v0[2] *= sigmoidf_(bf_lo(gw.y)); v0[3] *= sigmoidf_(bf_hi(gw.y));
                    v1[0] *= sigmoidf_(bf_lo(gw.z)); v1[1] *= sigmoidf_(bf_hi(gw.z)); v1[2] *= sigmoidf_(bf_lo(gw.w)); v1[3] *= sigmoidf_(bf_hi(gw.w));
                    const int idx = (((ai * 2 + bj) * 4 + m) * 2) * 512;
                    if (u.seg > 0) { v0 += sc[idx]; v1 += sc[idx + 512]; }
                    if (u.seg < 3) { sc[idx] = v0; sc[idx + 512] = v1; }
                    else { u32x4 w; w.x = cvt_pk_bf16(v0[0], v0[1]); w.y = cvt_pk_bf16(v0[2], v0[3]); w.z = cvt_pk_bf16(v1[0], v1[1]); w.w = cvt_pk_bf16(v1[2], v1[3]);
                        *(u32x4*)(O + (size_t)row * DM + col) = w; }
                    asm volatile("" ::: "memory"); } }
    }
};
struct EpiResid {
    static constexpr bool PERM = false;
    const float* xres; float* O;
    __device__ __forceinline__ void operator()(const f32x4 (&acc)[2][2][4][2], const Unit& u, int wr, int wc, int fr, int fq, int tz) const {
        const int row0 = u.pm * BM + wr * 64 + fr, col0 = u.pn * BM + wc * 32 + 4 * fq;
#pragma unroll
        for (int ai = 0; ai < 2; ++ai)
#pragma unroll
            for (int m = 0; m < 4; ++m) { const size_t ro = (size_t)(row0 + ai * HALF + m * 16) * DM + col0;
#pragma unroll
                for (int bj = 0; bj < 2; ++bj)
#pragma unroll
                    for (int n = 0; n < 2; ++n) { const f32x4 xr = *(const f32x4*)(xres + ro + bj * HALF + n * 16); *(f32x4*)(O + ro + bj * HALF + n * 16) = xr * ALPHA + acc[ai][bj][m][n]; } }
    }
};
struct EpiRelu2 {
    static constexpr bool PERM = true;
    bf16_t* O;
    __device__ __forceinline__ void operator()(const f32x4 (&acc)[2][2][4][2], const Unit& u, int wr, int wc, int fr, int fq, int tz) const {
        const int row0 = u.pm * BM + wr * 64 + fr, col0 = u.pn * BM + wc * 32 + 8 * fq;
#pragma unroll
        for (int ai = 0; ai < 2; ++ai)
#pragma unroll
            for (int m = 0; m < 4; ++m) { bf16_t* rowp = O + (size_t)(row0 + ai * HALF + m * 16) * DFF + col0;
#pragma unroll
                for (int bj = 0; bj < 2; ++bj) { f32x4 v0 = acc[ai][bj][m][0], v1 = acc[ai][bj][m][1];
#pragma unroll
                    for (int j = 0; j < 4; ++j) { const float a = fmaxf(v0[j], 0.f), b = fmaxf(v1[j], 0.f); v0[j] = a * a; v1[j] = b * b; }
                    u32x4 w; w.x = cvt_pk_bf16(v0[0], v0[1]); w.y = cvt_pk_bf16(v0[2], v0[3]); w.z = cvt_pk_bf16(v1[0], v1[1]); w.w = cvt_pk_bf16(v1[2], v1[3]);
                    *(u32x4*)(rowp + bj * HALF) = w; } }
    }
};
}

#define XB_TMO      128
#define XB_XCNT(j)  (256  + 64 * (j))
#define XB_XSUB(j)  (1280 + 64 * (j))
#define XB_XGEN(j)  (2304 + 64 * (j))
#define XB_TOP      3328
#define XB_TOPGEN   3392
#define XCD_BAR_WORDS 3456
#define XB_SPIN_CAP (1u << 18)
__device__ __forceinline__ unsigned xb_ld(unsigned* p)              { return __hip_atomic_load(p, __ATOMIC_RELAXED, __HIP_MEMORY_SCOPE_AGENT); }
__device__ __forceinline__ unsigned xb_add(unsigned* p, unsigned v) { return __hip_atomic_fetch_add(p, v, __ATOMIC_RELAXED, __HIP_MEMORY_SCOPE_AGENT); }
__device__ __forceinline__ unsigned xb_xcc_id() { return (unsigned)__builtin_amdgcn_s_getreg((3 << 11) | 20) & 0xFu; }
#define XB_SPIN(cond, bar) do { unsigned _sp = 0; while (cond) { __builtin_amdgcn_s_sleep(1); \
    if ((++_sp & 255u) == 0u) { if (xb_ld(&(bar)[XB_TMO])) break; if (_sp > XB_SPIN_CAP) { atomicAdd(&(bar)[XB_TMO], 1u); break; } } } } while (0)
struct XcdBarrier { unsigned* bar; unsigned x; volatile LAS unsigned* st; };
__device__ __forceinline__ XcdBarrier xcd_barrier_post(unsigned* bar, volatile LAS unsigned* st) {
    XcdBarrier b; b.bar = bar; b.x = xb_xcc_id(); b.st = st;
    if (threadIdx.x == 0) (void)xb_add(&bar[XB_XCNT(b.x)], 1u);
    return b;
}
__device__ __forceinline__ void xcd_barrier_complete(unsigned* bar, unsigned x, unsigned& nloc, unsigned& nx) {
    const unsigned G = gridDim.x * gridDim.y * gridDim.z;
    unsigned sum, cnt, mine, sp = 0u;
    for (;;) {
        sum = 0u; cnt = 0u; mine = 0u;
#pragma unroll
        for (unsigned j = 0; j < 16; ++j) { const unsigned c = xb_ld(&bar[XB_XCNT(j)]); sum += c; cnt += (c > 0u) ? 1u : 0u; mine = (j == x) ? c : mine; }
        if (sum == G) break;
        __builtin_amdgcn_s_sleep(1);
        if ((++sp & 255u) == 0u) { if (xb_ld(&bar[XB_TMO])) break; if (sp > XB_SPIN_CAP) { atomicAdd(&bar[XB_TMO], 1u); break; } }
    }
    nloc = mine > 0u ? mine : 1u; nx = cnt > 0u ? cnt : 1u;
}
__device__ __forceinline__ void xcd_barrier(const XcdBarrier& b) {
    asm volatile("s_waitcnt vmcnt(0)" ::: "memory");
    __syncthreads();
    if (threadIdx.x == 0) {
        unsigned* bar = b.bar;
        __builtin_amdgcn_s_waitcnt(0);
        unsigned nloc = b.st[0], nx = b.st[1];
        if (nloc == 0u) { xcd_barrier_complete(bar, b.x, nloc, nx); b.st[0] = nloc; b.st[1] = nx; }
        const unsigned old = xb_add(&bar[XB_XSUB(b.x)], 1u);
        const unsigned gen = old / nloc;
        if (old + 1u == (gen + 1u) * nloc) {
            __builtin_amdgcn_fence(__ATOMIC_RELEASE, "agent");
            asm volatile("s_waitcnt vmcnt(0)" ::: "memory");
            const unsigned og = xb_add(&bar[XB_TOP], 1u);
            const unsigned tg = og / nx;
            if (og + 1u == (tg + 1u) * nx) xb_add(&bar[XB_TOPGEN], 1u);
            else XB_SPIN(xb_ld(&bar[XB_TOPGEN]) == tg, bar);
            __builtin_amdgcn_fence(__ATOMIC_ACQUIRE, "agent");
            xb_add(&bar[XB_XGEN(b.x)], 1u);
            asm volatile("s_waitcnt vmcnt(0)" ::: "memory");
        } else {
            XB_SPIN(xb_ld(&bar[XB_XGEN(b.x)]) == gen, bar);
            __builtin_amdgcn_fence(__ATOMIC_ACQUIRE, "agent");
            asm volatile("s_waitcnt vmcnt(0)" ::: "memory");
        }
    }
    __syncthreads();
}

struct Args { const void* in[34]; float* out; unsigned char* ws; int ph_lo, ph_hi, li, pad; };
struct Frame {
    LAS unsigned char* lds;
    int tid, lane, wave, vcu, G;
    const void* const* in;
    unsigned char* ws;
    float* out;
};
__device__ __forceinline__ int opaque_tid() { int tz = threadIdx.x; asm volatile("" : "+v"(tz)); return tz; }
#define FIN(i) ((const float*)F.in[i])
#define WSP(type, off) ((type*)(F.ws + (off)))

__device__ __forceinline__ void p0_transpose_item(const float* W, int K, int N, bf16_t* WT, LAS float* scr, int item, int lane) {
    const int nblk = N / 32, kb = item / nblk, nb = item % nblk, k0 = 64 * kb, n0 = 32 * nb;
#pragma unroll 8
    for (int i = 0; i < 32; ++i) { const int kk = 2 * i + (lane >> 5); scr[kk * 33 + (lane & 31)] = W[(size_t)(k0 + kk) * N + n0 + (lane & 31)]; }
    asm volatile("s_waitcnt lgkmcnt(0)" ::: "memory");
    const int c = lane & 7;
#pragma unroll
    for (int j = 0; j < 4; ++j) { const int n = (lane >> 3) + 8 * j; const LAS float* s = scr + (8 * c) * 33 + n;
        u32x4 o; o.x = pk2(s[0 * 33], s[1 * 33]); o.y = pk2(s[2 * 33], s[3 * 33]); o.z = pk2(s[4 * 33], s[5 * 33]); o.w = pk2(s[6 * 33], s[7 * 33]);
        *(u32x4*)(WT + (size_t)(n0 + n) * K + k0 + 8 * c) = o; }
    asm volatile("s_waitcnt lgkmcnt(0)" ::: "memory");
}
__device__ __forceinline__ void p0_prologue(Frame& F) {
    LAS float* scr = (LAS float*)(F.lds + F.wave * 16384);
    const int gw = F.vcu * 8 + F.wave, NGW = F.G * 8; F.tid = opaque_tid(); F.lane = F.tid & 63;
    constexpr int I_IN = (DM / 64) * (NPROJ / 32), I_GLU = (1024 / 64) * (1024 / 32), I_BR = (1024 / 64) * (DM / 32), I_OUT = (DM / 64) * (DM / 32),
                  I_UP = (DM / 64) * (DFF / 32), I_DOWN = (DFF / 64) * (DM / 32), I_LAYER = I_IN + I_GLU + 4 * I_BR + I_OUT + I_UP + I_DOWN;
    for (int it = gw; it < NLAYER * I_LAYER; it += NGW) {
        const int l = it / I_LAYER; int r = it - l * I_LAYER;
        unsigned char* wt = F.ws + WS_WT + (size_t)l * WT_LAYER;
        if (r < I_IN) { p0_transpose_item(FIN(2) + (size_t)l * DM * NPROJ, DM, NPROJ, (bf16_t*)(wt + WT_IN), scr, r, F.lane); continue; } r -= I_IN;
        if (r < I_GLU) { p0_transpose_item(FIN(15) + (size_t)l * 1024 * 1024, 1024, 1024, (bf16_t*)(wt + WT_GLU), scr, r, F.lane); continue; } r -= I_GLU;
        if (r < I_BR) { p0_transpose_item(FIN(23) + (size_t)l * 1024 * DM, 1024, DM, (bf16_t*)(wt + WT_BR), scr, r, F.lane); continue; } r -= I_BR;
        if (r < I_BR) { p0_transpose_item(FIN(24) + (size_t)l * 1024 * DM, 1024, DM, (bf16_t*)(wt + WT_BR + 4 * MiB), scr, r, F.lane); continue; } r -= I_BR;
        if (r < I_BR) { p0_transpose_item(FIN(25) + (size_t)l * 1024 * DM, 1024, DM, (bf16_t*)(wt + WT_BR + 8 * MiB), scr, r, F.lane); continue; } r -= I_BR;
        if (r < I_BR) { p0_transpose_item(FIN(26) + (size_t)l * 1024 * DM, 1024, DM, (bf16_t*)(wt + WT_BR + 12 * MiB), scr, r, F.lane); continue; } r -= I_BR;
        if (r < I_OUT) { p0_transpose_item(FIN(27) + (size_t)l * DM * DM, DM, DM, (bf16_t*)(wt + WT_OUT), scr, r, F.lane); continue; } r -= I_OUT;
        if (r < I_UP) { p0_transpose_item(FIN(30) + (size_t)l * DM * DFF, DM, DFF, (bf16_t*)(wt + WT_UP), scr, r, F.lane); continue; } r -= I_UP;
        p0_transpose_item(FIN(31) + (size_t)l * DFF * DM, DFF, DM, (bf16_t*)(wt + WT_DOWN), scr, r, F.lane);
    }
    const int gt = F.vcu * 512 + F.tid, NGT = F.G * 512;
    for (int i = gt; i < NLAYER * (NPP - NPROJ) * DM / 8; i += NGT) { const int l = i / ((NPP - NPROJ) * DM / 8), r = i % ((NPP - NPROJ) * DM / 8);
        *(u32x4*)(F.ws + WS_WT + (size_t)l * WT_LAYER + WT_IN + (size_t)NPROJ * DM * 2 + (size_t)r * 16) = (u32x4){0u, 0u, 0u, 0u}; }
    { const int* pos = (const int*)F.in[1]; float* trig = WSP(float, WS_TRIG);
      for (int i = gt; i < T * 64; i += NGT) { const int t = i >> 6, j = i & 63;
          const double inv = exp2(-(double)j * (13.287712379549449 / 64.0));
          double s, c; sincos_d((double)pos[t] * inv, s, c);
          trig[(size_t)t * 128 + j] = (float)c; trig[(size_t)t * 128 + 64 + j] = (float)s; } }
    { const float* x = FIN(0); bf16_t* xb = WSP(bf16_t, WS_XB);
      for (int i = gt; i < T * DM / 4; i += NGT) { const f32x4 v = *(const f32x4*)(x + (size_t)i * 4); u32x2 w; w.x = pk2(v[0], v[1]); w.y = pk2(v[2], v[3]); *(u32x2*)(xb + (size_t)i * 4) = w; } }
    for (int i = gt; i < NLAYER * 4096; i += NGT) { const int l = i >> 12, gn = i & 4095, g = gn >> 6;
        const double lre = (double)FIN(7)[(size_t)l * 4096 + gn], lim = (double)FIN(8)[(size_t)l * 4096 + gn], step = exp((double)FIN(9)[l * 64 + g]);
        const double mag = exp(lre * step); double sn, cs; sincos_d(lim * step, sn, cs);
        const double are = mag * cs, aim = mag * sn, den = lre * lre + lim * lim;
        const double fre = ((are - 1.0) * lre + aim * lim) / den, fim = (aim * lre - (are - 1.0) * lim) / den;
        float* sp = (float*)(F.ws + WS_S5P + (size_t)l * MiB);
        sp[gn * 2] = (float)are; sp[gn * 2 + 1] = (float)aim;
        const float* bre = FIN(10) + ((size_t)l * 4096 + gn) * 16; const float* bim = FIN(11) + ((size_t)l * 4096 + gn) * 16;
        float* obre = sp + 16384 + (size_t)gn * 16; float* obim = sp + 16384 + 65536 + (size_t)gn * 16;
#pragma unroll
        for (int c = 0; c < 16; ++c) { const double br = bre[c], bi = bim[c]; obre[c] = (float)(fre * br - fim * bi); obim[c] = (float)(fre * bi + fim * br); } }
}

constexpr int LDP = 136;
__device__ __forceinline__ bf16x8 ldsfrag(const LAS bf16_t* base, int pitch, int row, int kk, int q) { return *(const LAS bf16x8*)(base + row * pitch + kk * 32 + 8 * q); }
__device__ __forceinline__ bf16x8 glbfrag(const bf16_t* base, int pitch, int row, int kk, int q) { return *(const bf16x8*)(base + (size_t)row * pitch + kk * 32 + 8 * q); }
#define MFMA16(a, b, c) __builtin_amdgcn_mfma_f32_16x16x32_bf16((a), (b), (c), 0, 0, 0)
#define LDS_BARRIER() do { asm volatile("s_waitcnt lgkmcnt(0)" ::: "memory"); __builtin_amdgcn_s_barrier(); asm volatile("" ::: "memory"); } while (0)

typedef float f32x16 __attribute__((ext_vector_type(16)));
__device__ __forceinline__ float gelu_tanh_(float y) { const float z = 0.7978845608028654f * (y + 0.044715f * y * y * y); const float th = 1.f - 2.f / (1.f + __expf(2.f * z)); return 0.5f * y * (1.f + th); }
__device__ __forceinline__ void s5_unit(Frame& F, int layer, int g) {
    const int tid = opaque_tid(), lane = tid & 63, w = F.wave, j = lane & 31, hh = lane >> 5, r16 = lane & 15, q = lane >> 4;
    LAS bf16_t* Xw = (LAS bf16_t*)(F.lds + w * 8704);
    LAS float* Ew = (LAS float*)(F.lds + 8 * 8704);
    const bf16_t* proj = WSP(bf16_t, WS_PROJ); bf16_t* ys = WSP(bf16_t, WS_YS5);
    const float* sp = (const float*)(F.ws + WS_S5P + (size_t)layer * MiB);
    float a1r[2], a1i[2], a2r[2], a2i[2], a3r[2], a3i[2], a4r[2], a4i[2];
#pragma unroll
    for (int s = 0; s < 2; ++s) { const int gn = g * 64 + j + 32 * s; a1r[s] = sp[gn * 2]; a1i[s] = sp[gn * 2 + 1];
        a2r[s] = a1r[s] * a1r[s] - a1i[s] * a1i[s]; a2i[s] = 2.f * a1r[s] * a1i[s];
        a3r[s] = a2r[s] * a1r[s] - a2i[s] * a1i[s]; a3i[s] = a2r[s] * a1i[s] + a2i[s] * a1r[s];
        a4r[s] = a2r[s] * a2r[s] - a2i[s] * a2i[s]; a4i[s] = 2.f * a2r[s] * a2i[s]; }
    bf16x8 bfr[4];
#pragma unroll
    for (int blk = 0; blk < 4; ++blk) { const float* src = sp + 16384 + (blk >> 1) * 65536 + (size_t)(g * 64 + j + 32 * (blk & 1)) * 16 + 8 * hh;
        const f32x4 v0 = *(const f32x4*)src, v1 = *(const f32x4*)(src + 4); u32x4 pk; pk.x = pk2(v0[0], v0[1]); pk.y = pk2(v0[2], v0[3]); pk.z = pk2(v1[0], v1[1]); pk.w = pk2(v1[2], v1[3]);
        bfr[blk] = __builtin_bit_cast(bf16x8, pk); }
    bf16x8 cfr[4];
    { const float* cre = FIN(12) + ((size_t)layer * 64 + g) * 1024 + r16 * 64; const float* cim = FIN(13) + ((size_t)layer * 64 + g) * 1024 + r16 * 64;
#pragma unroll
      for (int kk = 0; kk < 4; ++kk) { float v[8];
#pragma unroll
          for (int i = 0; i < 8; ++i) { const int ls = 8 * kk + 2 * q + (i >> 2), blk = i & 3, st = ls + 32 * (blk & 1); v[i] = (blk >> 1) ? -cim[st] : cre[st]; }
          u32x4 pk; pk.x = pk2(v[0], v[1]); pk.y = pk2(v[2], v[3]); pk.z = pk2(v[4], v[5]); pk.w = pk2(v[6], v[7]); cfr[kk] = __builtin_bit_cast(bf16x8, pk); } }
    const float dsk = FIN(14)[layer * 1024 + g * 16 + r16];
    const int t0 = w * 1024;
    float cr[2] = {0.f, 0.f}, ci[2] = {0.f, 0.f};
    const f32x16 zero16 = {0.f, 0.f, 0.f, 0.f, 0.f, 0.f, 0.f, 0.f, 0.f, 0.f, 0.f, 0.f, 0.f, 0.f, 0.f, 0.f};
#define S5_TILE(tt, DO_Y) do { \
        const bf16x8 afr = afn; \
        afn = *(const bf16x8*)(proj + (size_t)(t0 + 32 * (((tt) + 1) & 31) + j) * NPP + C_SU + 16 * g + 8 * hh);        \
        f32x16 acc[4]; \
        _Pragma("unroll") for (int blk = 0; blk < 4; ++blk) acc[blk] = __builtin_amdgcn_mfma_f32_32x32x16_bf16(afr, bfr[blk], zero16, 0, 0, 0); \
        float cjr[2][4], cji[2][4]; \
        _Pragma("unroll") for (int s = 0; s < 2; ++s) { \
            _Pragma("unroll") for (int gi = 0; gi < 4; ++gi) { float xr = 0.f, xi = 0.f; \
                _Pragma("unroll") for (int k = 0; k < 4; ++k) { const float nr = a1r[s] * xr - a1i[s] * xi + acc[s][4 * gi + k], ni = a1r[s] * xi + a1i[s] * xr + acc[2 + s][4 * gi + k]; xr = nr; xi = ni; acc[s][4 * gi + k] = xr; acc[2 + s][4 * gi + k] = xi; } } \
            float c_r = cr[s], c_i = ci[s]; \
            _Pragma("unroll") for (int gi = 0; gi < 4; ++gi) { const float er = acc[s][4 * gi + 3], ei = acc[2 + s][4 * gi + 3]; const float orr = __shfl_xor(er, 32), oi = __shfl_xor(ei, 32); \
                const float E0r = hh ? orr : er, E0i = hh ? oi : ei, E1r = hh ? er : orr, E1i = hh ? ei : oi;        \
                const float c0r = c_r, c0i = c_i; const float c1r = a4r[s] * c0r - a4i[s] * c0i + E0r, c1i = a4r[s] * c0i + a4i[s] * c0r + E0i; \
                cjr[s][gi] = hh ? c1r : c0r; cji[s][gi] = hh ? c1i : c0i; \
                c_r = a4r[s] * c1r - a4i[s] * c1i + E1r; c_i = a4r[s] * c1i + a4i[s] * c1r + E1i; } \
            cr[s] = c_r; ci[s] = c_i; } \
        if (DO_Y) { \
            _Pragma("unroll") for (int s = 0; s < 2; ++s) _Pragma("unroll") for (int gi = 0; gi < 4; ++gi) { const float kr = cjr[s][gi], ki = cji[s][gi]; \
                acc[s][4 * gi + 0] += a1r[s] * kr - a1i[s] * ki; acc[2 + s][4 * gi + 0] += a1r[s] * ki + a1i[s] * kr; \
                acc[s][4 * gi + 1] += a2r[s] * kr - a2i[s] * ki; acc[2 + s][4 * gi + 1] += a2r[s] * ki + a2i[s] * kr; \
                acc[s][4 * gi + 2] += a3r[s] * kr - a3i[s] * ki; acc[2 + s][4 * gi + 2] += a3r[s] * ki + a3i[s] * kr; \
                acc[s][4 * gi + 3] += a4r[s] * kr - a4i[s] * ki; acc[2 + s][4 * gi + 3] += a4r[s] * ki + a4i[s] * kr; } \
            _Pragma("unroll") for (int r = 0; r < 16; ++r) { const int tok = (r & 3) + 8 * (r >> 2) + 4 * hh; u32x2 o; o.x = pk2(acc[0][r], acc[1][r]); o.y = pk2(acc[2][r], acc[3][r]); *(LAS u32x2*)(Xw + tok * 136 + 4 * j) = o; } \
            bf16_t usk[2][4]; \
            _Pragma("unroll") for (int mt = 0; mt < 2; ++mt) _Pragma("unroll") for (int r = 0; r < 4; ++r) usk[mt][r] = proj[(size_t)(t0 + 32 * (tt) + 16 * mt + 4 * q + r) * NPP + C_SU + 16 * g + r16]; \
            asm volatile("s_waitcnt lgkmcnt(0)" ::: "memory"); \
            _Pragma("unroll") for (int mt = 0; mt < 2; ++mt) { f32x4 ya = {0.f, 0.f, 0.f, 0.f}; \
                _Pragma("unroll") for (int kk = 0; kk < 4; ++kk) ya = MFMA16(ldsfrag(Xw, 136, 16 * mt + r16, kk, q), cfr[kk], ya); \
                _Pragma("unroll") for (int r = 0; r < 4; ++r) { const size_t t = (size_t)(t0 + 32 * (tt) + 16 * mt + 4 * q + r); const float y = ya[r] + dsk * bf2f(usk[mt][r]); \
                    ys[t * 1024 + g * 16 + r16] = (bf16_t)f2bf(gelu_tanh_(y)); } } \
            asm volatile("s_waitcnt lgkmcnt(0)" ::: "memory"); } } while (0)
    bf16x8 afn = *(const bf16x8*)(proj + (size_t)(t0 + j) * NPP + C_SU + 16 * g + 8 * hh);
    for (int tt = 0; tt < 32; ++tt) S5_TILE(tt, false);
    if (hh == 0) {
#pragma unroll
        for (int s = 0; s < 2; ++s) { Ew[(w * 64 + j + 32 * s) * 2] = cr[s]; Ew[(w * 64 + j + 32 * s) * 2 + 1] = ci[s]; } }
    __syncthreads();
#pragma unroll
    for (int s = 0; s < 2; ++s) { float pr = a4r[s], pi = a4i[s];
#pragma unroll
        for (int k = 0; k < 8; ++k) { const float nr = pr * pr - pi * pi, ni = 2.f * pr * pi; pr = nr; pi = ni; }
        float xr = 0.f, xi = 0.f;
        for (int v = 0; v < w; ++v) { const float er = Ew[(v * 64 + j + 32 * s) * 2], ei = Ew[(v * 64 + j + 32 * s) * 2 + 1]; const float nr = pr * xr - pi * xi + er, ni = pr * xi + pi * xr + ei; xr = nr; xi = ni; }
        cr[s] = xr; ci[s] = xi; }
    for (int tt = 0; tt < 32; ++tt) S5_TILE(tt, true);
#undef S5_TILE
    __syncthreads();
}

constexpr size_t RET_BLK = 3 * 16384;
__device__ __forceinline__ void ret_pre_unit(Frame& F, int n, int h) {
    const int tid = opaque_tid(), lane = tid & 63, w = F.wave, r16 = lane & 15, q = lane >> 4;
    LAS bf16_t* Qs = (LAS bf16_t*)(F.lds); LAS bf16_t* Ks = (LAS bf16_t*)(F.lds + 128 * LDP * 2);
    const bf16_t* proj = WSP(bf16_t, WS_PROJ); const float* trig = WSP(float, WS_TRIG);
    bf16_t* blk = (bf16_t*)(F.ws + WS_TMP + TM_KR) + (size_t)(n * 4 + h) * RET_BLK;
    { const int tok = tid >> 2, qt = tid & 3; const size_t t = (size_t)n * 128 + tok;
      const bf16_t* pq = proj + t * NPP + C_RQ + h * 128 + 16 * qt; const bf16_t* pk = proj + t * NPP + C_RK + h * 128 + 16 * qt;
      const float* tc = trig + t * 128 + 16 * qt;
      float cs[16], sn[16];
#pragma unroll
      for (int i = 0; i < 4; ++i) { const f32x4 c4 = *(const f32x4*)(tc + 4 * i), s4 = *(const f32x4*)(tc + 64 + 4 * i);
#pragma unroll
          for (int j = 0; j < 4; ++j) { cs[4 * i + j] = c4[j]; sn[4 * i + j] = s4[j]; } }
#pragma unroll
      for (int isk = 0; isk < 2; ++isk) {
          const bf16_t* p = isk ? pk : pq; const float sc = isk ? 0.08838834764831845f : 1.0f;
          const u32x4 a0 = *(const u32x4*)p, a1 = *(const u32x4*)(p + 8), b0 = *(const u32x4*)(p + 64), b1 = *(const u32x4*)(p + 72);
          float x1[16], x2[16];
#pragma unroll
          for (int j = 0; j < 4; ++j) { x1[2 * j] = bf_lo(a0[j]); x1[2 * j + 1] = bf_hi(a0[j]); x1[8 + 2 * j] = bf_lo(a1[j]); x1[8 + 2 * j + 1] = bf_hi(a1[j]);
              x2[2 * j] = bf_lo(b0[j]); x2[2 * j + 1] = bf_hi(b0[j]); x2[8 + 2 * j] = bf_lo(b1[j]); x2[8 + 2 * j + 1] = bf_hi(b1[j]); }
          u32x4 o1[2], o2[2];
#pragma unroll
          for (int j = 0; j < 8; ++j) { const float ya = (x1[2 * j] * cs[2 * j] - x2[2 * j] * sn[2 * j]) * sc, yb = (x1[2 * j + 1] * cs[2 * j + 1] - x2[2 * j + 1] * sn[2 * j + 1]) * sc;
              const float za = (x1[2 * j] * sn[2 * j] + x2[2 * j] * cs[2 * j]) * sc, zb = (x1[2 * j + 1] * sn[2 * j + 1] + x2[2 * j + 1] * cs[2 * j + 1]) * sc;
              o1[j >> 2][j & 3] = pk2(ya, yb); o2[j >> 2][j & 3] = pk2(za, zb); }
          LAS bf16_t* ls = (isk ? Ks : Qs) + tok * LDP + 16 * qt;
          *(LAS u32x4*)ls = o1[0]; *(LAS u32x4*)(ls + 8) = o1[1]; *(LAS u32x4*)(ls + 64) = o2[0]; *(LAS u32x4*)(ls + 72) = o2[1];
          if (!isk) { bf16_t* g = blk + tok * 128 + 16 * qt; *(u32x4*)g = o1[0]; *(u32x4*)(g + 8) = o1[1]; *(u32x4*)(g + 64) = o2[0]; *(u32x4*)(g + 72) = o2[1]; } } }
    LDS_BARRIER();
    { const int d = tid >> 2, jq = tid & 3; bf16_t* g = blk + 2 * 16384 + d * 128 + 32 * jq;
#pragma unroll
      for (int c = 0; c < 4; ++c) { u32x4 o;
#pragma unroll
          for (int j = 0; j < 4; ++j) { const unsigned lo = Ks[(32 * jq + 8 * c + 2 * j) * LDP + d], hi = Ks[(32 * jq + 8 * c + 2 * j + 1) * LDP + d]; o[j] = lo | (hi << 16); }
          *(u32x4*)(g + 8 * c) = o; } }
    { const float lg = log2f(1.0f - exp2f(-5.0f - (float)h)); const int i = 16 * w + r16;
      bf16x8 bq[4];
#pragma unroll
      for (int kk = 0; kk < 4; ++kk) bq[kk] = ldsfrag(Qs, LDP, 16 * w + r16, kk, q);
      bf16_t* g = blk + 16384 + i * 128;
      for (int jt = 0; jt < 8; ++jt) {
          u32x2 o = {0u, 0u};
          if (jt <= w) { f32x4 acc = {0.f, 0.f, 0.f, 0.f};
#pragma unroll
              for (int kk = 0; kk < 4; ++kk) acc = MFMA16(ldsfrag(Ks, LDP, 16 * jt + r16, kk, q), bq[kk], acc);
              float v[4];
#pragma unroll
              for (int r = 0; r < 4; ++r) { const int j = 16 * jt + 4 * q + r; v[r] = (j <= i) ? acc[r] * exp2f((float)(i - j) * lg) : 0.f; }
              o.x = pk2(v[0], v[1]); o.y = pk2(v[2], v[3]); }
          *(u32x2*)(g + 16 * jt + 4 * q) = o; } }
    LDS_BARRIER();
}

__device__ __forceinline__ void ret_seq_unit(Frame& F, int u) {
    const int tid = opaque_tid(), lane = tid & 63, w = F.wave, r16 = lane & 15, q = lane >> 4;
    const int h = u >> 4, e0 = (u & 15) * 16;
    LAS bf16_t* Rt = (LAS bf16_t*)(F.lds); LAS bf16_t* Vt = (LAS bf16_t*)(F.lds + 2 * 16 * LDP * 2); LAS bf16_t* Vd = (LAS bf16_t*)(F.lds + 4 * 16 * LDP * 2);
    const bf16_t* proj = WSP(bf16_t, WS_PROJ); float* O = (float*)(F.ws + WS_TMP + TM_VR);
    const bf16_t* blk0 = (const bf16_t*)(F.ws + WS_TMP + TM_KR) + (size_t)h * RET_BLK;
    const float lg = log2f(1.0f - exp2f(-5.0f - (float)h)), g128 = exp2f(128.f * lg);
    float rsc[4];
#pragma unroll
    for (int r = 0; r < 4; ++r) rsc[r] = exp2f((float)(16 * w + 4 * q + r + 1) * lg);
    const int vj = tid >> 1, vh = tid & 1; const float vdec = exp2f((float)(127 - vj) * lg);
    u32x4 vreg = {0u, 0u, 0u, 0u};
#define RET_LOADV(c) do { if (tid < 256) vreg = *(const u32x4*)(proj + (size_t)((c) * 128 + vj) * NPP + C_RV + h * 256 + e0 + 8 * vh); } while (0)
#define RET_STOREV(b) do { if (tid < 256) { LAS bf16_t* vt = Vt + (b) * 16 * LDP + (8 * vh) * LDP + vj; LAS bf16_t* vd = Vd + (b) * 16 * LDP + (8 * vh) * LDP + vj; \
        _Pragma("unroll") for (int j = 0; j < 4; ++j) { const float lo = bf_lo(vreg[j]), hi = bf_hi(vreg[j]); vt[(2 * j) * LDP] = (bf16_t)(vreg[j] & 0xffffu); vt[(2 * j + 1) * LDP] = (bf16_t)(vreg[j] >> 16); \
            vd[(2 * j) * LDP] = (bf16_t)f2bf(lo * vdec); vd[(2 * j + 1) * LDP] = (bf16_t)f2bf(hi * vdec); } } } while (0)
#define RET_LOADF(FR, c) do { const bf16_t* bk = blk0 + (size_t)(c) * 4 * RET_BLK; _Pragma("unroll") for (int kk = 0; kk < 4; ++kk) { \
        FR[kk] = glbfrag(bk, 128, 16 * w + r16, kk, q); FR[4 + kk] = glbfrag(bk + 16384, 128, 16 * w + r16, kk, q); FR[8 + kk] = glbfrag(bk + 32768, 128, 16 * w + r16, kk, q); } } while (0)
    for (int i = tid; i < 16 * LDP; i += 512) Rt[i] = 0;
    RET_LOADV(0); RET_STOREV(0);
    bf16x8 fa[12], fb[12];
    RET_LOADF(fa, 0);
    f32x4 R = {0.f, 0.f, 0.f, 0.f};
    __syncthreads();
#define RET_CHUNK(c, CUR, NXT) do { const int b = (c) & 1; \
        if ((c) + 1 < T / 128) { RET_LOADF(NXT, (c) + 1); RET_LOADV((c) + 1); } \
        f32x4 a1 = {0.f, 0.f, 0.f, 0.f}, a2 = {0.f, 0.f, 0.f, 0.f}; f32x4 ra = R * g128; \
        _Pragma("unroll") for (int kk = 0; kk < 4; ++kk) { const bf16x8 bR = ldsfrag(Rt + b * 16 * LDP, LDP, r16, kk, q), bV = ldsfrag(Vt + b * 16 * LDP, LDP, r16, kk, q), bD = ldsfrag(Vd + b * 16 * LDP, LDP, r16, kk, q); \
            a1 = MFMA16(CUR[kk], bR, a1); a2 = MFMA16(CUR[4 + kk], bV, a2); ra = MFMA16(CUR[8 + kk], bD, ra); } \
        R = ra; \
        _Pragma("unroll") for (int r = 0; r < 4; ++r) O[(size_t)((c) * 128 + 16 * w + 4 * q + r) * 1024 + h * 256 + e0 + r16] = rsc[r] * a1[r] + a2[r]; \
        { u32x2 o; o.x = pk2(R[0], R[1]); o.y = pk2(R[2], R[3]); *(LAS u32x2*)(Rt + (b ^ 1) * 16 * LDP + r16 * LDP + 16 * w + 4 * q) = o; } \
        if ((c) + 1 < T / 128) RET_STOREV(b ^ 1); \
        LDS_BARRIER(); } while (0)
    for (int c = 0; c < T / 128; c += 2) { RET_CHUNK(c, fa, fb); RET_CHUNK(c + 1, fb, fa); }
#undef RET_CHUNK
#undef RET_LOADF
#undef RET_LOADV
#undef RET_STOREV
}


__device__ __forceinline__ void ssd_pre_unit(Frame& F, int layer, int n, int g) {
    const int tid = opaque_tid(), lane = tid & 63, w = F.wave, r16 = lane & 15, q = lane >> 4;
    LAS bf16_t* Cs = (LAS bf16_t*)(F.lds); LAS bf16_t* Bs = (LAS bf16_t*)(F.lds + 128 * LDP * 2);
    LAS float* Ac = (LAS float*)(F.lds + 2 * 128 * LDP * 2); LAS float* Dt = Ac + 8 * 128;
    const bf16_t* proj = WSP(bf16_t, WS_PROJ); const float* small = WSP(float, WS_SMALL);
    unsigned char* tm = F.ws + WS_TMP;
    float* acum = (float*)(tm + TM_SAC); bf16_t* XS = (bf16_t*)(tm + TM_SXS); bf16_t* XD = (bf16_t*)(tm + TM_SXD);
    bf16_t* cb = (bf16_t*)(tm + TM_SCB) + (size_t)(n * 2 + g) * 32768; bf16_t* sl = (bf16_t*)(tm + TM_SSL) + (size_t)(n * 16 + 8 * g) * 16384;
    const float* scw = FIN(17) + (size_t)layer * 1536 * 4; const float* scb = FIN(18) + layer * 1536; const float* sdtb = FIN(19) + layer * 16; const float* salog = FIN(20) + layer * 16;
    const int t0 = n * 128;
    { const int hh = 8 * g + w; const float a = -__expf(salog[hh]);
      const float dt0 = softplusf_(small[(size_t)(t0 + 2 * lane) * 32 + 16 + hh] + sdtb[hh]), dt1 = softplusf_(small[(size_t)(t0 + 2 * lane + 1) * 32 + 16 + hh] + sdtb[hh]);
      const float v0 = dt0 * a, v1 = dt1 * a, s = v0 + v1; float incl = s;
#pragma unroll
      for (int o = 1; o < 64; o <<= 1) { const float tmp = __shfl_up(incl, o); if (lane >= o) incl += tmp; }
      const float excl = incl - s;
      Ac[w * 128 + 2 * lane] = excl + v0; Ac[w * 128 + 2 * lane + 1] = excl + s; Dt[w * 128 + 2 * lane] = dt0; Dt[w * 128 + 2 * lane + 1] = dt1;
      acum[(size_t)(t0 + 2 * lane) * 16 + hh] = excl + v0; acum[(size_t)(t0 + 2 * lane + 1) * 16 + hh] = excl + s; }
    LDS_BARRIER();
    { const int cp = tid & 127, tq = tid >> 7; const int tb = t0 + 32 * tq;
      unsigned xa[3][35];
#pragma unroll
      for (int m = 0; m < 3; ++m) { const int ch = (m < 2) ? g * 512 + m * 256 + 2 * cp : (cp < 64 ? 1024 + g * 128 + 2 * cp : 1280 + g * 128 + 2 * (cp - 64)); const bf16_t* pc = proj + C_MX + ch;
#pragma unroll
          for (int i = 0; i < 35; ++i) xa[m][i] = (tb - 3 + i >= 0) ? *(const unsigned*)(pc + (size_t)(tb - 3 + i) * NPP) : 0u; }
#pragma unroll
      for (int m = 0; m < 3; ++m) {
          const int ch = (m < 2) ? g * 512 + m * 256 + 2 * cp : (cp < 64 ? 1024 + g * 128 + 2 * cp : 1280 + g * 128 + 2 * (cp - 64));
          const f32x4 w0 = *(const f32x4*)(scw + (size_t)ch * 4), w1 = *(const f32x4*)(scw + (size_t)ch * 4 + 4); const float b0 = scb[ch], b1 = scb[ch + 1];
          const unsigned (&xw)[35] = xa[m];
#pragma unroll
          for (int i = 0; i < 32; ++i) { const unsigned x0 = xw[i], x1 = xw[i + 1], x2 = xw[i + 2], x3 = xw[i + 3];
              const float ya = siluf_(w0[0] * bf_lo(x0) + w0[1] * bf_lo(x1) + w0[2] * bf_lo(x2) + w0[3] * bf_lo(x3) + b0);
              const float yb = siluf_(w1[0] * bf_hi(x0) + w1[1] * bf_hi(x1) + w1[2] * bf_hi(x2) + w1[3] * bf_hi(x3) + b1);
              if (m < 2) { const float dt = Dt[(m * 4 + (cp >> 5)) * 128 + 32 * tq + i]; const size_t go = (size_t)(tb + i) * 1024 + g * 512 + m * 256 + 2 * cp;
                  *(unsigned*)(XS + go) = pk2(ya, yb); *(unsigned*)(XD + go) = pk2(ya * dt, yb * dt); }
              else if (cp < 64) *(LAS unsigned*)(Bs + (32 * tq + i) * LDP + 2 * cp) = pk2(ya, yb);
              else *(LAS unsigned*)(Cs + (32 * tq + i) * LDP + 2 * (cp - 64)) = pk2(ya, yb); } } }
    LDS_BARRIER();
#pragma unroll
    for (int k = 0; k < 4; ++k) { const int idx = tid + 512 * k, row = idx >> 4, c8 = idx & 15; *(u32x4*)(cb + row * 128 + 8 * c8) = *(const LAS u32x4*)(Cs + row * LDP + 8 * c8); }
    { const int d = tid >> 2, jq = tid & 3; bf16_t* gp = cb + 16384 + d * 128 + 32 * jq;
#pragma unroll
      for (int c = 0; c < 4; ++c) { u32x4 o;
#pragma unroll
          for (int j = 0; j < 4; ++j) { const unsigned lo = Bs[(32 * jq + 8 * c + 2 * j) * LDP + d], hi = Bs[(32 * jq + 8 * c + 2 * j + 1) * LDP + d]; o[j] = lo | (hi << 16); }
          *(u32x4*)(gp + 8 * c) = o; } }
    { const int i = 16 * w + r16; bf16x8 bq[4];
#pragma unroll
      for (int kk = 0; kk < 4; ++kk) bq[kk] = ldsfrag(Cs, LDP, i, kk, q);
      float ai[8];
#pragma unroll
      for (int hh = 0; hh < 8; ++hh) ai[hh] = Ac[hh * 128 + i];
      for (int jt = 0; jt < 8; ++jt) {
          f32x4 acc = {0.f, 0.f, 0.f, 0.f};
          if (jt <= w) {
#pragma unroll
              for (int kk = 0; kk < 4; ++kk) acc = MFMA16(ldsfrag(Bs, LDP, 16 * jt + r16, kk, q), bq[kk], acc); }
#pragma unroll
          for (int hh = 0; hh < 8; ++hh) { u32x2 o = {0u, 0u};
              if (jt <= w) { const f32x4 aj = *(const LAS f32x4*)(Ac + hh * 128 + 16 * jt + 4 * q); float v[4];
#pragma unroll
                  for (int r = 0; r < 4; ++r) { const int j = 16 * jt + 4 * q + r; v[r] = (j <= i) ? acc[r] * __expf(ai[hh] - aj[r]) : 0.f; }
                  o.x = pk2(v[0], v[1]); o.y = pk2(v[2], v[3]); }
              *(u32x2*)(sl + (size_t)hh * 16384 + i * 128 + 16 * jt + 4 * q) = o; } } }
    LDS_BARRIER();
}

__device__ __forceinline__ void ssd_seq_unit(Frame& F, int u) {
    const int tid = opaque_tid(), lane = tid & 63, w = F.wave, r16 = lane & 15, q = lane >> 4;
    const int h = u >> 2, p0 = (u & 3) * 16, g = h >> 3;
    LAS bf16_t* St = (LAS bf16_t*)(F.lds); LAS bf16_t* Vt = (LAS bf16_t*)(F.lds + 2 * 16 * LDP * 2); LAS bf16_t* Vd = (LAS bf16_t*)(F.lds + 4 * 16 * LDP * 2);
    unsigned char* tm = F.ws + WS_TMP;
    const float* acum = (const float*)(tm + TM_SAC); const bf16_t* XD = (const bf16_t*)(tm + TM_SXD); float* O = (float*)(tm + TM_VS);
    const bf16_t* cb0 = (const bf16_t*)(tm + TM_SCB) + (size_t)g * 32768; const bf16_t* sl0 = (const bf16_t*)(tm + TM_SSL) + (size_t)h * 16384;
    const int vj = tid >> 1, vh = tid & 1;
    u32x4 vreg = {0u, 0u, 0u, 0u}; float vdl = 0.f, vdj = 0.f;
#define SSD_LOADV(c) do { if (tid < 256) { vreg = *(const u32x4*)(XD + (size_t)((c) * 128 + vj) * 1024 + h * 64 + p0 + 8 * vh); \
        vdl = acum[(size_t)((c) * 128 + 127) * 16 + h]; vdj = acum[(size_t)((c) * 128 + vj) * 16 + h]; } } while (0)
#define SSD_STOREV(b) do { if (tid < 256) { const float vdn = __expf(vdl - vdj); LAS bf16_t* vt = Vt + (b) * 16 * LDP + (8 * vh) * LDP + vj; LAS bf16_t* vd = Vd + (b) * 16 * LDP + (8 * vh) * LDP + vj; \
        _Pragma("unroll") for (int j = 0; j < 4; ++j) { const float lo = bf_lo(vreg[j]), hi = bf_hi(vreg[j]); vt[(2 * j) * LDP] = (bf16_t)(vreg[j] & 0xffffu); vt[(2 * j + 1) * LDP] = (bf16_t)(vreg[j] >> 16); \
            vd[(2 * j) * LDP] = (bf16_t)f2bf(lo * vdn); vd[(2 * j + 1) * LDP] = (bf16_t)f2bf(hi * vdn); } } } while (0)
#define SSD_LOADF(FR, AR, c) do { const bf16_t* bc = cb0 + (size_t)(c) * 2 * 32768; const bf16_t* bs = sl0 + (size_t)(c) * 16 * 16384; _Pragma("unroll") for (int kk = 0; kk < 4; ++kk) { \
        FR[kk] = glbfrag(bc, 128, 16 * w + r16, kk, q); FR[4 + kk] = glbfrag(bs, 128, 16 * w + r16, kk, q); FR[8 + kk] = glbfrag(bc + 16384, 128, 16 * w + r16, kk, q); } \
        _Pragma("unroll") for (int r = 0; r < 4; ++r) AR[r] = acum[(size_t)((c) * 128 + 16 * w + 4 * q + r) * 16 + h]; AR[4] = acum[(size_t)((c) * 128 + 127) * 16 + h]; } while (0)
    for (int i = tid; i < 16 * LDP; i += 512) St[i] = 0;
    SSD_LOADV(0); SSD_STOREV(0);
    bf16x8 fa[12], fb[12]; float aa[5], ab[5];
    SSD_LOADF(fa, aa, 0);
    f32x4 S = {0.f, 0.f, 0.f, 0.f};
    __syncthreads();
#define SSD_CHUNK(c, CUR, NXT, ACUR, ANXT) do { const int b = (c) & 1; \
        if ((c) + 1 < T / 128) { SSD_LOADF(NXT, ANXT, (c) + 1); SSD_LOADV((c) + 1); } \
        f32x4 a1 = {0.f, 0.f, 0.f, 0.f}, a2 = {0.f, 0.f, 0.f, 0.f}; f32x4 sa = S * __expf(ACUR[4]); \
        _Pragma("unroll") for (int kk = 0; kk < 4; ++kk) { const bf16x8 bS = ldsfrag(St + b * 16 * LDP, LDP, r16, kk, q), bV = ldsfrag(Vt + b * 16 * LDP, LDP, r16, kk, q), bD = ldsfrag(Vd + b * 16 * LDP, LDP, r16, kk, q); \
            a1 = MFMA16(CUR[kk], bS, a1); a2 = MFMA16(CUR[4 + kk], bV, a2); sa = MFMA16(CUR[8 + kk], bD, sa); } \
        S = sa; \
        _Pragma("unroll") for (int r = 0; r < 4; ++r) O[(size_t)((c) * 128 + 16 * w + 4 * q + r) * 1024 + h * 64 + p0 + r16] = __expf(ACUR[r]) * a1[r] + a2[r]; \
        { u32x2 o; o.x = pk2(S[0], S[1]); o.y = pk2(S[2], S[3]); *(LAS u32x2*)(St + (b ^ 1) * 16 * LDP + r16 * LDP + 16 * w + 4 * q) = o; } \
        if ((c) + 1 < T / 128) SSD_STOREV(b ^ 1); \
        LDS_BARRIER(); } while (0)
    for (int c = 0; c < T / 128; c += 2) { SSD_CHUNK(c, fa, fb, aa, ab); SSD_CHUNK(c + 1, fb, fa, ab, aa); }
#undef SSD_CHUNK
#undef SSD_LOADF
#undef SSD_LOADV
#undef SSD_STOREV
}


constexpr size_t GDN_BLK = 36864;
__device__ __forceinline__ void gdn_pre_unit(Frame& F, int layer, int n, int h) {
    const int tid = opaque_tid(), lane = tid & 63, w = F.wave, r16 = lane & 15, q = lane >> 4;
    LAS bf16_t* Qs = (LAS bf16_t*)(F.lds); LAS bf16_t* Ks = (LAS bf16_t*)(F.lds + 17408); LAS bf16_t* Kd = (LAS bf16_t*)(F.lds + 34816);
    LAS float* Mm = (LAS float*)(F.lds + 52224); LAS float* Rr = (LAS float*)(F.lds + 69632); LAS float* gc = (LAS float*)(F.lds + 135168); LAS float* be = gc + 64;
    LAS bf16_t* Ws = Qs;
    const bf16_t* proj = WSP(bf16_t, WS_PROJ); const float* small = WSP(float, WS_SMALL);
    unsigned char* tm = F.ws + WS_TMP;
    bf16_t* blk = (bf16_t*)(tm + TM_KG) + (size_t)(n * 8 + h) * GDN_BLK;
    const float* gcw = FIN(3) + (size_t)layer * 3072 * 4; const float* galog = FIN(4) + layer * 8; const float* gdtb = FIN(5) + layer * 8;
    const int t0 = n * 64;
    f32x4 wt[3][2];
#pragma unroll
      for (int p = 0; p < 3; ++p)
#pragma unroll
          for (int e = 0; e < 2; ++e) wt[p][e] = *(const f32x4*)(gcw + (size_t)(p * 1024 + h * 128 + 2 * lane + e) * 4);
    const bf16_t* pc = proj + C_DQ + h * 128 + 2 * lane; const int tb = t0 + 8 * w;
    unsigned x[3][4];
#pragma unroll
      for (int p = 0; p < 3; ++p)
#pragma unroll
          for (int k = 0; k < 3; ++k) x[p][k] = (tb - 3 + k >= 0) ? *(const unsigned*)(pc + (size_t)(tb - 3 + k) * NPP + p * 1024) : 0u;
    if (w == 0) { const float g = -__expf(galog[h]) * softplusf_(small[(size_t)(t0 + lane) * 32 + h] + gdtb[h]); float incl = g;
#pragma unroll
        for (int o = 1; o < 64; o <<= 1) { const float tmp = __shfl_up(incl, o); if (lane >= o) incl += tmp; }
        gc[lane] = incl; be[lane] = sigmoidf_(small[(size_t)(t0 + lane) * 32 + 8 + h]);
        if (lane == 63) ((float*)(tm + TM_SM))[n * 8 + h] = __expf(incl); }
    LDS_BARRIER();
    {
      const float gl63 = gc[63];
#pragma unroll
      for (int i = 0; i < 8; ++i) { const int tok = 8 * w + i; float v[3][2];
#pragma unroll
          for (int p = 0; p < 3; ++p) { x[p][3] = *(const unsigned*)(pc + (size_t)(tb + i) * NPP + p * 1024);
              v[p][0] = siluf_(wt[p][0][0] * bf_lo(x[p][0]) + wt[p][0][1] * bf_lo(x[p][1]) + wt[p][0][2] * bf_lo(x[p][2]) + wt[p][0][3] * bf_lo(x[p][3]));
              v[p][1] = siluf_(wt[p][1][0] * bf_hi(x[p][0]) + wt[p][1][1] * bf_hi(x[p][1]) + wt[p][1][2] * bf_hi(x[p][2]) + wt[p][1][3] * bf_hi(x[p][3]));
              x[p][0] = x[p][1]; x[p][1] = x[p][2]; x[p][2] = x[p][3]; }
          const float sq = wave_sum(v[0][0] * v[0][0] + v[0][1] * v[0][1]), sk = wave_sum(v[1][0] * v[1][0] + v[1][1] * v[1][1]);
          const float rq = rsqrtf(sq + RMS_EPS) * 0.08838834764831845f, rk = rsqrtf(sk + RMS_EPS);
          const float gci = gc[tok], bei = be[tok], eg = __expf(gci), et = __expf(gl63 - gci);
          const float q0 = v[0][0] * rq, q1 = v[0][1] * rq, k0 = v[1][0] * rk, k1 = v[1][1] * rk;
          *(LAS unsigned*)(Qs + tok * LDP + 2 * lane) = pk2(q0, q1); *(LAS unsigned*)(Ks + tok * LDP + 2 * lane) = pk2(k0, k1); *(LAS unsigned*)(Kd + tok * LDP + 2 * lane) = pk2(k0 * et, k1 * et);
          *(LAS f32x2*)(Rr + tok * 256 + 2 * lane) = (f32x2){bei * v[2][0], bei * v[2][1]}; *(LAS f32x2*)(Rr + tok * 256 + 128 + 2 * lane) = (f32x2){bei * eg * k0, bei * eg * k1};
          *(unsigned*)(blk + 16384 + tok * 128 + 2 * lane) = pk2(q0 * eg, q1 * eg); } }
    LDS_BARRIER();
    if (w < 4) { bf16x8 aK[4];
#pragma unroll
        for (int kk = 0; kk < 4; ++kk) aK[kk] = ldsfrag(Ks, LDP, 16 * w + r16, kk, q);
        for (int jt = 0; jt <= w; ++jt) { f32x4 acc = {0.f, 0.f, 0.f, 0.f};
#pragma unroll
            for (int kk = 0; kk < 4; ++kk) acc = MFMA16(aK[kk], ldsfrag(Ks, LDP, 16 * jt + r16, kk, q), acc);
            const int j = 16 * jt + r16; const float gj = gc[j];
#pragma unroll
            for (int r = 0; r < 4; ++r) { const int i = 16 * w + 4 * q + r; Mm[i * 68 + j] = (j < i) ? be[i] * acc[r] * __expf(gc[i] - gj) : 0.f; } } }
    else { const int wq = w - 4, i = 16 * wq + r16; bf16x8 bQ[4];
#pragma unroll
        for (int kk = 0; kk < 4; ++kk) bQ[kk] = ldsfrag(Qs, LDP, i, kk, q);
        const float gi = gc[i];
        for (int jt = 0; jt < 4; ++jt) { u32x2 o = {0u, 0u};
            if (jt <= wq) { f32x4 acc = {0.f, 0.f, 0.f, 0.f};
#pragma unroll
                for (int kk = 0; kk < 4; ++kk) acc = MFMA16(ldsfrag(Ks, LDP, 16 * jt + r16, kk, q), bQ[kk], acc);
                float v[4];
#pragma unroll
                for (int r = 0; r < 4; ++r) { const int j = 16 * jt + 4 * q + r; v[r] = (j <= i) ? acc[r] * __expf(gi - gc[j]) : 0.f; }
                o.x = pk2(v[0], v[1]); o.y = pk2(v[2], v[3]); }
            *(u32x2*)(blk + 24576 + i * 64 + 16 * jt + 4 * q) = o; } }
    { const int d = tid >> 2, jq = tid & 3; bf16_t* gp = blk + 28672 + d * 64 + 16 * jq;
#pragma unroll
      for (int c = 0; c < 2; ++c) { u32x4 o;
#pragma unroll
          for (int j = 0; j < 4; ++j) { const unsigned lo = Kd[(16 * jq + 8 * c + 2 * j) * LDP + d], hi = Kd[(16 * jq + 8 * c + 2 * j + 1) * LDP + d]; o[j] = lo | (hi << 16); }
          *(u32x4*)(gp + 8 * c) = o; } }
    LDS_BARRIER();
    if (tid < 256) { float x[64];
#pragma unroll
        for (int i = 0; i < 64; ++i) x[i] = 0.f;
#pragma unroll
        for (int i = 0; i < 64; ++i) { float s = Rr[i * 256 + tid];
#pragma unroll
            for (int j4 = 0; j4 < (i + 3) / 4; ++j4) { const f32x4 m4 = *(const LAS f32x4*)(Mm + i * 68 + 4 * j4); s -= m4[0] * x[4 * j4] + m4[1] * x[4 * j4 + 1] + m4[2] * x[4 * j4 + 2] + m4[3] * x[4 * j4 + 3]; }
            x[i] = s; }
        if (tid < 128) { bf16_t* gp = blk + 8192 + tid * 64;
#pragma unroll
            for (int c = 0; c < 8; ++c) { u32x4 o; o.x = pk2(x[8 * c], x[8 * c + 1]); o.y = pk2(x[8 * c + 2], x[8 * c + 3]); o.z = pk2(x[8 * c + 4], x[8 * c + 5]); o.w = pk2(x[8 * c + 6], x[8 * c + 7]); *(u32x4*)(gp + 8 * c) = o; } }
        else {
#pragma unroll
            for (int i = 0; i < 64; ++i) Ws[i * LDP + tid - 128] = (bf16_t)f2bf(x[i]); } }
    LDS_BARRIER();
#pragma unroll
    for (int k = 0; k < 2; ++k) { const int idx = tid + 512 * k, row = idx >> 4, c8 = idx & 15; *(u32x4*)(blk + row * 128 + 8 * c8) = *(const LAS u32x4*)(Ws + row * LDP + 8 * c8); }
    LDS_BARRIER();
}

__device__ __forceinline__ void gdn_seq_unit(Frame& F, int u) {
    const int tid = opaque_tid(), lane = tid & 63, w = F.wave, r16 = lane & 15, q = lane >> 4;
    const int h = u >> 3, e0 = (u & 7) * 16, mt = w & 3; const bool lo = w < 4;
    LAS bf16_t* St = (LAS bf16_t*)(F.lds); LAS bf16_t* Vt = (LAS bf16_t*)(F.lds + 16 * LDP * 2);
    unsigned char* tm = F.ws + WS_TMP; float* O = (float*)(tm + TM_VG);
    const bf16_t* blk0 = (const bf16_t*)(tm + TM_KG) + (size_t)h * GDN_BLK;
    const float* glp = (const float*)(tm + TM_SM) + h + (lane & 0);
    const int p0off = lo ? 0 : 16384;
    const int pfp = (u & 7) < 7 ? (u & 7) : 6;
    const int pfoff = (pfp < 2 ? pfp * 4096 : pfp < 4 ? 16384 + (pfp - 2) * 4096 : pfp == 4 ? 24576 : 28672 + (pfp - 5) * 4096) + tid * 8;
#define GDN_LOADF(S, c) do { const int cc = (c) < T / 64 ? (c) : T / 64 - 1; const bf16_t* bk = blk0 + (size_t)cc * 8 * GDN_BLK; \
        _Pragma("unroll") for (int kk = 0; kk < 4; ++kk) { const bf16_t* p = bk + p0off + (size_t)(16 * mt + r16) * 128 + kk * 32 + 8 * q; asm volatile("global_load_dwordx4 %0, %1, off" : "=v"(fr[S][kk]) : "v"(p) : "memory"); } \
        _Pragma("unroll") for (int kk = 0; kk < 2; ++kk) { const bf16_t* p = bk + 28672 + (size_t)(16 * w + r16) * 64 + kk * 32 + 8 * q; asm volatile("global_load_dwordx4 %0, %1, off" : "=v"(fr[S][4 + kk]) : "v"(p) : "memory"); } \
        _Pragma("unroll") for (int kk = 0; kk < 2; ++kk) { const bf16_t* p = bk + 24576 + (size_t)(16 * mt + r16) * 64 + kk * 32 + 8 * q; asm volatile("global_load_dwordx4 %0, %1, off" : "=v"(fr[S][6 + kk]) : "v"(p) : "memory"); } \
        { const bf16_t* p = bk + 8192 + (e0 + r16) * 64 + 16 * mt + 4 * q; asm volatile("global_load_dwordx2 %0, %1, off" : "=v"(uu[S]) : "v"(p) : "memory"); } \
        { const float* p = glp + cc * 8; asm volatile("global_load_dword %0, %1, off" : "=v"(gg[S]) : "v"(p) : "memory"); } \
        { const int c5 = (c) + 2 < T / 64 ? (c) + 2 : T / 64 - 1; const bf16_t* p = blk0 + (size_t)c5 * 8 * GDN_BLK + pfoff;        \
          asm volatile("global_load_dwordx4 %0, %1, off" : "=v"(dm[S]) : "v"(p) : "memory"); } } while (0)
#define GDN_WAIT(S) do { asm volatile("s_waitcnt vmcnt(33)" : "+v"(fr[S][0]), "+v"(fr[S][1]), "+v"(fr[S][2]), "+v"(fr[S][3]), "+v"(fr[S][4]), "+v"(fr[S][5]), "+v"(fr[S][6]), "+v"(fr[S][7]), "+v"(uu[S]), "+v"(gg[S]), "+v"(dm[S]) :: "memory"); \
        __builtin_amdgcn_sched_barrier(0); } while (0)
    for (int i = tid; i < 16 * LDP; i += 512) St[i] = 0;
    bf16x8 fr[4][8]; u32x2 uu[4]; float gg[4]; u32x4 dm[4];
    GDN_LOADF(0, 0); GDN_LOADF(1, 1); GDN_LOADF(2, 2);
    f32x4 S = {0.f, 0.f, 0.f, 0.f};
    LDS_BARRIER();
#define GDN_CHUNK(c, CS, LS) do { \
        GDN_LOADF(LS, (c) + 3); \
        GDN_WAIT(CS); \
        f32x4 a0 = {0.f, 0.f, 0.f, 0.f}; \
        _Pragma("unroll") for (int kk = 0; kk < 4; ++kk) a0 = MFMA16(fr[CS][kk], ldsfrag(St, LDP, r16, kk, q), a0); \
        if (lo) { u32x2 o; o.x = pk2(bf_lo(uu[CS].x) - a0[0], bf_hi(uu[CS].x) - a0[1]); o.y = pk2(bf_lo(uu[CS].y) - a0[2], bf_hi(uu[CS].y) - a0[3]); *(LAS u32x2*)(Vt + r16 * 72 + 16 * mt + 4 * q) = o; } \
        LDS_BARRIER(); \
        const bf16x8 bV0 = ldsfrag(Vt, 72, r16, 0, q), bV1 = ldsfrag(Vt, 72, r16, 1, q); \
        if (!lo) { a0 = MFMA16(fr[CS][6], bV0, a0); a0 = MFMA16(fr[CS][7], bV1, a0); \
            _Pragma("unroll") for (int r = 0; r < 4; ++r) O[(size_t)((c) * 64 + 16 * mt + 4 * q + r) * 1024 + h * 128 + e0 + r16] = a0[r]; } \
        f32x4 sa = S * gg[CS]; sa = MFMA16(fr[CS][4], bV0, sa); sa = MFMA16(fr[CS][5], bV1, sa); S = sa; \
        { u32x2 o; o.x = pk2(S[0], S[1]); o.y = pk2(S[2], S[3]); *(LAS u32x2*)(St + r16 * LDP + 16 * w + 4 * q) = o; } \
        LDS_BARRIER(); } while (0)
    for (int c = 0; c < T / 64; c += 4) { GDN_CHUNK(c, 0, 3); GDN_CHUNK(c + 1, 1, 0); GDN_CHUNK(c + 2, 2, 1); GDN_CHUNK(c + 3, 3, 2); }
    asm volatile("s_waitcnt vmcnt(0)" ::: "memory");
#undef GDN_WAIT
#undef GDN_CHUNK
#undef GDN_LOADF
}

__device__ __forceinline__ void mixer_phase(Frame& F, int layer) {
    for (int u = F.vcu; u < 256; u += F.G) {
        if (u < 64) { gdn_seq_unit(F, u); if (MIXREP & 1) gdn_seq_unit(F, u); }
        else if (u < 128) { s5_unit(F, layer, u - 64); if (MIXREP & 2) s5_unit(F, layer, u - 64); }
        else if (u < 192) { ret_seq_unit(F, u - 128); if (MIXREP & 4) ret_seq_unit(F, u - 128); }
        else { ssd_seq_unit(F, u - 192); if (MIXREP & 8) ssd_seq_unit(F, u - 192); }
    }
}
__device__ __forceinline__ void pre_phase(Frame& F, int layer) {
    for (int u = F.vcu; u < 1280; u += F.G) {
        if (u < 1024) { gdn_pre_unit(F, layer, u >> 3, u & 7); if (MIXREP & 16) gdn_pre_unit(F, layer, u >> 3, u & 7); }
        else if (u < 1152) { ssd_pre_unit(F, layer, (u - 1024) >> 1, (u - 1024) & 1); if (MIXREP & 32) ssd_pre_unit(F, layer, (u - 1024) >> 1, (u - 1024) & 1); }
        else { const int ru = 2 * (u - 1152);
            ret_pre_unit(F, ru >> 2, ru & 3); ret_pre_unit(F, (ru + 1) >> 2, (ru + 1) & 3); if (MIXREP & 64) ret_pre_unit(F, ru >> 2, ru & 3); }
    }
}

__device__ __forceinline__ void post_phase(Frame& F, int layer) {
    const int gw = F.vcu * 8 + F.wave, NGW = F.G * 8, lane = opaque_tid() & 63;
    const bf16_t* proj = WSP(bf16_t, WS_PROJ); bf16_t* ycat = WSP(bf16_t, WS_YCAT);
    unsigned char* tm = F.ws + WS_TMP;
    const float* Or = (const float*)(tm + TM_VR); const float* Os = (const float*)(tm + TM_VS); const float* Og = (const float*)(tm + TM_VG);
    const float* gnw = FIN(6) + layer * 128; const bf16_t* XS = (const bf16_t*)(tm + TM_SXS);
    const float* sdk = FIN(21) + layer * 16; const float* snw = FIN(22) + layer * 1024;
    for (int t = gw; t < T; t += NGW) {
        const bf16_t* pr = proj + (size_t)t * NPP; bf16_t* yo = ycat + (size_t)t * 4096;
#pragma unroll
        for (int h = 0; h < 4; ++h) { f32x4 y = *(const f32x4*)(Or + (size_t)t * 1024 + h * 256 + 4 * lane);
            const float mu = wave_sum((y[0] + y[1]) + (y[2] + y[3])) * (1.f / 256.f); y = y - mu;
            const float rs = rsqrtf(wave_sum((y[0] * y[0] + y[1] * y[1]) + (y[2] * y[2] + y[3] * y[3])) * (1.f / 256.f) + LN_EPS);
            const u32x2 gw2 = *(const u32x2*)(pr + C_RG + h * 256 + 4 * lane);
            u32x2 o; o.x = pk2(y[0] * rs * siluf_(bf_lo(gw2.x)), y[1] * rs * siluf_(bf_hi(gw2.x))); o.y = pk2(y[2] * rs * siluf_(bf_lo(gw2.y)), y[3] * rs * siluf_(bf_hi(gw2.y)));
            *(u32x2*)(yo + h * 256 + 4 * lane) = o; }
#pragma unroll
        for (int h = 0; h < 8; ++h) { const f32x2 o = *(const f32x2*)(Og + (size_t)t * 1024 + h * 128 + 2 * lane);
            const float rs = rsqrtf(wave_sum(o[0] * o[0] + o[1] * o[1]) * (1.f / 128.f) + RMS_EPS);
            const unsigned zw = *(const unsigned*)(pr + C_DZ + h * 128 + 2 * lane); const f32x2 nw = *(const f32x2*)(gnw + 2 * lane);
            *(unsigned*)(yo + 1024 + h * 128 + 2 * lane) = pk2(o[0] * rs * nw[0] * siluf_(bf_lo(zw)), o[1] * rs * nw[1] * siluf_(bf_hi(zw))); }
        { float y[8][2]; float ss0 = 0.f, ss1 = 0.f;
#pragma unroll
          for (int j = 0; j < 8; ++j) { const f32x2 o = *(const f32x2*)(Os + (size_t)t * 1024 + j * 128 + 2 * lane); const float d = sdk[2 * j + (lane >> 5)];
              const unsigned zw = *(const unsigned*)(pr + C_MZ + j * 128 + 2 * lane);
              const unsigned xw = *(const unsigned*)(XS + (size_t)t * 1024 + j * 128 + 2 * lane);
              y[j][0] = (o[0] + d * bf_lo(xw)) * siluf_(bf_lo(zw)); y[j][1] = (o[1] + d * bf_hi(xw)) * siluf_(bf_hi(zw));
              const float s2 = y[j][0] * y[j][0] + y[j][1] * y[j][1]; if (j < 4) ss0 += s2; else ss1 += s2; }
          const float r0 = rsqrtf(wave_sum(ss0) * (1.f / 512.f) + RMS_EPS), r1 = rsqrtf(wave_sum(ss1) * (1.f / 512.f) + RMS_EPS);
#pragma unroll
          for (int j = 0; j < 8; ++j) { const float rs = j < 4 ? r0 : r1; const f32x2 nw = *(const f32x2*)(snw + j * 128 + 2 * lane);
              *(unsigned*)(yo + 3072 + j * 128 + 2 * lane) = pk2(y[j][0] * rs * nw[0], y[j][1] * rs * nw[1]); } }
    }
}

__device__ __forceinline__ void ln_phase(Frame& F, const float* in, const float* gam, const float* bet, float* outf, bf16_t* outb) {
    const int gw = F.vcu * 8 + F.wave, NGW = F.G * 8, lane = opaque_tid() & 63;
    for (int t = gw; t < T; t += NGW) {
        const f32x4* xr = (const f32x4*)(in + (size_t)t * DM) + lane;
        f32x4 v[8]; float s = 0.f;
#pragma unroll
        for (int j = 0; j < 8; ++j) { v[j] = xr[64 * j]; s += (v[j][0] + v[j][1]) + (v[j][2] + v[j][3]); }
        const float mean = wave_sum(s) * (1.f / DM); float s2 = 0.f;
#pragma unroll
        for (int j = 0; j < 8; ++j) { v[j] = v[j] - mean; s2 += (v[j][0] * v[j][0] + v[j][1] * v[j][1]) + (v[j][2] * v[j][2] + v[j][3] * v[j][3]); }
        const float rstd = rsqrtf(wave_sum(s2) * (1.f / DM) + LN_EPS);
#pragma unroll
        for (int j = 0; j < 8; ++j) { const f32x4 gm = *((const f32x4*)gam + lane + 64 * j), bt = *((const f32x4*)bet + lane + 64 * j);
            const f32x4 o = v[j] * rstd * gm + bt;
            *((f32x4*)(outf + (size_t)t * DM) + lane + 64 * j) = o;
            u32x2 w; w.x = pk2(o[0], o[1]); w.y = pk2(o[2], o[3]); *((u32x2*)(outb + (size_t)t * DM) + lane + 64 * j) = w; }
    }
}

constexpr int N_PHASES = 1 + 10 * NLAYER;
__global__ void __launch_bounds__(512, 2) mega(Args args) {
    extern __shared__ __attribute__((aligned(16))) unsigned char lds_raw[];
    Frame F;
    F.lds = (LAS unsigned char*)lds_raw;
    F.tid = threadIdx.x; F.lane = F.tid & 63; F.wave = __builtin_amdgcn_readfirstlane(F.tid >> 6);
    F.G = gridDim.x; { const int bx = blockIdx.x; F.vcu = (F.G % 8 == 0) ? (bx % 8) * (F.G / 8) + bx / 8 : bx; }
    F.in = args.in; F.ws = args.ws; F.out = args.out;
    for (int u = F.tid; u < (LDS_BYTES - LDSCTL_OFF) / 4; u += 512) ((LAS unsigned*)(F.lds + LDSCTL_OFF))[u] = 0u;
    __syncthreads();
    const int lo = args.ph_lo, hi = args.ph_hi;
    unsigned* barw = (unsigned*)(args.ws + WS_CTL) + CW_BAR + args.li * XCD_BAR_WORDS;
    XcdBarrier bar; bar.bar = barw; bar.x = 0; bar.st = nullptr;
    if (hi - lo > 1) bar = xcd_barrier_post(barw, (volatile LAS unsigned*)(F.lds + MISC_OFF) + 8);
#define IN(k) (lo <= (k) && (k) < hi)
#define SEAM(k) do { if ((k) + 1 < hi) xcd_barrier(bar); } while (0)

    if (IN(0)) { p0_prologue(F); if (REPMASK & 1) { xcd_barrier(bar); p0_prologue(F); } SEAM(0); }

    for (int layer = 0; layer < NLAYER; ++layer) {
        const int pb = 1 + 10 * layer;
        unsigned char* wt = F.ws + WS_WT + (size_t)layer * WT_LAYER;
        const float* xcur = layer == 0 ? FIN(0) : WSP(float, WS_XR0);
#define B_INPROJ do { pg8::Gemm g{WSP(bf16_t, WS_XB), (const bf16_t*)(wt + WT_IN), T, NP_MAIN, DM, DM, DM, 0, 0}; pg8::StaticOrder S; S.init(T, NP_MAIN, F.G, (int)blockIdx.x); \
            pg8::EpiProj E{WSP(bf16_t, WS_PROJ), WSP(float, WS_SMALL)}; pg8::gemm_phase<pg8::EpiProj, pg8::StaticOrder, true, true>(F.lds, g, S, E); } while (0)
#define B_INPROJ_DEFER do { pg8::Gemm g{WSP(bf16_t, WS_XB), (const bf16_t*)(wt + WT_IN) + (size_t)NP_MAIN * DM, T, NPP - NP_MAIN, DM, DM, DM, 0, 0}; pg8::DeferOrder S; S.init(T, NPP - NP_MAIN, F.G, (F.vcu + F.G - 64 % F.G) % F.G); \
            pg8::EpiProj E{WSP(bf16_t, WS_PROJ) + NP_MAIN, WSP(float, WS_SMALL)}; pg8::gemm_phase<pg8::EpiProj, pg8::DeferOrder, true, true>(F.lds, g, S, E); } while (0)
#define B_PREP pre_phase(F, layer)
#define B_MIX do { B_INPROJ_DEFER; mixer_phase(F, layer); } while (0)
#define B_GLUPOST do { pg8::Gemm g{WSP(bf16_t, WS_YS5), (const bf16_t*)(wt + WT_GLU), T, 1024, 1024, 1024, 1024, 0, 0}; pg8::StaticOrder S; S.init(T, 1024, F.G, (int)blockIdx.x); \
            pg8::EpiGlu E{WSP(bf16_t, WS_YS5), FIN(16) + layer * 1024, WSP(bf16_t, WS_YCAT)}; pg8::gemm_phase<pg8::EpiGlu, pg8::StaticOrder, true, true>(F.lds, g, S, E); post_phase(F, layer); } while (0)
#define B_MERGE do { pg8::Gemm g{WSP(bf16_t, WS_YCAT), (const bf16_t*)(wt + WT_BR), T, DM, 1024, 4096, 1024, 2048, 4 * MiB}; pg8::SegOrder<4> S; S.init(T, DM, F.G, (int)blockIdx.x); \
            pg8::EpiMerge E{WSP(bf16_t, WS_PROJ), (float*)(F.ws + WS_TMP + TM_PRE), (bf16_t*)(F.ws + WS_TMP + TM_MERGED)}; pg8::gemm_phase<pg8::EpiMerge, pg8::SegOrder<4>, true, true>(F.lds, g, S, E); } while (0)
#define B_WOUT do { pg8::Gemm g{(const bf16_t*)(F.ws + WS_TMP + TM_MERGED), (const bf16_t*)(wt + WT_OUT), T, DM, DM, DM, DM, 0, 0}; pg8::StaticOrder S; S.init(T, DM, F.G, (int)blockIdx.x); \
            pg8::EpiResid E{xcur, (float*)(F.ws + WS_TMP + TM_PRE)}; pg8::gemm_phase<pg8::EpiResid, pg8::StaticOrder, true, true>(F.lds, g, S, E); } while (0)
#define B_LN1 ln_phase(F, (const float*)(F.ws + WS_TMP + TM_PRE), FIN(28) + layer * DM, FIN(29) + layer * DM, WSP(float, WS_XR1), WSP(bf16_t, WS_XB))
#define B_UP do { pg8::Gemm g{WSP(bf16_t, WS_XB), (const bf16_t*)(wt + WT_UP), T, DFF, DM, DM, DM, 0, 0}; pg8::StaticOrder S; S.init(T, DFF, F.G, (int)blockIdx.x); \
            pg8::EpiRelu2 E{WSP(bf16_t, WS_HID)}; pg8::gemm_phase<pg8::EpiRelu2, pg8::StaticOrder, true, true>(F.lds, g, S, E); } while (0)
#define B_DOWN do { pg8::Gemm g{WSP(bf16_t, WS_HID), (const bf16_t*)(wt + WT_DOWN), T, DM, DFF, DFF, DFF, 0, 0}; pg8::StaticOrder S; S.init(T, DM, F.G, (int)blockIdx.x); \
            pg8::EpiResid E{WSP(float, WS_XR1), (float*)(F.ws + WS_TMP + TM_PRE)}; pg8::gemm_phase<pg8::EpiResid, pg8::StaticOrder, true, true>(F.lds, g, S, E); } while (0)
#define B_LN2 ln_phase(F, (const float*)(F.ws + WS_TMP + TM_PRE), FIN(32) + layer * DM, FIN(33) + layer * DM, layer == NLAYER - 1 ? F.out : WSP(float, WS_XR0), WSP(bf16_t, WS_XB))
#define PH(k, body) do { if (IN(pb + (k))) { body; if ((REPMASK >> ((k) + 1)) & 1) { xcd_barrier(bar); body; } SEAM(pb + (k)); } } while (0)
        PH(0, B_INPROJ);
        PH(1, B_PREP);
        if (IN(pb + 2)) { B_MIX; if ((REPMASK >> 3) & 1) { xcd_barrier(bar); B_PREP; xcd_barrier(bar); B_MIX; } SEAM(pb + 2); }
        PH(3, B_GLUPOST);
        PH(4, B_MERGE);
        PH(5, B_WOUT);
        PH(6, B_LN1);
        PH(7, B_UP);
        PH(8, B_DOWN);
        PH(9, B_LN2);
    }
#undef IN
#undef SEAM
}

extern "C" void kernel_launch(void* const* d_in, const int* in_sizes, int n_in, void* d_out, int out_size, void* d_ws, size_t ws_size, hipStream_t stream) {
    static int grid = 0;
    if (grid == 0) {
        if (n_in != 34 || out_size != T * DM || ws_size < WS_END) { fprintf(stderr, "kernel_launch: unexpected sizes (n_in %d, out %d, ws %zu need %zu)\n", n_in, out_size, ws_size, (size_t)WS_END); grid = -1; return; }
        int dev = 0, cus = 0, per_cu = 0;
        if (hipGetDevice(&dev) != hipSuccess || hipDeviceGetAttribute(&cus, hipDeviceAttributeMultiprocessorCount, dev) != hipSuccess) { grid = -1; return; }
        if (hipFuncSetAttribute((const void*)mega, hipFuncAttributeMaxDynamicSharedMemorySize, LDS_BYTES) != hipSuccess) { fprintf(stderr, "kernel_launch: hipFuncSetAttribute failed\n"); grid = -1; return; }
        if (hipOccupancyMaxActiveBlocksPerMultiprocessor(&per_cu, (const void*)mega, 512, LDS_BYTES) != hipSuccess || per_cu < 1) fprintf(stderr, "kernel_launch: occupancy query reports %d\n", per_cu);
        (void)hipGetLastError();
        grid = cus;
    }
    if (grid < 0) return;
    if (hipMemsetAsync((char*)d_ws + WS_CTL, 0, CTL_ZERO_BYTES, stream) != hipSuccess) return;
    Args a{};
    for (int i = 0; i < 34; ++i) a.in[i] = d_in[i];
    a.out = (float*)d_out; a.ws = (unsigned char*)d_ws;
#if MK_N_LAUNCHES == 1
    a.ph_lo = 0; a.ph_hi = N_PHASES; a.li = 0;
    hipLaunchKernelGGL(mega, dim3(grid), dim3(512), LDS_BYTES, stream, a);
#else
    for (int p = 0; p < N_PHASES; ++p) { a.ph_lo = p; a.ph_hi = p + 1; a.li = p; hipLaunchKernelGGL(mega, dim3(grid), dim3(512), LDS_BYTES, stream, a); }
#endif
}
```

```cpp
#include <hip/hip_runtime.h>
#include <cstdio>
#include <cstdint>

#ifndef MK_N_LAUNCHES
#define MK_N_LAUNCHES 1
#endif

#ifndef MIXREP
#define MIXREP 0
#endif
#ifndef REPMASK
#define REPMASK 0
#endif
#define LAS __attribute__((address_space(3)))
#define GAS __attribute__((address_space(1)))
typedef unsigned short bf16_t;
typedef short bf16x8 __attribute__((ext_vector_type(8)));
typedef float f32x4 __attribute__((ext_vector_type(4)));
typedef float f32x2 __attribute__((ext_vector_type(2)));
typedef unsigned u32x4 __attribute__((ext_vector_type(4)));
typedef unsigned u32x2 __attribute__((ext_vector_type(2)));

constexpr int T = 8192, DM = 2048, NPROJ = 18976, NPP = 19200, NP_MAIN = 18432, DFF = 8192, NLAYER = 2;
constexpr int C_RQ = 0, C_RK = 512, C_RV = 1024, C_RG = 2048, C_DQ = 3072, C_DK = 4096, C_DV = 5120, C_DZ = 6144, C_DA = 7168, C_DB = 7176,
              C_SU = 7184, C_MZ = 8208, C_MX = 9232, C_MB = 10256, C_MC = 10512, C_MDT = 10768, C_GATE = 10784;
constexpr float LN_EPS = 1e-5f, RMS_EPS = 1e-6f, ALPHA = 1.41421356237f;

constexpr size_t MiB = 1u << 20;
constexpr size_t WS_CTL = 0, CTL_ZERO_BYTES = 1 * MiB;
constexpr size_t WT_IN = 0, WT_GLU = 75 * MiB, WT_BR = 77 * MiB, WT_OUT = 93 * MiB, WT_UP = 101 * MiB, WT_DOWN = 133 * MiB, WT_LAYER = 165 * MiB;
constexpr size_t WS_WT = 1 * MiB;
constexpr size_t WS_PROJ = WS_WT + 2 * WT_LAYER;
constexpr size_t WS_HID = WS_PROJ;
constexpr size_t WS_SMALL = WS_PROJ + 300 * MiB;
constexpr size_t WS_TRIG = WS_SMALL + 1 * MiB;
constexpr size_t WS_S5P = WS_TRIG + 4 * MiB;
constexpr size_t WS_YCAT = WS_S5P + 2 * MiB;
constexpr size_t WS_YS5 = WS_YCAT + 64 * MiB;
constexpr size_t WS_XB = WS_YS5 + 16 * MiB;
constexpr size_t WS_XR0 = WS_XB + 32 * MiB;
constexpr size_t WS_XR1 = WS_XR0 + 64 * MiB;
constexpr size_t WS_TMP = WS_XR1 + 64 * MiB;
constexpr size_t TM_KR = 0, TM_VR = 32 * MiB,
                 TM_SCB = 64 * MiB, TM_SSL = 72 * MiB, TM_SXD = 104 * MiB, TM_SXS = 120 * MiB, TM_SAC = 136 * MiB, TM_VS = 138 * MiB,
                 TM_KG = 170 * MiB, TM_VG = 242 * MiB, TM_SM = 274 * MiB, TM_END = 278 * MiB;
constexpr size_t TM_MERGED = 0, TM_PRE = 32 * MiB;
constexpr size_t WS_END = WS_TMP + TM_END;
constexpr int CW_BAR = 4096;

constexpr int RING_BYTES = 131072, LDSCTL_OFF = 155648, MISC_OFF = LDSCTL_OFF + 320, LDS_BYTES = 163840;

__device__ __forceinline__ unsigned f2bf(float f) { unsigned u = __builtin_bit_cast(unsigned, f); return (u + 0x7fffu + ((u >> 16) & 1u)) >> 16; }
__device__ __forceinline__ unsigned pk2(float lo, float hi) { return f2bf(lo) | (f2bf(hi) << 16); }
__device__ __forceinline__ float bf_lo(unsigned u) { return __builtin_bit_cast(float, u << 16); }
__device__ __forceinline__ float bf_hi(unsigned u) { return __builtin_bit_cast(float, u & 0xffff0000u); }
__device__ __forceinline__ float bf2f(bf16_t h) { return __builtin_bit_cast(float, (unsigned)h << 16); }
__device__ __forceinline__ float sigmoidf_(float x) { return 1.f / (1.f + __expf(-x)); }
__device__ __forceinline__ float siluf_(float x) { return x / (1.f + __expf(-x)); }
__device__ __forceinline__ float softplusf_(float x) { return x > 20.f ? x : log1pf(__expf(x)); }
template <int CTRL> __device__ __forceinline__ float dppf(float v) { return __builtin_bit_cast(float, __builtin_amdgcn_update_dpp(0, __builtin_bit_cast(int, v), CTRL, 0xF, 0xF, true)); }
__device__ __forceinline__ float row_sum16(float v) {
    v += dppf<0xB1>(v); v += dppf<0x4E>(v); v += dppf<0x141>(v); v += dppf<0x140>(v); return v;
}
__device__ __forceinline__ float wave_sum(float v) { v = row_sum16(v); v += __shfl_xor(v, 16); v += __shfl_xor(v, 32); return v; }
__device__ __forceinline__ void sincos_d(double x, double& s, double& c) {
    const double k = __builtin_rint(x * 0.63661977236758134308);
    double r = __builtin_fma(-k, 1.57079632679489655800e+00, x);
    r = __builtin_fma(-k, 6.12323399573676603587e-17, r);
    const double r2 = r * r;
    double sp = 1.58969099521155010221e-10;
    sp = __builtin_fma(sp, r2, -2.50507602534068634195e-08);
    sp = __builtin_fma(sp, r2, 2.75573137070700676789e-06);
    sp = __builtin_fma(sp, r2, -1.98412698298579493134e-04);
    sp = __builtin_fma(sp, r2, 8.33333333332248946124e-03);
    sp = __builtin_fma(sp, r2, -1.66666666666666324348e-01);
    const double sn = __builtin_fma(sp * r2, r, r);
    double cp = -1.13596475577881948265e-11;
    cp = __builtin_fma(cp, r2, 2.08757232129817482790e-09);
    cp = __builtin_fma(cp, r2, -2.75573143513906633035e-07);
    cp = __builtin_fma(cp, r2, 2.48015872894767294178e-05);
    cp = __builtin_fma(cp, r2, -1.38888888888741095749e-03);
    cp = __builtin_fma(cp, r2, 4.16666666666666019037e-02);
    const double cs = __builtin_fma(cp * r2, r2, __builtin_fma(-0.5, r2, 1.0));
    const long q = (long)k & 3;
    s = (q == 0) ? sn : (q == 1) ? cs : (q == 2) ? -sn : -cs;
    c = (q == 0) ? cs : (q == 1) ? -sn : (q == 2) ? -cs : sn;
}

namespace pg8 {
constexpr int BM = 256, BK = 64, HALF = 128, HTB = HALF * BK * 2, STAGE_BYTES = 8 * HTB, NXCD = 8, WGM = 8;
__host__ __device__ __forceinline__ int lds_byte(int r, int c) { const int st = (r >> 4) * 2 + (c >> 5), rr = r & 15, cc = c & 31, ob = rr * 64 + cc * 2; return st * 1024 + (ob ^ (((ob >> 9) & 1) << 5)); }
__host__ __device__ __forceinline__ void stage_rc(int b, int& R, int& C) { const int st = b / 1024, sb = b % 1024, swz = sb ^ (((sb >> 9) & 1) << 5); R = (st >> 1) * 16 + swz / 64; C = (st & 1) * 32 + (swz % 64) / 2; }
__host__ __device__ __forceinline__ int perm32(int rho) { const int n = rho >> 4, i = rho & 15; return 8 * (i >> 2) + 4 * n + (i & 3); }

struct Unit { int pm, pn, seg; };
struct Gemm { const bf16_t* A; const bf16_t* Bt; int M, N, K, lda, ldb; size_t segA, segB; };

__host__ __device__ __forceinline__ void tile_of(long L, int nM, int nN, int& pm, int& pn) {
    const int nwg = nM * nN; int wgid = (int)L;
    { const int q = nwg / NXCD, r = nwg % NXCD, xcd = wgid % NXCD, off = wgid / NXCD; wgid = (xcd < r ? xcd * (q + 1) : r * (q + 1) + (xcd - r) * q) + off; }
    const int nig = WGM * nN, gid = wgid / nig, fm = gid * WGM, gsz = (nM - fm) < WGM ? (nM - fm) : WGM;
    pm = fm + ((wgid % nig) % gsz); pn = (wgid % nig) / gsz;
}
struct StaticOrder {
    int nM, nN, nwg, G, c;
    __host__ __device__ void init(int M, int N, int G_, int c_) { nM = M / BM; nN = N / BM; nwg = nM * nN; G = G_; c = c_; }
    __host__ __device__ bool next(int i, Unit& u) const {
        const long L = (long)i * G + c; if (L >= nwg) return false;
        tile_of(L, nM, nN, u.pm, u.pn); u.seg = 0; return true;
    }
    __device__ __forceinline__ void a_ready(const Unit&) const {}
    __device__ __forceinline__ void done(const Unit&) const {}
};
template <int NSEG> struct SegOrder {
    int nM, nN, nwg, G, c;
    __host__ __device__ void init(int M, int N, int G_, int c_) { nM = M / BM; nN = N / BM; nwg = nM * nN; G = G_; c = c_; }
    __host__ __device__ bool next(int i, Unit& u) const {
        const long L = (long)(i / NSEG) * G + c; if (L >= nwg) return false;
        tile_of(L, nM, nN, u.pm, u.pn); u.seg = i % NSEG; return true;
    }
    __device__ __forceinline__ void a_ready(const Unit&) const {}
    __device__ __forceinline__ void done(const Unit&) const {}
};

struct DeferOrder {
    int nM, nunits, G, c;
    __host__ __device__ void init(int M, int N, int G_, int c_) { nM = M / BM; nunits = nM * (N / BM); G = G_; c = c_; }
    __host__ __device__ bool next(int i, Unit& u) const { const long L = (long)i * G + c; if (L >= nunits) return false; u.pm = (int)(L % nM); u.pn = (int)(L / nM); u.seg = 0; return true; }
    __device__ __forceinline__ void a_ready(const Unit&) const {}
    __device__ __forceinline__ void done(const Unit&) const {}
};
__device__ __forceinline__ unsigned cvt_pk_bf16(float lo, float hi) { unsigned r; asm volatile("v_cvt_pk_bf16_f32 %0, %1, %2" : "=v"(r) : "v"(lo), "v"(hi)); return r; }


template <class Epi, class Sched, bool ALIGN_EPI = false, bool SP2 = false>
__device__ __forceinline__ void gemm_phase(LAS unsigned char* lds, const Gemm g, const Sched& S, const Epi& E) {
    int tid = threadIdx.x; asm volatile("" : "+v"(tid));
    const int wid = __builtin_amdgcn_readfirstlane(tid >> 6), lane = tid & 63, wr = wid >> 2, wc = wid & 3, fr = lane & 15, fq = lane >> 4;
    const int K = g.K, nt = K / BK;
    unsigned voffA[2], voffB[2];
#pragma unroll
    for (int i = 0; i < 2; ++i) { int R, C; stage_rc(tid * 16 + i * 8192, R, C); const int Rb = Epi::PERM ? ((R & ~31) + perm32(R & 31)) : R;
        voffA[i] = (unsigned)(R * g.lda + C) * 2u; voffB[i] = (unsigned)(Rb * g.ldb + C) * 2u; }
    const size_t kstep = (size_t)(BK * 2);
    const size_t hstepA = (size_t)HALF * g.lda * 2, hstepB = (size_t)HALF * g.ldb * 2;
    const size_t tstepA = 2 * hstepA, tstepB = 2 * hstepB;
    const unsigned ldsw = (unsigned)wid * 1024u;
    const int aoff = lds_byte(wr * 64 + fr, fq * 8), boff = lds_byte(wc * 32 + fr, fq * 8);
#define PG8_SA(b, h) (((b) * 2 + (h)) * HTB)
#define PG8_SB(b, h) ((4 + (b) * 2 + (h)) * HTB)
#define PG8_STAGE(bufoff, gbase, voff) do { _Pragma("unroll") for (int _i = 0; _i < 2; ++_i) \
        __builtin_amdgcn_global_load_lds((const unsigned*)((const char*)(gbase) + (voff)[_i]), (LAS unsigned*)(lds + (bufoff) + ldsw + _i * 8192), 16, 0, 0); } while (0)
#define PG8_LDA(dst, b, h) do { _Pragma("unroll") for (int m = 0; m < 4; ++m) _Pragma("unroll") for (int k = 0; k < 2; ++k) dst[m][k] = *(const LAS bf16x8*)(lds + PG8_SA(b, h) + aoff + m * 2048 + k * 1024); } while (0)
#define PG8_LDB(dst, b, h) do { _Pragma("unroll") for (int n = 0; n < 2; ++n) _Pragma("unroll") for (int k = 0; k < 2; ++k) dst[n][k] = *(const LAS bf16x8*)(lds + PG8_SB(b, h) + boff + n * 2048 + k * 1024); } while (0)
#define PG8_MMA(ai, bj, At, Bt) do { __builtin_amdgcn_s_setprio(1); _Pragma("unroll") for (int m = 0; m < 4; ++m) _Pragma("unroll") for (int n = 0; n < 2; ++n) _Pragma("unroll") for (int k = 0; k < 2; ++k) \
        acc[ai][bj][m][n] = __builtin_amdgcn_mfma_f32_16x16x32_bf16(Bt[n][k], At[m][k], acc[ai][bj][m][n], 0, 0, 0); __builtin_amdgcn_s_setprio(0); } while (0)
#define PG8_WAIT_V(n) asm volatile("s_waitcnt vmcnt(" #n ")" ::: "memory")
#define PG8_WAIT_L(n) asm volatile("s_waitcnt lgkmcnt(" #n ")" ::: "memory")
#define PG8_BAR __builtin_amdgcn_s_barrier()
#define PG8_SCHED __builtin_amdgcn_sched_barrier(0)
    Unit cur, nxt; int ui = 0;
    if (!S.next(0, cur)) return;
    f32x4 acc[2][2][4][2];
#pragma unroll
    for (int a = 0; a < 2; ++a)
#pragma unroll
        for (int b = 0; b < 2; ++b)
#pragma unroll
            for (int m = 0; m < 4; ++m)
#pragma unroll
                for (int n = 0; n < 2; ++n) acc[a][b][m][n] = (f32x4){0.f, 0.f, 0.f, 0.f};
    bf16x8 At[4][2], B0[2][2], B1[2][2];
    const char* cA = (const char*)g.A + (size_t)cur.seg * g.segA + (size_t)cur.pm * tstepA; const char* cB = (const char*)g.Bt + (size_t)cur.seg * g.segB + (size_t)cur.pn * tstepB;
    S.a_ready(cur);
    if constexpr (SP2) {
        PG8_STAGE(PG8_SB(0, 0), cB, voffB); PG8_STAGE(PG8_SB(0, 1), cB + hstepB, voffB); PG8_STAGE(PG8_SA(0, 0), cA, voffA); PG8_STAGE(PG8_SA(0, 1), cA + hstepA, voffA);
        if (wr == 1) PG8_BAR;
        PG8_WAIT_V(2); PG8_BAR;
        PG8_STAGE(PG8_SB(1, 0), cB + kstep, voffB); PG8_STAGE(PG8_SA(1, 0), cA + kstep, voffA); PG8_STAGE(PG8_SB(1, 1), cB + hstepB + kstep, voffB);
        PG8_WAIT_V(6); PG8_BAR;
    } else {
        PG8_STAGE(PG8_SB(0, 0), cB, voffB); PG8_STAGE(PG8_SA(0, 0), cA, voffA); PG8_STAGE(PG8_SB(0, 1), cB + hstepB, voffB); PG8_STAGE(PG8_SA(0, 1), cA + hstepA, voffA);
        if (wr == 1) PG8_BAR;
        PG8_WAIT_V(4); PG8_BAR;
        PG8_STAGE(PG8_SB(1, 0), cB + kstep, voffB); PG8_STAGE(PG8_SA(1, 0), cA + kstep, voffA); PG8_STAGE(PG8_SB(1, 1), cB + hstepB + kstep, voffB);
        PG8_WAIT_V(6); PG8_BAR;
    }
    for (;;) {
        const bool has_next = S.next(ui + 1, nxt);
        const char* nA = has_next ? (const char*)g.A + (size_t)nxt.seg * g.segA + (size_t)nxt.pm * tstepA : cA;
        const char* nB = has_next ? (const char*)g.Bt + (size_t)nxt.seg * g.segB + (size_t)nxt.pn * tstepB : cB;
        for (int t = 0; t < nt; t += 2) {
            const bool last = (t == nt - 2);
            const char* a1 = cA + (size_t)(t + 1) * kstep;
            const char* a2 = last ? nA : cA + (size_t)(t + 2) * kstep; const char* b2 = last ? nB : cB + (size_t)(t + 2) * kstep;
            const char* a3 = a2 + kstep; const char* b3 = b2 + kstep;
            if (last && has_next) S.a_ready(nxt);
            if constexpr (SP2) {
            PG8_LDB(B0, 0, 0); PG8_LDB(B1, 0, 1); PG8_SCHED; PG8_LDA(At, 0, 0); PG8_STAGE(PG8_SA(1, 1), a1 + hstepA, voffA);
            PG8_WAIT_V(8); PG8_WAIT_L(0); PG8_BAR; PG8_MMA(0, 0, At, B0); PG8_MMA(0, 1, At, B1); PG8_BAR; PG8_SCHED;
            PG8_LDA(At, 0, 1); PG8_STAGE(PG8_SB(0, 0), b2, voffB); PG8_STAGE(PG8_SB(0, 1), b2 + hstepB, voffB); PG8_STAGE(PG8_SA(0, 0), a2, voffA);
            PG8_WAIT_V(8); PG8_WAIT_L(0); PG8_BAR; PG8_MMA(1, 0, At, B0); PG8_MMA(1, 1, At, B1); PG8_BAR; PG8_SCHED;
            PG8_LDB(B0, 1, 0); PG8_LDB(B1, 1, 1); PG8_SCHED; PG8_LDA(At, 1, 0); PG8_STAGE(PG8_SA(0, 1), a2 + hstepA, voffA);
            PG8_WAIT_V(8); PG8_WAIT_L(0); PG8_BAR; PG8_MMA(0, 0, At, B0); PG8_MMA(0, 1, At, B1); PG8_BAR; PG8_SCHED;
            PG8_LDA(At, 1, 1); PG8_STAGE(PG8_SB(1, 0), b3, voffB); PG8_STAGE(PG8_SB(1, 1), b3 + hstepB, voffB); PG8_STAGE(PG8_SA(1, 0), a3, voffA);
            PG8_WAIT_V(8); PG8_WAIT_L(0); PG8_BAR; PG8_MMA(1, 0, At, B0); PG8_MMA(1, 1, At, B1); PG8_BAR; PG8_SCHED;
            } else {
            PG8_LDB(B0, 0, 0); PG8_SCHED; PG8_LDA(At, 0, 0); PG8_STAGE(PG8_SA(1, 1), a1 + hstepA, voffA);
            PG8_WAIT_L(8); PG8_BAR; PG8_WAIT_L(0); PG8_MMA(0, 0, At, B0); PG8_BAR; PG8_SCHED;
            PG8_LDB(B1, 0, 1); PG8_STAGE(PG8_SB(0, 0), b2, voffB);
            PG8_BAR; PG8_WAIT_L(0); PG8_MMA(0, 1, At, B1); PG8_BAR;
            PG8_LDA(At, 0, 1); PG8_STAGE(PG8_SA(0, 0), a2, voffA);
            PG8_BAR; PG8_WAIT_L(0); PG8_MMA(1, 0, At, B0); PG8_BAR; PG8_SCHED;
            PG8_STAGE(PG8_SB(0, 1), b2 + hstepB, voffB);
            PG8_WAIT_V(6); PG8_BAR; PG8_MMA(1, 1, At, B1); PG8_BAR;
            PG8_LDB(B0, 1, 0); PG8_SCHED; PG8_LDA(At, 1, 0); PG8_STAGE(PG8_SA(0, 1), a2 + hstepA, voffA);
            PG8_WAIT_L(8); PG8_BAR; PG8_WAIT_L(0); PG8_MMA(0, 0, At, B0); PG8_BAR; PG8_SCHED;
            PG8_LDB(B1, 1, 1); PG8_STAGE(PG8_SB(1, 0), b3, voffB);
            PG8_BAR; PG8_WAIT_L(0); PG8_MMA(0, 1, At, B1); PG8_BAR;
            PG8_LDA(At, 1, 1); PG8_STAGE(PG8_SA(1, 0), a3, voffA);
            PG8_BAR; PG8_WAIT_L(0); PG8_MMA(1, 0, At, B0); PG8_BAR; PG8_SCHED;
            PG8_STAGE(PG8_SB(1, 1), b3 + hstepB, voffB);
            PG8_WAIT_V(6); PG8_BAR; PG8_MMA(1, 1, At, B1); PG8_BAR;
            }
        }
        if constexpr (ALIGN_EPI) { if (wr == 0) PG8_BAR; }
        { int tz = threadIdx.x; asm volatile("" : "+v"(tz));
          const int l2 = tz & 63; E(acc, cur, wr, wc, l2 & 15, l2 >> 4, tz); }
        S.done(cur);
        if (!has_next) break;
        if (!Epi::keep_acc(cur))
#pragma unroll
        for (int a = 0; a < 2; ++a)
#pragma unroll
            for (int b = 0; b < 2; ++b)
#pragma unroll
                for (int m = 0; m < 4; ++m)
#pragma unroll
                    for (int n = 0; n < 2; ++n) acc[a][b][m][n] = (f32x4){0.f, 0.f, 0.f, 0.f};
        cur = nxt; cA = nA; cB = nB; ++ui;
        if constexpr (ALIGN_EPI) { if (wr == 1) PG8_BAR; }
    }
    PG8_WAIT_V(0);
    if constexpr (!ALIGN_EPI) { if (wr == 0) PG8_BAR; }
    PG8_BAR;
#undef PG8_SA
#undef PG8_SB
#undef PG8_STAGE
#undef PG8_LDA
#undef PG8_LDB
#undef PG8_MMA
#undef PG8_WAIT_V
#undef PG8_WAIT_L
#undef PG8_BAR
#undef PG8_SCHED
}

struct EpiProj {
    static constexpr bool PERM = true; static __device__ __forceinline__ bool keep_acc(const Unit&) { return false; }
    bf16_t* O; float* small; int gate_from;
    __device__ __forceinline__ void operator()(const f32x4 (&acc)[2][2][4][2], const Unit& u, int wr, int wc, int fr, int fq, int tz) const {
        const int row0 = u.pm * BM + wr * 64 + fr, col0 = u.pn * BM + wc * 32 + 8 * fq;
#pragma unroll
        for (int ai = 0; ai < 2; ++ai)
#pragma unroll
            for (int m = 0; m < 4; ++m) { const int row = row0 + ai * HALF + m * 16; bf16_t* rowp = O + (size_t)row * NPP + col0;
#pragma unroll
                for (int bj = 0; bj < 2; ++bj) { f32x4 v0 = acc[ai][bj][m][0], v1 = acc[ai][bj][m][1];
                    const int col = col0 + bj * HALF;
                    if (col + gate_from >= C_GATE) {
#pragma unroll
                        for (int j = 0; j < 4; ++j) { v0[j] = fmaxf(sigmoidf_(v0[j]), 1e-30f); v1[j] = fmaxf(sigmoidf_(v1[j]), 1e-30f); } }
                    u32x4 w; w.x = cvt_pk_bf16(v0[0], v0[1]); w.y = cvt_pk_bf16(v0[2], v0[3]); w.z = cvt_pk_bf16(v1[0], v1[1]); w.w = cvt_pk_bf16(v1[2], v1[3]);
                    *(u32x4*)(rowp + bj * HALF) = w;
                    v0 = acc[ai][bj][m][0]; v1 = acc[ai][bj][m][1];
                    int si = -1; if (col == C_DA) si = 0; else if (col == C_DB) si = 8; else if (col == C_MDT) si = 16; else if (col == C_MDT + 8) si = 24;
                    if (si >= 0) { float* sp = small + (size_t)row * 32 + si; *(f32x4*)sp = v0; *(f32x4*)(sp + 4) = v1; } } }
    }
};
struct EpiGlu {
    static constexpr bool PERM = true; static __device__ __forceinline__ bool keep_acc(const Unit&) { return false; }
    const bf16_t* Y; const float* bias; bf16_t* O;
    __device__ __forceinline__ void operator()(const f32x4 (&acc)[2][2][4][2], const Unit& u, int wr, int wc, int fr, int fq, int tz) const {
        const int row0 = u.pm * BM + wr * 64 + fr, col0 = u.pn * BM + wc * 32 + 8 * fq;
#pragma unroll
        for (int ai = 0; ai < 2; ++ai)
#pragma unroll
            for (int m = 0; m < 4; ++m) { const int row = row0 + ai * HALF + m * 16;
#pragma unroll
                for (int bj = 0; bj < 2; ++bj) { const int col = col0 + bj * HALF;
                    const f32x4 b0 = *(const f32x4*)(bias + col), b1 = *(const f32x4*)(bias + col + 4);
                    const u32x4 yw = *(const u32x4*)(Y + (size_t)row * 1024 + col);
                    const f32x4 v0 = acc[ai][bj][m][0] + b0, v1 = acc[ai][bj][m][1] + b1;
                    float o[8];
                    o[0] = bf_lo(yw.x) * sigmoidf_(v0[0]); o[1] = bf_hi(yw.x) * sigmoidf_(v0[1]); o[2] = bf_lo(yw.y) * sigmoidf_(v0[2]); o[3] = bf_hi(yw.y) * sigmoidf_(v0[3]);
                    o[4] = bf_lo(yw.z) * sigmoidf_(v1[0]); o[5] = bf_hi(yw.z) * sigmoidf_(v1[1]); o[6] = bf_lo(yw.w) * sigmoidf_(v1[2]); o[7] = bf_hi(yw.w) * sigmoidf_(v1[3]);
                    u32x4 w; w.x = cvt_pk_bf16(o[0], o[1]); w.y = cvt_pk_bf16(o[2], o[3]); w.z = cvt_pk_bf16(o[4], o[5]); w.w = cvt_pk_bf16(o[6], o[7]);
                    *(u32x4*)(O + (size_t)row * 4096 + 2048 + col) = w; asm volatile("" ::: "memory"); } }
    }
};
struct EpiMerge {
    static constexpr bool PERM = true; static __device__ __forceinline__ bool keep_acc(const Unit& u) { return u.seg < 3; }
    const bf16_t* proj; bf16_t* O;
    __device__ __forceinline__ void operator()(f32x4 (&acc)[2][2][4][2], const Unit& u, int wr, int wc, int fr, int fq, int tz) const {
        const int row0 = u.pm * BM + wr * 64 + fr, col0 = u.pn * BM + wc * 32 + 8 * fq;
        const bool lastseg = (u.seg == 3);
#pragma unroll
        for (int ai = 0; ai < 2; ++ai) {
            u32x4 gw[4][2], gn[4][2];
#pragma unroll
            for (int m = 0; m < 4; ++m)
#pragma unroll
                for (int bj = 0; bj < 2; ++bj) { const bf16_t* gp = proj + (size_t)(row0 + ai * HALF + m * 16) * NPP + C_GATE + u.seg * 2048 + col0 + bj * HALF;
                    gw[m][bj] = *(const u32x4*)gp; gn[m][bj] = *(const u32x4*)(gp + (lastseg ? 0 : 2048)); }
#pragma unroll
            for (int m = 0; m < 4; ++m)
#pragma unroll
                for (int bj = 0; bj < 2; ++bj) { const int row = row0 + ai * HALF + m * 16, col = col0 + bj * HALF;
                    const u32x4 a = gw[m][bj], d4 = gn[m][bj];
                    float s[8] = {bf_lo(a.x), bf_hi(a.x), bf_lo(a.y), bf_hi(a.y), bf_lo(a.z), bf_hi(a.z), bf_lo(a.w), bf_hi(a.w)};
                    if (!lastseg) { const float d[8] = {bf_lo(d4.x), bf_hi(d4.x), bf_lo(d4.y), bf_hi(d4.y), bf_lo(d4.z), bf_hi(d4.z), bf_lo(d4.w), bf_hi(d4.w)};
#pragma unroll
                        for (int j = 0; j < 8; ++j) s[j] = s[j] * __builtin_amdgcn_rcpf(d[j]); }
                    f32x4 v0 = acc[ai][bj][m][0], v1 = acc[ai][bj][m][1];
#pragma unroll
                    for (int j = 0; j < 4; ++j) { v0[j] *= s[j]; v1[j] *= s[4 + j]; }
                    acc[ai][bj][m][0] = v0; acc[ai][bj][m][1] = v1;
                    if (lastseg) { u32x4 w; w.x = cvt_pk_bf16(v0[0], v0[1]); w.y = cvt_pk_bf16(v0[2], v0[3]); w.z = cvt_pk_bf16(v1[0], v1[1]); w.w = cvt_pk_bf16(v1[2], v1[3]);
                        *(u32x4*)(O + (size_t)row * DM + col) = w; } }
            asm volatile("" ::: "memory"); }
    }
};
struct EpiResid {
    static constexpr bool PERM = false; static __device__ __forceinline__ bool keep_acc(const Unit&) { return false; }
    const float* xres; float* O;
    __device__ __forceinline__ void operator()(const f32x4 (&acc)[2][2][4][2], const Unit& u, int wr, int wc, int fr, int fq, int tz) const {
        const int row0 = u.pm * BM + wr * 64 + fr, col0 = u.pn * BM + wc * 32 + 4 * fq;
#pragma unroll
        for (int ai = 0; ai < 2; ++ai)
#pragma unroll
            for (int m = 0; m < 4; ++m) { const size_t ro = (size_t)(row0 + ai * HALF + m * 16) * DM + col0;
#pragma unroll
                for (int bj = 0; bj < 2; ++bj)
#pragma unroll
                    for (int n = 0; n < 2; ++n) *(f32x4*)(O + ro + bj * HALF + n * 16) = acc[ai][bj][m][n]; }
    }
};
struct EpiRelu2 {
    static constexpr bool PERM = true; static __device__ __forceinline__ bool keep_acc(const Unit&) { return false; }
    bf16_t* O;
    __device__ __forceinline__ void operator()(const f32x4 (&acc)[2][2][4][2], const Unit& u, int wr, int wc, int fr, int fq, int tz) const {
        const int row0 = u.pm * BM + wr * 64 + fr, col0 = u.pn * BM + wc * 32 + 8 * fq;
#pragma unroll
        for (int ai = 0; ai < 2; ++ai)
#pragma unroll
            for (int m = 0; m < 4; ++m) { bf16_t* rowp = O + (size_t)(row0 + ai * HALF + m * 16) * DFF + col0;
#pragma unroll
                for (int bj = 0; bj < 2; ++bj) { f32x4 v0 = acc[ai][bj][m][0], v1 = acc[ai][bj][m][1];
#pragma unroll
                    for (int j = 0; j < 4; ++j) { const float a = fmaxf(v0[j], 0.f), b = fmaxf(v1[j], 0.f); v0[j] = a * a; v1[j] = b * b; }
                    u32x4 w; w.x = cvt_pk_bf16(v0[0], v0[1]); w.y = cvt_pk_bf16(v0[2], v0[3]); w.z = cvt_pk_bf16(v1[0], v1[1]); w.w = cvt_pk_bf16(v1[2], v1[3]);
                    *(u32x4*)(rowp + bj * HALF) = w; } }
    }
};
}

#define XB_TMO      128
#define XB_XCNT(j)  (256  + 64 * (j))
#define XB_XSUB(j)  (1280 + 64 * (j))
#define XB_XGEN(j)  (2304 + 64 * (j))
#define XB_TOP      3328
#define XB_TOPGEN   3392
#define XCD_BAR_WORDS 3456
#define XB_SPIN_CAP (1u << 18)
__device__ __forceinline__ unsigned xb_ld(unsigned* p)              { return __hip_atomic_load(p, __ATOMIC_RELAXED, __HIP_MEMORY_SCOPE_AGENT); }
__device__ __forceinline__ unsigned xb_add(unsigned* p, unsigned v) { return __hip_atomic_fetch_add(p, v, __ATOMIC_RELAXED, __HIP_MEMORY_SCOPE_AGENT); }
__device__ __forceinline__ unsigned xb_xcc_id() { return (unsigned)__builtin_amdgcn_s_getreg((3 << 11) | 20) & 0xFu; }
#define XB_SPIN(cond, bar) do { unsigned _sp = 0; while (cond) { __builtin_amdgcn_s_sleep(1); \
    if ((++_sp & 255u) == 0u) { if (xb_ld(&(bar)[XB_TMO])) break; if (_sp > XB_SPIN_CAP) { atomicAdd(&(bar)[XB_TMO], 1u); break; } } } } while (0)
struct XcdBarrier { unsigned* bar; unsigned x; volatile LAS unsigned* st; };
__device__ __forceinline__ XcdBarrier xcd_barrier_post(unsigned* bar, volatile LAS unsigned* st) {
    XcdBarrier b; b.bar = bar; b.x = xb_xcc_id(); b.st = st;
    if (threadIdx.x == 0) (void)xb_add(&bar[XB_XCNT(b.x)], 1u);
    return b;
}
__device__ __forceinline__ void xcd_barrier_complete(unsigned* bar, unsigned x, unsigned& nloc, unsigned& nx) {
    const unsigned G = gridDim.x * gridDim.y * gridDim.z;
    unsigned sum, cnt, mine, sp = 0u;
    for (;;) {
        sum = 0u; cnt = 0u; mine = 0u;
#pragma unroll
        for (unsigned j = 0; j < 16; ++j) { const unsigned c = xb_ld(&bar[XB_XCNT(j)]); sum += c; cnt += (c > 0u) ? 1u : 0u; mine = (j == x) ? c : mine; }
        if (sum == G) break;
        __builtin_amdgcn_s_sleep(1);
        if ((++sp & 255u) == 0u) { if (xb_ld(&bar[XB_TMO])) break; if (sp > XB_SPIN_CAP) { atomicAdd(&bar[XB_TMO], 1u); break; } }
    }
    nloc = mine > 0u ? mine : 1u; nx = cnt > 0u ? cnt : 1u;
}
__device__ __forceinline__ void xcd_barrier(const XcdBarrier& b) {
    asm volatile("s_waitcnt vmcnt(0)" ::: "memory");
    __syncthreads();
    if (threadIdx.x == 0) {
        unsigned* bar = b.bar;
        __builtin_amdgcn_s_waitcnt(0);
        unsigned nloc = b.st[0], nx = b.st[1];
        if (nloc == 0u) { xcd_barrier_complete(bar, b.x, nloc, nx); b.st[0] = nloc; b.st[1] = nx; }
        const unsigned old = xb_add(&bar[XB_XSUB(b.x)], 1u);
        const unsigned gen = old / nloc;
        if (old + 1u == (gen + 1u) * nloc) {
            __builtin_amdgcn_fence(__ATOMIC_RELEASE, "agent");
            asm volatile("s_waitcnt vmcnt(0)" ::: "memory");
            const unsigned og = xb_add(&bar[XB_TOP], 1u);
            const unsigned tg = og / nx;
            if (og + 1u == (tg + 1u) * nx) xb_add(&bar[XB_TOPGEN], 1u);
            else XB_SPIN(xb_ld(&bar[XB_TOPGEN]) == tg, bar);
            __builtin_amdgcn_fence(__ATOMIC_ACQUIRE, "agent");
            xb_add(&bar[XB_XGEN(b.x)], 1u);
            asm volatile("s_waitcnt vmcnt(0)" ::: "memory");
        } else {
            XB_SPIN(xb_ld(&bar[XB_XGEN(b.x)]) == gen, bar);
            __builtin_amdgcn_fence(__ATOMIC_ACQUIRE, "agent");
            asm volatile("s_waitcnt vmcnt(0)" ::: "memory");
        }
    }
    __syncthreads();
}

struct Args { const void* in[34]; float* out; unsigned char* ws; int ph_lo, ph_hi, li, pad; };
struct Frame {
    LAS unsigned char* lds;
    int tid, lane, wave, vcu, G;
    const void* const* in;
    unsigned char* ws;
    float* out;
};
__device__ __forceinline__ int opaque_tid() { int tz = threadIdx.x; asm volatile("" : "+v"(tz)); return tz; }
#define FIN(i) ((const float*)F.in[i])
#define WSP(type, off) ((type*)(F.ws + (off)))

constexpr int I_IN = (DM / 64) * (NPROJ / 32), I_GLU = (1024 / 64) * (1024 / 32), I_BR = (1024 / 64) * (DM / 32), I_OUT = (DM / 64) * (DM / 32),
              I_UP = (DM / 64) * (DFF / 32), I_DOWN = (DFF / 64) * (DM / 32), I_LAYER = I_IN + I_GLU + 4 * I_BR + I_OUT + I_UP + I_DOWN;
__device__ __forceinline__ void p0_resolve(Frame& F, int it, const float*& W, int& K, int& N, bf16_t*& WT, int& r) {
    const int l = it / I_LAYER; r = it - l * I_LAYER;
    unsigned char* wt = F.ws + WS_WT + (size_t)l * WT_LAYER;
    if (r < I_IN) { W = FIN(2) + (size_t)l * DM * NPROJ; K = DM; N = NPROJ; WT = (bf16_t*)(wt + WT_IN); return; } r -= I_IN;
    if (r < I_GLU) { W = FIN(15) + (size_t)l * 1024 * 1024; K = 1024; N = 1024; WT = (bf16_t*)(wt + WT_GLU); return; } r -= I_GLU;
    if (r < I_BR) { W = FIN(23) + (size_t)l * 1024 * DM; K = 1024; N = DM; WT = (bf16_t*)(wt + WT_BR); return; } r -= I_BR;
    if (r < I_BR) { W = FIN(24) + (size_t)l * 1024 * DM; K = 1024; N = DM; WT = (bf16_t*)(wt + WT_BR + 4 * MiB); return; } r -= I_BR;
    if (r < I_BR) { W = FIN(25) + (size_t)l * 1024 * DM; K = 1024; N = DM; WT = (bf16_t*)(wt + WT_BR + 8 * MiB); return; } r -= I_BR;
    if (r < I_BR) { W = FIN(26) + (size_t)l * 1024 * DM; K = 1024; N = DM; WT = (bf16_t*)(wt + WT_BR + 12 * MiB); return; } r -= I_BR;
    if (r < I_OUT) { W = FIN(27) + (size_t)l * DM * DM; K = DM; N = DM; WT = (bf16_t*)(wt + WT_OUT); return; } r -= I_OUT;
    if (r < I_UP) { W = FIN(30) + (size_t)l * DM * DFF; K = DM; N = DFF; WT = (bf16_t*)(wt + WT_UP); return; } r -= I_UP;
    W = FIN(31) + (size_t)l * DFF * DM; K = DFF; N = DM; WT = (bf16_t*)(wt + WT_DOWN);
}
__device__ __forceinline__ void p0_prologue(Frame& F) {
    LAS float* scr = (LAS float*)(F.lds + F.wave * 16384);
    const int gw = F.vcu * 8 + F.wave, NGW = F.G * 8; F.tid = opaque_tid(); F.lane = F.tid & 63;
    const int lane = F.lane;
    { float v[32]; const float* W; int K, N, r; bf16_t* WT;
      int it = gw;
#define P0_LOAD() do { p0_resolve(F, it, W, K, N, WT, r); const int nblk = N / 32, kb = r / nblk, nb = r - kb * nblk; const float* src = W + (size_t)(64 * kb + (lane >> 5)) * N + 32 * nb + (lane & 31); \
        _Pragma("unroll") for (int i = 0; i < 32; ++i) v[i] = src[(size_t)(2 * i) * N]; } while (0)
      if (it < NLAYER * I_LAYER) P0_LOAD();
      while (it < NLAYER * I_LAYER) {
          const int nblk = N / 32, kb = r / nblk, nb = r - kb * nblk, k0 = 64 * kb, n0 = 32 * nb, Kc = K; bf16_t* WTc = WT;
#pragma unroll
          for (int i = 0; i < 32; ++i) scr[(2 * i + (lane >> 5)) * 33 + (lane & 31)] = v[i];
          asm volatile("s_waitcnt lgkmcnt(0)" ::: "memory");
          it += NGW;
          if (it < NLAYER * I_LAYER) P0_LOAD();
          const int c = lane & 7;
#pragma unroll
          for (int j = 0; j < 4; ++j) { const int n = (lane >> 3) + 8 * j; const LAS float* s = scr + (8 * c) * 33 + n;
              u32x4 o; o.x = pk2(s[0 * 33], s[1 * 33]); o.y = pk2(s[2 * 33], s[3 * 33]); o.z = pk2(s[4 * 33], s[5 * 33]); o.w = pk2(s[6 * 33], s[7 * 33]);
              *(u32x4*)(WTc + (size_t)(n0 + n) * Kc + k0 + 8 * c) = o; }
          asm volatile("s_waitcnt lgkmcnt(0)" ::: "memory");
      }
#undef P0_LOAD
    }
    const int gt = F.vcu * 512 + F.tid, NGT = F.G * 512;
    for (int i = gt; i < NLAYER * (NPP - NPROJ) * DM / 8; i += NGT) { const int l = i / ((NPP - NPROJ) * DM / 8), r = i % ((NPP - NPROJ) * DM / 8);
        *(u32x4*)(F.ws + WS_WT + (size_t)l * WT_LAYER + WT_IN + (size_t)NPROJ * DM * 2 + (size_t)r * 16) = (u32x4){0u, 0u, 0u, 0u}; }
    { const int* pos = (const int*)F.in[1]; float* trig = WSP(float, WS_TRIG);
      for (int i = gt; i < T * 64; i += NGT) { const int t = i >> 6, j = i & 63;
          const double inv = exp2(-(double)j * (13.287712379549449 / 64.0));
          double s, c; sincos_d((double)pos[t] * inv, s, c);
          trig[(size_t)t * 128 + j] = (float)c; trig[(size_t)t * 128 + 64 + j] = (float)s; } }
    { const float* x = FIN(0); bf16_t* xb = WSP(bf16_t, WS_XB);
      for (int i = gt; i < T * DM / 4; i += NGT) { const f32x4 v = *(const f32x4*)(x + (size_t)i * 4); u32x2 w; w.x = pk2(v[0], v[1]); w.y = pk2(v[2], v[3]); *(u32x2*)(xb + (size_t)i * 4) = w; } }
    for (int i = gt; i < NLAYER * 4096; i += NGT) { const int l = i >> 12, gn = i & 4095, g = gn >> 6;
        const double lre = (double)FIN(7)[(size_t)l * 4096 + gn], lim = (double)FIN(8)[(size_t)l * 4096 + gn], step = exp((double)FIN(9)[l * 64 + g]);
        const double mag = exp(lre * step); double sn, cs; sincos_d(lim * step, sn, cs);
        const double are = mag * cs, aim = mag * sn, den = lre * lre + lim * lim;
        const double fre = ((are - 1.0) * lre + aim * lim) / den, fim = (aim * lre - (are - 1.0) * lim) / den;
        float* sp = (float*)(F.ws + WS_S5P + (size_t)l * MiB);
        sp[gn * 2] = (float)are; sp[gn * 2 + 1] = (float)aim;
        const float* bre = FIN(10) + ((size_t)l * 4096 + gn) * 16; const float* bim = FIN(11) + ((size_t)l * 4096 + gn) * 16;
        float* obre = sp + 16384 + (size_t)gn * 16; float* obim = sp + 16384 + 65536 + (size_t)gn * 16;
#pragma unroll
        for (int c = 0; c < 16; ++c) { const double br = bre[c], bi = bim[c]; obre[c] = (float)(fre * br - fim * bi); obim[c] = (float)(fre * bi + fim * br); } }
}

constexpr int LDP = 136;
__device__ __forceinline__ bf16x8 ldsfrag(const LAS bf16_t* base, int pitch, int row, int kk, int q) { return *(const LAS bf16x8*)(base + row * pitch + kk * 32 + 8 * q); }
__device__ __forceinline__ bf16x8 glbfrag(const bf16_t* base, int pitch, int row, int kk, int q) { return *(const bf16x8*)(base + (size_t)row * pitch + kk * 32 + 8 * q); }
#define MFMA16(a, b, c) __builtin_amdgcn_mfma_f32_16x16x32_bf16((a), (b), (c), 0, 0, 0)
#define LDS_BARRIER() do { asm volatile("s_waitcnt lgkmcnt(0)" ::: "memory"); __builtin_amdgcn_s_barrier(); asm volatile("" ::: "memory"); } while (0)

typedef float f32x16 __attribute__((ext_vector_type(16)));
__device__ __forceinline__ float gelu_tanh_(float y) { const float z = 0.7978845608028654f * (y + 0.044715f * y * y * y); const float th = 1.f - 2.f / (1.f + __expf(2.f * z)); return 0.5f * y * (1.f + th); }
__device__ __forceinline__ void s5_unit(Frame& F, int layer, int g) {
    const int tid = opaque_tid(), lane = tid & 63, w = F.wave, j = lane & 31, hh = lane >> 5, r16 = lane & 15, q = lane >> 4;
    LAS bf16_t* Xw = (LAS bf16_t*)(F.lds + w * 8704);
    LAS float* Ew = (LAS float*)(F.lds + 8 * 8704);
    const bf16_t* proj = WSP(bf16_t, WS_PROJ); bf16_t* ys = WSP(bf16_t, WS_YS5);
    const float* sp = (const float*)(F.ws + WS_S5P + (size_t)layer * MiB);
    float a1r[2], a1i[2], a2r[2], a2i[2], a3r[2], a3i[2], a4r[2], a4i[2];
#pragma unroll
    for (int s = 0; s < 2; ++s) { const int gn = g * 64 + j + 32 * s; a1r[s] = sp[gn * 2]; a1i[s] = sp[gn * 2 + 1];
        a2r[s] = a1r[s] * a1r[s] - a1i[s] * a1i[s]; a2i[s] = 2.f * a1r[s] * a1i[s];
        a3r[s] = a2r[s] * a1r[s] - a2i[s] * a1i[s]; a3i[s] = a2r[s] * a1i[s] + a2i[s] * a1r[s];
        a4r[s] = a2r[s] * a2r[s] - a2i[s] * a2i[s]; a4i[s] = 2.f * a2r[s] * a2i[s]; }
    bf16x8 bfr[4];
#pragma unroll
    for (int blk = 0; blk < 4; ++blk) { const float* src = sp + 16384 + (blk >> 1) * 65536 + (size_t)(g * 64 + j + 32 * (blk & 1)) * 16 + 8 * hh;
        const f32x4 v0 = *(const f32x4*)src, v1 = *(const f32x4*)(src + 4); u32x4 pk; pk.x = pk2(v0[0], v0[1]); pk.y = pk2(v0[2], v0[3]); pk.z = pk2(v1[0], v1[1]); pk.w = pk2(v1[2], v1[3]);
        bfr[blk] = __builtin_bit_cast(bf16x8, pk); }
    bf16x8 cfr[4];
    { const float* cre = FIN(12) + ((size_t)layer * 64 + g) * 1024 + r16 * 64; const float* cim = FIN(13) + ((size_t)layer * 64 + g) * 1024 + r16 * 64;
#pragma unroll
      for (int kk = 0; kk < 4; ++kk) { float v[8];
#pragma unroll
          for (int i = 0; i < 8; ++i) { const int ls = 8 * kk + 2 * q + (i >> 2), blk = i & 3, st = ls + 32 * (blk & 1); v[i] = (blk >> 1) ? -cim[st] : cre[st]; }
          u32x4 pk; pk.x = pk2(v[0], v[1]); pk.y = pk2(v[2], v[3]); pk.z = pk2(v[4], v[5]); pk.w = pk2(v[6], v[7]); cfr[kk] = __builtin_bit_cast(bf16x8, pk); } }
    const float dsk = FIN(14)[layer * 1024 + g * 16 + r16];
    const int t0 = w * 1024;
    float cr[2] = {0.f, 0.f}, ci[2] = {0.f, 0.f};
    const f32x16 zero16 = {0.f, 0.f, 0.f, 0.f, 0.f, 0.f, 0.f, 0.f, 0.f, 0.f, 0.f, 0.f, 0.f, 0.f, 0.f, 0.f};
#define S5_TILE(tt, DO_Y) do { \
        const bf16x8 afr = afn; \
        afn = *(const bf16x8*)(proj + (size_t)(t0 + 32 * (((tt) + 1) & 31) + j) * NPP + C_SU + 16 * g + 8 * hh);        \
        f32x16 acc[4]; \
        _Pragma("unroll") for (int blk = 0; blk < 4; ++blk) acc[blk] = __builtin_amdgcn_mfma_f32_32x32x16_bf16(afr, bfr[blk], zero16, 0, 0, 0); \
        float cjr[2][4], cji[2][4]; \
        _Pragma("unroll") for (int s = 0; s < 2; ++s) { \
            _Pragma("unroll") for (int gi = 0; gi < 4; ++gi) { float xr = 0.f, xi = 0.f; \
                _Pragma("unroll") for (int k = 0; k < 4; ++k) { const float nr = a1r[s] * xr - a1i[s] * xi + acc[s][4 * gi + k], ni = a1r[s] * xi + a1i[s] * xr + acc[2 + s][4 * gi + k]; xr = nr; xi = ni; acc[s][4 * gi + k] = xr; acc[2 + s][4 * gi + k] = xi; } } \
            float c_r = cr[s], c_i = ci[s]; \
            _Pragma("unroll") for (int gi = 0; gi < 4; ++gi) { const float er = acc[s][4 * gi + 3], ei = acc[2 + s][4 * gi + 3]; const float orr = __shfl_xor(er, 32), oi = __shfl_xor(ei, 32); \
                const float E0r = hh ? orr : er, E0i = hh ? oi : ei, E1r = hh ? er : orr, E1i = hh ? ei : oi;        \
                const float c0r = c_r, c0i = c_i; const float c1r = a4r[s] * c0r - a4i[s] * c0i + E0r, c1i = a4r[s] * c0i + a4i[s] * c0r + E0i; \
                cjr[s][gi] = hh ? c1r : c0r; cji[s][gi] = hh ? c1i : c0i; \
                c_r = a4r[s] * c1r - a4i[s] * c1i + E1r; c_i = a4r[s] * c1i + a4i[s] * c1r + E1i; } \
            cr[s] = c_r; ci[s] = c_i; } \
        if (DO_Y) { \
            _Pragma("unroll") for (int s = 0; s < 2; ++s) _Pragma("unroll") for (int gi = 0; gi < 4; ++gi) { const float kr = cjr[s][gi], ki = cji[s][gi]; \
                acc[s][4 * gi + 0] += a1r[s] * kr - a1i[s] * ki; acc[2 + s][4 * gi + 0] += a1r[s] * ki + a1i[s] * kr; \
                acc[s][4 * gi + 1] += a2r[s] * kr - a2i[s] * ki; acc[2 + s][4 * gi + 1] += a2r[s] * ki + a2i[s] * kr; \
                acc[s][4 * gi + 2] += a3r[s] * kr - a3i[s] * ki; acc[2 + s][4 * gi + 2] += a3r[s] * ki + a3i[s] * kr; \
                acc[s][4 * gi + 3] += a4r[s] * kr - a4i[s] * ki; acc[2 + s][4 * gi + 3] += a4r[s] * ki + a4i[s] * kr; } \
            _Pragma("unroll") for (int r = 0; r < 16; ++r) { const int tok = (r & 3) + 8 * (r >> 2) + 4 * hh; u32x2 o; o.x = pk2(acc[0][r], acc[1][r]); o.y = pk2(acc[2][r], acc[3][r]); *(LAS u32x2*)(Xw + tok * 136 + 4 * j) = o; } \
            bf16_t usk[2][4]; \
            _Pragma("unroll") for (int mt = 0; mt < 2; ++mt) _Pragma("unroll") for (int r = 0; r < 4; ++r) usk[mt][r] = proj[(size_t)(t0 + 32 * (tt) + 16 * mt + 4 * q + r) * NPP + C_SU + 16 * g + r16]; \
            asm volatile("s_waitcnt lgkmcnt(0)" ::: "memory"); \
            _Pragma("unroll") for (int mt = 0; mt < 2; ++mt) { f32x4 ya = {0.f, 0.f, 0.f, 0.f}; \
                _Pragma("unroll") for (int kk = 0; kk < 4; ++kk) ya = MFMA16(ldsfrag(Xw, 136, 16 * mt + r16, kk, q), cfr[kk], ya); \
                _Pragma("unroll") for (int r = 0; r < 4; ++r) { const size_t t = (size_t)(t0 + 32 * (tt) + 16 * mt + 4 * q + r); const float y = ya[r] + dsk * bf2f(usk[mt][r]); \
                    ys[t * 1024 + g * 16 + r16] = (bf16_t)f2bf(gelu_tanh_(y)); } } \
            asm volatile("s_waitcnt lgkmcnt(0)" ::: "memory"); } } while (0)
    bf16x8 afn = *(const bf16x8*)(proj + (size_t)(t0 + j) * NPP + C_SU + 16 * g + 8 * hh);
    for (int tt = 0; tt < 32; ++tt) S5_TILE(tt, false);
    if (hh == 0) {
#pragma unroll
        for (int s = 0; s < 2; ++s) { Ew[(w * 64 + j + 32 * s) * 2] = cr[s]; Ew[(w * 64 + j + 32 * s) * 2 + 1] = ci[s]; } }
    __syncthreads();
#pragma unroll
    for (int s = 0; s < 2; ++s) { float pr = a4r[s], pi = a4i[s];
#pragma unroll
        for (int k = 0; k < 8; ++k) { const float nr = pr * pr - pi * pi, ni = 2.f * pr * pi; pr = nr; pi = ni; }
        float xr = 0.f, xi = 0.f;
        for (int v = 0; v < w; ++v) { const float er = Ew[(v * 64 + j + 32 * s) * 2], ei = Ew[(v * 64 + j + 32 * s) * 2 + 1]; const float nr = pr * xr - pi * xi + er, ni = pr * xi + pi * xr + ei; xr = nr; xi = ni; }
        cr[s] = xr; ci[s] = xi; }
    for (int tt = 0; tt < 32; ++tt) S5_TILE(tt, true);
#undef S5_TILE
    __syncthreads();
}

constexpr size_t RET_BLK = 3 * 16384;
__device__ __forceinline__ void ret_pre_unit(Frame& F, int n, int h) {
    const int tid = opaque_tid(), lane = tid & 63, w = F.wave, r16 = lane & 15, q = lane >> 4;
    LAS bf16_t* Qs = (LAS bf16_t*)(F.lds); LAS bf16_t* Ks = (LAS bf16_t*)(F.lds + 128 * LDP * 2);
    const bf16_t* proj = WSP(bf16_t, WS_PROJ); const float* trig = WSP(float, WS_TRIG);
    bf16_t* blk = (bf16_t*)(F.ws + WS_TMP + TM_KR) + (size_t)(n * 4 + h) * RET_BLK;
    { const int tok = tid >> 2, qt = tid & 3; const size_t t = (size_t)n * 128 + tok;
      const bf16_t* pq = proj + t * NPP + C_RQ + h * 128 + 16 * qt; const bf16_t* pk = proj + t * NPP + C_RK + h * 128 + 16 * qt;
      const float* tc = trig + t * 128 + 16 * qt;
      float cs[16], sn[16];
#pragma unroll
      for (int i = 0; i < 4; ++i) { const f32x4 c4 = *(const f32x4*)(tc + 4 * i), s4 = *(const f32x4*)(tc + 64 + 4 * i);
#pragma unroll
          for (int j = 0; j < 4; ++j) { cs[4 * i + j] = c4[j]; sn[4 * i + j] = s4[j]; } }
#pragma unroll
      for (int isk = 0; isk < 2; ++isk) {
          const bf16_t* p = isk ? pk : pq; const float sc = isk ? 0.08838834764831845f : 1.0f;
          const u32x4 a0 = *(const u32x4*)p, a1 = *(const u32x4*)(p + 8), b0 = *(const u32x4*)(p + 64), b1 = *(const u32x4*)(p + 72);
          float x1[16], x2[16];
#pragma unroll
          for (int j = 0; j < 4; ++j) { x1[2 * j] = bf_lo(a0[j]); x1[2 * j + 1] = bf_hi(a0[j]); x1[8 + 2 * j] = bf_lo(a1[j]); x1[8 + 2 * j + 1] = bf_hi(a1[j]);
              x2[2 * j] = bf_lo(b0[j]); x2[2 * j + 1] = bf_hi(b0[j]); x2[8 + 2 * j] = bf_lo(b1[j]); x2[8 + 2 * j + 1] = bf_hi(b1[j]); }
          u32x4 o1[2], o2[2];
#pragma unroll
          for (int j = 0; j < 8; ++j) { const float ya = (x1[2 * j] * cs[2 * j] - x2[2 * j] * sn[2 * j]) * sc, yb = (x1[2 * j + 1] * cs[2 * j + 1] - x2[2 * j + 1] * sn[2 * j + 1]) * sc;
              const float za = (x1[2 * j] * sn[2 * j] + x2[2 * j] * cs[2 * j]) * sc, zb = (x1[2 * j + 1] * sn[2 * j + 1] + x2[2 * j + 1] * cs[2 * j + 1]) * sc;
              o1[j >> 2][j & 3] = pk2(ya, yb); o2[j >> 2][j & 3] = pk2(za, zb); }
          LAS bf16_t* ls = (isk ? Ks : Qs) + tok * LDP + 16 * qt;
          *(LAS u32x4*)ls = o1[0]; *(LAS u32x4*)(ls + 8) = o1[1]; *(LAS u32x4*)(ls + 64) = o2[0]; *(LAS u32x4*)(ls + 72) = o2[1];
          if (!isk) { bf16_t* g = blk + tok * 128 + 16 * qt; *(u32x4*)g = o1[0]; *(u32x4*)(g + 8) = o1[1]; *(u32x4*)(g + 64) = o2[0]; *(u32x4*)(g + 72) = o2[1]; } } }
    LDS_BARRIER();
    { const int d = tid >> 2, jq = tid & 3; bf16_t* g = blk + 2 * 16384 + d * 128 + 32 * jq;
#pragma unroll
      for (int c = 0; c < 4; ++c) { u32x4 o;
#pragma unroll
          for (int j = 0; j < 4; ++j) { const unsigned lo = Ks[(32 * jq + 8 * c + 2 * j) * LDP + d], hi = Ks[(32 * jq + 8 * c + 2 * j + 1) * LDP + d]; o[j] = lo | (hi << 16); }
          *(u32x4*)(g + 8 * c) = o; } }
    { const float lg = log2f(1.0f - exp2f(-5.0f - (float)h)); const int i = 16 * w + r16;
      bf16x8 bq[4];
#pragma unroll
      for (int kk = 0; kk < 4; ++kk) bq[kk] = ldsfrag(Qs, LDP, 16 * w + r16, kk, q);
      bf16_t* g = blk + 16384 + i * 128;
      for (int jt = 0; jt < 8; ++jt) {
          u32x2 o = {0u, 0u};
          if (jt <= w) { f32x4 acc = {0.f, 0.f, 0.f, 0.f};
#pragma unroll
              for (int kk = 0; kk < 4; ++kk) acc = MFMA16(ldsfrag(Ks, LDP, 16 * jt + r16, kk, q), bq[kk], acc);
              float v[4];
#pragma unroll
              for (int r = 0; r < 4; ++r) { const int j = 16 * jt + 4 * q + r; v[r] = (j <= i) ? acc[r] * exp2f((float)(i - j) * lg) : 0.f; }
              o.x = pk2(v[0], v[1]); o.y = pk2(v[2], v[3]); }
          *(u32x2*)(g + 16 * jt + 4 * q) = o; } }
    LDS_BARRIER();
}

__device__ __forceinline__ void ret_seq_unit(Frame& F, int u) {
    const int tid = opaque_tid(), lane = tid & 63, w = F.wave, r16 = lane & 15, q = lane >> 4;
    const int h = u >> 4, e0 = (u & 15) * 16;
    LAS bf16_t* Rt = (LAS bf16_t*)(F.lds); LAS bf16_t* Vt = (LAS bf16_t*)(F.lds + 2 * 16 * LDP * 2); LAS bf16_t* Vd = (LAS bf16_t*)(F.lds + 4 * 16 * LDP * 2);
    const bf16_t* proj = WSP(bf16_t, WS_PROJ); bf16_t* O = (bf16_t*)(F.ws + WS_TMP + TM_VR);
    const bf16_t* blk0 = (const bf16_t*)(F.ws + WS_TMP + TM_KR) + (size_t)h * RET_BLK;
    const float lg = log2f(1.0f - exp2f(-5.0f - (float)h)), g128 = exp2f(128.f * lg);
    float rsc[4];
#pragma unroll
    for (int r = 0; r < 4; ++r) rsc[r] = exp2f((float)(16 * w + 4 * q + r + 1) * lg);
    const int vj = tid >> 1, vh = tid & 1; const float vdec = exp2f((float)(127 - vj) * lg);
    u32x4 vreg = {0u, 0u, 0u, 0u};
#define RET_LOADV(c) do { if (tid < 256) vreg = *(const u32x4*)(proj + (size_t)((c) * 128 + vj) * NPP + C_RV + h * 256 + e0 + 8 * vh); } while (0)
#define RET_STOREV(b) do { if (tid < 256) { LAS bf16_t* vt = Vt + (b) * 16 * LDP + (8 * vh) * LDP + vj; LAS bf16_t* vd = Vd + (b) * 16 * LDP + (8 * vh) * LDP + vj; \
        _Pragma("unroll") for (int j = 0; j < 4; ++j) { const float lo = bf_lo(vreg[j]), hi = bf_hi(vreg[j]); vt[(2 * j) * LDP] = (bf16_t)(vreg[j] & 0xffffu); vt[(2 * j + 1) * LDP] = (bf16_t)(vreg[j] >> 16); \
            vd[(2 * j) * LDP] = (bf16_t)f2bf(lo * vdec); vd[(2 * j + 1) * LDP] = (bf16_t)f2bf(hi * vdec); } } } while (0)
#define RET_LOADF(FR, c) do { const bf16_t* bk = blk0 + (size_t)(c) * 4 * RET_BLK; _Pragma("unroll") for (int kk = 0; kk < 4; ++kk) { \
        FR[kk] = glbfrag(bk, 128, 16 * w + r16, kk, q); FR[4 + kk] = glbfrag(bk + 16384, 128, 16 * w + r16, kk, q); FR[8 + kk] = glbfrag(bk + 32768, 128, 16 * w + r16, kk, q); } } while (0)
    for (int i = tid; i < 16 * LDP; i += 512) Rt[i] = 0;
    RET_LOADV(0); RET_STOREV(0);
    bf16x8 fa[12], fb[12];
    RET_LOADF(fa, 0);
    f32x4 R = {0.f, 0.f, 0.f, 0.f};
    __syncthreads();
#define RET_CHUNK(c, CUR, NXT) do { const int b = (c) & 1; \
        if ((c) + 1 < T / 128) { RET_LOADF(NXT, (c) + 1); RET_LOADV((c) + 1); } \
        f32x4 a1 = {0.f, 0.f, 0.f, 0.f}, a2 = {0.f, 0.f, 0.f, 0.f}; f32x4 ra = R * g128; \
        _Pragma("unroll") for (int kk = 0; kk < 4; ++kk) { const bf16x8 bR = ldsfrag(Rt + b * 16 * LDP, LDP, r16, kk, q), bV = ldsfrag(Vt + b * 16 * LDP, LDP, r16, kk, q), bD = ldsfrag(Vd + b * 16 * LDP, LDP, r16, kk, q); \
            a1 = MFMA16(CUR[kk], bR, a1); a2 = MFMA16(CUR[4 + kk], bV, a2); ra = MFMA16(CUR[8 + kk], bD, ra); } \
        R = ra; \
        _Pragma("unroll") for (int r = 0; r < 4; ++r) O[(size_t)((c) * 128 + 16 * w + 4 * q + r) * 1024 + h * 256 + e0 + r16] = (bf16_t)f2bf(rsc[r] * a1[r] + a2[r]); \
        { u32x2 o; o.x = pk2(R[0], R[1]); o.y = pk2(R[2], R[3]); *(LAS u32x2*)(Rt + (b ^ 1) * 16 * LDP + r16 * LDP + 16 * w + 4 * q) = o; } \
        if ((c) + 1 < T / 128) RET_STOREV(b ^ 1); \
        LDS_BARRIER(); } while (0)
    for (int c = 0; c < T / 128; c += 2) { RET_CHUNK(c, fa, fb); RET_CHUNK(c + 1, fb, fa); }
#undef RET_CHUNK
#undef RET_LOADF
#undef RET_LOADV
#undef RET_STOREV
}


__device__ __forceinline__ void ssd_pre_unit(Frame& F, int layer, int n, int g) {
    const int tid = opaque_tid(), lane = tid & 63, w = F.wave, r16 = lane & 15, q = lane >> 4;
    LAS bf16_t* Cs = (LAS bf16_t*)(F.lds); LAS bf16_t* Bs = (LAS bf16_t*)(F.lds + 128 * LDP * 2);
    LAS float* Ac = (LAS float*)(F.lds + 2 * 128 * LDP * 2); LAS float* Dt = Ac + 8 * 128;
    const bf16_t* proj = WSP(bf16_t, WS_PROJ); const float* small = WSP(float, WS_SMALL);
    unsigned char* tm = F.ws + WS_TMP;
    float* acum = (float*)(tm + TM_SAC); bf16_t* XS = (bf16_t*)(tm + TM_SXS); bf16_t* XD = (bf16_t*)(tm + TM_SXD);
    bf16_t* cb = (bf16_t*)(tm + TM_SCB) + (size_t)(n * 2 + g) * 32768; bf16_t* sl = (bf16_t*)(tm + TM_SSL) + (size_t)(n * 16 + 8 * g) * 16384;
    const float* scw = FIN(17) + (size_t)layer * 1536 * 4; const float* scb = FIN(18) + layer * 1536; const float* sdtb = FIN(19) + layer * 16; const float* salog = FIN(20) + layer * 16;
    const int t0 = n * 128;
    { const int hh = 8 * g + w; const float a = -__expf(salog[hh]);
      const float dt0 = softplusf_(small[(size_t)(t0 + 2 * lane) * 32 + 16 + hh] + sdtb[hh]), dt1 = softplusf_(small[(size_t)(t0 + 2 * lane + 1) * 32 + 16 + hh] + sdtb[hh]);
      const float v0 = dt0 * a, v1 = dt1 * a, s = v0 + v1; float incl = s;
#pragma unroll
      for (int o = 1; o < 64; o <<= 1) { const float tmp = __shfl_up(incl, o); if (lane >= o) incl += tmp; }
      const float excl = incl - s;
      Ac[w * 128 + 2 * lane] = excl + v0; Ac[w * 128 + 2 * lane + 1] = excl + s; Dt[w * 128 + 2 * lane] = dt0; Dt[w * 128 + 2 * lane + 1] = dt1;
      acum[(size_t)(t0 + 2 * lane) * 16 + hh] = excl + v0; acum[(size_t)(t0 + 2 * lane + 1) * 16 + hh] = excl + s; }
    LDS_BARRIER();
    { const int cp = tid & 127, tq = tid >> 7; const int tb = t0 + 32 * tq;
      unsigned xa[3][35];
#pragma unroll
      for (int m = 0; m < 3; ++m) { const int ch = (m < 2) ? g * 512 + m * 256 + 2 * cp : (cp < 64 ? 1024 + g * 128 + 2 * cp : 1280 + g * 128 + 2 * (cp - 64)); const bf16_t* pc = proj + C_MX + ch;
#pragma unroll
          for (int i = 0; i < 35; ++i) xa[m][i] = (tb - 3 + i >= 0) ? *(const unsigned*)(pc + (size_t)(tb - 3 + i) * NPP) : 0u; }
#pragma unroll
      for (int m = 0; m < 3; ++m) {
          const int ch = (m < 2) ? g * 512 + m * 256 + 2 * cp : (cp < 64 ? 1024 + g * 128 + 2 * cp : 1280 + g * 128 + 2 * (cp - 64));
          const f32x4 w0 = *(const f32x4*)(scw + (size_t)ch * 4), w1 = *(const f32x4*)(scw + (size_t)ch * 4 + 4); const float b0 = scb[ch], b1 = scb[ch + 1];
          const unsigned (&xw)[35] = xa[m];
#pragma unroll
          for (int i = 0; i < 32; ++i) { const unsigned x0 = xw[i], x1 = xw[i + 1], x2 = xw[i + 2], x3 = xw[i + 3];
              const float ya = siluf_(w0[0] * bf_lo(x0) + w0[1] * bf_lo(x1) + w0[2] * bf_lo(x2) + w0[3] * bf_lo(x3) + b0);
              const float yb = siluf_(w1[0] * bf_hi(x0) + w1[1] * bf_hi(x1) + w1[2] * bf_hi(x2) + w1[3] * bf_hi(x3) + b1);
              if (m < 2) { const float dt = Dt[(m * 4 + (cp >> 5)) * 128 + 32 * tq + i]; const size_t go = (size_t)(tb + i) * 1024 + g * 512 + m * 256 + 2 * cp;
                  *(unsigned*)(XS + go) = pk2(ya, yb); *(unsigned*)(XD + go) = pk2(ya * dt, yb * dt); }
              else if (cp < 64) *(LAS unsigned*)(Bs + (32 * tq + i) * LDP + 2 * cp) = pk2(ya, yb);
              else *(LAS unsigned*)(Cs + (32 * tq + i) * LDP + 2 * (cp - 64)) = pk2(ya, yb); } } }
    LDS_BARRIER();
#pragma unroll
    for (int k = 0; k < 4; ++k) { const int idx = tid + 512 * k, row = idx >> 4, c8 = idx & 15; *(u32x4*)(cb + row * 128 + 8 * c8) = *(const LAS u32x4*)(Cs + row * LDP + 8 * c8); }
    { const int d = tid >> 2, jq = tid & 3; bf16_t* gp = cb + 16384 + d * 128 + 32 * jq;
#pragma unroll
      for (int c = 0; c < 4; ++c) { u32x4 o;
#pragma unroll
          for (int j = 0; j < 4; ++j) { const unsigned lo = Bs[(32 * jq + 8 * c + 2 * j) * LDP + d], hi = Bs[(32 * jq + 8 * c + 2 * j + 1) * LDP + d]; o[j] = lo | (hi << 16); }
          *(u32x4*)(gp + 8 * c) = o; } }
    { const int i = 16 * w + r16; bf16x8 bq[4];
#pragma unroll
      for (int kk = 0; kk < 4; ++kk) bq[kk] = ldsfrag(Cs, LDP, i, kk, q);
      float ai[8];
#pragma unroll
      for (int hh = 0; hh < 8; ++hh) ai[hh] = Ac[hh * 128 + i];
      for (int jt = 0; jt < 8; ++jt) {
          f32x4 acc = {0.f, 0.f, 0.f, 0.f};
          if (jt <= w) {
#pragma unroll
              for (int kk = 0; kk < 4; ++kk) acc = MFMA16(ldsfrag(Bs, LDP, 16 * jt + r16, kk, q), bq[kk], acc); }
#pragma unroll
          for (int hh = 0; hh < 8; ++hh) { u32x2 o = {0u, 0u};
              if (jt <= w) { const f32x4 aj = *(const LAS f32x4*)(Ac + hh * 128 + 16 * jt + 4 * q); float v[4];
#pragma unroll
                  for (int r = 0; r < 4; ++r) { const int j = 16 * jt + 4 * q + r; v[r] = (j <= i) ? acc[r] * __expf(ai[hh] - aj[r]) : 0.f; }
                  o.x = pk2(v[0], v[1]); o.y = pk2(v[2], v[3]); }
              *(u32x2*)(sl + (size_t)hh * 16384 + i * 128 + 16 * jt + 4 * q) = o; } } }
    LDS_BARRIER();
}

__device__ __forceinline__ void ssd_seq_unit(Frame& F, int u) {
    const int tid = opaque_tid(), lane = tid & 63, w = F.wave, r16 = lane & 15, q = lane >> 4;
    const int h = u >> 2, p0 = (u & 3) * 16, g = h >> 3;
    LAS bf16_t* St = (LAS bf16_t*)(F.lds); LAS bf16_t* Vt = (LAS bf16_t*)(F.lds + 2 * 16 * LDP * 2); LAS bf16_t* Vd = (LAS bf16_t*)(F.lds + 4 * 16 * LDP * 2);
    unsigned char* tm = F.ws + WS_TMP;
    const float* acum = (const float*)(tm + TM_SAC); const bf16_t* XD = (const bf16_t*)(tm + TM_SXD); bf16_t* O = (bf16_t*)(tm + TM_VS);
    const bf16_t* cb0 = (const bf16_t*)(tm + TM_SCB) + (size_t)g * 32768; const bf16_t* sl0 = (const bf16_t*)(tm + TM_SSL) + (size_t)h * 16384;
    const int vj = tid >> 1, vh = tid & 1;
    u32x4 vreg = {0u, 0u, 0u, 0u}; float vdl = 0.f, vdj = 0.f;
#define SSD_LOADV(c) do { if (tid < 256) { vreg = *(const u32x4*)(XD + (size_t)((c) * 128 + vj) * 1024 + h * 64 + p0 + 8 * vh); \
        vdl = acum[(size_t)((c) * 128 + 127) * 16 + h]; vdj = acum[(size_t)((c) * 128 + vj) * 16 + h]; } } while (0)
#define SSD_STOREV(b) do { if (tid < 256) { const float vdn = __expf(vdl - vdj); LAS bf16_t* vt = Vt + (b) * 16 * LDP + (8 * vh) * LDP + vj; LAS bf16_t* vd = Vd + (b) * 16 * LDP + (8 * vh) * LDP + vj; \
        _Pragma("unroll") for (int j = 0; j < 4; ++j) { const float lo = bf_lo(vreg[j]), hi = bf_hi(vreg[j]); vt[(2 * j) * LDP] = (bf16_t)(vreg[j] & 0xffffu); vt[(2 * j + 1) * LDP] = (bf16_t)(vreg[j] >> 16); \
            vd[(2 * j) * LDP] = (bf16_t)f2bf(lo * vdn); vd[(2 * j + 1) * LDP] = (bf16_t)f2bf(hi * vdn); } } } while (0)
#define SSD_LOADF(FR, AR, c) do { const bf16_t* bc = cb0 + (size_t)(c) * 2 * 32768; const bf16_t* bs = sl0 + (size_t)(c) * 16 * 16384; _Pragma("unroll") for (int kk = 0; kk < 4; ++kk) { \
        FR[kk] = glbfrag(bc, 128, 16 * w + r16, kk, q); FR[4 + kk] = glbfrag(bs, 128, 16 * w + r16, kk, q); FR[8 + kk] = glbfrag(bc + 16384, 128, 16 * w + r16, kk, q); } \
        _Pragma("unroll") for (int r = 0; r < 4; ++r) AR[r] = acum[(size_t)((c) * 128 + 16 * w + 4 * q + r) * 16 + h]; AR[4] = acum[(size_t)((c) * 128 + 127) * 16 + h]; } while (0)
    for (int i = tid; i < 16 * LDP; i += 512) St[i] = 0;
    SSD_LOADV(0); SSD_STOREV(0);
    bf16x8 fa[12], fb[12]; float aa[5], ab[5];
    SSD_LOADF(fa, aa, 0);
    f32x4 S = {0.f, 0.f, 0.f, 0.f};
    __syncthreads();
#define SSD_CHUNK(c, CUR, NXT, ACUR, ANXT) do { const int b = (c) & 1; \
        if ((c) + 1 < T / 128) { SSD_LOADF(NXT, ANXT, (c) + 1); SSD_LOADV((c) + 1); } \
        f32x4 a1 = {0.f, 0.f, 0.f, 0.f}, a2 = {0.f, 0.f, 0.f, 0.f}; f32x4 sa = S * __expf(ACUR[4]); \
        _Pragma("unroll") for (int kk = 0; kk < 4; ++kk) { const bf16x8 bS = ldsfrag(St + b * 16 * LDP, LDP, r16, kk, q), bV = ldsfrag(Vt + b * 16 * LDP, LDP, r16, kk, q), bD = ldsfrag(Vd + b * 16 * LDP, LDP, r16, kk, q); \
            a1 = MFMA16(CUR[kk], bS, a1); a2 = MFMA16(CUR[4 + kk], bV, a2); sa = MFMA16(CUR[8 + kk], bD, sa); } \
        S = sa; \
        _Pragma("unroll") for (int r = 0; r < 4; ++r) O[(size_t)((c) * 128 + 16 * w + 4 * q + r) * 1024 + h * 64 + p0 + r16] = (bf16_t)f2bf(__expf(ACUR[r]) * a1[r] + a2[r]); \
        { u32x2 o; o.x = pk2(S[0], S[1]); o.y = pk2(S[2], S[3]); *(LAS u32x2*)(St + (b ^ 1) * 16 * LDP + r16 * LDP + 16 * w + 4 * q) = o; } \
        if ((c) + 1 < T / 128) SSD_STOREV(b ^ 1); \
        LDS_BARRIER(); } while (0)
    for (int c = 0; c < T / 128; c += 2) { SSD_CHUNK(c, fa, fb, aa, ab); SSD_CHUNK(c + 1, fb, fa, ab, aa); }
#undef SSD_CHUNK
#undef SSD_LOADF
#undef SSD_LOADV
#undef SSD_STOREV
}


constexpr size_t GDN_BLK = 36864;
__device__ __forceinline__ void gdn_pre_unit(Frame& F, int layer, int n, int h) {
    const int tid = opaque_tid(), lane = tid & 63, w = F.wave, r16 = lane & 15, q = lane >> 4;
    LAS bf16_t* Qs = (LAS bf16_t*)(F.lds); LAS bf16_t* Ks = (LAS bf16_t*)(F.lds + 17408); LAS bf16_t* Kd = (LAS bf16_t*)(F.lds + 34816);
    LAS float* Mm = (LAS float*)(F.lds + 52224); LAS float* Rr = (LAS float*)(F.lds + 69632); LAS float* gc = (LAS float*)(F.lds + 135168); LAS float* be = gc + 64;
    LAS bf16_t* Ws = Qs;
    const bf16_t* proj = WSP(bf16_t, WS_PROJ); const float* small = WSP(float, WS_SMALL);
    unsigned char* tm = F.ws + WS_TMP;
    bf16_t* blk = (bf16_t*)(tm + TM_KG) + (size_t)(n * 8 + h) * GDN_BLK;
    const float* gcw = FIN(3) + (size_t)layer * 3072 * 4; const float* galog = FIN(4) + layer * 8; const float* gdtb = FIN(5) + layer * 8;
    const int t0 = n * 64;
    f32x4 wt[3][2];
#pragma unroll
      for (int p = 0; p < 3; ++p)
#pragma unroll
          for (int e = 0; e < 2; ++e) wt[p][e] = *(const f32x4*)(gcw + (size_t)(p * 1024 + h * 128 + 2 * lane + e) * 4);
    const bf16_t* pc = proj + C_DQ + h * 128 + 2 * lane; const int tb = t0 + 8 * w;
    unsigned x[3][4];
#pragma unroll
      for (int p = 0; p < 3; ++p)
#pragma unroll
          for (int k = 0; k < 3; ++k) x[p][k] = (tb - 3 + k >= 0) ? *(const unsigned*)(pc + (size_t)(tb - 3 + k) * NPP + p * 1024) : 0u;
    if (w == 0) { const float g = -__expf(galog[h]) * softplusf_(small[(size_t)(t0 + lane) * 32 + h] + gdtb[h]); float incl = g;
#pragma unroll
        for (int o = 1; o < 64; o <<= 1) { const float tmp = __shfl_up(incl, o); if (lane >= o) incl += tmp; }
        gc[lane] = incl; be[lane] = sigmoidf_(small[(size_t)(t0 + lane) * 32 + 8 + h]);
        if (lane == 63) ((float*)(tm + TM_SM))[n * 8 + h] = __expf(incl); }
    LDS_BARRIER();
    {
      const float gl63 = gc[63];
#pragma unroll
      for (int i = 0; i < 8; ++i) { const int tok = 8 * w + i; float v[3][2];
#pragma unroll
          for (int p = 0; p < 3; ++p) { x[p][3] = *(const unsigned*)(pc + (size_t)(tb + i) * NPP + p * 1024);
              v[p][0] = siluf_(wt[p][0][0] * bf_lo(x[p][0]) + wt[p][0][1] * bf_lo(x[p][1]) + wt[p][0][2] * bf_lo(x[p][2]) + wt[p][0][3] * bf_lo(x[p][3]));
              v[p][1] = siluf_(wt[p][1][0] * bf_hi(x[p][0]) + wt[p][1][1] * bf_hi(x[p][1]) + wt[p][1][2] * bf_hi(x[p][2]) + wt[p][1][3] * bf_hi(x[p][3]));
              x[p][0] = x[p][1]; x[p][1] = x[p][2]; x[p][2] = x[p][3]; }
          const float sq = wave_sum(v[0][0] * v[0][0] + v[0][1] * v[0][1]), sk = wave_sum(v[1][0] * v[1][0] + v[1][1] * v[1][1]);
          const float rq = rsqrtf(sq + RMS_EPS) * 0.08838834764831845f, rk = rsqrtf(sk + RMS_EPS);
          const float gci = gc[tok], bei = be[tok], eg = __expf(gci), et = __expf(gl63 - gci);
          const float q0 = v[0][0] * rq, q1 = v[0][1] * rq, k0 = v[1][0] * rk, k1 = v[1][1] * rk;
          *(LAS unsigned*)(Qs + tok * LDP + 2 * lane) = pk2(q0, q1); *(LAS unsigned*)(Ks + tok * LDP + 2 * lane) = pk2(k0, k1); *(LAS unsigned*)(Kd + tok * LDP + 2 * lane) = pk2(k0 * et, k1 * et);
          *(LAS f32x2*)(Rr + tok * 256 + 2 * lane) = (f32x2){bei * v[2][0], bei * v[2][1]}; *(LAS f32x2*)(Rr + tok * 256 + 128 + 2 * lane) = (f32x2){bei * eg * k0, bei * eg * k1};
          *(unsigned*)(blk + 16384 + tok * 128 + 2 * lane) = pk2(q0 * eg, q1 * eg); } }
    LDS_BARRIER();
    if (w < 4) { bf16x8 aK[4];
#pragma unroll
        for (int kk = 0; kk < 4; ++kk) aK[kk] = ldsfrag(Ks, LDP, 16 * w + r16, kk, q);
        for (int jt = 0; jt <= w; ++jt) { f32x4 acc = {0.f, 0.f, 0.f, 0.f};
#pragma unroll
            for (int kk = 0; kk < 4; ++kk) acc = MFMA16(aK[kk], ldsfrag(Ks, LDP, 16 * jt + r16, kk, q), acc);
            const int j = 16 * jt + r16; const float gj = gc[j];
#pragma unroll
            for (int r = 0; r < 4; ++r) { const int i = 16 * w + 4 * q + r; Mm[i * 68 + j] = (j < i) ? be[i] * acc[r] * __expf(gc[i] - gj) : 0.f; } } }
    else { const int wq = w - 4, i = 16 * wq + r16; bf16x8 bQ[4];
#pragma unroll
        for (int kk = 0; kk < 4; ++kk) bQ[kk] = ldsfrag(Qs, LDP, i, kk, q);
        const float gi = gc[i];
        for (int jt = 0; jt < 4; ++jt) { u32x2 o = {0u, 0u};
            if (jt <= wq) { f32x4 acc = {0.f, 0.f, 0.f, 0.f};
#pragma unroll
                for (int kk = 0; kk < 4; ++kk) acc = MFMA16(ldsfrag(Ks, LDP, 16 * jt + r16, kk, q), bQ[kk], acc);
                float v[4];
#pragma unroll
                for (int r = 0; r < 4; ++r) { const int j = 16 * jt + 4 * q + r; v[r] = (j <= i) ? acc[r] * __expf(gi - gc[j]) : 0.f; }
                o.x = pk2(v[0], v[1]); o.y = pk2(v[2], v[3]); }
            *(u32x2*)(blk + 24576 + i * 64 + 16 * jt + 4 * q) = o; } }
    { const int d = tid >> 2, jq = tid & 3; bf16_t* gp = blk + 28672 + d * 64 + 16 * jq;
#pragma unroll
      for (int c = 0; c < 2; ++c) { u32x4 o;
#pragma unroll
          for (int j = 0; j < 4; ++j) { const unsigned lo = Kd[(16 * jq + 8 * c + 2 * j) * LDP + d], hi = Kd[(16 * jq + 8 * c + 2 * j + 1) * LDP + d]; o[j] = lo | (hi << 16); }
          *(u32x4*)(gp + 8 * c) = o; } }
    LDS_BARRIER();
    if (tid < 256) { float x[64];
#pragma unroll
        for (int i = 0; i < 64; ++i) x[i] = 0.f;
#pragma unroll
        for (int i = 0; i < 64; ++i) { float s = Rr[i * 256 + tid];
#pragma unroll
            for (int j4 = 0; j4 < (i + 3) / 4; ++j4) { const f32x4 m4 = *(const LAS f32x4*)(Mm + i * 68 + 4 * j4); s -= m4[0] * x[4 * j4] + m4[1] * x[4 * j4 + 1] + m4[2] * x[4 * j4 + 2] + m4[3] * x[4 * j4 + 3]; }
            x[i] = s; }
        if (tid < 128) { bf16_t* gp = blk + 8192 + tid * 64;
#pragma unroll
            for (int c = 0; c < 8; ++c) { u32x4 o; o.x = pk2(x[8 * c], x[8 * c + 1]); o.y = pk2(x[8 * c + 2], x[8 * c + 3]); o.z = pk2(x[8 * c + 4], x[8 * c + 5]); o.w = pk2(x[8 * c + 6], x[8 * c + 7]); *(u32x4*)(gp + 8 * c) = o; } }
        else {
#pragma unroll
            for (int i = 0; i < 64; ++i) Ws[i * LDP + tid - 128] = (bf16_t)f2bf(x[i]); } }
    LDS_BARRIER();
#pragma unroll
    for (int k = 0; k < 2; ++k) { const int idx = tid + 512 * k, row = idx >> 4, c8 = idx & 15; *(u32x4*)(blk + row * 128 + 8 * c8) = *(const LAS u32x4*)(Ws + row * LDP + 8 * c8); }
    LDS_BARRIER();
}

__device__ __forceinline__ void gdn_seq_unit(Frame& F, int u) {
    const int tid = opaque_tid(), lane = tid & 63, w = F.wave, r16 = lane & 15, q = lane >> 4;
    const int h = u >> 3, e0 = (u & 7) * 16, mt = w & 3; const bool lo = w < 4;
    LAS bf16_t* St = (LAS bf16_t*)(F.lds); LAS bf16_t* Vt = (LAS bf16_t*)(F.lds + 16 * LDP * 2);
    unsigned char* tm = F.ws + WS_TMP; bf16_t* O = (bf16_t*)(tm + TM_VG);
    const bf16_t* blk0 = (const bf16_t*)(tm + TM_KG) + (size_t)h * GDN_BLK;
    const float* glp = (const float*)(tm + TM_SM) + h + (lane & 0);
    const int p0off = lo ? 0 : 16384;
    const int pfp = (u & 7) < 7 ? (u & 7) : 6;
    const int pfoff = (pfp < 2 ? pfp * 4096 : pfp < 4 ? 16384 + (pfp - 2) * 4096 : pfp == 4 ? 24576 : 28672 + (pfp - 5) * 4096) + tid * 8;
#define GDN_LOADF(S, c) do { const int cc = (c) < T / 64 ? (c) : T / 64 - 1; const bf16_t* bk = blk0 + (size_t)cc * 8 * GDN_BLK; \
        _Pragma("unroll") for (int kk = 0; kk < 4; ++kk) { const bf16_t* p = bk + p0off + (size_t)(16 * mt + r16) * 128 + kk * 32 + 8 * q; asm volatile("global_load_dwordx4 %0, %1, off" : "=v"(fr[S][kk]) : "v"(p) : "memory"); } \
        _Pragma("unroll") for (int kk = 0; kk < 2; ++kk) { const bf16_t* p = bk + 28672 + (size_t)(16 * w + r16) * 64 + kk * 32 + 8 * q; asm volatile("global_load_dwordx4 %0, %1, off" : "=v"(fr[S][4 + kk]) : "v"(p) : "memory"); } \
        _Pragma("unroll") for (int kk = 0; kk < 2; ++kk) { const bf16_t* p = bk + 24576 + (size_t)(16 * mt + r16) * 64 + kk * 32 + 8 * q; asm volatile("global_load_dwordx4 %0, %1, off" : "=v"(fr[S][6 + kk]) : "v"(p) : "memory"); } \
        { const bf16_t* p = bk + 8192 + (e0 + r16) * 64 + 16 * mt + 4 * q; asm volatile("global_load_dwordx2 %0, %1, off" : "=v"(uu[S]) : "v"(p) : "memory"); } \
        { const float* p = glp + cc * 8; asm volatile("global_load_dword %0, %1, off" : "=v"(gg[S]) : "v"(p) : "memory"); } \
        { const int c5 = (c) + 2 < T / 64 ? (c) + 2 : T / 64 - 1; const bf16_t* p = blk0 + (size_t)c5 * 8 * GDN_BLK + pfoff;        \
          asm volatile("global_load_dwordx4 %0, %1, off" : "=v"(dm[S]) : "v"(p) : "memory"); } } while (0)
#define GDN_WAIT(S) do { asm volatile("s_waitcnt vmcnt(33)" : "+v"(fr[S][0]), "+v"(fr[S][1]), "+v"(fr[S][2]), "+v"(fr[S][3]), "+v"(fr[S][4]), "+v"(fr[S][5]), "+v"(fr[S][6]), "+v"(fr[S][7]), "+v"(uu[S]), "+v"(gg[S]), "+v"(dm[S]) :: "memory"); \
        __builtin_amdgcn_sched_barrier(0); } while (0)
    for (int i = tid; i < 16 * LDP; i += 512) St[i] = 0;
    bf16x8 fr[4][8]; u32x2 uu[4]; float gg[4]; u32x4 dm[4];
    GDN_LOADF(0, 0); GDN_LOADF(1, 1); GDN_LOADF(2, 2);
    f32x4 S = {0.f, 0.f, 0.f, 0.f};
    LDS_BARRIER();
#define GDN_CHUNK(c, CS, LS) do { \
        GDN_LOADF(LS, (c) + 3); \
        GDN_WAIT(CS); \
        f32x4 a0 = {0.f, 0.f, 0.f, 0.f}; \
        _Pragma("unroll") for (int kk = 0; kk < 4; ++kk) a0 = MFMA16(fr[CS][kk], ldsfrag(St, LDP, r16, kk, q), a0); \
        if (lo) { u32x2 o; o.x = pk2(bf_lo(uu[CS].x) - a0[0], bf_hi(uu[CS].x) - a0[1]); o.y = pk2(bf_lo(uu[CS].y) - a0[2], bf_hi(uu[CS].y) - a0[3]); *(LAS u32x2*)(Vt + r16 * 72 + 16 * mt + 4 * q) = o; } \
        LDS_BARRIER(); \
        const bf16x8 bV0 = ldsfrag(Vt, 72, r16, 0, q), bV1 = ldsfrag(Vt, 72, r16, 1, q); \
        if (!lo) { a0 = MFMA16(fr[CS][6], bV0, a0); a0 = MFMA16(fr[CS][7], bV1, a0); \
            _Pragma("unroll") for (int r = 0; r < 4; ++r) O[(size_t)((c) * 64 + 16 * mt + 4 * q + r) * 1024 + h * 128 + e0 + r16] = (bf16_t)f2bf(a0[r]); } \
        f32x4 sa = S * gg[CS]; sa = MFMA16(fr[CS][4], bV0, sa); sa = MFMA16(fr[CS][5], bV1, sa); S = sa; \
        { u32x2 o; o.x = pk2(S[0], S[1]); o.y = pk2(S[2], S[3]); *(LAS u32x2*)(St + r16 * LDP + 16 * w + 4 * q) = o; } \
        LDS_BARRIER(); } while (0)
    for (int c = 0; c < T / 64; c += 4) { GDN_CHUNK(c, 0, 3); GDN_CHUNK(c + 1, 1, 0); GDN_CHUNK(c + 2, 2, 1); GDN_CHUNK(c + 3, 3, 2); }
    asm volatile("s_waitcnt vmcnt(0)" ::: "memory");
#undef GDN_WAIT
#undef GDN_CHUNK
#undef GDN_LOADF
}

__device__ __forceinline__ void mixer_phase(Frame& F, int layer) {
    for (int u = F.vcu; u < 256; u += F.G) {
        if (u < 64) { gdn_seq_unit(F, u); if (MIXREP & 1) gdn_seq_unit(F, u); }
        else if (u < 128) { s5_unit(F, layer, u - 64); if (MIXREP & 2) s5_unit(F, layer, u - 64); }
        else if (u < 192) { ret_seq_unit(F, u - 128); if (MIXREP & 4) ret_seq_unit(F, u - 128); }
        else { ssd_seq_unit(F, u - 192); if (MIXREP & 8) ssd_seq_unit(F, u - 192); }
    }
}
__device__ __forceinline__ void pre_phase(Frame& F, int layer) {
    for (int u = F.vcu; u < 1280; u += F.G) {
        if (u < 1024) { gdn_pre_unit(F, layer, u >> 3, u & 7); if (MIXREP & 16) gdn_pre_unit(F, layer, u >> 3, u & 7); }
        else if (u < 1152) { ssd_pre_unit(F, layer, (u - 1024) >> 1, (u - 1024) & 1); if (MIXREP & 32) ssd_pre_unit(F, layer, (u - 1024) >> 1, (u - 1024) & 1); }
        else { const int ru = 2 * (u - 1152);
            ret_pre_unit(F, ru >> 2, ru & 3); ret_pre_unit(F, (ru + 1) >> 2, (ru + 1) & 3); if (MIXREP & 64) ret_pre_unit(F, ru >> 2, ru & 3); }
    }
}

__device__ __forceinline__ void post_phase(Frame& F, int layer) {
    const int gw = F.vcu * 8 + F.wave, NGW = F.G * 8, lane = opaque_tid() & 63;
    const bf16_t* proj = WSP(bf16_t, WS_PROJ); bf16_t* ycat = WSP(bf16_t, WS_YCAT);
    unsigned char* tm = F.ws + WS_TMP;
    const bf16_t* Or = (const bf16_t*)(tm + TM_VR); const bf16_t* Os = (const bf16_t*)(tm + TM_VS); const bf16_t* Og = (const bf16_t*)(tm + TM_VG);
    const float* gnw = FIN(6) + layer * 128; const bf16_t* XS = (const bf16_t*)(tm + TM_SXS);
    const float* sdk = FIN(21) + layer * 16; const float* snw = FIN(22) + layer * 1024;
    const bool deal = (F.G == 256); const int bx = blockIdx.x;
    const int tbeg = deal ? (bx < 128 ? (bx * 8 + F.wave) * 3 : 3072 + ((bx - 128) * 8 + F.wave) * 5) : gw;
    const int tcnt = deal ? (bx < 128 ? 3 : 5) : (T - gw + NGW - 1) / NGW, tstep = deal ? 1 : NGW;
    for (int ti = 0; ti < tcnt; ++ti) { const int t = tbeg + ti * tstep;
        const bf16_t* pr = proj + (size_t)t * NPP; bf16_t* yo = ycat + (size_t)t * 4096;
#pragma unroll
        for (int h = 0; h < 4; ++h) { const u32x2 yw = *(const u32x2*)(Or + (size_t)t * 1024 + h * 256 + 4 * lane); f32x4 y = {bf_lo(yw.x), bf_hi(yw.x), bf_lo(yw.y), bf_hi(yw.y)};
            const float mu = wave_sum((y[0] + y[1]) + (y[2] + y[3])) * (1.f / 256.f); y = y - mu;
            const float rs = rsqrtf(wave_sum((y[0] * y[0] + y[1] * y[1]) + (y[2] * y[2] + y[3] * y[3])) * (1.f / 256.f) + LN_EPS);
            const u32x2 gw2 = *(const u32x2*)(pr + C_RG + h * 256 + 4 * lane);
            u32x2 o; o.x = pk2(y[0] * rs * siluf_(bf_lo(gw2.x)), y[1] * rs * siluf_(bf_hi(gw2.x))); o.y = pk2(y[2] * rs * siluf_(bf_lo(gw2.y)), y[3] * rs * siluf_(bf_hi(gw2.y)));
            *(u32x2*)(yo + h * 256 + 4 * lane) = o; }
#pragma unroll
        for (int h = 0; h < 8; ++h) { const unsigned ow = *(const unsigned*)(Og + (size_t)t * 1024 + h * 128 + 2 * lane); const f32x2 o = {bf_lo(ow), bf_hi(ow)};
            const float rs = rsqrtf(wave_sum(o[0] * o[0] + o[1] * o[1]) * (1.f / 128.f) + RMS_EPS);
            const unsigned zw = *(const unsigned*)(pr + C_DZ + h * 128 + 2 * lane); const f32x2 nw = *(const f32x2*)(gnw + 2 * lane);
            *(unsigned*)(yo + 1024 + h * 128 + 2 * lane) = pk2(o[0] * rs * nw[0] * siluf_(bf_lo(zw)), o[1] * rs * nw[1] * siluf_(bf_hi(zw))); }
        { float y[8][2]; float ss0 = 0.f, ss1 = 0.f;
#pragma unroll
          for (int j = 0; j < 8; ++j) { const unsigned ow = *(const unsigned*)(Os + (size_t)t * 1024 + j * 128 + 2 * lane); const f32x2 o = {bf_lo(ow), bf_hi(ow)}; const float d = sdk[2 * j + (lane >> 5)];
              const unsigned zw = *(const unsigned*)(pr + C_MZ + j * 128 + 2 * lane);
              const unsigned xw = *(const unsigned*)(XS + (size_t)t * 1024 + j * 128 + 2 * lane);
              y[j][0] = (o[0] + d * bf_lo(xw)) * siluf_(bf_lo(zw)); y[j][1] = (o[1] + d * bf_hi(xw)) * siluf_(bf_hi(zw));
              const float s2 = y[j][0] * y[j][0] + y[j][1] * y[j][1]; if (j < 4) ss0 += s2; else ss1 += s2; }
          const float r0 = rsqrtf(wave_sum(ss0) * (1.f / 512.f) + RMS_EPS), r1 = rsqrtf(wave_sum(ss1) * (1.f / 512.f) + RMS_EPS);
#pragma unroll
          for (int j = 0; j < 8; ++j) { const float rs = j < 4 ? r0 : r1; const f32x2 nw = *(const f32x2*)(snw + j * 128 + 2 * lane);
              *(unsigned*)(yo + 3072 + j * 128 + 2 * lane) = pk2(y[j][0] * rs * nw[0], y[j][1] * rs * nw[1]); } }
    }
}

__device__ __forceinline__ void ln_phase(Frame& F, const float* in, const float* res, const float* gam, const float* bet, float* outf, bf16_t* outb) {
    const int gw = F.vcu * 8 + F.wave, NGW = F.G * 8, lane = opaque_tid() & 63;
    for (int t = gw; t < T; t += NGW) {
        const f32x4* xr = (const f32x4*)(in + (size_t)t * DM) + lane; const f32x4* rr = (const f32x4*)(res + (size_t)t * DM) + lane;
        f32x4 v[8]; float s = 0.f;
#pragma unroll
        for (int j = 0; j < 8; ++j) { v[j] = xr[64 * j] + rr[64 * j] * ALPHA; s += (v[j][0] + v[j][1]) + (v[j][2] + v[j][3]); }
        const float mean = wave_sum(s) * (1.f / DM); float s2 = 0.f;
#pragma unroll
        for (int j = 0; j < 8; ++j) { v[j] = v[j] - mean; s2 += (v[j][0] * v[j][0] + v[j][1] * v[j][1]) + (v[j][2] * v[j][2] + v[j][3] * v[j][3]); }
        const float rstd = rsqrtf(wave_sum(s2) * (1.f / DM) + LN_EPS);
#pragma unroll
        for (int j = 0; j < 8; ++j) { const f32x4 gm = *((const f32x4*)gam + lane + 64 * j), bt = *((const f32x4*)bet + lane + 64 * j);
            const f32x4 o = v[j] * rstd * gm + bt;
            *((f32x4*)(outf + (size_t)t * DM) + lane + 64 * j) = o;
            u32x2 w; w.x = pk2(o[0], o[1]); w.y = pk2(o[2], o[3]); *((u32x2*)(outb + (size_t)t * DM) + lane + 64 * j) = w; }
    }
}

constexpr int N_PHASES = 1 + 10 * NLAYER;
__global__ void __launch_bounds__(512, 2) mega(Args args) {
    extern __shared__ __attribute__((aligned(16))) unsigned char lds_raw[];
    Frame F;
    F.lds = (LAS unsigned char*)lds_raw;
    F.tid = threadIdx.x; F.lane = F.tid & 63; F.wave = __builtin_amdgcn_readfirstlane(F.tid >> 6);
    F.G = gridDim.x; { const int bx = blockIdx.x; F.vcu = (F.G % 8 == 0) ? (bx % 8) * (F.G / 8) + bx / 8 : bx; }
    F.in = args.in; F.ws = args.ws; F.out = args.out;
    for (int u = F.tid; u < (LDS_BYTES - LDSCTL_OFF) / 4; u += 512) ((LAS unsigned*)(F.lds + LDSCTL_OFF))[u] = 0u;
    __syncthreads();
    const int lo = args.ph_lo, hi = args.ph_hi;
    unsigned* barw = (unsigned*)(args.ws + WS_CTL) + CW_BAR + args.li * XCD_BAR_WORDS;
    XcdBarrier bar; bar.bar = barw; bar.x = 0; bar.st = nullptr;
    if (hi - lo > 1) bar = xcd_barrier_post(barw, (volatile LAS unsigned*)(F.lds + MISC_OFF) + 8);
#define IN(k) (lo <= (k) && (k) < hi)
#define SEAM(k) do { if ((k) + 1 < hi) xcd_barrier(bar); } while (0)

    if (IN(0)) { p0_prologue(F); if (REPMASK & 1) { xcd_barrier(bar); p0_prologue(F); } SEAM(0); }

    for (int layer = 0; layer < NLAYER; ++layer) {
        const int pb = 1 + 10 * layer;
        unsigned char* wt = F.ws + WS_WT + (size_t)layer * WT_LAYER;
        const float* xcur = layer == 0 ? FIN(0) : WSP(float, WS_XR0);
#define B_INPROJ do { pg8::Gemm g{WSP(bf16_t, WS_XB), (const bf16_t*)(wt + WT_IN), T, NP_MAIN, DM, DM, DM, 0, 0}; pg8::StaticOrder S; S.init(T, NP_MAIN, F.G, (int)blockIdx.x); \
            pg8::EpiProj E{WSP(bf16_t, WS_PROJ), WSP(float, WS_SMALL), 0}; pg8::gemm_phase<pg8::EpiProj, pg8::StaticOrder, true, true>(F.lds, g, S, E); } while (0)
#define B_INPROJ_DEFER do { pg8::Gemm g{WSP(bf16_t, WS_XB), (const bf16_t*)(wt + WT_IN) + (size_t)NP_MAIN * DM, T, NPP - NP_MAIN, DM, DM, DM, 0, 0}; pg8::DeferOrder S; S.init(T, NPP - NP_MAIN, F.G, (F.vcu + F.G - 64 % F.G) % F.G); \
            pg8::EpiProj E{WSP(bf16_t, WS_PROJ) + NP_MAIN, WSP(float, WS_SMALL), NP_MAIN}; pg8::gemm_phase<pg8::EpiProj, pg8::DeferOrder, true, true>(F.lds, g, S, E); } while (0)
#define B_PREP pre_phase(F, layer)
#define B_MIX do { B_INPROJ_DEFER; mixer_phase(F, layer); } while (0)
#define B_GLUPOST do { pg8::Gemm g{WSP(bf16_t, WS_YS5), (const bf16_t*)(wt + WT_GLU), T, 1024, 1024, 1024, 1024, 0, 0}; pg8::StaticOrder S; S.init(T, 1024, F.G, (int)blockIdx.x); \
            pg8::EpiGlu E{WSP(bf16_t, WS_YS5), FIN(16) + layer * 1024, WSP(bf16_t, WS_YCAT)}; pg8::gemm_phase<pg8::EpiGlu, pg8::StaticOrder, true, true>(F.lds, g, S, E); post_phase(F, layer); } while (0)
#define B_MERGE do { pg8::Gemm g{WSP(bf16_t, WS_YCAT), (const bf16_t*)(wt + WT_BR), T, DM, 1024, 4096, 1024, 2048, 4 * MiB}; pg8::SegOrder<4> S; S.init(T, DM, F.G, (int)blockIdx.x); \
            pg8::EpiMerge E{WSP(bf16_t, WS_PROJ), (bf16_t*)(F.ws + WS_TMP + TM_MERGED)}; pg8::gemm_phase<pg8::EpiMerge, pg8::SegOrder<4>, true, true>(F.lds, g, S, E); } while (0)
#define B_WOUT do { pg8::Gemm g{(const bf16_t*)(F.ws + WS_TMP + TM_MERGED), (const bf16_t*)(wt + WT_OUT), T, DM, DM, DM, DM, 0, 0}; pg8::StaticOrder S; S.init(T, DM, F.G, (int)blockIdx.x); \
            pg8::EpiResid E{xcur, (float*)(F.ws + WS_TMP + TM_PRE)}; pg8::gemm_phase<pg8::EpiResid, pg8::StaticOrder, true, true>(F.lds, g, S, E); } while (0)
#define B_LN1 ln_phase(F, (const float*)(F.ws + WS_TMP + TM_PRE), xcur, FIN(28) + layer * DM, FIN(29) + layer * DM, WSP(float, WS_XR1), WSP(bf16_t, WS_XB))
#define B_UP do { pg8::Gemm g{WSP(bf16_t, WS_XB), (const bf16_t*)(wt + WT_UP), T, DFF, DM, DM, DM, 0, 0}; pg8::StaticOrder S; S.init(T, DFF, F.G, (int)blockIdx.x); \
            pg8::EpiRelu2 E{WSP(bf16_t, WS_HID)}; pg8::gemm_phase<pg8::EpiRelu2, pg8::StaticOrder, true, true>(F.lds, g, S, E); } while (0)
#define B_DOWN do { pg8::Gemm g{WSP(bf16_t, WS_HID), (const bf16_t*)(wt + WT_DOWN), T, DM, DFF, DFF, DFF, 0, 0}; pg8::StaticOrder S; S.init(T, DM, F.G, (int)blockIdx.x); \
            pg8::EpiResid E{WSP(float, WS_XR1), (float*)(F.ws + WS_TMP + TM_PRE)}; pg8::gemm_phase<pg8::EpiResid, pg8::StaticOrder, true, true>(F.lds, g, S, E); } while (0)
#define B_LN2 ln_phase(F, (const float*)(F.ws + WS_TMP + TM_PRE), WSP(float, WS_XR1), FIN(32) + layer * DM, FIN(33) + layer * DM, layer == NLAYER - 1 ? F.out : WSP(float, WS_XR0), WSP(bf16_t, WS_XB))
#define PH(k, body) do { if (IN(pb + (k))) { body; if ((REPMASK >> ((k) + 1)) & 1) { xcd_barrier(bar); body; } SEAM(pb + (k)); } } while (0)
        PH(0, B_INPROJ);
        PH(1, B_PREP);
        if (IN(pb + 2)) { B_MIX; if ((REPMASK >> 3) & 1) { xcd_barrier(bar); B_PREP; xcd_barrier(bar); B_MIX; } SEAM(pb + 2); }
        PH(3, B_GLUPOST);
        PH(4, B_MERGE);
        PH(5, B_WOUT);
        PH(6, B_LN1);
        PH(7, B_UP);
        PH(8, B_DOWN);
        PH(9, B_LN2);
    }
#undef IN
#undef SEAM
}

extern "C" void kernel_launch(void* const* d_in, const int* in_sizes, int n_in, void* d_out, int out_size, void* d_ws, size_t ws_size, hipStream_t stream) {
    static int grid = 0;
    if (grid == 0) {
        if (n_in != 34 || out_size != T * DM || ws_size < WS_END) { fprintf(stderr, "kernel_launch: unexpected sizes (n_in %d, out %d, ws %zu need %zu)\n", n_in, out_size, ws_size, (size_t)WS_END); grid = -1; return; }
        int dev = 0, cus = 0, per_cu = 0;
        if (hipGetDevice(&dev) != hipSuccess || hipDeviceGetAttribute(&cus, hipDeviceAttributeMultiprocessorCount, dev) != hipSuccess) { grid = -1; return; }
        if (hipFuncSetAttribute((const void*)mega, hipFuncAttributeMaxDynamicSharedMemorySize, LDS_BYTES) != hipSuccess) { fprintf(stderr, "kernel_launch: hipFuncSetAttribute failed\n"); grid = -1; return; }
        if (hipOccupancyMaxActiveBlocksPerMultiprocessor(&per_cu, (const void*)mega, 512, LDS_BYTES) != hipSuccess || per_cu < 1) fprintf(stderr, "kernel_launch: occupancy query reports %d\n", per_cu);
        (void)hipGetLastError();
        grid = cus;
    }
    if (grid < 0) return;
    if (hipMemsetAsync((char*)d_ws + WS_CTL, 0, CTL_ZERO_BYTES, stream) != hipSuccess) return;
    Args a{};
    for (int i = 0; i < 34; ++i) a.in[i] = d_in[i];
    a.out = (float*)d_out; a.ws = (unsigned char*)d_ws;
#if MK_N_LAUNCHES == 1
    a.ph_lo = 0; a.ph_hi = N_PHASES; a.li = 0;
    hipLaunchKernelGGL(mega, dim3(grid), dim3(512), LDS_BYTES, stream, a);
#else
    for (int p = 0; p < N_PHASES; ++p) { a.ph_lo = p; a.ph_hi = p + 1; a.li = p; hipLaunchKernelGGL(mega, dim3(grid), dim3(512), LDS_BYTES, stream, a); }
#endif
}
```

```cpp
#include <hip/hip_runtime.h>
#include <cstdio>
#include <cstdint>

#ifndef MK_N_LAUNCHES
#define MK_N_LAUNCHES 1
#endif

#ifndef MIXREP
#define MIXREP 0
#endif
#ifndef REPMASK
#define REPMASK 0
#endif
#define LAS __attribute__((address_space(3)))
#define GAS __attribute__((address_space(1)))
typedef unsigned short bf16_t;
typedef short bf16x8 __attribute__((ext_vector_type(8)));
typedef float f32x4 __attribute__((ext_vector_type(4)));
typedef float f32x2 __attribute__((ext_vector_type(2)));
typedef unsigned u32x4 __attribute__((ext_vector_type(4)));
typedef unsigned u32x2 __attribute__((ext_vector_type(2)));

constexpr int T = 8192, DM = 2048, NPROJ = 18976, NPP = 19200, NP_MAIN = 18432, DFF = 8192, NLAYER = 2;
constexpr int C_RQ = 0, C_RK = 512, C_RV = 1024, C_RG = 2048, C_DQ = 3072, C_DK = 4096, C_DV = 5120, C_DZ = 6144, C_DA = 7168, C_DB = 7176,
              C_SU = 7184, C_MZ = 8208, C_MX = 9232, C_MB = 10256, C_MC = 10512, C_MDT = 10768, C_GATE = 10784;
constexpr float LN_EPS = 1e-5f, RMS_EPS = 1e-6f, ALPHA = 1.41421356237f;

constexpr size_t MiB = 1u << 20;
constexpr size_t WS_CTL = 0, CTL_ZERO_BYTES = 1 * MiB;
constexpr size_t WT_IN = 0, WT_GLU = 75 * MiB, WT_BR = 77 * MiB, WT_OUT = 93 * MiB, WT_UP = 101 * MiB, WT_DOWN = 133 * MiB, WT_LAYER = 165 * MiB;
constexpr size_t WS_WT = 1 * MiB;
constexpr size_t WS_PROJ = WS_WT + 2 * WT_LAYER;
constexpr size_t WS_HID = WS_PROJ;
constexpr size_t WS_SMALL = WS_PROJ + 300 * MiB;
constexpr size_t WS_TRIG = WS_SMALL + 1 * MiB;
constexpr size_t WS_S5P = WS_TRIG + 4 * MiB;
constexpr size_t WS_YCAT = WS_S5P + 2 * MiB;
constexpr size_t WS_YS5 = WS_YCAT + 64 * MiB;
constexpr size_t WS_XB = WS_YS5 + 16 * MiB;
constexpr size_t WS_XR0 = WS_XB + 32 * MiB;
constexpr size_t WS_XR1 = WS_XR0 + 64 * MiB;
constexpr size_t WS_TMP = WS_XR1 + 64 * MiB;
constexpr size_t TM_KR = 0, TM_VR = 32 * MiB,
                 TM_SCB = 64 * MiB, TM_SSL = 72 * MiB, TM_SXD = 104 * MiB, TM_SXS = 120 * MiB, TM_SAC = 136 * MiB, TM_VS = 138 * MiB,
                 TM_KG = 170 * MiB, TM_VG = 242 * MiB, TM_SM = 274 * MiB, TM_END = 278 * MiB;
constexpr size_t TM_MERGED = 0, TM_PRE = 32 * MiB;
constexpr size_t WS_END = WS_TMP + TM_END;
constexpr int CW_BAR = 4096;

constexpr int RING_BYTES = 131072, LDSCTL_OFF = 155648, MISC_OFF = LDSCTL_OFF + 320, LDS_BYTES = 163840;

__device__ __forceinline__ unsigned f2bf(float f) { return (unsigned)__builtin_bit_cast(unsigned short, (__bf16)f); }
__device__ __forceinline__ unsigned pk2(float lo, float hi) { typedef __bf16 bf2_t __attribute__((ext_vector_type(2))); const bf2_t v = {(__bf16)lo, (__bf16)hi}; return __builtin_bit_cast(unsigned, v); }
__device__ __forceinline__ float bf_lo(unsigned u) { return __builtin_bit_cast(float, u << 16); }
__device__ __forceinline__ float bf_hi(unsigned u) { return __builtin_bit_cast(float, u & 0xffff0000u); }
__device__ __forceinline__ float bf2f(bf16_t h) { return __builtin_bit_cast(float, (unsigned)h << 16); }
__device__ __forceinline__ float sigmoidf_(float x) { return 1.f / (1.f + __expf(-x)); }
__device__ __forceinline__ float siluf_(float x) { return x / (1.f + __expf(-x)); }
__device__ __forceinline__ float softplusf_(float x) { return x > 20.f ? x : log1pf(__expf(x)); }
template <int CTRL> __device__ __forceinline__ float dppf(float v) { return __builtin_bit_cast(float, __builtin_amdgcn_update_dpp(0, __builtin_bit_cast(int, v), CTRL, 0xF, 0xF, true)); }
__device__ __forceinline__ float row_sum16(float v) {
    v += dppf<0xB1>(v); v += dppf<0x4E>(v); v += dppf<0x141>(v); v += dppf<0x140>(v); return v;
}
__device__ __forceinline__ float wave_sum(float v) { v = row_sum16(v); v += __shfl_xor(v, 16); v += __shfl_xor(v, 32); return v; }
__device__ __forceinline__ void sincos_d(double x, double& s, double& c) {
    const double k = __builtin_rint(x * 0.63661977236758134308);
    double r = __builtin_fma(-k, 1.57079632679489655800e+00, x);
    r = __builtin_fma(-k, 6.12323399573676603587e-17, r);
    const double r2 = r * r;
    double sp = 1.58969099521155010221e-10;
    sp = __builtin_fma(sp, r2, -2.50507602534068634195e-08);
    sp = __builtin_fma(sp, r2, 2.75573137070700676789e-06);
    sp = __builtin_fma(sp, r2, -1.98412698298579493134e-04);
    sp = __builtin_fma(sp, r2, 8.33333333332248946124e-03);
    sp = __builtin_fma(sp, r2, -1.66666666666666324348e-01);
    const double sn = __builtin_fma(sp * r2, r, r);
    double cp = -1.13596475577881948265e-11;
    cp = __builtin_fma(cp, r2, 2.08757232129817482790e-09);
    cp = __builtin_fma(cp, r2, -2.75573143513906633035e-07);
    cp = __builtin_fma(cp, r2, 2.48015872894767294178e-05);
    cp = __builtin_fma(cp, r2, -1.38888888888741095749e-03);
    cp = __builtin_fma(cp, r2, 4.16666666666666019037e-02);
    const double cs = __builtin_fma(cp * r2, r2, __builtin_fma(-0.5, r2, 1.0));
    const long q = (long)k & 3;
    s = (q == 0) ? sn : (q == 1) ? cs : (q == 2) ? -sn : -cs;
    c = (q == 0) ? cs : (q == 1) ? -sn : (q == 2) ? -cs : sn;
}

namespace pg8 {
constexpr int BM = 256, BK = 64, HALF = 128, HTB = HALF * BK * 2, STAGE_BYTES = 8 * HTB, NXCD = 8, WGM = 8;
__host__ __device__ __forceinline__ int lds_byte(int r, int c) { const int st = (r >> 4) * 2 + (c >> 5), rr = r & 15, cc = c & 31, ob = rr * 64 + cc * 2; return st * 1024 + (ob ^ (((ob >> 9) & 1) << 5)); }
__host__ __device__ __forceinline__ void stage_rc(int b, int& R, int& C) { const int st = b / 1024, sb = b % 1024, swz = sb ^ (((sb >> 9) & 1) << 5); R = (st >> 1) * 16 + swz / 64; C = (st & 1) * 32 + (swz % 64) / 2; }
__host__ __device__ __forceinline__ int perm32(int rho) { const int n = rho >> 4, i = rho & 15; return 8 * (i >> 2) + 4 * n + (i & 3); }

struct Unit { int pm, pn, seg; };
struct Gemm { const bf16_t* A; const bf16_t* Bt; int M, N, K, lda, ldb; size_t segA, segB; };

__host__ __device__ __forceinline__ void tile_of(long L, int nM, int nN, int& pm, int& pn) {
    const int nwg = nM * nN; int wgid = (int)L;
    { const int q = nwg / NXCD, r = nwg % NXCD, xcd = wgid % NXCD, off = wgid / NXCD; wgid = (xcd < r ? xcd * (q + 1) : r * (q + 1) + (xcd - r) * q) + off; }
    const int nig = WGM * nN, gid = wgid / nig, fm = gid * WGM, gsz = (nM - fm) < WGM ? (nM - fm) : WGM;
    pm = fm + ((wgid % nig) % gsz); pn = (wgid % nig) / gsz;
}
struct StaticOrder {
    int nM, nN, nwg, G, c;
    __host__ __device__ void init(int M, int N, int G_, int c_) { nM = M / BM; nN = N / BM; nwg = nM * nN; G = G_; c = c_; }
    __host__ __device__ bool next(int i, Unit& u) const {
        const long L = (long)i * G + c; if (L >= nwg) return false;
        tile_of(L, nM, nN, u.pm, u.pn); u.seg = 0; return true;
    }
    __device__ __forceinline__ void a_ready(const Unit&) const {}
    __device__ __forceinline__ void done(const Unit&) const {}
};
template <int NSEG> struct SegOrder {
    int nM, nN, nwg, G, c;
    __host__ __device__ void init(int M, int N, int G_, int c_) { nM = M / BM; nN = N / BM; nwg = nM * nN; G = G_; c = c_; }
    __host__ __device__ bool next(int i, Unit& u) const {
        const long L = (long)(i / NSEG) * G + c; if (L >= nwg) return false;
        tile_of(L, nM, nN, u.pm, u.pn); u.seg = i % NSEG; return true;
    }
    __device__ __forceinline__ void a_ready(const Unit&) const {}
    __device__ __forceinline__ void done(const Unit&) const {}
};

struct DeferOrder {
    int nM, nunits, G, c;
    __host__ __device__ void init(int M, int N, int G_, int c_) { nM = M / BM; nunits = nM * (N / BM); G = G_; c = c_; }
    __host__ __device__ bool next(int i, Unit& u) const { const long L = (long)i * G + c; if (L >= nunits) return false; u.pm = (int)(L % nM); u.pn = (int)(L / nM); u.seg = 0; return true; }
    __device__ __forceinline__ void a_ready(const Unit&) const {}
    __device__ __forceinline__ void done(const Unit&) const {}
};
__device__ __forceinline__ unsigned cvt_pk_bf16(float lo, float hi) { unsigned r; asm volatile("v_cvt_pk_bf16_f32 %0, %1, %2" : "=v"(r) : "v"(lo), "v"(hi)); return r; }


template <class Epi, class Sched, bool ALIGN_EPI = false, bool SP2 = false>
__device__ __forceinline__ void gemm_phase(LAS unsigned char* lds, const Gemm g, const Sched& S, const Epi& E) {
    int tid = threadIdx.x; asm volatile("" : "+v"(tid));
    const int wid = __builtin_amdgcn_readfirstlane(tid >> 6), lane = tid & 63, wr = wid >> 2, wc = wid & 3, fr = lane & 15, fq = lane >> 4;
    const int K = g.K, nt = K / BK;
    unsigned voffA[2], voffB[2];
#pragma unroll
    for (int i = 0; i < 2; ++i) { int R, C; stage_rc(tid * 16 + i * 8192, R, C); const int Rb = Epi::PERM ? ((R & ~31) + perm32(R & 31)) : R;
        voffA[i] = (unsigned)(R * g.lda + C) * 2u; voffB[i] = (unsigned)(Rb * g.ldb + C) * 2u; }
    const size_t kstep = (size_t)(BK * 2);
    const size_t hstepA = (size_t)HALF * g.lda * 2, hstepB = (size_t)HALF * g.ldb * 2;
    const size_t tstepA = 2 * hstepA, tstepB = 2 * hstepB;
    const unsigned ldsw = (unsigned)wid * 1024u;
    const int aoff = lds_byte(wr * 64 + fr, fq * 8), boff = lds_byte(wc * 32 + fr, fq * 8);
#define PG8_SA(b, h) (((b) * 2 + (h)) * HTB)
#define PG8_SB(b, h) ((4 + (b) * 2 + (h)) * HTB)
#define PG8_STAGE(bufoff, gbase, voff) do { _Pragma("unroll") for (int _i = 0; _i < 2; ++_i) \
        __builtin_amdgcn_global_load_lds((const unsigned*)((const char*)(gbase) + (voff)[_i]), (LAS unsigned*)(lds + (bufoff) + ldsw + _i * 8192), 16, 0, 0); } while (0)
#define PG8_LDA(dst, b, h) do { _Pragma("unroll") for (int m = 0; m < 4; ++m) _Pragma("unroll") for (int k = 0; k < 2; ++k) dst[m][k] = *(const LAS bf16x8*)(lds + PG8_SA(b, h) + aoff + m * 2048 + k * 1024); } while (0)
#define PG8_LDB(dst, b, h) do { _Pragma("unroll") for (int n = 0; n < 2; ++n) _Pragma("unroll") for (int k = 0; k < 2; ++k) dst[n][k] = *(const LAS bf16x8*)(lds + PG8_SB(b, h) + boff + n * 2048 + k * 1024); } while (0)
#define PG8_MMA(ai, bj, At, Bt) do { __builtin_amdgcn_s_setprio(1); _Pragma("unroll") for (int m = 0; m < 4; ++m) _Pragma("unroll") for (int n = 0; n < 2; ++n) _Pragma("unroll") for (int k = 0; k < 2; ++k) \
        acc[ai][bj][m][n] = __builtin_amdgcn_mfma_f32_16x16x32_bf16(Bt[n][k], At[m][k], acc[ai][bj][m][n], 0, 0, 0); __builtin_amdgcn_s_setprio(0); } while (0)
#define PG8_WAIT_V(n) asm volatile("s_waitcnt vmcnt(" #n ")" ::: "memory")
#define PG8_WAIT_L(n) asm volatile("s_waitcnt lgkmcnt(" #n ")" ::: "memory")
#define PG8_BAR __builtin_amdgcn_s_barrier()
#define PG8_SCHED __builtin_amdgcn_sched_barrier(0)
    Unit cur, nxt; int ui = 0;
    if (!S.next(0, cur)) return;
    f32x4 acc[2][2][4][2];
#pragma unroll
    for (int a = 0; a < 2; ++a)
#pragma unroll
        for (int b = 0; b < 2; ++b)
#pragma unroll
            for (int m = 0; m < 4; ++m)
#pragma unroll
                for (int n = 0; n < 2; ++n) acc[a][b][m][n] = (f32x4){0.f, 0.f, 0.f, 0.f};
    bf16x8 At[4][2], B0[2][2], B1[2][2];
    const char* cA = (const char*)g.A + (size_t)cur.seg * g.segA + (size_t)cur.pm * tstepA; const char* cB = (const char*)g.Bt + (size_t)cur.seg * g.segB + (size_t)cur.pn * tstepB;
    S.a_ready(cur);
    if constexpr (SP2) {
        PG8_STAGE(PG8_SB(0, 0), cB, voffB); PG8_STAGE(PG8_SB(0, 1), cB + hstepB, voffB); PG8_STAGE(PG8_SA(0, 0), cA, voffA); PG8_STAGE(PG8_SA(0, 1), cA + hstepA, voffA);
        if (wr == 1) PG8_BAR;
        PG8_WAIT_V(2); PG8_BAR;
        PG8_STAGE(PG8_SB(1, 0), cB + kstep, voffB); PG8_STAGE(PG8_SA(1, 0), cA + kstep, voffA); PG8_STAGE(PG8_SB(1, 1), cB + hstepB + kstep, voffB);
        PG8_WAIT_V(6); PG8_BAR;
    } else {
        PG8_STAGE(PG8_SB(0, 0), cB, voffB); PG8_STAGE(PG8_SA(0, 0), cA, voffA); PG8_STAGE(PG8_SB(0, 1), cB + hstepB, voffB); PG8_STAGE(PG8_SA(0, 1), cA + hstepA, voffA);
        if (wr == 1) PG8_BAR;
        PG8_WAIT_V(4); PG8_BAR;
        PG8_STAGE(PG8_SB(1, 0), cB + kstep, voffB); PG8_STAGE(PG8_SA(1, 0), cA + kstep, voffA); PG8_STAGE(PG8_SB(1, 1), cB + hstepB + kstep, voffB);
        PG8_WAIT_V(6); PG8_BAR;
    }
    for (;;) {
        const bool has_next = S.next(ui + 1, nxt);
        const char* nA = has_next ? (const char*)g.A + (size_t)nxt.seg * g.segA + (size_t)nxt.pm * tstepA : cA;
        const char* nB = has_next ? (const char*)g.Bt + (size_t)nxt.seg * g.segB + (size_t)nxt.pn * tstepB : cB;
        for (int t = 0; t < nt; t += 2) {
            const bool last = (t == nt - 2);
            const char* a1 = cA + (size_t)(t + 1) * kstep;
            const char* a2 = last ? nA : cA + (size_t)(t + 2) * kstep; const char* b2 = last ? nB : cB + (size_t)(t + 2) * kstep;
            const char* a3 = a2 + kstep; const char* b3 = b2 + kstep;
            if (last && has_next) S.a_ready(nxt);
            if constexpr (SP2) {
            PG8_LDB(B0, 0, 0); PG8_LDB(B1, 0, 1); PG8_SCHED; PG8_LDA(At, 0, 0); PG8_STAGE(PG8_SA(1, 1), a1 + hstepA, voffA);
            PG8_WAIT_V(8); PG8_WAIT_L(0); PG8_BAR; PG8_MMA(0, 0, At, B0); PG8_MMA(0, 1, At, B1); PG8_BAR; PG8_SCHED;
            PG8_LDA(At, 0, 1); PG8_STAGE(PG8_SB(0, 0), b2, voffB); PG8_STAGE(PG8_SB(0, 1), b2 + hstepB, voffB); PG8_STAGE(PG8_SA(0, 0), a2, voffA);
            PG8_WAIT_V(8); PG8_WAIT_L(0); PG8_BAR; PG8_MMA(1, 0, At, B0); PG8_MMA(1, 1, At, B1); PG8_BAR; PG8_SCHED;
            PG8_LDB(B0, 1, 0); PG8_LDB(B1, 1, 1); PG8_SCHED; PG8_LDA(At, 1, 0); PG8_STAGE(PG8_SA(0, 1), a2 + hstepA, voffA);
            PG8_WAIT_V(8); PG8_WAIT_L(0); PG8_BAR; PG8_MMA(0, 0, At, B0); PG8_MMA(0, 1, At, B1); PG8_BAR; PG8_SCHED;
            PG8_LDA(At, 1, 1); PG8_STAGE(PG8_SB(1, 0), b3, voffB); PG8_STAGE(PG8_SB(1, 1), b3 + hstepB, voffB); PG8_STAGE(PG8_SA(1, 0), a3, voffA);
            PG8_WAIT_V(8); PG8_WAIT_L(0); PG8_BAR; PG8_MMA(1, 0, At, B0); PG8_MMA(1, 1, At, B1); PG8_BAR; PG8_SCHED;
            } else {
            PG8_LDB(B0, 0, 0); PG8_SCHED; PG8_LDA(At, 0, 0); PG8_STAGE(PG8_SA(1, 1), a1 + hstepA, voffA);
            PG8_WAIT_L(8); PG8_BAR; PG8_WAIT_L(0); PG8_MMA(0, 0, At, B0); PG8_BAR; PG8_SCHED;
            PG8_LDB(B1, 0, 1); PG8_STAGE(PG8_SB(0, 0), b2, voffB);
            PG8_BAR; PG8_WAIT_L(0); PG8_MMA(0, 1, At, B1); PG8_BAR;
            PG8_LDA(At, 0, 1); PG8_STAGE(PG8_SA(0, 0), a2, voffA);
            PG8_BAR; PG8_WAIT_L(0); PG8_MMA(1, 0, At, B0); PG8_BAR; PG8_SCHED;
            PG8_STAGE(PG8_SB(0, 1), b2 + hstepB, voffB);
            PG8_WAIT_V(6); PG8_BAR; PG8_MMA(1, 1, At, B1); PG8_BAR;
            PG8_LDB(B0, 1, 0); PG8_SCHED; PG8_LDA(At, 1, 0); PG8_STAGE(PG8_SA(0, 1), a2 + hstepA, voffA);
            PG8_WAIT_L(8); PG8_BAR; PG8_WAIT_L(0); PG8_MMA(0, 0, At, B0); PG8_BAR; PG8_SCHED;
            PG8_LDB(B1, 1, 1); PG8_STAGE(PG8_SB(1, 0), b3, voffB);
            PG8_BAR; PG8_WAIT_L(0); PG8_MMA(0, 1, At, B1); PG8_BAR;
            PG8_LDA(At, 1, 1); PG8_STAGE(PG8_SA(1, 0), a3, voffA);
            PG8_BAR; PG8_WAIT_L(0); PG8_MMA(1, 0, At, B0); PG8_BAR; PG8_SCHED;
            PG8_STAGE(PG8_SB(1, 1), b3 + hstepB, voffB);
            PG8_WAIT_V(6); PG8_BAR; PG8_MMA(1, 1, At, B1); PG8_BAR;
            }
        }
        if constexpr (ALIGN_EPI) { if (wr == 0) PG8_BAR; }
        { int tz = threadIdx.x; asm volatile("" : "+v"(tz));
          const int l2 = tz & 63; E(acc, cur, wr, wc, l2 & 15, l2 >> 4, tz); }
        S.done(cur);
        if (!has_next) break;
        if (!Epi::keep_acc(cur))
#pragma unroll
        for (int a = 0; a < 2; ++a)
#pragma unroll
            for (int b = 0; b < 2; ++b)
#pragma unroll
                for (int m = 0; m < 4; ++m)
#pragma unroll
                    for (int n = 0; n < 2; ++n) acc[a][b][m][n] = (f32x4){0.f, 0.f, 0.f, 0.f};
        cur = nxt; cA = nA; cB = nB; ++ui;
        if constexpr (ALIGN_EPI) { if (wr == 1) PG8_BAR; }
    }
    PG8_WAIT_V(0);
    if constexpr (!ALIGN_EPI) { if (wr == 0) PG8_BAR; }
    PG8_BAR;
#undef PG8_SA
#undef PG8_SB
#undef PG8_STAGE
#undef PG8_LDA
#undef PG8_LDB
#undef PG8_MMA
#undef PG8_WAIT_V
#undef PG8_WAIT_L
#undef PG8_BAR
#undef PG8_SCHED
}

struct EpiProj {
    static constexpr bool PERM = true; static __device__ __forceinline__ bool keep_acc(const Unit&) { return false; }
    bf16_t* O; float* small; int gate_from;
    __device__ __forceinline__ void operator()(const f32x4 (&acc)[2][2][4][2], const Unit& u, int wr, int wc, int fr, int fq, int tz) const {
        const int row0 = u.pm * BM + wr * 64 + fr, col0 = u.pn * BM + wc * 32 + 8 * fq;
#pragma unroll
        for (int ai = 0; ai < 2; ++ai)
#pragma unroll
            for (int m = 0; m < 4; ++m) { const int row = row0 + ai * HALF + m * 16; bf16_t* rowp = O + (size_t)row * NPP + col0;
#pragma unroll
                for (int bj = 0; bj < 2; ++bj) { f32x4 v0 = acc[ai][bj][m][0], v1 = acc[ai][bj][m][1];
                    const int col = col0 + bj * HALF;
                    if (col + gate_from >= C_GATE) {
#pragma unroll
                        for (int j = 0; j < 4; ++j) { v0[j] = fmaxf(sigmoidf_(v0[j]), 1e-30f); v1[j] = fmaxf(sigmoidf_(v1[j]), 1e-30f); } }
                    u32x4 w; w.x = cvt_pk_bf16(v0[0], v0[1]); w.y = cvt_pk_bf16(v0[2], v0[3]); w.z = cvt_pk_bf16(v1[0], v1[1]); w.w = cvt_pk_bf16(v1[2], v1[3]);
                    *(u32x4*)(rowp + bj * HALF) = w;
                    v0 = acc[ai][bj][m][0]; v1 = acc[ai][bj][m][1];
                    int si = -1; if (col == C_DA) si = 0; else if (col == C_DB) si = 8; else if (col == C_MDT) si = 16; else if (col == C_MDT + 8) si = 24;
                    if (si >= 0) { float* sp = small + (size_t)row * 32 + si; *(f32x4*)sp = v0; *(f32x4*)(sp + 4) = v1; } } }
    }
};
struct EpiGlu {
    static constexpr bool PERM = true; static __device__ __forceinline__ bool keep_acc(const Unit&) { return false; }
    const bf16_t* Y; const float* bias; bf16_t* O;
    __device__ __forceinline__ void operator()(const f32x4 (&acc)[2][2][4][2], const Unit& u, int wr, int wc, int fr, int fq, int tz) const {
        const int row0 = u.pm * BM + wr * 64 + fr, col0 = u.pn * BM + wc * 32 + 8 * fq;
#pragma unroll
        for (int ai = 0; ai < 2; ++ai)
#pragma unroll
            for (int m = 0; m < 4; ++m) { const int row = row0 + ai * HALF + m * 16;
#pragma unroll
                for (int bj = 0; bj < 2; ++bj) { const int col = col0 + bj * HALF;
                    const f32x4 b0 = *(const f32x4*)(bias + col), b1 = *(const f32x4*)(bias + col + 4);
                    const u32x4 yw = *(const u32x4*)(Y + (size_t)row * 1024 + col);
                    const f32x4 v0 = acc[ai][bj][m][0] + b0, v1 = acc[ai][bj][m][1] + b1;
                    float o[8];
                    o[0] = bf_lo(yw.x) * sigmoidf_(v0[0]); o[1] = bf_hi(yw.x) * sigmoidf_(v0[1]); o[2] = bf_lo(yw.y) * sigmoidf_(v0[2]); o[3] = bf_hi(yw.y) * sigmoidf_(v0[3]);
                    o[4] = bf_lo(yw.z) * sigmoidf_(v1[0]); o[5] = bf_hi(yw.z) * sigmoidf_(v1[1]); o[6] = bf_lo(yw.w) * sigmoidf_(v1[2]); o[7] = bf_hi(yw.w) * sigmoidf_(v1[3]);
                    u32x4 w; w.x = cvt_pk_bf16(o[0], o[1]); w.y = cvt_pk_bf16(o[2], o[3]); w.z = cvt_pk_bf16(o[4], o[5]); w.w = cvt_pk_bf16(o[6], o[7]);
                    *(u32x4*)(O + (size_t)row * 4096 + 2048 + col) = w; asm volatile("" ::: "memory"); } }
    }
};
struct EpiMerge {
    static constexpr bool PERM = true; static __device__ __forceinline__ bool keep_acc(const Unit& u) { return u.seg < 3; }
    const bf16_t* proj; bf16_t* O;
    __device__ __forceinline__ void operator()(f32x4 (&acc)[2][2][4][2], const Unit& u, int wr, int wc, int fr, int fq, int tz) const {
        const int row0 = u.pm * BM + wr * 64 + fr, col0 = u.pn * BM + wc * 32 + 8 * fq;
        const bool lastseg = (u.seg == 3);
#pragma unroll
        for (int ai = 0; ai < 2; ++ai) {
            u32x4 gw[4][2], gn[4][2];
#pragma unroll
            for (int m = 0; m < 4; ++m)
#pragma unroll
                for (int bj = 0; bj < 2; ++bj) { const bf16_t* gp = proj + (size_t)(row0 + ai * HALF + m * 16) * NPP + C_GATE + u.seg * 2048 + col0 + bj * HALF;
                    gw[m][bj] = *(const u32x4*)gp; gn[m][bj] = *(const u32x4*)(gp + (lastseg ? 0 : 2048)); }
#pragma unroll
            for (int m = 0; m < 4; ++m)
#pragma unroll
                for (int bj = 0; bj < 2; ++bj) { const int row = row0 + ai * HALF + m * 16, col = col0 + bj * HALF;
                    const u32x4 a = gw[m][bj], d4 = gn[m][bj];
                    float s[8] = {bf_lo(a.x), bf_hi(a.x), bf_lo(a.y), bf_hi(a.y), bf_lo(a.z), bf_hi(a.z), bf_lo(a.w), bf_hi(a.w)};
                    if (!lastseg) { const float d[8] = {bf_lo(d4.x), bf_hi(d4.x), bf_lo(d4.y), bf_hi(d4.y), bf_lo(d4.z), bf_hi(d4.z), bf_lo(d4.w), bf_hi(d4.w)};
#pragma unroll
                        for (int j = 0; j < 8; ++j) s[j] = s[j] * __builtin_amdgcn_rcpf(d[j]); }
                    f32x4 v0 = acc[ai][bj][m][0], v1 = acc[ai][bj][m][1];
#pragma unroll
                    for (int j = 0; j < 4; ++j) { v0[j] *= s[j]; v1[j] *= s[4 + j]; }
                    acc[ai][bj][m][0] = v0; acc[ai][bj][m][1] = v1;
                    if (lastseg) { u32x4 w; w.x = cvt_pk_bf16(v0[0], v0[1]); w.y = cvt_pk_bf16(v0[2], v0[3]); w.z = cvt_pk_bf16(v1[0], v1[1]); w.w = cvt_pk_bf16(v1[2], v1[3]);
                        *(u32x4*)(O + (size_t)row * DM + col) = w; } }
            asm volatile("" ::: "memory"); }
    }
};
struct EpiResid {
    static constexpr bool PERM = false; static __device__ __forceinline__ bool keep_acc(const Unit&) { return false; }
    const float* xres; float* O;
    __device__ __forceinline__ void operator()(const f32x4 (&acc)[2][2][4][2], const Unit& u, int wr, int wc, int fr, int fq, int tz) const {
        const int row0 = u.pm * BM + wr * 64 + fr, col0 = u.pn * BM + wc * 32 + 4 * fq;
#pragma unroll
        for (int ai = 0; ai < 2; ++ai)
#pragma unroll
            for (int m = 0; m < 4; ++m) { const size_t ro = (size_t)(row0 + ai * HALF + m * 16) * DM + col0;
#pragma unroll
                for (int bj = 0; bj < 2; ++bj)
#pragma unroll
                    for (int n = 0; n < 2; ++n) *(f32x4*)(O + ro + bj * HALF + n * 16) = acc[ai][bj][m][n]; }
    }
};
struct EpiRelu2 {
    static constexpr bool PERM = true; static __device__ __forceinline__ bool keep_acc(const Unit&) { return false; }
    bf16_t* O;
    __device__ __forceinline__ void operator()(const f32x4 (&acc)[2][2][4][2], const Unit& u, int wr, int wc, int fr, int fq, int tz) const {
        const int row0 = u.pm * BM + wr * 64 + fr, col0 = u.pn * BM + wc * 32 + 8 * fq;
#pragma unroll
        for (int ai = 0; ai < 2; ++ai)
#pragma unroll
            for (int m = 0; m < 4; ++m) { bf16_t* rowp = O + (size_t)(row0 + ai * HALF + m * 16) * DFF + col0;
#pragma unroll
                for (int bj = 0; bj < 2; ++bj) { f32x4 v0 = acc[ai][bj][m][0], v1 = acc[ai][bj][m][1];
#pragma unroll
                    for (int j = 0; j < 4; ++j) { const float a = fmaxf(v0[j], 0.f), b = fmaxf(v1[j], 0.f); v0[j] = a * a; v1[j] = b * b; }
                    u32x4 w; w.x = cvt_pk_bf16(v0[0], v0[1]); w.y = cvt_pk_bf16(v0[2], v0[3]); w.z = cvt_pk_bf16(v1[0], v1[1]); w.w = cvt_pk_bf16(v1[2], v1[3]);
                    *(u32x4*)(rowp + bj * HALF) = w; } }
    }
};
}

#define XB_TMO      128
#define XB_XCNT(j)  (256  + 64 * (j))
#define XB_XSUB(j)  (1280 + 64 * (j))
#define XB_XGEN(j)  (2304 + 64 * (j))
#define XB_TOP      3328
#define XB_TOPGEN   3392
#define XCD_BAR_WORDS 3456
#define XB_SPIN_CAP (1u << 18)
__device__ __forceinline__ unsigned xb_ld(unsigned* p)              { return __hip_atomic_load(p, __ATOMIC_RELAXED, __HIP_MEMORY_SCOPE_AGENT); }
__device__ __forceinline__ unsigned xb_add(unsigned* p, unsigned v) { return __hip_atomic_fetch_add(p, v, __ATOMIC_RELAXED, __HIP_MEMORY_SCOPE_AGENT); }
__device__ __forceinline__ unsigned xb_xcc_id() { return (unsigned)__builtin_amdgcn_s_getreg((3 << 11) | 20) & 0xFu; }
#define XB_SPIN(cond, bar) do { unsigned _sp = 0; while (cond) { __builtin_amdgcn_s_sleep(1); \
    if ((++_sp & 255u) == 0u) { if (xb_ld(&(bar)[XB_TMO])) break; if (_sp > XB_SPIN_CAP) { atomicAdd(&(bar)[XB_TMO], 1u); break; } } } } while (0)
struct XcdBarrier { unsigned* bar; unsigned x; volatile LAS unsigned* st; };
__device__ __forceinline__ XcdBarrier xcd_barrier_post(unsigned* bar, volatile LAS unsigned* st) {
    XcdBarrier b; b.bar = bar; b.x = xb_xcc_id(); b.st = st;
    if (threadIdx.x == 0) (void)xb_add(&bar[XB_XCNT(b.x)], 1u);
    return b;
}
__device__ __forceinline__ void xcd_barrier_complete(unsigned* bar, unsigned x, unsigned& nloc, unsigned& nx) {
    const unsigned G = gridDim.x * gridDim.y * gridDim.z;
    unsigned sum, cnt, mine, sp = 0u;
    for (;;) {
        sum = 0u; cnt = 0u; mine = 0u;
#pragma unroll
        for (unsigned j = 0; j < 16; ++j) { const unsigned c = xb_ld(&bar[XB_XCNT(j)]); sum += c; cnt += (c > 0u) ? 1u : 0u; mine = (j == x) ? c : mine; }
        if (sum == G) break;
        __builtin_amdgcn_s_sleep(1);
        if ((++sp & 255u) == 0u) { if (xb_ld(&bar[XB_TMO])) break; if (sp > XB_SPIN_CAP) { atomicAdd(&bar[XB_TMO], 1u); break; } }
    }
    nloc = mine > 0u ? mine : 1u; nx = cnt > 0u ? cnt : 1u;
}
__device__ __forceinline__ void xcd_barrier(const XcdBarrier& b) {
    asm volatile("s_waitcnt vmcnt(0)" ::: "memory");
    __syncthreads();
    if (threadIdx.x == 0) {
        unsigned* bar = b.bar;
        __builtin_amdgcn_s_waitcnt(0);
        unsigned nloc = b.st[0], nx = b.st[1];
        if (nloc == 0u) { xcd_barrier_complete(bar, b.x, nloc, nx); b.st[0] = nloc; b.st[1] = nx; }
        const unsigned old = xb_add(&bar[XB_XSUB(b.x)], 1u);
        const unsigned gen = old / nloc;
        if (old + 1u == (gen + 1u) * nloc) {
            __builtin_amdgcn_fence(__ATOMIC_RELEASE, "agent");
            asm volatile("s_waitcnt vmcnt(0)" ::: "memory");
            const unsigned og = xb_add(&bar[XB_TOP], 1u);
            const unsigned tg = og / nx;
            if (og + 1u == (tg + 1u) * nx) xb_add(&bar[XB_TOPGEN], 1u);
            else XB_SPIN(xb_ld(&bar[XB_TOPGEN]) == tg, bar);
            __builtin_amdgcn_fence(__ATOMIC_ACQUIRE, "agent");
            xb_add(&bar[XB_XGEN(b.x)], 1u);
            asm volatile("s_waitcnt vmcnt(0)" ::: "memory");
        } else {
            XB_SPIN(xb_ld(&bar[XB_XGEN(b.x)]) == gen, bar);
            __builtin_amdgcn_fence(__ATOMIC_ACQUIRE, "agent");
            asm volatile("s_waitcnt vmcnt(0)" ::: "memory");
        }
    }
    __syncthreads();
}

struct Args { const void* in[34]; float* out; unsigned char* ws; int ph_lo, ph_hi, li, pad; };
struct Frame {
    LAS unsigned char* lds;
    int tid, lane, wave, vcu, G;
    const void* const* in;
    unsigned char* ws;
    float* out;
};
__device__ __forceinline__ int opaque_tid() { int tz = threadIdx.x; asm volatile("" : "+v"(tz)); return tz; }
#define FIN(i) ((const float*)F.in[i])
#define WSP(type, off) ((type*)(F.ws + (off)))

constexpr int I_IN = (DM / 64) * (NPROJ / 32), I_GLU = (1024 / 64) * (1024 / 32), I_BR = (1024 / 64) * (DM / 32), I_OUT = (DM / 64) * (DM / 32),
              I_UP = (DM / 64) * (DFF / 32), I_DOWN = (DFF / 64) * (DM / 32), I_LAYER = I_IN + I_GLU + 4 * I_BR + I_OUT + I_UP + I_DOWN;
__device__ __forceinline__ void p0_resolve(Frame& F, int it, const float*& W, int& K, int& N, bf16_t*& WT, int& r) {
    const int l = it / I_LAYER; r = it - l * I_LAYER;
    unsigned char* wt = F.ws + WS_WT + (size_t)l * WT_LAYER;
    if (r < I_IN) { W = FIN(2) + (size_t)l * DM * NPROJ; K = DM; N = NPROJ; WT = (bf16_t*)(wt + WT_IN); return; } r -= I_IN;
    if (r < I_GLU) { W = FIN(15) + (size_t)l * 1024 * 1024; K = 1024; N = 1024; WT = (bf16_t*)(wt + WT_GLU); return; } r -= I_GLU;
    if (r < I_BR) { W = FIN(23) + (size_t)l * 1024 * DM; K = 1024; N = DM; WT = (bf16_t*)(wt + WT_BR); return; } r -= I_BR;
    if (r < I_BR) { W = FIN(24) + (size_t)l * 1024 * DM; K = 1024; N = DM; WT = (bf16_t*)(wt + WT_BR + 4 * MiB); return; } r -= I_BR;
    if (r < I_BR) { W = FIN(25) + (size_t)l * 1024 * DM; K = 1024; N = DM; WT = (bf16_t*)(wt + WT_BR + 8 * MiB); return; } r -= I_BR;
    if (r < I_BR) { W = FIN(26) + (size_t)l * 1024 * DM; K = 1024; N = DM; WT = (bf16_t*)(wt + WT_BR + 12 * MiB); return; } r -= I_BR;
    if (r < I_OUT) { W = FIN(27) + (size_t)l * DM * DM; K = DM; N = DM; WT = (bf16_t*)(wt + WT_OUT); return; } r -= I_OUT;
    if (r < I_UP) { W = FIN(30) + (size_t)l * DM * DFF; K = DM; N = DFF; WT = (bf16_t*)(wt + WT_UP); return; } r -= I_UP;
    W = FIN(31) + (size_t)l * DFF * DM; K = DFF; N = DM; WT = (bf16_t*)(wt + WT_DOWN);
}
__device__ __forceinline__ void p0_prologue(Frame& F) {
    LAS float* scr = (LAS float*)(F.lds + F.wave * 16384);
    const int gw = F.vcu * 8 + F.wave, NGW = F.G * 8; F.tid = opaque_tid(); F.lane = F.tid & 63;
    const int lane = F.lane;
    { float v[32]; const float* W; int K, N, r; bf16_t* WT;
      int it = gw;
#define P0_LOAD() do { p0_resolve(F, it, W, K, N, WT, r); const int nblk = N / 32, kb = r / nblk, nb = r - kb * nblk; const float* src = W + (size_t)(64 * kb + (lane >> 5)) * N + 32 * nb + (lane & 31); \
        _Pragma("unroll") for (int i = 0; i < 32; ++i) v[i] = src[(size_t)(2 * i) * N]; } while (0)
      if (it < NLAYER * I_LAYER) P0_LOAD();
      while (it < NLAYER * I_LAYER) {
          const int nblk = N / 32, kb = r / nblk, nb = r - kb * nblk, k0 = 64 * kb, n0 = 32 * nb, Kc = K; bf16_t* WTc = WT;
#pragma unroll
          for (int i = 0; i < 32; ++i) scr[(2 * i + (lane >> 5)) * 33 + (lane & 31)] = v[i];
          asm volatile("s_waitcnt lgkmcnt(0)" ::: "memory");
          it += NGW;
          if (it < NLAYER * I_LAYER) P0_LOAD();
          const int c = lane & 7;
#pragma unroll
          for (int j = 0; j < 4; ++j) { const int n = (lane >> 3) + 8 * j; const LAS float* s = scr + (8 * c) * 33 + n;
              u32x4 o; o.x = pk2(s[0 * 33], s[1 * 33]); o.y = pk2(s[2 * 33], s[3 * 33]); o.z = pk2(s[4 * 33], s[5 * 33]); o.w = pk2(s[6 * 33], s[7 * 33]);
              *(u32x4*)(WTc + (size_t)(n0 + n) * Kc + k0 + 8 * c) = o; }
          asm volatile("s_waitcnt lgkmcnt(0)" ::: "memory");
      }
#undef P0_LOAD
    }
    const int gt = F.vcu * 512 + F.tid, NGT = F.G * 512;
    for (int i = gt; i < NLAYER * (NPP - NPROJ) * DM / 8; i += NGT) { const int l = i / ((NPP - NPROJ) * DM / 8), r = i % ((NPP - NPROJ) * DM / 8);
        *(u32x4*)(F.ws + WS_WT + (size_t)l * WT_LAYER + WT_IN + (size_t)NPROJ * DM * 2 + (size_t)r * 16) = (u32x4){0u, 0u, 0u, 0u}; }
    { const int* pos = (const int*)F.in[1]; float* trig = WSP(float, WS_TRIG);
      for (int i = gt; i < T * 64; i += NGT) { const int t = i >> 6, j = i & 63;
          const double inv = exp2(-(double)j * (13.287712379549449 / 64.0));
          double s, c; sincos_d((double)pos[t] * inv, s, c);
          trig[(size_t)t * 128 + j] = (float)c; trig[(size_t)t * 128 + 64 + j] = (float)s; } }
    { const float* x = FIN(0); bf16_t* xb = WSP(bf16_t, WS_XB);
      for (int i = gt; i < T * DM / 4; i += NGT) { const f32x4 v = *(const f32x4*)(x + (size_t)i * 4); u32x2 w; w.x = pk2(v[0], v[1]); w.y = pk2(v[2], v[3]); *(u32x2*)(xb + (size_t)i * 4) = w; } }
    for (int i = gt; i < NLAYER * 4096; i += NGT) { const int l = i >> 12, gn = i & 4095, g = gn >> 6;
        const double lre = (double)FIN(7)[(size_t)l * 4096 + gn], lim = (double)FIN(8)[(size_t)l * 4096 + gn], step = exp((double)FIN(9)[l * 64 + g]);
        const double mag = exp(lre * step); double sn, cs; sincos_d(lim * step, sn, cs);
        const double are = mag * cs, aim = mag * sn, den = lre * lre + lim * lim;
        const double fre = ((are - 1.0) * lre + aim * lim) / den, fim = (aim * lre - (are - 1.0) * lim) / den;
        float* sp = (float*)(F.ws + WS_S5P + (size_t)l * MiB);
        sp[gn * 2] = (float)are; sp[gn * 2 + 1] = (float)aim;
        const float* bre = FIN(10) + ((size_t)l * 4096 + gn) * 16; const float* bim = FIN(11) + ((size_t)l * 4096 + gn) * 16;
        float* obre = sp + 16384 + (size_t)gn * 16; float* obim = sp + 16384 + 65536 + (size_t)gn * 16;
#pragma unroll
        for (int c = 0; c < 16; ++c) { const double br = bre[c], bi = bim[c]; obre[c] = (float)(fre * br - fim * bi); obim[c] = (float)(fre * bi + fim * br); } }
}

constexpr int LDP = 136;
__device__ __forceinline__ bf16x8 ldsfrag(const LAS bf16_t* base, int pitch, int row, int kk, int q) { return *(const LAS bf16x8*)(base + row * pitch + kk * 32 + 8 * q); }
__device__ __forceinline__ bf16x8 glbfrag(const bf16_t* base, int pitch, int row, int kk, int q) { return *(const bf16x8*)(base + (size_t)row * pitch + kk * 32 + 8 * q); }
#define MFMA16(a, b, c) __builtin_amdgcn_mfma_f32_16x16x32_bf16((a), (b), (c), 0, 0, 0)
#define LDS_BARRIER() do { asm volatile("s_waitcnt lgkmcnt(0)" ::: "memory"); __builtin_amdgcn_s_barrier(); asm volatile("" ::: "memory"); } while (0)

typedef float f32x16 __attribute__((ext_vector_type(16)));
__device__ __forceinline__ float gelu_tanh_(float y) { const float z = 0.7978845608028654f * (y + 0.044715f * y * y * y); const float th = 1.f - 2.f / (1.f + __expf(2.f * z)); return 0.5f * y * (1.f + th); }
__device__ __forceinline__ void s5_unit(Frame& F, int layer, int g) {
    const int tid = opaque_tid(), lane = tid & 63, w = F.wave, j = lane & 31, hh = lane >> 5, r16 = lane & 15, q = lane >> 4;
    LAS bf16_t* Xw = (LAS bf16_t*)(F.lds + w * 8704);
    LAS float* Ew = (LAS float*)(F.lds + 8 * 8704);
    const bf16_t* proj = WSP(bf16_t, WS_PROJ); bf16_t* ys = WSP(bf16_t, WS_YS5);
    const float* sp = (const float*)(F.ws + WS_S5P + (size_t)layer * MiB);
    float a1r[2], a1i[2], a2r[2], a2i[2], a3r[2], a3i[2], a4r[2], a4i[2];
#pragma unroll
    for (int s = 0; s < 2; ++s) { const int gn = g * 64 + j + 32 * s; a1r[s] = sp[gn * 2]; a1i[s] = sp[gn * 2 + 1];
        a2r[s] = a1r[s] * a1r[s] - a1i[s] * a1i[s]; a2i[s] = 2.f * a1r[s] * a1i[s];
        a3r[s] = a2r[s] * a1r[s] - a2i[s] * a1i[s]; a3i[s] = a2r[s] * a1i[s] + a2i[s] * a1r[s];
        a4r[s] = a2r[s] * a2r[s] - a2i[s] * a2i[s]; a4i[s] = 2.f * a2r[s] * a2i[s]; }
    bf16x8 bfr[4];
#pragma unroll
    for (int blk = 0; blk < 4; ++blk) { const float* src = sp + 16384 + (blk >> 1) * 65536 + (size_t)(g * 64 + j + 32 * (blk & 1)) * 16 + 8 * hh;
        const f32x4 v0 = *(const f32x4*)src, v1 = *(const f32x4*)(src + 4); u32x4 pk; pk.x = pk2(v0[0], v0[1]); pk.y = pk2(v0[2], v0[3]); pk.z = pk2(v1[0], v1[1]); pk.w = pk2(v1[2], v1[3]);
        bfr[blk] = __builtin_bit_cast(bf16x8, pk); }
    bf16x8 cfr[4];
    { const float* cre = FIN(12) + ((size_t)layer * 64 + g) * 1024 + r16 * 64; const float* cim = FIN(13) + ((size_t)layer * 64 + g) * 1024 + r16 * 64;
#pragma unroll
      for (int kk = 0; kk < 4; ++kk) { float v[8];
#pragma unroll
          for (int i = 0; i < 8; ++i) { const int ls = 8 * kk + 2 * q + (i >> 2), blk = i & 3, st = ls + 32 * (blk & 1); v[i] = (blk >> 1) ? -cim[st] : cre[st]; }
          u32x4 pk; pk.x = pk2(v[0], v[1]); pk.y = pk2(v[2], v[3]); pk.z = pk2(v[4], v[5]); pk.w = pk2(v[6], v[7]); cfr[kk] = __builtin_bit_cast(bf16x8, pk); } }
    const float dsk = FIN(14)[layer * 1024 + g * 16 + r16];
    const int t0 = w * 1024;
    float cr[2] = {0.f, 0.f}, ci[2] = {0.f, 0.f};
    const f32x16 zero16 = {0.f, 0.f, 0.f, 0.f, 0.f, 0.f, 0.f, 0.f, 0.f, 0.f, 0.f, 0.f, 0.f, 0.f, 0.f, 0.f};
#define S5_TILE(tt, DO_Y) do { \
        const bf16x8 afr = afn; \
        afn = *(const bf16x8*)(proj + (size_t)(t0 + 32 * (((tt) + 1) & 31) + j) * NPP + C_SU + 16 * g + 8 * hh);        \
        f32x16 acc[4]; \
        _Pragma("unroll") for (int blk = 0; blk < 4; ++blk) acc[blk] = __builtin_amdgcn_mfma_f32_32x32x16_bf16(afr, bfr[blk], zero16, 0, 0, 0); \
        float cjr[2][4], cji[2][4]; \
        _Pragma("unroll") for (int s = 0; s < 2; ++s) { \
            _Pragma("unroll") for (int gi = 0; gi < 4; ++gi) { float xr = 0.f, xi = 0.f; \
                _Pragma("unroll") for (int k = 0; k < 4; ++k) { const float nr = a1r[s] * xr - a1i[s] * xi + acc[s][4 * gi + k], ni = a1r[s] * xi + a1i[s] * xr + acc[2 + s][4 * gi + k]; xr = nr; xi = ni; acc[s][4 * gi + k] = xr; acc[2 + s][4 * gi + k] = xi; } } \
            float c_r = cr[s], c_i = ci[s]; \
            _Pragma("unroll") for (int gi = 0; gi < 4; ++gi) { const float er = acc[s][4 * gi + 3], ei = acc[2 + s][4 * gi + 3]; const float orr = __shfl_xor(er, 32), oi = __shfl_xor(ei, 32); \
                const float E0r = hh ? orr : er, E0i = hh ? oi : ei, E1r = hh ? er : orr, E1i = hh ? ei : oi;        \
                const float c0r = c_r, c0i = c_i; const float c1r = a4r[s] * c0r - a4i[s] * c0i + E0r, c1i = a4r[s] * c0i + a4i[s] * c0r + E0i; \
                cjr[s][gi] = hh ? c1r : c0r; cji[s][gi] = hh ? c1i : c0i; \
                c_r = a4r[s] * c1r - a4i[s] * c1i + E1r; c_i = a4r[s] * c1i + a4i[s] * c1r + E1i; } \
            cr[s] = c_r; ci[s] = c_i; } \
        if (DO_Y) { \
            _Pragma("unroll") for (int s = 0; s < 2; ++s) _Pragma("unroll") for (int gi = 0; gi < 4; ++gi) { const float kr = cjr[s][gi], ki = cji[s][gi]; \
                acc[s][4 * gi + 0] += a1r[s] * kr - a1i[s] * ki; acc[2 + s][4 * gi + 0] += a1r[s] * ki + a1i[s] * kr; \
                acc[s][4 * gi + 1] += a2r[s] * kr - a2i[s] * ki; acc[2 + s][4 * gi + 1] += a2r[s] * ki + a2i[s] * kr; \
                acc[s][4 * gi + 2] += a3r[s] * kr - a3i[s] * ki; acc[2 + s][4 * gi + 2] += a3r[s] * ki + a3i[s] * kr; \
                acc[s][4 * gi + 3] += a4r[s] * kr - a4i[s] * ki; acc[2 + s][4 * gi + 3] += a4r[s] * ki + a4i[s] * kr; } \
            _Pragma("unroll") for (int r = 0; r < 16; ++r) { const int tok = (r & 3) + 8 * (r >> 2) + 4 * hh; u32x2 o; o.x = pk2(acc[0][r], acc[1][r]); o.y = pk2(acc[2][r], acc[3][r]); *(LAS u32x2*)(Xw + tok * 136 + 4 * j) = o; } \
            bf16_t usk[2][4]; \
            _Pragma("unroll") for (int mt = 0; mt < 2; ++mt) _Pragma("unroll") for (int r = 0; r < 4; ++r) usk[mt][r] = proj[(size_t)(t0 + 32 * (tt) + 16 * mt + 4 * q + r) * NPP + C_SU + 16 * g + r16]; \
            asm volatile("s_waitcnt lgkmcnt(0)" ::: "memory"); \
            _Pragma("unroll") for (int mt = 0; mt < 2; ++mt) { f32x4 ya = {0.f, 0.f, 0.f, 0.f}; \
                _Pragma("unroll") for (int kk = 0; kk < 4; ++kk) ya = MFMA16(ldsfrag(Xw, 136, 16 * mt + r16, kk, q), cfr[kk], ya); \
                _Pragma("unroll") for (int r = 0; r < 4; ++r) { const size_t t = (size_t)(t0 + 32 * (tt) + 16 * mt + 4 * q + r); const float y = ya[r] + dsk * bf2f(usk[mt][r]); \
                    ys[t * 1024 + g * 16 + r16] = (bf16_t)f2bf(gelu_tanh_(y)); } } \
            asm volatile("s_waitcnt lgkmcnt(0)" ::: "memory"); } } while (0)
    bf16x8 afn = *(const bf16x8*)(proj + (size_t)(t0 + j) * NPP + C_SU + 16 * g + 8 * hh);
    for (int tt = 0; tt < 32; ++tt) S5_TILE(tt, false);
    if (hh == 0) {
#pragma unroll
        for (int s = 0; s < 2; ++s) { Ew[(w * 64 + j + 32 * s) * 2] = cr[s]; Ew[(w * 64 + j + 32 * s) * 2 + 1] = ci[s]; } }
    __syncthreads();
#pragma unroll
    for (int s = 0; s < 2; ++s) { float pr = a4r[s], pi = a4i[s];
#pragma unroll
        for (int k = 0; k < 8; ++k) { const float nr = pr * pr - pi * pi, ni = 2.f * pr * pi; pr = nr; pi = ni; }
        float xr = 0.f, xi = 0.f;
        for (int v = 0; v < w; ++v) { const float er = Ew[(v * 64 + j + 32 * s) * 2], ei = Ew[(v * 64 + j + 32 * s) * 2 + 1]; const float nr = pr * xr - pi * xi + er, ni = pr * xi + pi * xr + ei; xr = nr; xi = ni; }
        cr[s] = xr; ci[s] = xi; }
    for (int tt = 0; tt < 32; ++tt) S5_TILE(tt, true);
#undef S5_TILE
    __syncthreads();
}

constexpr size_t RET_BLK = 3 * 16384;
__device__ __forceinline__ void ret_pre_unit(Frame& F, int n, int h) {
    const int tid = opaque_tid(), lane = tid & 63, w = F.wave, r16 = lane & 15, q = lane >> 4;
    LAS bf16_t* Qs = (LAS bf16_t*)(F.lds); LAS bf16_t* Ks = (LAS bf16_t*)(F.lds + 128 * LDP * 2);
    const bf16_t* proj = WSP(bf16_t, WS_PROJ); const float* trig = WSP(float, WS_TRIG);
    bf16_t* blk = (bf16_t*)(F.ws + WS_TMP + TM_KR) + (size_t)(n * 4 + h) * RET_BLK;
    { const int tok = tid >> 2, qt = tid & 3; const size_t t = (size_t)n * 128 + tok;
      const bf16_t* pq = proj + t * NPP + C_RQ + h * 128 + 16 * qt; const bf16_t* pk = proj + t * NPP + C_RK + h * 128 + 16 * qt;
      const float* tc = trig + t * 128 + 16 * qt;
      float cs[16], sn[16];
#pragma unroll
      for (int i = 0; i < 4; ++i) { const f32x4 c4 = *(const f32x4*)(tc + 4 * i), s4 = *(const f32x4*)(tc + 64 + 4 * i);
#pragma unroll
          for (int j = 0; j < 4; ++j) { cs[4 * i + j] = c4[j]; sn[4 * i + j] = s4[j]; } }
#pragma unroll
      for (int isk = 0; isk < 2; ++isk) {
          const bf16_t* p = isk ? pk : pq; const float sc = isk ? 0.08838834764831845f : 1.0f;
          const u32x4 a0 = *(const u32x4*)p, a1 = *(const u32x4*)(p + 8), b0 = *(const u32x4*)(p + 64), b1 = *(const u32x4*)(p + 72);
          float x1[16], x2[16];
#pragma unroll
          for (int j = 0; j < 4; ++j) { x1[2 * j] = bf_lo(a0[j]); x1[2 * j + 1] = bf_hi(a0[j]); x1[8 + 2 * j] = bf_lo(a1[j]); x1[8 + 2 * j + 1] = bf_hi(a1[j]);
              x2[2 * j] = bf_lo(b0[j]); x2[2 * j + 1] = bf_hi(b0[j]); x2[8 + 2 * j] = bf_lo(b1[j]); x2[8 + 2 * j + 1] = bf_hi(b1[j]); }
          u32x4 o1[2], o2[2];
#pragma unroll
          for (int j = 0; j < 8; ++j) { const float ya = (x1[2 * j] * cs[2 * j] - x2[2 * j] * sn[2 * j]) * sc, yb = (x1[2 * j + 1] * cs[2 * j + 1] - x2[2 * j + 1] * sn[2 * j + 1]) * sc;
              const float za = (x1[2 * j] * sn[2 * j] + x2[2 * j] * cs[2 * j]) * sc, zb = (x1[2 * j + 1] * sn[2 * j + 1] + x2[2 * j + 1] * cs[2 * j + 1]) * sc;
              o1[j >> 2][j & 3] = pk2(ya, yb); o2[j >> 2][j & 3] = pk2(za, zb); }
          LAS bf16_t* ls = (isk ? Ks : Qs) + tok * LDP + 16 * qt;
          *(LAS u32x4*)ls = o1[0]; *(LAS u32x4*)(ls + 8) = o1[1]; *(LAS u32x4*)(ls + 64) = o2[0]; *(LAS u32x4*)(ls + 72) = o2[1];
          if (!isk) { bf16_t* g = blk + tok * 128 + 16 * qt; *(u32x4*)g = o1[0]; *(u32x4*)(g + 8) = o1[1]; *(u32x4*)(g + 64) = o2[0]; *(u32x4*)(g + 72) = o2[1]; } } }
    LDS_BARRIER();
    { const int d = tid >> 2, jq = tid & 3; bf16_t* g = blk + 2 * 16384 + d * 128 + 32 * jq;
#pragma unroll
      for (int c = 0; c < 4; ++c) { u32x4 o;
#pragma unroll
          for (int j = 0; j < 4; ++j) { const unsigned lo = Ks[(32 * jq + 8 * c + 2 * j) * LDP + d], hi = Ks[(32 * jq + 8 * c + 2 * j + 1) * LDP + d]; o[j] = lo | (hi << 16); }
          *(u32x4*)(g + 8 * c) = o; } }
    { const float lg = log2f(1.0f - exp2f(-5.0f - (float)h)); const int i = 16 * w + r16;
      bf16x8 bq[4];
#pragma unroll
      for (int kk = 0; kk < 4; ++kk) bq[kk] = ldsfrag(Qs, LDP, 16 * w + r16, kk, q);
      bf16_t* g = blk + 16384 + i * 128;
      for (int jt = 0; jt < 8; ++jt) {
          u32x2 o = {0u, 0u};
          if (jt <= w) { f32x4 acc = {0.f, 0.f, 0.f, 0.f};
#pragma unroll
              for (int kk = 0; kk < 4; ++kk) acc = MFMA16(ldsfrag(Ks, LDP, 16 * jt + r16, kk, q), bq[kk], acc);
              float v[4];
#pragma unroll
              for (int r = 0; r < 4; ++r) { const int j = 16 * jt + 4 * q + r; v[r] = (j <= i) ? acc[r] * exp2f((float)(i - j) * lg) : 0.f; }
              o.x = pk2(v[0], v[1]); o.y = pk2(v[2], v[3]); }
          *(u32x2*)(g + 16 * jt + 4 * q) = o; } }
    LDS_BARRIER();
}

__device__ __forceinline__ void ret_seq_unit(Frame& F, int u) {
    const int tid = opaque_tid(), lane = tid & 63, w = F.wave, r16 = lane & 15, q = lane >> 4;
    const int h = u >> 4, e0 = (u & 15) * 16;
    LAS bf16_t* Rt = (LAS bf16_t*)(F.lds); LAS bf16_t* Vt = (LAS bf16_t*)(F.lds + 2 * 16 * LDP * 2); LAS bf16_t* Vd = (LAS bf16_t*)(F.lds + 4 * 16 * LDP * 2);
    const bf16_t* proj = WSP(bf16_t, WS_PROJ); bf16_t* O = (bf16_t*)(F.ws + WS_TMP + TM_VR);
    const bf16_t* blk0 = (const bf16_t*)(F.ws + WS_TMP + TM_KR) + (size_t)h * RET_BLK;
    const float lg = log2f(1.0f - exp2f(-5.0f - (float)h)), g128 = exp2f(128.f * lg);
    float rsc[4];
#pragma unroll
    for (int r = 0; r < 4; ++r) rsc[r] = exp2f((float)(16 * w + 4 * q + r + 1) * lg);
    const int vj = tid >> 1, vh = tid & 1; const float vdec = exp2f((float)(127 - vj) * lg);
    u32x4 vreg = {0u, 0u, 0u, 0u};
#define RET_LOADV(c) do { if (tid < 256) vreg = *(const u32x4*)(proj + (size_t)((c) * 128 + vj) * NPP + C_RV + h * 256 + e0 + 8 * vh); } while (0)
#define RET_STOREV(b) do { if (tid < 256) { LAS bf16_t* vt = Vt + (b) * 16 * LDP + (8 * vh) * LDP + vj; LAS bf16_t* vd = Vd + (b) * 16 * LDP + (8 * vh) * LDP + vj; \
        _Pragma("unroll") for (int j = 0; j < 4; ++j) { const float lo = bf_lo(vreg[j]), hi = bf_hi(vreg[j]); vt[(2 * j) * LDP] = (bf16_t)(vreg[j] & 0xffffu); vt[(2 * j + 1) * LDP] = (bf16_t)(vreg[j] >> 16); \
            vd[(2 * j) * LDP] = (bf16_t)f2bf(lo * vdec); vd[(2 * j + 1) * LDP] = (bf16_t)f2bf(hi * vdec); } } } while (0)
#define RET_LOADF(FR, c) do { const bf16_t* bk = blk0 + (size_t)(c) * 4 * RET_BLK; _Pragma("unroll") for (int kk = 0; kk < 4; ++kk) { \
        FR[kk] = glbfrag(bk, 128, 16 * w + r16, kk, q); FR[4 + kk] = glbfrag(bk + 16384, 128, 16 * w + r16, kk, q); FR[8 + kk] = glbfrag(bk + 32768, 128, 16 * w + r16, kk, q); } } while (0)
    for (int i = tid; i < 16 * LDP; i += 512) Rt[i] = 0;
    RET_LOADV(0); RET_STOREV(0);
    bf16x8 fa[12], fb[12];
    RET_LOADF(fa, 0);
    f32x4 R = {0.f, 0.f, 0.f, 0.f};
    __syncthreads();
#define RET_CHUNK(c, CUR, NXT) do { const int b = (c) & 1; \
        if ((c) + 1 < T / 128) { RET_LOADF(NXT, (c) + 1); RET_LOADV((c) + 1); } \
        f32x4 a1 = {0.f, 0.f, 0.f, 0.f}, a2 = {0.f, 0.f, 0.f, 0.f}; f32x4 ra = R * g128; \
        _Pragma("unroll") for (int kk = 0; kk < 4; ++kk) { const bf16x8 bR = ldsfrag(Rt + b * 16 * LDP, LDP, r16, kk, q), bV = ldsfrag(Vt + b * 16 * LDP, LDP, r16, kk, q), bD = ldsfrag(Vd + b * 16 * LDP, LDP, r16, kk, q); \
            a1 = MFMA16(CUR[kk], bR, a1); a2 = MFMA16(CUR[4 + kk], bV, a2); ra = MFMA16(CUR[8 + kk], bD, ra); } \
        R = ra; \
        _Pragma("unroll") for (int r = 0; r < 4; ++r) O[(size_t)((c) * 128 + 16 * w + 4 * q + r) * 1024 + h * 256 + e0 + r16] = (bf16_t)f2bf(rsc[r] * a1[r] + a2[r]); \
        { u32x2 o; o.x = pk2(R[0], R[1]); o.y = pk2(R[2], R[3]); *(LAS u32x2*)(Rt + (b ^ 1) * 16 * LDP + r16 * LDP + 16 * w + 4 * q) = o; } \
        if ((c) + 1 < T / 128) RET_STOREV(b ^ 1); \
        LDS_BARRIER(); } while (0)
    for (int c = 0; c < T / 128; c += 2) { RET_CHUNK(c, fa, fb); RET_CHUNK(c + 1, fb, fa); }
#undef RET_CHUNK
#undef RET_LOADF
#undef RET_LOADV
#undef RET_STOREV
}


__device__ __forceinline__ void ssd_pre_unit(Frame& F, int layer, int n, int g) {
    const int tid = opaque_tid(), lane = tid & 63, w = F.wave, r16 = lane & 15, q = lane >> 4;
    LAS bf16_t* Cs = (LAS bf16_t*)(F.lds); LAS bf16_t* Bs = (LAS bf16_t*)(F.lds + 128 * LDP * 2);
    LAS float* Ac = (LAS float*)(F.lds + 2 * 128 * LDP * 2); LAS float* Dt = Ac + 8 * 128;
    const bf16_t* proj = WSP(bf16_t, WS_PROJ); const float* small = WSP(float, WS_SMALL);
    unsigned char* tm = F.ws + WS_TMP;
    float* acum = (float*)(tm + TM_SAC); bf16_t* XS = (bf16_t*)(tm + TM_SXS); bf16_t* XD = (bf16_t*)(tm + TM_SXD);
    bf16_t* cb = (bf16_t*)(tm + TM_SCB) + (size_t)(n * 2 + g) * 32768; bf16_t* sl = (bf16_t*)(tm + TM_SSL) + (size_t)(n * 16 + 8 * g) * 16384;
    const float* scw = FIN(17) + (size_t)layer * 1536 * 4; const float* scb = FIN(18) + layer * 1536; const float* sdtb = FIN(19) + layer * 16; const float* salog = FIN(20) + layer * 16;
    const int t0 = n * 128;
    { const int hh = 8 * g + w; const float a = -__expf(salog[hh]);
      const float dt0 = softplusf_(small[(size_t)(t0 + 2 * lane) * 32 + 16 + hh] + sdtb[hh]), dt1 = softplusf_(small[(size_t)(t0 + 2 * lane + 1) * 32 + 16 + hh] + sdtb[hh]);
      const float v0 = dt0 * a, v1 = dt1 * a, s = v0 + v1; float incl = s;
#pragma unroll
      for (int o = 1; o < 64; o <<= 1) { const float tmp = __shfl_up(incl, o); if (lane >= o) incl += tmp; }
      const float excl = incl - s;
      Ac[w * 128 + 2 * lane] = excl + v0; Ac[w * 128 + 2 * lane + 1] = excl + s; Dt[w * 128 + 2 * lane] = dt0; Dt[w * 128 + 2 * lane + 1] = dt1;
      acum[(size_t)(t0 + 2 * lane) * 16 + hh] = excl + v0; acum[(size_t)(t0 + 2 * lane + 1) * 16 + hh] = excl + s; }
    LDS_BARRIER();
    { const int cp = tid & 127, tq = tid >> 7; const int tb = t0 + 32 * tq;
      unsigned xa[3][35];
#pragma unroll
      for (int m = 0; m < 3; ++m) { const int ch = (m < 2) ? g * 512 + m * 256 + 2 * cp : (cp < 64 ? 1024 + g * 128 + 2 * cp : 1280 + g * 128 + 2 * (cp - 64)); const bf16_t* pc = proj + C_MX + ch;
#pragma unroll
          for (int i = 0; i < 35; ++i) xa[m][i] = (tb - 3 + i >= 0) ? *(const unsigned*)(pc + (size_t)(tb - 3 + i) * NPP) : 0u; }
#pragma unroll
      for (int m = 0; m < 3; ++m) {
          const int ch = (m < 2) ? g * 512 + m * 256 + 2 * cp : (cp < 64 ? 1024 + g * 128 + 2 * cp : 1280 + g * 128 + 2 * (cp - 64));
          const f32x4 w0 = *(const f32x4*)(scw + (size_t)ch * 4), w1 = *(const f32x4*)(scw + (size_t)ch * 4 + 4); const float b0 = scb[ch], b1 = scb[ch + 1];
          const unsigned (&xw)[35] = xa[m];
#pragma unroll
          for (int i = 0; i < 32; ++i) { const unsigned x0 = xw[i], x1 = xw[i + 1], x2 = xw[i + 2], x3 = xw[i + 3];
              const float ya = siluf_(w0[0] * bf_lo(x0) + w0[1] * bf_lo(x1) + w0[2] * bf_lo(x2) + w0[3] * bf_lo(x3) + b0);
              const float yb = siluf_(w1[0] * bf_hi(x0) + w1[1] * bf_hi(x1) + w1[2] * bf_hi(x2) + w1[3] * bf_hi(x3) + b1);
              if (m < 2) { const float dt = Dt[(m * 4 + (cp >> 5)) * 128 + 32 * tq + i]; const size_t go = (size_t)(tb + i) * 1024 + g * 512 + m * 256 + 2 * cp;
                  *(unsigned*)(XS + go) = pk2(ya, yb); *(unsigned*)(XD + go) = pk2(ya * dt, yb * dt); }
              else if (cp < 64) *(LAS unsigned*)(Bs + (32 * tq + i) * LDP + 2 * cp) = pk2(ya, yb);
              else *(LAS unsigned*)(Cs + (32 * tq + i) * LDP + 2 * (cp - 64)) = pk2(ya, yb); } } }
    LDS_BARRIER();
#pragma unroll
    for (int k = 0; k < 4; ++k) { const int idx = tid + 512 * k, row = idx >> 4, c8 = idx & 15; *(u32x4*)(cb + row * 128 + 8 * c8) = *(const LAS u32x4*)(Cs + row * LDP + 8 * c8); }
    { const int d = tid >> 2, jq = tid & 3; bf16_t* gp = cb + 16384 + d * 128 + 32 * jq;
#pragma unroll
      for (int c = 0; c < 4; ++c) { u32x4 o;
#pragma unroll
          for (int j = 0; j < 4; ++j) { const unsigned lo = Bs[(32 * jq + 8 * c + 2 * j) * LDP + d], hi = Bs[(32 * jq + 8 * c + 2 * j + 1) * LDP + d]; o[j] = lo | (hi << 16); }
          *(u32x4*)(gp + 8 * c) = o; } }
    { const int i = 16 * w + r16; bf16x8 bq[4];
#pragma unroll
      for (int kk = 0; kk < 4; ++kk) bq[kk] = ldsfrag(Cs, LDP, i, kk, q);
      float ai[8];
#pragma unroll
      for (int hh = 0; hh < 8; ++hh) ai[hh] = Ac[hh * 128 + i];
      for (int jt = 0; jt < 8; ++jt) {
          f32x4 acc = {0.f, 0.f, 0.f, 0.f};
          if (jt <= w) {
#pragma unroll
              for (int kk = 0; kk < 4; ++kk) acc = MFMA16(ldsfrag(Bs, LDP, 16 * jt + r16, kk, q), bq[kk], acc); }
#pragma unroll
          for (int hh = 0; hh < 8; ++hh) { u32x2 o = {0u, 0u};
              if (jt <= w) { const f32x4 aj = *(const LAS f32x4*)(Ac + hh * 128 + 16 * jt + 4 * q); float v[4];
#pragma unroll
                  for (int r = 0; r < 4; ++r) { const int j = 16 * jt + 4 * q + r; v[r] = (j <= i) ? acc[r] * __expf(ai[hh] - aj[r]) : 0.f; }
                  o.x = pk2(v[0], v[1]); o.y = pk2(v[2], v[3]); }
              *(u32x2*)(sl + (size_t)hh * 16384 + i * 128 + 16 * jt + 4 * q) = o; } } }
    LDS_BARRIER();
}

__device__ __forceinline__ void ssd_seq_unit(Frame& F, int u) {
    const int tid = opaque_tid(), lane = tid & 63, w = F.wave, r16 = lane & 15, q = lane >> 4;
    const int h = u >> 2, p0 = (u & 3) * 16, g = h >> 3;
    LAS bf16_t* St = (LAS bf16_t*)(F.lds); LAS bf16_t* Vt = (LAS bf16_t*)(F.lds + 2 * 16 * LDP * 2); LAS bf16_t* Vd = (LAS bf16_t*)(F.lds + 4 * 16 * LDP * 2);
    unsigned char* tm = F.ws + WS_TMP;
    const float* acum = (const float*)(tm + TM_SAC); const bf16_t* XD = (const bf16_t*)(tm + TM_SXD); bf16_t* O = (bf16_t*)(tm + TM_VS);
    const bf16_t* cb0 = (const bf16_t*)(tm + TM_SCB) + (size_t)g * 32768; const bf16_t* sl0 = (const bf16_t*)(tm + TM_SSL) + (size_t)h * 16384;
    const int vj = tid >> 1, vh = tid & 1;
    u32x4 vreg = {0u, 0u, 0u, 0u}; float vdl = 0.f, vdj = 0.f;
#define SSD_LOADV(c) do { if (tid < 256) { vreg = *(const u32x4*)(XD + (size_t)((c) * 128 + vj) * 1024 + h * 64 + p0 + 8 * vh); \
        vdl = acum[(size_t)((c) * 128 + 127) * 16 + h]; vdj = acum[(size_t)((c) * 128 + vj) * 16 + h]; } } while (0)
#define SSD_STOREV(b) do { if (tid < 256) { const float vdn = __expf(vdl - vdj); LAS bf16_t* vt = Vt + (b) * 16 * LDP + (8 * vh) * LDP + vj; LAS bf16_t* vd = Vd + (b) * 16 * LDP + (8 * vh) * LDP + vj; \
        _Pragma("unroll") for (int j = 0; j < 4; ++j) { const float lo = bf_lo(vreg[j]), hi = bf_hi(vreg[j]); vt[(2 * j) * LDP] = (bf16_t)(vreg[j] & 0xffffu); vt[(2 * j + 1) * LDP] = (bf16_t)(vreg[j] >> 16); \
            vd[(2 * j) * LDP] = (bf16_t)f2bf(lo * vdn); vd[(2 * j + 1) * LDP] = (bf16_t)f2bf(hi * vdn); } } } while (0)
#define SSD_LOADF(FR, AR, c) do { const bf16_t* bc = cb0 + (size_t)(c) * 2 * 32768; const bf16_t* bs = sl0 + (size_t)(c) * 16 * 16384; _Pragma("unroll") for (int kk = 0; kk < 4; ++kk) { \
        FR[kk] = glbfrag(bc, 128, 16 * w + r16, kk, q); FR[4 + kk] = glbfrag(bs, 128, 16 * w + r16, kk, q); FR[8 + kk] = glbfrag(bc + 16384, 128, 16 * w + r16, kk, q); } \
        _Pragma("unroll") for (int r = 0; r < 4; ++r) AR[r] = acum[(size_t)((c) * 128 + 16 * w + 4 * q + r) * 16 + h]; AR[4] = acum[(size_t)((c) * 128 + 127) * 16 + h]; } while (0)
    for (int i = tid; i < 16 * LDP; i += 512) St[i] = 0;
    SSD_LOADV(0); SSD_STOREV(0);
    bf16x8 fa[12], fb[12]; float aa[5], ab[5];
    SSD_LOADF(fa, aa, 0);
    f32x4 S = {0.f, 0.f, 0.f, 0.f};
    __syncthreads();
#define SSD_CHUNK(c, CUR, NXT, ACUR, ANXT) do { const int b = (c) & 1; \
        if ((c) + 1 < T / 128) { SSD_LOADF(NXT, ANXT, (c) + 1); SSD_LOADV((c) + 1); } \
        f32x4 a1 = {0.f, 0.f, 0.f, 0.f}, a2 = {0.f, 0.f, 0.f, 0.f}; f32x4 sa = S * __expf(ACUR[4]); \
        _Pragma("unroll") for (int kk = 0; kk < 4; ++kk) { const bf16x8 bS = ldsfrag(St + b * 16 * LDP, LDP, r16, kk, q), bV = ldsfrag(Vt + b * 16 * LDP, LDP, r16, kk, q), bD = ldsfrag(Vd + b * 16 * LDP, LDP, r16, kk, q); \
            a1 = MFMA16(CUR[kk], bS, a1); a2 = MFMA16(CUR[4 + kk], bV, a2); sa = MFMA16(CUR[8 + kk], bD, sa); } \
        S = sa; \
        _Pragma("unroll") for (int r = 0; r < 4; ++r) O[(size_t)((c) * 128 + 16 * w + 4 * q + r) * 1024 + h * 64 + p0 + r16] = (bf16_t)f2bf(__expf(ACUR[r]) * a1[r] + a2[r]); \
        { u32x2 o; o.x = pk2(S[0], S[1]); o.y = pk2(S[2], S[3]); *(LAS u32x2*)(St + (b ^ 1) * 16 * LDP + r16 * LDP + 16 * w + 4 * q) = o; } \
        if ((c) + 1 < T / 128) SSD_STOREV(b ^ 1); \
        LDS_BARRIER(); } while (0)
    for (int c = 0; c < T / 128; c += 2) { SSD_CHUNK(c, fa, fb, aa, ab); SSD_CHUNK(c + 1, fb, fa, ab, aa); }
#undef SSD_CHUNK
#undef SSD_LOADF
#undef SSD_LOADV
#undef SSD_STOREV
}


constexpr size_t GDN_BLK = 36864;
__device__ __forceinline__ void gdn_pre_unit(Frame& F, int layer, int n, int h) {
    const int tid = opaque_tid(), lane = tid & 63, w = F.wave, r16 = lane & 15, q = lane >> 4;
    LAS bf16_t* Qs = (LAS bf16_t*)(F.lds); LAS bf16_t* Ks = (LAS bf16_t*)(F.lds + 17408); LAS bf16_t* Kd = (LAS bf16_t*)(F.lds + 34816);
    LAS float* Mm = (LAS float*)(F.lds + 52224); LAS float* Rr = (LAS float*)(F.lds + 69632); LAS float* gc = (LAS float*)(F.lds + 135168); LAS float* be = gc + 64;
    LAS bf16_t* Xt = Qs;
    LAS bf16_t* Mb = (LAS bf16_t*)(F.lds + 135680);
    const bf16_t* proj = WSP(bf16_t, WS_PROJ); const float* small = WSP(float, WS_SMALL);
    unsigned char* tm = F.ws + WS_TMP;
    bf16_t* blk = (bf16_t*)(tm + TM_KG) + (size_t)(n * 8 + h) * GDN_BLK;
    const float* gcw = FIN(3) + (size_t)layer * 3072 * 4; const float* galog = FIN(4) + layer * 8; const float* gdtb = FIN(5) + layer * 8;
    const int t0 = n * 64;
    f32x4 wt[3][2];
#pragma unroll
      for (int p = 0; p < 3; ++p)
#pragma unroll
          for (int e = 0; e < 2; ++e) wt[p][e] = *(const f32x4*)(gcw + (size_t)(p * 1024 + h * 128 + 2 * lane + e) * 4);
    const bf16_t* pc = proj + C_DQ + h * 128 + 2 * lane; const int tb = t0 + 8 * w;
    unsigned xw[3][11];
#pragma unroll
      for (int p = 0; p < 3; ++p)
#pragma unroll
          for (int k = 0; k < 11; ++k) xw[p][k] = (tb - 3 + k >= 0) ? *(const unsigned*)(pc + (size_t)(tb - 3 + k) * NPP + p * 1024) : 0u;
    if (w == 0) { const float g = -__expf(galog[h]) * softplusf_(small[(size_t)(t0 + lane) * 32 + h] + gdtb[h]); float incl = g;
#pragma unroll
        for (int o = 1; o < 64; o <<= 1) { const float tmp = __shfl_up(incl, o); if (lane >= o) incl += tmp; }
        gc[lane] = incl; be[lane] = sigmoidf_(small[(size_t)(t0 + lane) * 32 + 8 + h]);
        if (lane == 63) ((float*)(tm + TM_SM))[n * 8 + h] = __expf(incl); }
    LDS_BARRIER();
    {
      const float gl63 = gc[63];
#pragma unroll
      for (int i = 0; i < 8; ++i) { const int tok = 8 * w + i; float v[3][2];
#pragma unroll
          for (int p = 0; p < 3; ++p) {
              v[p][0] = siluf_(wt[p][0][0] * bf_lo(xw[p][i]) + wt[p][0][1] * bf_lo(xw[p][i + 1]) + wt[p][0][2] * bf_lo(xw[p][i + 2]) + wt[p][0][3] * bf_lo(xw[p][i + 3]));
              v[p][1] = siluf_(wt[p][1][0] * bf_hi(xw[p][i]) + wt[p][1][1] * bf_hi(xw[p][i + 1]) + wt[p][1][2] * bf_hi(xw[p][i + 2]) + wt[p][1][3] * bf_hi(xw[p][i + 3])); }
          const float sq = wave_sum(v[0][0] * v[0][0] + v[0][1] * v[0][1]), sk = wave_sum(v[1][0] * v[1][0] + v[1][1] * v[1][1]);
          const float rq = rsqrtf(sq + RMS_EPS) * 0.08838834764831845f, rk = rsqrtf(sk + RMS_EPS);
          const float gci = gc[tok], bei = be[tok], eg = __expf(gci), et = __expf(gl63 - gci);
          const float q0 = v[0][0] * rq, q1 = v[0][1] * rq, k0 = v[1][0] * rk, k1 = v[1][1] * rk;
          *(LAS unsigned*)(Qs + tok * LDP + 2 * lane) = pk2(q0, q1); *(LAS unsigned*)(Ks + tok * LDP + 2 * lane) = pk2(k0, k1); *(LAS unsigned*)(Kd + tok * LDP + 2 * lane) = pk2(k0 * et, k1 * et);
          *(LAS f32x2*)(Rr + tok * 256 + 2 * lane) = (f32x2){bei * v[2][0], bei * v[2][1]}; *(LAS f32x2*)(Rr + tok * 256 + 128 + 2 * lane) = (f32x2){bei * eg * k0, bei * eg * k1};
          *(unsigned*)(blk + 16384 + tok * 128 + 2 * lane) = pk2(q0 * eg, q1 * eg); } }
    LDS_BARRIER();
    if (w < 4) { bf16x8 aK[4];
#pragma unroll
        for (int kk = 0; kk < 4; ++kk) aK[kk] = ldsfrag(Ks, LDP, 16 * w + r16, kk, q);
        for (int jt = 0; jt <= w; ++jt) { f32x4 acc = {0.f, 0.f, 0.f, 0.f};
#pragma unroll
            for (int kk = 0; kk < 4; ++kk) acc = MFMA16(aK[kk], ldsfrag(Ks, LDP, 16 * jt + r16, kk, q), acc);
            const int j = 16 * jt + r16; const float gj = gc[j];
#pragma unroll
            for (int r = 0; r < 4; ++r) { const int i = 16 * w + 4 * q + r; const float mv = (j < i) ? be[i] * acc[r] * __expf(gc[i] - gj) : 0.f; Mm[i * 68 + j] = mv; Mb[i * 72 + j] = (bf16_t)f2bf(mv); } } }
    else { const int wq = w - 4, i = 16 * wq + r16; bf16x8 bQ[4];
#pragma unroll
        for (int kk = 0; kk < 4; ++kk) bQ[kk] = ldsfrag(Qs, LDP, i, kk, q);
        const float gi = gc[i];
        for (int jt = 0; jt < 4; ++jt) { u32x2 o = {0u, 0u};
            if (jt <= wq) { f32x4 acc = {0.f, 0.f, 0.f, 0.f};
#pragma unroll
                for (int kk = 0; kk < 4; ++kk) acc = MFMA16(ldsfrag(Ks, LDP, 16 * jt + r16, kk, q), bQ[kk], acc);
                float v[4];
#pragma unroll
                for (int r = 0; r < 4; ++r) { const int j = 16 * jt + 4 * q + r; v[r] = (j <= i) ? acc[r] * __expf(gi - gc[j]) : 0.f; }
                o.x = pk2(v[0], v[1]); o.y = pk2(v[2], v[3]); }
            *(u32x2*)(blk + 24576 + i * 64 + 16 * jt + 4 * q) = o; } }
    { const int d = tid >> 2, jq = tid & 3; bf16_t* gp = blk + 28672 + d * 64 + 16 * jq;
#pragma unroll
      for (int c = 0; c < 2; ++c) { u32x4 o;
#pragma unroll
          for (int j = 0; j < 4; ++j) { const unsigned lo = Kd[(16 * jq + 8 * c + 2 * j) * LDP + d], hi = Kd[(16 * jq + 8 * c + 2 * j + 1) * LDP + d]; o[j] = lo | (hi << 16); }
          *(u32x4*)(gp + 8 * c) = o; } }
    LDS_BARRIER();
#pragma unroll
    for (int b = 0; b < 4; ++b) {
        if (b > 0) {
#pragma unroll
            for (int t2 = 0; t2 < 2; ++t2) { const int nt = 2 * w + t2; f32x4 acc = {0.f, 0.f, 0.f, 0.f};
#pragma unroll
                for (int ks = 0; ks < (b + 1) / 2; ++ks) { bf16x8 a = *(const LAS bf16x8*)(Mb + (16 * b + r16) * 72 + 32 * ks + 8 * q);
                    bf16x8 xb = *(const LAS bf16x8*)(Xt + (16 * nt + r16) * 72 + 32 * ks + 8 * q);
                    if (32 * ks + 8 * q >= 16 * b) { a = (bf16x8){0, 0, 0, 0, 0, 0, 0, 0}; xb = a; }
                    acc = MFMA16(a, xb, acc); }
#pragma unroll
                for (int r = 0; r < 4; ++r) Rr[(16 * b + 4 * q + r) * 256 + 16 * nt + r16] -= acc[r]; }
            LDS_BARRIER();
        }
        if (tid < 256) { float x[16];
#pragma unroll
            for (int ii = 0; ii < 16; ++ii) { float s = Rr[(16 * b + ii) * 256 + tid];
#pragma unroll
                for (int j4 = 0; j4 < (ii + 3) / 4; ++j4) { const f32x4 m4 = *(const LAS f32x4*)(Mm + (16 * b + ii) * 68 + 16 * b + 4 * j4);
#pragma unroll
                    for (int jj = 0; jj < 4; ++jj) if (4 * j4 + jj < ii) s -= m4[jj] * x[4 * j4 + jj]; }
                x[ii] = s; }
            u32x4 o0, o1; o0.x = pk2(x[0], x[1]); o0.y = pk2(x[2], x[3]); o0.z = pk2(x[4], x[5]); o0.w = pk2(x[6], x[7]); o1.x = pk2(x[8], x[9]); o1.y = pk2(x[10], x[11]); o1.z = pk2(x[12], x[13]); o1.w = pk2(x[14], x[15]);
            *(LAS u32x4*)(Xt + tid * 72 + 16 * b) = o0; *(LAS u32x4*)(Xt + tid * 72 + 16 * b + 8) = o1; }
        LDS_BARRIER();
    }
    { const int e = tid >> 2, part = tid & 3; const u32x4 a0 = *(const LAS u32x4*)(Xt + e * 72 + 16 * part), a1 = *(const LAS u32x4*)(Xt + e * 72 + 16 * part + 8);
      *(u32x4*)(blk + 8192 + e * 64 + 16 * part) = a0; *(u32x4*)(blk + 8192 + e * 64 + 16 * part + 8) = a1; }
#pragma unroll
    for (int k = 0; k < 2; ++k) { const int idx = tid + 512 * k, row = idx >> 4, d8 = idx & 15; u32x4 o;
#pragma unroll
        for (int j = 0; j < 4; ++j) { const unsigned lo = Xt[(128 + 8 * d8 + 2 * j) * 72 + row], hi = Xt[(128 + 8 * d8 + 2 * j + 1) * 72 + row]; o[j] = lo | (hi << 16); }
        *(u32x4*)(blk + row * 128 + 8 * d8) = o; }
    LDS_BARRIER();
}

__device__ __forceinline__ void gdn_seq_unit(Frame& F, int u) {
    const int tid = opaque_tid(), lane = tid & 63, w = F.wave, r16 = lane & 15, q = lane >> 4;
    const int h = u >> 3, e0 = (u & 7) * 16, mt = w & 3; const bool lo = w < 4;
    LAS bf16_t* St = (LAS bf16_t*)(F.lds); LAS bf16_t* Vt = (LAS bf16_t*)(F.lds + 16 * LDP * 2);
    unsigned char* tm = F.ws + WS_TMP; bf16_t* O = (bf16_t*)(tm + TM_VG);
    const bf16_t* blk0 = (const bf16_t*)(tm + TM_KG) + (size_t)h * GDN_BLK;
    const float* glp = (const float*)(tm + TM_SM) + h + (lane & 0);
    const int p0off = lo ? 0 : 16384;
    const int pfp = (u & 7) < 7 ? (u & 7) : 6;
    const int pfoff = (pfp < 2 ? pfp * 4096 : pfp < 4 ? 16384 + (pfp - 2) * 4096 : pfp == 4 ? 24576 : 28672 + (pfp - 5) * 4096) + tid * 8;
#define GDN_LOADF(S, c) do { const int cc = (c) < T / 64 ? (c) : T / 64 - 1; const bf16_t* bk = blk0 + (size_t)cc * 8 * GDN_BLK; \
        _Pragma("unroll") for (int kk = 0; kk < 4; ++kk) { const bf16_t* p = bk + p0off + (size_t)(16 * mt + r16) * 128 + kk * 32 + 8 * q; asm volatile("global_load_dwordx4 %0, %1, off" : "=v"(fr[S][kk]) : "v"(p) : "memory"); } \
        _Pragma("unroll") for (int kk = 0; kk < 2; ++kk) { const bf16_t* p = bk + 28672 + (size_t)(16 * w + r16) * 64 + kk * 32 + 8 * q; asm volatile("global_load_dwordx4 %0, %1, off" : "=v"(fr[S][4 + kk]) : "v"(p) : "memory"); } \
        _Pragma("unroll") for (int kk = 0; kk < 2; ++kk) { const bf16_t* p = bk + 24576 + (size_t)(16 * mt + r16) * 64 + kk * 32 + 8 * q; asm volatile("global_load_dwordx4 %0, %1, off" : "=v"(fr[S][6 + kk]) : "v"(p) : "memory"); } \
        { const bf16_t* p = bk + 8192 + (e0 + r16) * 64 + 16 * mt + 4 * q; asm volatile("global_load_dwordx2 %0, %1, off" : "=v"(uu[S]) : "v"(p) : "memory"); } \
        { const float* p = glp + cc * 8; asm volatile("global_load_dword %0, %1, off" : "=v"(gg[S]) : "v"(p) : "memory"); } \
        { const int c5 = (c) + 2 < T / 64 ? (c) + 2 : T / 64 - 1; const bf16_t* p = blk0 + (size_t)c5 * 8 * GDN_BLK + pfoff;        \
          asm volatile("global_load_dwordx4 %0, %1, off" : "=v"(dm[S]) : "v"(p) : "memory"); } } while (0)
#define GDN_WAIT(S) do { asm volatile("s_waitcnt vmcnt(33)" : "+v"(fr[S][0]), "+v"(fr[S][1]), "+v"(fr[S][2]), "+v"(fr[S][3]), "+v"(fr[S][4]), "+v"(fr[S][5]), "+v"(fr[S][6]), "+v"(fr[S][7]), "+v"(uu[S]), "+v"(gg[S]), "+v"(dm[S]) :: "memory"); \
        __builtin_amdgcn_sched_barrier(0); } while (0)
    for (int i = tid; i < 16 * LDP; i += 512) St[i] = 0;
    bf16x8 fr[4][8]; u32x2 uu[4]; float gg[4]; u32x4 dm[4];
    GDN_LOADF(0, 0); GDN_LOADF(1, 1); GDN_LOADF(2, 2);
    f32x4 S = {0.f, 0.f, 0.f, 0.f};
    LDS_BARRIER();
#define GDN_CHUNK(c, CS, LS) do { \
        GDN_LOADF(LS, (c) + 3); \
        const bf16x8 bs0 = ldsfrag(St, LDP, r16, 0, q), bs1 = ldsfrag(St, LDP, r16, 1, q), bs2 = ldsfrag(St, LDP, r16, 2, q), bs3 = ldsfrag(St, LDP, r16, 3, q);     \
        GDN_WAIT(CS); \
        f32x4 a0 = {0.f, 0.f, 0.f, 0.f}; \
        a0 = MFMA16(fr[CS][0], bs0, a0); a0 = MFMA16(fr[CS][1], bs1, a0); a0 = MFMA16(fr[CS][2], bs2, a0); a0 = MFMA16(fr[CS][3], bs3, a0); \
        if (lo) { u32x2 o; o.x = pk2(bf_lo(uu[CS].x) - a0[0], bf_hi(uu[CS].x) - a0[1]); o.y = pk2(bf_lo(uu[CS].y) - a0[2], bf_hi(uu[CS].y) - a0[3]); *(LAS u32x2*)(Vt + r16 * 72 + 16 * mt + 4 * q) = o; } \
        LDS_BARRIER(); \
        const bf16x8 bV0 = ldsfrag(Vt, 72, r16, 0, q), bV1 = ldsfrag(Vt, 72, r16, 1, q); \
        f32x4 sa = S * gg[CS]; sa = MFMA16(fr[CS][4], bV0, sa); sa = MFMA16(fr[CS][5], bV1, sa); S = sa; \
        { u32x2 o; o.x = pk2(S[0], S[1]); o.y = pk2(S[2], S[3]); *(LAS u32x2*)(St + r16 * LDP + 16 * w + 4 * q) = o; } \
        if (!lo) { a0 = MFMA16(fr[CS][6], bV0, a0); a0 = MFMA16(fr[CS][7], bV1, a0);        \
            const unsigned p01 = pk2(a0[0], a0[1]), p23 = pk2(a0[2], a0[3]); bf16_t* op = O + (size_t)((c) * 64 + 16 * mt + 4 * q) * 1024 + h * 128 + e0 + r16; \
            op[0] = (bf16_t)(p01 & 0xffffu); op[1024] = (bf16_t)(p01 >> 16); op[2048] = (bf16_t)(p23 & 0xffffu); op[3072] = (bf16_t)(p23 >> 16); } \
        LDS_BARRIER(); } while (0)
    for (int c = 0; c < T / 64; c += 4) { GDN_CHUNK(c, 0, 3); GDN_CHUNK(c + 1, 1, 0); GDN_CHUNK(c + 2, 2, 1); GDN_CHUNK(c + 3, 3, 2); }
    asm volatile("s_waitcnt vmcnt(0)" ::: "memory");
#undef GDN_WAIT
#undef GDN_CHUNK
#undef GDN_LOADF
}

__device__ __forceinline__ void mixer_phase(Frame& F, int layer) {
    for (int u = F.vcu; u < 256; u += F.G) {
        if (u < 64) { gdn_seq_unit(F, u); if (MIXREP & 1) gdn_seq_unit(F, u); }
        else if (u < 128) { s5_unit(F, layer, u - 64); if (MIXREP & 2) s5_unit(F, layer, u - 64); }
        else if (u < 192) { ret_seq_unit(F, u - 128); if (MIXREP & 4) ret_seq_unit(F, u - 128); }
        else { ssd_seq_unit(F, u - 192); if (MIXREP & 8) ssd_seq_unit(F, u - 192); }
    }
}
__device__ __forceinline__ void pre_phase(Frame& F, int layer) {
    for (int u = F.vcu; u < 1280; u += F.G) {
        if (u < 1024) { gdn_pre_unit(F, layer, u >> 3, u & 7); if (MIXREP & 16) gdn_pre_unit(F, layer, u >> 3, u & 7); }
        else if (u < 1152) { ssd_pre_unit(F, layer, (u - 1024) >> 1, (u - 1024) & 1); if (MIXREP & 32) ssd_pre_unit(F, layer, (u - 1024) >> 1, (u - 1024) & 1); }
        else { const int ru = 2 * (u - 1152);
            ret_pre_unit(F, ru >> 2, ru & 3); ret_pre_unit(F, (ru + 1) >> 2, (ru + 1) & 3); if (MIXREP & 64) ret_pre_unit(F, ru >> 2, ru & 3); }
    }
}

__device__ __forceinline__ void post_phase(Frame& F, int layer) {
    const int gw = F.vcu * 8 + F.wave, NGW = F.G * 8, lane = opaque_tid() & 63;
    const bf16_t* proj = WSP(bf16_t, WS_PROJ); bf16_t* ycat = WSP(bf16_t, WS_YCAT);
    unsigned char* tm = F.ws + WS_TMP;
    const bf16_t* Or = (const bf16_t*)(tm + TM_VR); const bf16_t* Os = (const bf16_t*)(tm + TM_VS); const bf16_t* Og = (const bf16_t*)(tm + TM_VG);
    const float* gnw = FIN(6) + layer * 128; const bf16_t* XS = (const bf16_t*)(tm + TM_SXS);
    const float* sdk = FIN(21) + layer * 16; const float* snw = FIN(22) + layer * 1024;
    const bool deal = (F.G == 256); const int bx = blockIdx.x;
    const int tbeg = deal ? (bx < 128 ? (bx * 8 + F.wave) * 3 : 3072 + ((bx - 128) * 8 + F.wave) * 5) : gw;
    const int tcnt = deal ? (bx < 128 ? 3 : 5) : (T - gw + NGW - 1) / NGW, tstep = deal ? 1 : NGW;
#define UNPK8(dst, VV) do { dst[0] = bf_lo(VV[0]); dst[1] = bf_hi(VV[0]); dst[2] = bf_lo(VV[1]); dst[3] = bf_hi(VV[1]); dst[4] = bf_lo(VV[2]); dst[5] = bf_hi(VV[2]); dst[6] = bf_lo(VV[3]); dst[7] = bf_hi(VV[3]); } while (0)
#define PK8(VV, SRC) do { VV[0] = pk2(SRC[0], SRC[1]); VV[1] = pk2(SRC[2], SRC[3]); VV[2] = pk2(SRC[4], SRC[5]); VV[3] = pk2(SRC[6], SRC[7]); } while (0)
    for (int ti = 0; ti < tcnt; ++ti) { const int t = tbeg + ti * tstep;
        const bf16_t* pr = proj + (size_t)t * NPP; bf16_t* yo = ycat + (size_t)t * 4096;
        u32x4 wo[6], wg[6], wx[2];
#pragma unroll
        for (int s = 0; s < 2; ++s) { const int ch = 512 * s + 8 * lane;
            wo[s] = *(const u32x4*)(Or + (size_t)t * 1024 + ch); wg[s] = *(const u32x4*)(pr + C_RG + ch);
            wo[2 + s] = *(const u32x4*)(Og + (size_t)t * 1024 + ch); wg[2 + s] = *(const u32x4*)(pr + C_DZ + ch);
            wo[4 + s] = *(const u32x4*)(Os + (size_t)t * 1024 + ch); wg[4 + s] = *(const u32x4*)(pr + C_MZ + ch); wx[s] = *(const u32x4*)(XS + (size_t)t * 1024 + ch); }
        const f32x4 gn0 = *(const f32x4*)(gnw + 8 * (lane & 15)), gn1 = *(const f32x4*)(gnw + 8 * (lane & 15) + 4);
#pragma unroll
        for (int s = 0; s < 2; ++s) { const int ch = 512 * s + 8 * lane;
            { float y[8], gt[8]; UNPK8(y, wo[s]); UNPK8(gt, wg[s]);
              float sm = ((y[0] + y[1]) + (y[2] + y[3])) + ((y[4] + y[5]) + (y[6] + y[7])); sm = row_sum16(sm); sm += __shfl_xor(sm, 16);
              const float mu = sm * (1.f / 256.f); float s2 = 0.f;
#pragma unroll
              for (int i = 0; i < 8; ++i) { y[i] -= mu; s2 += y[i] * y[i]; }
              s2 = row_sum16(s2); s2 += __shfl_xor(s2, 16);
              const float rs = rsqrtf(s2 * (1.f / 256.f) + LN_EPS);
#pragma unroll
              for (int i = 0; i < 8; ++i) y[i] = y[i] * rs * siluf_(gt[i]);
              u32x4 ow; PK8(ow, y); *(u32x4*)(yo + ch) = ow; }
            { float y[8], gt[8]; UNPK8(y, wo[2 + s]); UNPK8(gt, wg[2 + s]);
              float s2 = 0.f;
#pragma unroll
              for (int i = 0; i < 8; ++i) s2 += y[i] * y[i];
              s2 = row_sum16(s2);
              const float rs = rsqrtf(s2 * (1.f / 128.f) + RMS_EPS);
#pragma unroll
              for (int i = 0; i < 8; ++i) y[i] = y[i] * rs * (i < 4 ? gn0[i] : gn1[i - 4]) * siluf_(gt[i]);
              u32x4 ow; PK8(ow, y); *(u32x4*)(yo + 1024 + ch) = ow; }
            { float y[8], gt[8], xh[8]; UNPK8(y, wo[4 + s]); UNPK8(gt, wg[4 + s]); UNPK8(xh, wx[s]);
              const float d = sdk[8 * s + (lane >> 3)]; float s2 = 0.f;
#pragma unroll
              for (int i = 0; i < 8; ++i) { y[i] = (y[i] + d * xh[i]) * siluf_(gt[i]); s2 += y[i] * y[i]; }
              s2 = wave_sum(s2);
              const float rs = rsqrtf(s2 * (1.f / 512.f) + RMS_EPS);
              const f32x4 n0 = *(const f32x4*)(snw + ch), n1 = *(const f32x4*)(snw + ch + 4);
#pragma unroll
              for (int i = 0; i < 8; ++i) y[i] = y[i] * rs * (i < 4 ? n0[i] : n1[i - 4]);
              u32x4 ow; PK8(ow, y); *(u32x4*)(yo + 3072 + ch) = ow; } }
    }
#undef UNPK8
#undef PK8
}

__device__ __forceinline__ void ln_phase(Frame& F, const float* in, const float* res, const float* gam, const float* bet, float* outf, bf16_t* outb) {
    const int gw = F.vcu * 8 + F.wave, NGW = F.G * 8, lane = opaque_tid() & 63;
    for (int t = gw; t < T; t += NGW) {
        const f32x4* xr = (const f32x4*)(in + (size_t)t * DM) + lane; const f32x4* rr = (const f32x4*)(res + (size_t)t * DM) + lane;
        f32x4 v[8]; float s = 0.f;
#pragma unroll
        for (int j = 0; j < 8; ++j) { v[j] = xr[64 * j] + rr[64 * j] * ALPHA; s += (v[j][0] + v[j][1]) + (v[j][2] + v[j][3]); }
        const float mean = wave_sum(s) * (1.f / DM); float s2 = 0.f;
#pragma unroll
        for (int j = 0; j < 8; ++j) { v[j] = v[j] - mean; s2 += (v[j][0] * v[j][0] + v[j][1] * v[j][1]) + (v[j][2] * v[j][2] + v[j][3] * v[j][3]); }
        const float rstd = rsqrtf(wave_sum(s2) * (1.f / DM) + LN_EPS);
#pragma unroll
        for (int j = 0; j < 8; ++j) { const f32x4 gm = *((const f32x4*)gam + lane + 64 * j), bt = *((const f32x4*)bet + lane + 64 * j);
            const f32x4 o = v[j] * rstd * gm + bt;
            *((f32x4*)(outf + (size_t)t * DM) + lane + 64 * j) = o;
            u32x2 w; w.x = pk2(o[0], o[1]); w.y = pk2(o[2], o[3]); *((u32x2*)(outb + (size_t)t * DM) + lane + 64 * j) = w; }
    }
}

constexpr int N_PHASES = 1 + 10 * NLAYER;
__global__ void __launch_bounds__(512, 2) mega(Args args) {
    extern __shared__ __attribute__((aligned(16))) unsigned char lds_raw[];
    Frame F;
    F.lds = (LAS unsigned char*)lds_raw;
    F.tid = threadIdx.x; F.lane = F.tid & 63; F.wave = __builtin_amdgcn_readfirstlane(F.tid >> 6);
    F.G = gridDim.x; { const int bx = blockIdx.x; F.vcu = (F.G % 8 == 0) ? (bx % 8) * (F.G / 8) + bx / 8 : bx; }
    F.in = args.in; F.ws = args.ws; F.out = args.out;
    for (int u = F.tid; u < (LDS_BYTES - LDSCTL_OFF) / 4; u += 512) ((LAS unsigned*)(F.lds + LDSCTL_OFF))[u] = 0u;
    __syncthreads();
    const int lo = args.ph_lo, hi = args.ph_hi;
    unsigned* barw = (unsigned*)(args.ws + WS_CTL) + CW_BAR + args.li * XCD_BAR_WORDS;
    XcdBarrier bar; bar.bar = barw; bar.x = 0; bar.st = nullptr;
    if (hi - lo > 1) bar = xcd_barrier_post(barw, (volatile LAS unsigned*)(F.lds + MISC_OFF) + 8);
#define IN(k) (lo <= (k) && (k) < hi)
#define SEAM(k) do { if ((k) + 1 < hi) xcd_barrier(bar); } while (0)

    if (IN(0)) { p0_prologue(F); if (REPMASK & 1) { xcd_barrier(bar); p0_prologue(F); } SEAM(0); }

    for (int layer = 0; layer < NLAYER; ++layer) {
        const int pb = 1 + 10 * layer;
        unsigned char* wt = F.ws + WS_WT + (size_t)layer * WT_LAYER;
        const float* xcur = layer == 0 ? FIN(0) : WSP(float, WS_XR0);
#define B_INPROJ do { pg8::Gemm g{WSP(bf16_t, WS_XB), (const bf16_t*)(wt + WT_IN), T, NP_MAIN, DM, DM, DM, 0, 0}; pg8::StaticOrder S; S.init(T, NP_MAIN, F.G, (int)blockIdx.x); \
            pg8::EpiProj E{WSP(bf16_t, WS_PROJ), WSP(float, WS_SMALL), 0}; pg8::gemm_phase<pg8::EpiProj, pg8::StaticOrder, true, true>(F.lds, g, S, E); } while (0)
#define B_INPROJ_DEFER do { pg8::Gemm g{WSP(bf16_t, WS_XB), (const bf16_t*)(wt + WT_IN) + (size_t)NP_MAIN * DM, T, NPP - NP_MAIN, DM, DM, DM, 0, 0}; pg8::DeferOrder S; S.init(T, NPP - NP_MAIN, F.G, (F.vcu + F.G - 64 % F.G) % F.G); \
            pg8::EpiProj E{WSP(bf16_t, WS_PROJ) + NP_MAIN, WSP(float, WS_SMALL), NP_MAIN}; pg8::gemm_phase<pg8::EpiProj, pg8::DeferOrder, true, true>(F.lds, g, S, E); } while (0)
#define B_PREP pre_phase(F, layer)
#define B_MIX do { B_INPROJ_DEFER; if (MIXREP & 128) B_INPROJ_DEFER; mixer_phase(F, layer); } while (0)
#define B_GLUPOST do { pg8::Gemm g{WSP(bf16_t, WS_YS5), (const bf16_t*)(wt + WT_GLU), T, 1024, 1024, 1024, 1024, 0, 0}; pg8::StaticOrder S; S.init(T, 1024, F.G, (int)blockIdx.x); \
            pg8::EpiGlu E{WSP(bf16_t, WS_YS5), FIN(16) + layer * 1024, WSP(bf16_t, WS_YCAT)}; pg8::gemm_phase<pg8::EpiGlu, pg8::StaticOrder, true, true>(F.lds, g, S, E); post_phase(F, layer); } while (0)
#define B_MERGE do { pg8::Gemm g{WSP(bf16_t, WS_YCAT), (const bf16_t*)(wt + WT_BR), T, DM, 1024, 4096, 1024, 2048, 4 * MiB}; pg8::SegOrder<4> S; S.init(T, DM, F.G, (int)blockIdx.x); \
            pg8::EpiMerge E{WSP(bf16_t, WS_PROJ), (bf16_t*)(F.ws + WS_TMP + TM_MERGED)}; pg8::gemm_phase<pg8::EpiMerge, pg8::SegOrder<4>, true, true>(F.lds, g, S, E); } while (0)
#define B_WOUT do { pg8::Gemm g{(const bf16_t*)(F.ws + WS_TMP + TM_MERGED), (const bf16_t*)(wt + WT_OUT), T, DM, DM, DM, DM, 0, 0}; pg8::StaticOrder S; S.init(T, DM, F.G, (int)blockIdx.x); \
            pg8::EpiResid E{xcur, (float*)(F.ws + WS_TMP + TM_PRE)}; pg8::gemm_phase<pg8::EpiResid, pg8::StaticOrder, true, true>(F.lds, g, S, E); } while (0)
#define B_LN1 ln_phase(F, (const float*)(F.ws + WS_TMP + TM_PRE), xcur, FIN(28) + layer * DM, FIN(29) + layer * DM, WSP(float, WS_XR1), WSP(bf16_t, WS_XB))
#define B_UP do { pg8::Gemm g{WSP(bf16_t, WS_XB), (const bf16_t*)(wt + WT_UP), T, DFF, DM, DM, DM, 0, 0}; pg8::StaticOrder S; S.init(T, DFF, F.G, (int)blockIdx.x); \
            pg8::EpiRelu2 E{WSP(bf16_t, WS_HID)}; pg8::gemm_phase<pg8::EpiRelu2, pg8::StaticOrder, true, true>(F.lds, g, S, E); } while (0)
#define B_DOWN do { pg8::Gemm g{WSP(bf16_t, WS_HID), (const bf16_t*)(wt + WT_DOWN), T, DM, DFF, DFF, DFF, 0, 0}; pg8::StaticOrder S; S.init(T, DM, F.G, (int)blockIdx.x); \
            pg8::EpiResid E{WSP(float, WS_XR1), (float*)(F.ws + WS_TMP + TM_PRE)}; pg8::gemm_phase<pg8::EpiResid, pg8::StaticOrder, true, true>(F.lds, g, S, E); } while (0)
#define B_LN2 ln_phase(F, (const float*)(F.ws + WS_TMP + TM_PRE), WSP(float, WS_XR1), FIN(32) + layer * DM, FIN(33) + layer * DM, layer == NLAYER - 1 ? F.out : WSP(float, WS_XR0), WSP(bf16_t, WS_XB))
#define PH(k, body) do { if (IN(pb + (k))) { body; if ((REPMASK >> ((k) + 1)) & 1) { xcd_barrier(bar); body; } SEAM(pb + (k)); } } while (0)
        PH(0, B_INPROJ);
        PH(1, B_PREP);
        if (IN(pb + 2)) { B_MIX; if ((REPMASK >> 3) & 1) { xcd_barrier(bar); B_PREP; xcd_barrier(bar); B_MIX; } SEAM(pb + 2); }
        PH(3, B_GLUPOST);
        PH(4, B_MERGE);
        PH(5, B_WOUT);
        PH(6, B_LN1);
        PH(7, B_UP);
        PH(8, B_DOWN);
        PH(9, B_LN2);
    }
#undef IN
#undef SEAM
}

extern "C" void kernel_launch(void* const* d_in, const int* in_sizes, int n_in, void* d_out, int out_size, void* d_ws, size_t ws_size, hipStream_t stream) {
    static int grid = 0;
    if (grid == 0) {
        if (n_in != 34 || out_size != T * DM || ws_size < WS_END) { fprintf(stderr, "kernel_launch: unexpected sizes (n_in %d, out %d, ws %zu need %zu)\n", n_in, out_size, ws_size, (size_t)WS_END); grid = -1; return; }
        int dev = 0, cus = 0, per_cu = 0;
        if (hipGetDevice(&dev) != hipSuccess || hipDeviceGetAttribute(&cus, hipDeviceAttributeMultiprocessorCount, dev) != hipSuccess) { grid = -1; return; }
        if (hipFuncSetAttribute((const void*)mega, hipFuncAttributeMaxDynamicSharedMemorySize, LDS_BYTES) != hipSuccess) { fprintf(stderr, "kernel_launch: hipFuncSetAttribute failed\n"); grid = -1; return; }
        if (hipOccupancyMaxActiveBlocksPerMultiprocessor(&per_cu, (const void*)mega, 512, LDS_BYTES) != hipSuccess || per_cu < 1) fprintf(stderr, "kernel_launch: occupancy query reports %d\n", per_cu);
        (void)hipGetLastError();
        grid = cus;
    }
    if (grid < 0) return;
    if (hipMemsetAsync((char*)d_ws + WS_CTL, 0, CTL_ZERO_BYTES, stream) != hipSuccess) return;
    Args a{};
    for (int i = 0; i < 34; ++i) a.in[i] = d_in[i];
    a.out = (float*)d_out; a.ws = (unsigned char*)d_ws;
#if MK_N_LAUNCHES == 1
    a.ph_lo = 0; a.ph_hi = N_PHASES; a.li = 0;
    hipLaunchKernelGGL(mega, dim3(grid), dim3(512), LDS_BYTES, stream, a);
#else
    for (int p = 0; p < N_PHASES; ++p) { a.ph_lo = p; a.ph_hi = p + 1; a.li = p; hipLaunchKernelGGL(mega, dim3(grid), dim3(512), LDS_BYTES, stream, a); }
#endif
}
```

```cpp
#include <hip/hip_runtime.h>
#include <cstdio>
#include <cstdint>

#ifndef MK_N_LAUNCHES
#define MK_N_LAUNCHES 1
#endif

#ifndef MIXREP
#define MIXREP 0
#endif
#ifndef REPMASK
#define REPMASK 0
#endif
#define LAS __attribute__((address_space(3)))
#define GAS __attribute__((address_space(1)))
typedef unsigned short bf16_t;
typedef short bf16x8 __attribute__((ext_vector_type(8)));
typedef float f32x4 __attribute__((ext_vector_type(4)));
typedef float f32x2 __attribute__((ext_vector_type(2)));
typedef unsigned u32x4 __attribute__((ext_vector_type(4)));
typedef unsigned u32x2 __attribute__((ext_vector_type(2)));

constexpr int T = 8192, DM = 2048, NPROJ = 18976, NPP = 19200, NP_MAIN = 18432, DFF = 8192, NLAYER = 2;
constexpr int C_RQ = 0, C_RK = 512, C_RV = 1024, C_RG = 2048, C_DQ = 3072, C_DK = 4096, C_DV = 5120, C_DZ = 6144, C_DA = 7168, C_DB = 7176,
              C_SU = 7184, C_MZ = 8208, C_MX = 9232, C_MB = 10256, C_MC = 10512, C_MDT = 10768, C_GATE = 10784;
constexpr float LN_EPS = 1e-5f, RMS_EPS = 1e-6f, ALPHA = 1.41421356237f;

constexpr size_t MiB = 1u << 20;
constexpr size_t WS_CTL = 0, CTL_ZERO_BYTES = 1 * MiB;
constexpr size_t WT_IN = 0, WT_GLU = 75 * MiB, WT_BR = 77 * MiB, WT_OUT = 93 * MiB, WT_UP = 101 * MiB, WT_DOWN = 133 * MiB, WT_LAYER = 165 * MiB;
constexpr size_t WS_WT = 1 * MiB;
constexpr size_t WS_PROJ = WS_WT + 2 * WT_LAYER;
constexpr size_t WS_HID = WS_PROJ;
constexpr size_t WS_SMALL = WS_PROJ + 300 * MiB;
constexpr size_t WS_TRIG = WS_SMALL + 1 * MiB;
constexpr size_t WS_S5P = WS_TRIG + 4 * MiB;
constexpr size_t WS_YCAT = WS_S5P + 2 * MiB;
constexpr size_t WS_YS5 = WS_YCAT + 64 * MiB;
constexpr size_t WS_XB = WS_YS5 + 16 * MiB;
constexpr size_t WS_XR0 = WS_XB + 32 * MiB;
constexpr size_t WS_XR1 = WS_XR0 + 64 * MiB;
constexpr size_t WS_TMP = WS_XR1 + 64 * MiB;
constexpr size_t TM_KR = 0, TM_VR = 32 * MiB,
                 TM_SCB = 64 * MiB, TM_SSL = 72 * MiB, TM_SXD = 104 * MiB, TM_SXS = 120 * MiB, TM_SAC = 136 * MiB, TM_VS = 138 * MiB,
                 TM_KG = 170 * MiB, TM_VG = 242 * MiB, TM_SM = 274 * MiB, TM_END = 278 * MiB;
constexpr size_t TM_MERGED = 0, TM_PRE = 32 * MiB;
constexpr size_t WS_END = WS_TMP + TM_END;
constexpr int CW_BAR = 4096;

constexpr int RING_BYTES = 131072, LDSCTL_OFF = 155648, MISC_OFF = LDSCTL_OFF + 320, LDS_BYTES = 163840;

__device__ __forceinline__ unsigned f2bf(float f) { return (unsigned)__builtin_bit_cast(unsigned short, (__bf16)f); }
__device__ __forceinline__ unsigned pk2(float lo, float hi) { typedef __bf16 bf2_t __attribute__((ext_vector_type(2))); const bf2_t v = {(__bf16)lo, (__bf16)hi}; return __builtin_bit_cast(unsigned, v); }
__device__ __forceinline__ float bf_lo(unsigned u) { return __builtin_bit_cast(float, u << 16); }
__device__ __forceinline__ float bf_hi(unsigned u) { return __builtin_bit_cast(float, u & 0xffff0000u); }
__device__ __forceinline__ float bf2f(bf16_t h) { return __builtin_bit_cast(float, (unsigned)h << 16); }
__device__ __forceinline__ float sigmoidf_(float x) { return 1.f / (1.f + __expf(-x)); }
__device__ __forceinline__ float siluf_(float x) { return x / (1.f + __expf(-x)); }
__device__ __forceinline__ float softplusf_(float x) { return x > 20.f ? x : log1pf(__expf(x)); }
template <int CTRL> __device__ __forceinline__ float dppf(float v) { return __builtin_bit_cast(float, __builtin_amdgcn_update_dpp(0, __builtin_bit_cast(int, v), CTRL, 0xF, 0xF, true)); }
__device__ __forceinline__ float row_sum16(float v) {
    v += dppf<0xB1>(v); v += dppf<0x4E>(v); v += dppf<0x141>(v); v += dppf<0x140>(v); return v;
}
__device__ __forceinline__ float wave_sum(float v) { v = row_sum16(v); v += __shfl_xor(v, 16); v += __shfl_xor(v, 32); return v; }
__device__ __forceinline__ void sincos_d(double x, double& s, double& c) {
    const double k = __builtin_rint(x * 0.63661977236758134308);
    double r = __builtin_fma(-k, 1.57079632679489655800e+00, x);
    r = __builtin_fma(-k, 6.12323399573676603587e-17, r);
    const double r2 = r * r;
    double sp = 1.58969099521155010221e-10;
    sp = __builtin_fma(sp, r2, -2.50507602534068634195e-08);
    sp = __builtin_fma(sp, r2, 2.75573137070700676789e-06);
    sp = __builtin_fma(sp, r2, -1.98412698298579493134e-04);
    sp = __builtin_fma(sp, r2, 8.33333333332248946124e-03);
    sp = __builtin_fma(sp, r2, -1.66666666666666324348e-01);
    const double sn = __builtin_fma(sp * r2, r, r);
    double cp = -1.13596475577881948265e-11;
    cp = __builtin_fma(cp, r2, 2.08757232129817482790e-09);
    cp = __builtin_fma(cp, r2, -2.75573143513906633035e-07);
    cp = __builtin_fma(cp, r2, 2.48015872894767294178e-05);
    cp = __builtin_fma(cp, r2, -1.38888888888741095749e-03);
    cp = __builtin_fma(cp, r2, 4.16666666666666019037e-02);
    const double cs = __builtin_fma(cp * r2, r2, __builtin_fma(-0.5, r2, 1.0));
    const long q = (long)k & 3;
    s = (q == 0) ? sn : (q == 1) ? cs : (q == 2) ? -sn : -cs;
    c = (q == 0) ? cs : (q == 1) ? -sn : (q == 2) ? -cs : sn;
}

namespace pg8 {
constexpr int BM = 256, BK = 64, HALF = 128, HTB = HALF * BK * 2, STAGE_BYTES = 8 * HTB, NXCD = 8, WGM = 8;
__host__ __device__ __forceinline__ int lds_byte(int r, int c) { const int st = (r >> 4) * 2 + (c >> 5), rr = r & 15, cc = c & 31, ob = rr * 64 + cc * 2; return st * 1024 + (ob ^ (((ob >> 9) & 1) << 5)); }
__host__ __device__ __forceinline__ void stage_rc(int b, int& R, int& C) { const int st = b / 1024, sb = b % 1024, swz = sb ^ (((sb >> 9) & 1) << 5); R = (st >> 1) * 16 + swz / 64; C = (st & 1) * 32 + (swz % 64) / 2; }
__host__ __device__ __forceinline__ int perm32(int rho) { const int n = rho >> 4, i = rho & 15; return 8 * (i >> 2) + 4 * n + (i & 3); }

struct Unit { int pm, pn, seg; };
struct Gemm { const bf16_t* A; const bf16_t* Bt; int M, N, K, lda, ldb; size_t segA, segB; };

__host__ __device__ __forceinline__ void tile_of(long L, int nM, int nN, int& pm, int& pn) {
    const int nwg = nM * nN; int wgid = (int)L;
    { const int q = nwg / NXCD, r = nwg % NXCD, xcd = wgid % NXCD, off = wgid / NXCD; wgid = (xcd < r ? xcd * (q + 1) : r * (q + 1) + (xcd - r) * q) + off; }
    const int nig = WGM * nN, gid = wgid / nig, fm = gid * WGM, gsz = (nM - fm) < WGM ? (nM - fm) : WGM;
    pm = fm + ((wgid % nig) % gsz); pn = (wgid % nig) / gsz;
}
struct StaticOrder {
    int nM, nN, nwg, G, c;
    __host__ __device__ void init(int M, int N, int G_, int c_) { nM = M / BM; nN = N / BM; nwg = nM * nN; G = G_; c = c_; }
    __host__ __device__ bool next(int i, Unit& u) const {
        const long L = (long)i * G + c; if (L >= nwg) return false;
        tile_of(L, nM, nN, u.pm, u.pn); u.seg = 0; return true;
    }
    __device__ __forceinline__ void a_ready(const Unit&) const {}
    __device__ __forceinline__ void done(const Unit&) const {}
};
template <int NSEG> struct SegOrder {
    int nM, nN, nwg, G, c;
    __host__ __device__ void init(int M, int N, int G_, int c_) { nM = M / BM; nN = N / BM; nwg = nM * nN; G = G_; c = c_; }
    __host__ __device__ bool next(int i, Unit& u) const {
        const long L = (long)(i / NSEG) * G + c; if (L >= nwg) return false;
        tile_of(L, nM, nN, u.pm, u.pn); u.seg = i % NSEG; return true;
    }
    __device__ __forceinline__ void a_ready(const Unit&) const {}
    __device__ __forceinline__ void done(const Unit&) const {}
};

struct DeferOrder {
    int nM, nunits, G, c;
    __host__ __device__ void init(int M, int N, int G_, int c_) { nM = M / BM; nunits = nM * (N / BM); G = G_; c = c_; }
    __host__ __device__ bool next(int i, Unit& u) const { const long L = (long)i * G + c; if (L >= nunits) return false; u.pm = (int)(L % nM); u.pn = (int)(L / nM); u.seg = 0; return true; }
    __device__ __forceinline__ void a_ready(const Unit&) const {}
    __device__ __forceinline__ void done(const Unit&) const {}
};
__device__ __forceinline__ unsigned cvt_pk_bf16(float lo, float hi) { unsigned r; asm volatile("v_cvt_pk_bf16_f32 %0, %1, %2" : "=v"(r) : "v"(lo), "v"(hi)); return r; }


template <class Epi, class Sched, bool ALIGN_EPI = false, bool SP2 = false>
__device__ __forceinline__ void gemm_phase(LAS unsigned char* lds, const Gemm g, const Sched& S, const Epi& E) {
    int tid = threadIdx.x; asm volatile("" : "+v"(tid));
    const int wid = __builtin_amdgcn_readfirstlane(tid >> 6), lane = tid & 63, wr = wid >> 2, wc = wid & 3, fr = lane & 15, fq = lane >> 4;
    const int K = g.K, nt = K / BK;
    unsigned voffA[2], voffB[2];
#pragma unroll
    for (int i = 0; i < 2; ++i) { int R, C; stage_rc(tid * 16 + i * 8192, R, C); const int Rb = Epi::PERM ? ((R & ~31) + perm32(R & 31)) : R;
        voffA[i] = (unsigned)(R * g.lda + C) * 2u; voffB[i] = (unsigned)(Rb * g.ldb + C) * 2u; }
    const size_t kstep = (size_t)(BK * 2);
    const size_t hstepA = (size_t)HALF * g.lda * 2, hstepB = (size_t)HALF * g.ldb * 2;
    const size_t tstepA = 2 * hstepA, tstepB = 2 * hstepB;
    const unsigned ldsw = (unsigned)wid * 1024u;
    const int aoff = lds_byte(wr * 64 + fr, fq * 8), boff = lds_byte(wc * 32 + fr, fq * 8);
#define PG8_SA(b, h) (((b) * 2 + (h)) * HTB)
#define PG8_SB(b, h) ((4 + (b) * 2 + (h)) * HTB)
#define PG8_STAGE(bufoff, gbase, voff) do { _Pragma("unroll") for (int _i = 0; _i < 2; ++_i) \
        __builtin_amdgcn_global_load_lds((const unsigned*)((const char*)(gbase) + (voff)[_i]), (LAS unsigned*)(lds + (bufoff) + ldsw + _i * 8192), 16, 0, 0); } while (0)
#define PG8_LDA(dst, b, h) do { _Pragma("unroll") for (int m = 0; m < 4; ++m) _Pragma("unroll") for (int k = 0; k < 2; ++k) dst[m][k] = *(const LAS bf16x8*)(lds + PG8_SA(b, h) + aoff + m * 2048 + k * 1024); } while (0)
#define PG8_LDB(dst, b, h) do { _Pragma("unroll") for (int n = 0; n < 2; ++n) _Pragma("unroll") for (int k = 0; k < 2; ++k) dst[n][k] = *(const LAS bf16x8*)(lds + PG8_SB(b, h) + boff + n * 2048 + k * 1024); } while (0)
#define PG8_MMA(ai, bj, At, Bt) do { __builtin_amdgcn_s_setprio(1); _Pragma("unroll") for (int m = 0; m < 4; ++m) _Pragma("unroll") for (int n = 0; n < 2; ++n) _Pragma("unroll") for (int k = 0; k < 2; ++k) \
        acc[ai][bj][m][n] = __builtin_amdgcn_mfma_f32_16x16x32_bf16(Bt[n][k], At[m][k], acc[ai][bj][m][n], 0, 0, 0); __builtin_amdgcn_s_setprio(0); } while (0)
#define PG8_WAIT_V(n) asm volatile("s_waitcnt vmcnt(" #n ")" ::: "memory")
#define PG8_WAIT_L(n) asm volatile("s_waitcnt lgkmcnt(" #n ")" ::: "memory")
#define PG8_BAR __builtin_amdgcn_s_barrier()
#define PG8_SCHED __builtin_amdgcn_sched_barrier(0)
    Unit cur, nxt; int ui = 0;
    if (!S.next(0, cur)) return;
    f32x4 acc[2][2][4][2];
#pragma unroll
    for (int a = 0; a < 2; ++a)
#pragma unroll
        for (int b = 0; b < 2; ++b)
#pragma unroll
            for (int m = 0; m < 4; ++m)
#pragma unroll
                for (int n = 0; n < 2; ++n) acc[a][b][m][n] = (f32x4){0.f, 0.f, 0.f, 0.f};
    bf16x8 At[4][2], B0[2][2], B1[2][2];
    const char* cA = (const char*)g.A + (size_t)cur.seg * g.segA + (size_t)cur.pm * tstepA; const char* cB = (const char*)g.Bt + (size_t)cur.seg * g.segB + (size_t)cur.pn * tstepB;
    S.a_ready(cur);
    if constexpr (SP2) {
        PG8_STAGE(PG8_SB(0, 0), cB, voffB); PG8_STAGE(PG8_SB(0, 1), cB + hstepB, voffB); PG8_STAGE(PG8_SA(0, 0), cA, voffA); PG8_STAGE(PG8_SA(0, 1), cA + hstepA, voffA);
        if (wr == 1) PG8_BAR;
        PG8_WAIT_V(2); PG8_BAR;
        PG8_STAGE(PG8_SB(1, 0), cB + kstep, voffB); PG8_STAGE(PG8_SA(1, 0), cA + kstep, voffA); PG8_STAGE(PG8_SB(1, 1), cB + hstepB + kstep, voffB);
        PG8_WAIT_V(6); PG8_BAR;
    } else {
        PG8_STAGE(PG8_SB(0, 0), cB, voffB); PG8_STAGE(PG8_SA(0, 0), cA, voffA); PG8_STAGE(PG8_SB(0, 1), cB + hstepB, voffB); PG8_STAGE(PG8_SA(0, 1), cA + hstepA, voffA);
        if (wr == 1) PG8_BAR;
        PG8_WAIT_V(4); PG8_BAR;
        PG8_STAGE(PG8_SB(1, 0), cB + kstep, voffB); PG8_STAGE(PG8_SA(1, 0), cA + kstep, voffA); PG8_STAGE(PG8_SB(1, 1), cB + hstepB + kstep, voffB);
        PG8_WAIT_V(6); PG8_BAR;
    }
    for (;;) {
        const bool has_next = S.next(ui + 1, nxt);
        const char* nA = has_next ? (const char*)g.A + (size_t)nxt.seg * g.segA + (size_t)nxt.pm * tstepA : cA;
        const char* nB = has_next ? (const char*)g.Bt + (size_t)nxt.seg * g.segB + (size_t)nxt.pn * tstepB : cB;
        for (int t = 0; t < nt; t += 2) {
            const bool last = (t == nt - 2);
            const char* a1 = cA + (size_t)(t + 1) * kstep;
            const char* a2 = last ? nA : cA + (size_t)(t + 2) * kstep; const char* b2 = last ? nB : cB + (size_t)(t + 2) * kstep;
            const char* a3 = a2 + kstep; const char* b3 = b2 + kstep;
            if (last && has_next) S.a_ready(nxt);
            if constexpr (SP2) {
            PG8_LDB(B0, 0, 0); PG8_LDB(B1, 0, 1); PG8_SCHED; PG8_LDA(At, 0, 0); PG8_STAGE(PG8_SA(1, 1), a1 + hstepA, voffA);
            PG8_WAIT_V(8); PG8_WAIT_L(0); PG8_BAR; PG8_MMA(0, 0, At, B0); PG8_MMA(0, 1, At, B1); PG8_BAR; PG8_SCHED;
            PG8_LDA(At, 0, 1); PG8_STAGE(PG8_SB(0, 0), b2, voffB); PG8_STAGE(PG8_SB(0, 1), b2 + hstepB, voffB); PG8_STAGE(PG8_SA(0, 0), a2, voffA);
            PG8_WAIT_V(8); PG8_WAIT_L(0); PG8_BAR; PG8_MMA(1, 0, At, B0); PG8_MMA(1, 1, At, B1); PG8_BAR; PG8_SCHED;
            PG8_LDB(B0, 1, 0); PG8_LDB(B1, 1, 1); PG8_SCHED; PG8_LDA(At, 1, 0); PG8_STAGE(PG8_SA(0, 1), a2 + hstepA, voffA);
            PG8_WAIT_V(8); PG8_WAIT_L(0); PG8_BAR; PG8_MMA(0, 0, At, B0); PG8_MMA(0, 1, At, B1); PG8_BAR; PG8_SCHED;
            PG8_LDA(At, 1, 1); PG8_STAGE(PG8_SB(1, 0), b3, voffB); PG8_STAGE(PG8_SB(1, 1), b3 + hstepB, voffB); PG8_STAGE(PG8_SA(1, 0), a3, voffA);
            PG8_WAIT_V(8); PG8_WAIT_L(0); PG8_BAR; PG8_MMA(1, 0, At, B0); PG8_MMA(1, 1, At, B1); PG8_BAR; PG8_SCHED;
            } else {
            PG8_LDB(B0, 0, 0); PG8_SCHED; PG8_LDA(At, 0, 0); PG8_STAGE(PG8_SA(1, 1), a1 + hstepA, voffA);
            PG8_WAIT_L(8); PG8_BAR; PG8_WAIT_L(0); PG8_MMA(0, 0, At, B0); PG8_BAR; PG8_SCHED;
            PG8_LDB(B1, 0, 1); PG8_STAGE(PG8_SB(0, 0), b2, voffB);
            PG8_BAR; PG8_WAIT_L(0); PG8_MMA(0, 1, At, B1); PG8_BAR;
            PG8_LDA(At, 0, 1); PG8_STAGE(PG8_SA(0, 0), a2, voffA);
            PG8_BAR; PG8_WAIT_L(0); PG8_MMA(1, 0, At, B0); PG8_BAR; PG8_SCHED;
            PG8_STAGE(PG8_SB(0, 1), b2 + hstepB, voffB);
            PG8_WAIT_V(6); PG8_BAR; PG8_MMA(1, 1, At, B1); PG8_BAR;
            PG8_LDB(B0, 1, 0); PG8_SCHED; PG8_LDA(At, 1, 0); PG8_STAGE(PG8_SA(0, 1), a2 + hstepA, voffA);
            PG8_WAIT_L(8); PG8_BAR; PG8_WAIT_L(0); PG8_MMA(0, 0, At, B0); PG8_BAR; PG8_SCHED;
            PG8_LDB(B1, 1, 1); PG8_STAGE(PG8_SB(1, 0), b3, voffB);
            PG8_BAR; PG8_WAIT_L(0); PG8_MMA(0, 1, At, B1); PG8_BAR;
            PG8_LDA(At, 1, 1); PG8_STAGE(PG8_SA(1, 0), a3, voffA);
            PG8_BAR; PG8_WAIT_L(0); PG8_MMA(1, 0, At, B0); PG8_BAR; PG8_SCHED;
            PG8_STAGE(PG8_SB(1, 1), b3 + hstepB, voffB);
            PG8_WAIT_V(6); PG8_BAR; PG8_MMA(1, 1, At, B1); PG8_BAR;
            }
        }
        if constexpr (ALIGN_EPI) { if (wr == 0) PG8_BAR; }
        { int tz = threadIdx.x; asm volatile("" : "+v"(tz));
          const int l2 = tz & 63; E(acc, cur, wr, wc, l2 & 15, l2 >> 4, tz); }
        S.done(cur);
        if (!has_next) break;
        if (!Epi::keep_acc(cur))
#pragma unroll
        for (int a = 0; a < 2; ++a)
#pragma unroll
            for (int b = 0; b < 2; ++b)
#pragma unroll
                for (int m = 0; m < 4; ++m)
#pragma unroll
                    for (int n = 0; n < 2; ++n) acc[a][b][m][n] = (f32x4){0.f, 0.f, 0.f, 0.f};
        cur = nxt; cA = nA; cB = nB; ++ui;
        if constexpr (ALIGN_EPI) { if (wr == 1) PG8_BAR; }
    }
    PG8_WAIT_V(0);
    if constexpr (!ALIGN_EPI) { if (wr == 0) PG8_BAR; }
    PG8_BAR;
#undef PG8_SA
#undef PG8_SB
#undef PG8_STAGE
#undef PG8_LDA
#undef PG8_LDB
#undef PG8_MMA
#undef PG8_WAIT_V
#undef PG8_WAIT_L
#undef PG8_BAR
#undef PG8_SCHED
}

struct EpiProj {
    static constexpr bool PERM = true; static __device__ __forceinline__ bool keep_acc(const Unit&) { return false; }
    bf16_t* O; float* small; int gate_from;
    __device__ __forceinline__ void operator()(const f32x4 (&acc)[2][2][4][2], const Unit& u, int wr, int wc, int fr, int fq, int tz) const {
        const int row0 = u.pm * BM + wr * 64 + fr, col0 = u.pn * BM + wc * 32 + 8 * fq;
#pragma unroll
        for (int ai = 0; ai < 2; ++ai)
#pragma unroll
            for (int m = 0; m < 4; ++m) { const int row = row0 + ai * HALF + m * 16; bf16_t* rowp = O + (size_t)row * NPP + col0;
#pragma unroll
                for (int bj = 0; bj < 2; ++bj) { f32x4 v0 = acc[ai][bj][m][0], v1 = acc[ai][bj][m][1];
                    const int col = col0 + bj * HALF;
                    if (col + gate_from >= C_GATE) {
#pragma unroll
                        for (int j = 0; j < 4; ++j) { v0[j] = fmaxf(sigmoidf_(v0[j]), 1e-30f); v1[j] = fmaxf(sigmoidf_(v1[j]), 1e-30f); } }
                    u32x4 w; w.x = cvt_pk_bf16(v0[0], v0[1]); w.y = cvt_pk_bf16(v0[2], v0[3]); w.z = cvt_pk_bf16(v1[0], v1[1]); w.w = cvt_pk_bf16(v1[2], v1[3]);
                    *(u32x4*)(rowp + bj * HALF) = w;
                    v0 = acc[ai][bj][m][0]; v1 = acc[ai][bj][m][1];
                    int si = -1; if (col == C_DA) si = 0; else if (col == C_DB) si = 8; else if (col == C_MDT) si = 16; else if (col == C_MDT + 8) si = 24;
                    if (si >= 0) { float* sp = small + (size_t)row * 32 + si; *(f32x4*)sp = v0; *(f32x4*)(sp + 4) = v1; } } }
    }
};
struct EpiGlu {
    static constexpr bool PERM = true; static __device__ __forceinline__ bool keep_acc(const Unit&) { return false; }
    const bf16_t* Y; const float* bias; bf16_t* O;
    __device__ __forceinline__ void operator()(const f32x4 (&acc)[2][2][4][2], const Unit& u, int wr, int wc, int fr, int fq, int tz) const {
        const int row0 = u.pm * BM + wr * 64 + fr, col0 = u.pn * BM + wc * 32 + 8 * fq;
#pragma unroll
        for (int ai = 0; ai < 2; ++ai)
#pragma unroll
            for (int m = 0; m < 4; ++m) { const int row = row0 + ai * HALF + m * 16;
#pragma unroll
                for (int bj = 0; bj < 2; ++bj) { const int col = col0 + bj * HALF;
                    const f32x4 b0 = *(const f32x4*)(bias + col), b1 = *(const f32x4*)(bias + col + 4);
                    const u32x4 yw = *(const u32x4*)(Y + (size_t)row * 1024 + col);
                    const f32x4 v0 = acc[ai][bj][m][0] + b0, v1 = acc[ai][bj][m][1] + b1;
                    float o[8];
                    o[0] = bf_lo(yw.x) * sigmoidf_(v0[0]); o[1] = bf_hi(yw.x) * sigmoidf_(v0[1]); o[2] = bf_lo(yw.y) * sigmoidf_(v0[2]); o[3] = bf_hi(yw.y) * sigmoidf_(v0[3]);
                    o[4] = bf_lo(yw.z) * sigmoidf_(v1[0]); o[5] = bf_hi(yw.z) * sigmoidf_(v1[1]); o[6] = bf_lo(yw.w) * sigmoidf_(v1[2]); o[7] = bf_hi(yw.w) * sigmoidf_(v1[3]);
                    u32x4 w; w.x = cvt_pk_bf16(o[0], o[1]); w.y = cvt_pk_bf16(o[2], o[3]); w.z = cvt_pk_bf16(o[4], o[5]); w.w = cvt_pk_bf16(o[6], o[7]);
                    *(u32x4*)(O + (size_t)row * 4096 + 2048 + col) = w; asm volatile("" ::: "memory"); } }
    }
};
struct EpiMerge {
    static constexpr bool PERM = true; static __device__ __forceinline__ bool keep_acc(const Unit& u) { return u.seg < 3; }
    const bf16_t* proj; bf16_t* O;
    __device__ __forceinline__ void operator()(f32x4 (&acc)[2][2][4][2], const Unit& u, int wr, int wc, int fr, int fq, int tz) const {
        const int row0 = u.pm * BM + wr * 64 + fr, col0 = u.pn * BM + wc * 32 + 8 * fq;
        const bool lastseg = (u.seg == 3);
#pragma unroll
        for (int ai = 0; ai < 2; ++ai) {
            u32x4 gw[4][2], gn[4][2];
#pragma unroll
            for (int m = 0; m < 4; ++m)
#pragma unroll
                for (int bj = 0; bj < 2; ++bj) { const bf16_t* gp = proj + (size_t)(row0 + ai * HALF + m * 16) * NPP + C_GATE + u.seg * 2048 + col0 + bj * HALF;
                    gw[m][bj] = *(const u32x4*)gp; gn[m][bj] = *(const u32x4*)(gp + (lastseg ? 0 : 2048)); }
#pragma unroll
            for (int m = 0; m < 4; ++m)
#pragma unroll
                for (int bj = 0; bj < 2; ++bj) { const int row = row0 + ai * HALF + m * 16, col = col0 + bj * HALF;
                    const u32x4 a = gw[m][bj], d4 = gn[m][bj];
                    float s[8] = {bf_lo(a.x), bf_hi(a.x), bf_lo(a.y), bf_hi(a.y), bf_lo(a.z), bf_hi(a.z), bf_lo(a.w), bf_hi(a.w)};
                    if (!lastseg) { const float d[8] = {bf_lo(d4.x), bf_hi(d4.x), bf_lo(d4.y), bf_hi(d4.y), bf_lo(d4.z), bf_hi(d4.z), bf_lo(d4.w), bf_hi(d4.w)};
#pragma unroll
                        for (int j = 0; j < 8; ++j) s[j] = s[j] * __builtin_amdgcn_rcpf(d[j]); }
                    f32x4 v0 = acc[ai][bj][m][0], v1 = acc[ai][bj][m][1];
#pragma unroll
                    for (int j = 0; j < 4; ++j) { v0[j] *= s[j]; v1[j] *= s[4 + j]; }
                    acc[ai][bj][m][0] = v0; acc[ai][bj][m][1] = v1;
                    if (lastseg) { u32x4 w; w.x = cvt_pk_bf16(v0[0], v0[1]); w.y = cvt_pk_bf16(v0[2], v0[3]); w.z = cvt_pk_bf16(v1[0], v1[1]); w.w = cvt_pk_bf16(v1[2], v1[3]);
                        *(u32x4*)(O + (size_t)row * DM + col) = w; } }
            asm volatile("" ::: "memory"); }
    }
};
struct EpiResid {
    static constexpr bool PERM = true; static __device__ __forceinline__ bool keep_acc(const Unit&) { return false; }
    bf16_t* O;
    __device__ __forceinline__ void operator()(const f32x4 (&acc)[2][2][4][2], const Unit& u, int wr, int wc, int fr, int fq, int tz) const {
        const int row0 = u.pm * BM + wr * 64 + fr, col0 = u.pn * BM + wc * 32 + 8 * fq;
#pragma unroll
        for (int ai = 0; ai < 2; ++ai)
#pragma unroll
            for (int m = 0; m < 4; ++m) { bf16_t* rowp = O + (size_t)(row0 + ai * HALF + m * 16) * DM + col0;
#pragma unroll
                for (int bj = 0; bj < 2; ++bj) { const f32x4 v0 = acc[ai][bj][m][0], v1 = acc[ai][bj][m][1];
                    u32x4 w; w.x = cvt_pk_bf16(v0[0], v0[1]); w.y = cvt_pk_bf16(v0[2], v0[3]); w.z = cvt_pk_bf16(v1[0], v1[1]); w.w = cvt_pk_bf16(v1[2], v1[3]);
                    *(u32x4*)(rowp + bj * HALF) = w; } }
    }
};
struct EpiRelu2 {
    static constexpr bool PERM = true; static __device__ __forceinline__ bool keep_acc(const Unit&) { return false; }
    bf16_t* O;
    __device__ __forceinline__ void operator()(const f32x4 (&acc)[2][2][4][2], const Unit& u, int wr, int wc, int fr, int fq, int tz) const {
        const int row0 = u.pm * BM + wr * 64 + fr, col0 = u.pn * BM + wc * 32 + 8 * fq;
#pragma unroll
        for (int ai = 0; ai < 2; ++ai)
#pragma unroll
            for (int m = 0; m < 4; ++m) { bf16_t* rowp = O + (size_t)(row0 + ai * HALF + m * 16) * DFF + col0;
#pragma unroll
                for (int bj = 0; bj < 2; ++bj) { f32x4 v0 = acc[ai][bj][m][0], v1 = acc[ai][bj][m][1];
#pragma unroll
                    for (int j = 0; j < 4; ++j) { const float a = fmaxf(v0[j], 0.f), b = fmaxf(v1[j], 0.f); v0[j] = a * a; v1[j] = b * b; }
                    u32x4 w; w.x = cvt_pk_bf16(v0[0], v0[1]); w.y = cvt_pk_bf16(v0[2], v0[3]); w.z = cvt_pk_bf16(v1[0], v1[1]); w.w = cvt_pk_bf16(v1[2], v1[3]);
                    *(u32x4*)(rowp + bj * HALF) = w; } }
    }
};
}

#define XB_TMO      128
#define XB_XCNT(j)  (256  + 64 * (j))
#define XB_XSUB(j)  (1280 + 64 * (j))
#define XB_XGEN(j)  (2304 + 64 * (j))
#define XB_TOP      3328
#define XB_TOPGEN   3392
#define XCD_BAR_WORDS 3456
#define XB_SPIN_CAP (1u << 18)
__device__ __forceinline__ unsigned xb_ld(unsigned* p)              { return __hip_atomic_load(p, __ATOMIC_RELAXED, __HIP_MEMORY_SCOPE_AGENT); }
__device__ __forceinline__ unsigned xb_add(unsigned* p, unsigned v) { return __hip_atomic_fetch_add(p, v, __ATOMIC_RELAXED, __HIP_MEMORY_SCOPE_AGENT); }
__device__ __forceinline__ unsigned xb_xcc_id() { return (unsigned)__builtin_amdgcn_s_getreg((3 << 11) | 20) & 0xFu; }
#define XB_SPIN(cond, bar) do { unsigned _sp = 0; while (cond) { __builtin_amdgcn_s_sleep(1); \
    if ((++_sp & 255u) == 0u) { if (xb_ld(&(bar)[XB_TMO])) break; if (_sp > XB_SPIN_CAP) { atomicAdd(&(bar)[XB_TMO], 1u); break; } } } } while (0)
struct XcdBarrier { unsigned* bar; unsigned x; volatile LAS unsigned* st; };
__device__ __forceinline__ XcdBarrier xcd_barrier_post(unsigned* bar, volatile LAS unsigned* st) {
    XcdBarrier b; b.bar = bar; b.x = xb_xcc_id(); b.st = st;
    if (threadIdx.x == 0) (void)xb_add(&bar[XB_XCNT(b.x)], 1u);
    return b;
}
__device__ __forceinline__ void xcd_barrier_complete(unsigned* bar, unsigned x, unsigned& nloc, unsigned& nx) {
    const unsigned G = gridDim.x * gridDim.y * gridDim.z;
    unsigned sum, cnt, mine, sp = 0u;
    for (;;) {
        sum = 0u; cnt = 0u; mine = 0u;
#pragma unroll
        for (unsigned j = 0; j < 16; ++j) { const unsigned c = xb_ld(&bar[XB_XCNT(j)]); sum += c; cnt += (c > 0u) ? 1u : 0u; mine = (j == x) ? c : mine; }
        if (sum == G) break;
        __builtin_amdgcn_s_sleep(1);
        if ((++sp & 255u) == 0u) { if (xb_ld(&bar[XB_TMO])) break; if (sp > XB_SPIN_CAP) { atomicAdd(&bar[XB_TMO], 1u); break; } }
    }
    nloc = mine > 0u ? mine : 1u; nx = cnt > 0u ? cnt : 1u;
}
__device__ __forceinline__ void xcd_barrier(const XcdBarrier& b) {
    asm volatile("s_waitcnt vmcnt(0)" ::: "memory");
    __syncthreads();
    if (threadIdx.x == 0) {
        unsigned* bar = b.bar;
        __builtin_amdgcn_s_waitcnt(0);
        unsigned nloc = b.st[0], nx = b.st[1];
        if (nloc == 0u) { xcd_barrier_complete(bar, b.x, nloc, nx); b.st[0] = nloc; b.st[1] = nx; }
        const unsigned old = xb_add(&bar[XB_XSUB(b.x)], 1u);
        const unsigned gen = old / nloc;
        if (old + 1u == (gen + 1u) * nloc) {
            __builtin_amdgcn_fence(__ATOMIC_RELEASE, "agent");
            asm volatile("s_waitcnt vmcnt(0)" ::: "memory");
            const unsigned og = xb_add(&bar[XB_TOP], 1u);
            const unsigned tg = og / nx;
            if (og + 1u == (tg + 1u) * nx) xb_add(&bar[XB_TOPGEN], 1u);
            else XB_SPIN(xb_ld(&bar[XB_TOPGEN]) == tg, bar);
            __builtin_amdgcn_fence(__ATOMIC_ACQUIRE, "agent");
            xb_add(&bar[XB_XGEN(b.x)], 1u);
            asm volatile("s_waitcnt vmcnt(0)" ::: "memory");
        } else {
            XB_SPIN(xb_ld(&bar[XB_XGEN(b.x)]) == gen, bar);
            __builtin_amdgcn_fence(__ATOMIC_ACQUIRE, "agent");
            asm volatile("s_waitcnt vmcnt(0)" ::: "memory");
        }
    }
    __syncthreads();
}

struct Args { const void* in[34]; float* out; unsigned char* ws; int ph_lo, ph_hi, li, pad; };
struct Frame {
    LAS unsigned char* lds;
    int tid, lane, wave, vcu, G;
    const void* const* in;
    unsigned char* ws;
    float* out;
};
__device__ __forceinline__ int opaque_tid() { int tz = threadIdx.x; asm volatile("" : "+v"(tz)); return tz; }
#define FIN(i) ((const float*)F.in[i])
#define WSP(type, off) ((type*)(F.ws + (off)))

constexpr int NB_IN = (NPROJ + 63) / 64;
constexpr int I_IN = (DM / 64) * NB_IN, I_GLU = (1024 / 64) * (1024 / 64), I_BR = (1024 / 64) * (DM / 64), I_OUT = (DM / 64) * (DM / 64),
              I_UP = (DM / 64) * (DFF / 64), I_DOWN = (DFF / 64) * (DM / 64), I_LAYER = I_IN + I_GLU + 4 * I_BR + I_OUT + I_UP + I_DOWN;
__device__ __forceinline__ void p0_resolve(Frame& F, int it, const float*& W, int& K, int& N, bf16_t*& WT, int& r) {
    const int l = it / I_LAYER; r = it - l * I_LAYER;
    unsigned char* wt = F.ws + WS_WT + (size_t)l * WT_LAYER;
    if (r < I_IN) { W = FIN(2) + (size_t)l * DM * NPROJ; K = DM; N = NPROJ; WT = (bf16_t*)(wt + WT_IN); return; } r -= I_IN;
    if (r < I_GLU) { W = FIN(15) + (size_t)l * 1024 * 1024; K = 1024; N = 1024; WT = (bf16_t*)(wt + WT_GLU); return; } r -= I_GLU;
    if (r < I_BR) { W = FIN(23) + (size_t)l * 1024 * DM; K = 1024; N = DM; WT = (bf16_t*)(wt + WT_BR); return; } r -= I_BR;
    if (r < I_BR) { W = FIN(24) + (size_t)l * 1024 * DM; K = 1024; N = DM; WT = (bf16_t*)(wt + WT_BR + 4 * MiB); return; } r -= I_BR;
    if (r < I_BR) { W = FIN(25) + (size_t)l * 1024 * DM; K = 1024; N = DM; WT = (bf16_t*)(wt + WT_BR + 8 * MiB); return; } r -= I_BR;
    if (r < I_BR) { W = FIN(26) + (size_t)l * 1024 * DM; K = 1024; N = DM; WT = (bf16_t*)(wt + WT_BR + 12 * MiB); return; } r -= I_BR;
    if (r < I_OUT) { W = FIN(27) + (size_t)l * DM * DM; K = DM; N = DM; WT = (bf16_t*)(wt + WT_OUT); return; } r -= I_OUT;
    if (r < I_UP) { W = FIN(30) + (size_t)l * DM * DFF; K = DM; N = DFF; WT = (bf16_t*)(wt + WT_UP); return; } r -= I_UP;
    W = FIN(31) + (size_t)l * DFF * DM; K = DFF; N = DM; WT = (bf16_t*)(wt + WT_DOWN);
}
__device__ __forceinline__ void p0_prologue(Frame& F) {
    LAS float* scr = (LAS float*)(F.lds + F.wave * 16896);
    const int gw = F.vcu * 8 + F.wave, NGW = F.G * 8; F.tid = opaque_tid(); F.lane = F.tid & 63;
    const int lane = F.lane;
    { float v[64]; const float* W; int K, N, r; bf16_t* WT;
      int it = gw;
#define P0_LOAD() do { p0_resolve(F, it, W, K, N, WT, r); const int nblk = (N + 63) / 64, kb = r / nblk, nb = r - kb * nblk; const bool ok = 64 * nb + lane < N; const float* src = W + (size_t)(64 * kb) * N + 64 * nb + (ok ? lane : 0); \
        _Pragma("unroll") for (int i = 0; i < 64; ++i) v[i] = src[(size_t)i * N]; } while (0)
      if (it < NLAYER * I_LAYER) P0_LOAD();
      while (it < NLAYER * I_LAYER) {
          const int nblk = (N + 63) / 64, kb = r / nblk, nb = r - kb * nblk, k0 = 64 * kb, n0 = 64 * nb, Kc = K, Nc = N; bf16_t* WTc = WT;
#pragma unroll
          for (int i = 0; i < 64; ++i) scr[i * 65 + lane] = v[i];
          asm volatile("s_waitcnt lgkmcnt(0)" ::: "memory");
          it += NGW;
          if (it < NLAYER * I_LAYER) P0_LOAD();
          const int c = lane & 7;
#pragma unroll
          for (int j = 0; j < 8; ++j) { const int n = (lane >> 3) + 8 * j; const LAS float* s = scr + (8 * c) * 65 + n;
              u32x4 o; o.x = pk2(s[0 * 65], s[1 * 65]); o.y = pk2(s[2 * 65], s[3 * 65]); o.z = pk2(s[4 * 65], s[5 * 65]); o.w = pk2(s[6 * 65], s[7 * 65]);
              if (n0 + n < Nc) *(u32x4*)(WTc + (size_t)(n0 + n) * Kc + k0 + 8 * c) = o; }
          asm volatile("s_waitcnt lgkmcnt(0)" ::: "memory");
      }
#undef P0_LOAD
    }
    const int gt = F.vcu * 512 + F.tid, NGT = F.G * 512;
    for (int i = gt; i < NLAYER * (NPP - NPROJ) * DM / 8; i += NGT) { const int l = i / ((NPP - NPROJ) * DM / 8), r = i % ((NPP - NPROJ) * DM / 8);
        *(u32x4*)(F.ws + WS_WT + (size_t)l * WT_LAYER + WT_IN + (size_t)NPROJ * DM * 2 + (size_t)r * 16) = (u32x4){0u, 0u, 0u, 0u}; }
    { const int* pos = (const int*)F.in[1]; float* trig = WSP(float, WS_TRIG);
      for (int i = gt; i < T * 64; i += NGT) { const int t = i >> 6, j = i & 63;
          const double inv = exp2(-(double)j * (13.287712379549449 / 64.0));
          double s, c; sincos_d((double)pos[t] * inv, s, c);
          trig[(size_t)t * 128 + j] = (float)c; trig[(size_t)t * 128 + 64 + j] = (float)s; } }
    { const float* x = FIN(0); bf16_t* xb = WSP(bf16_t, WS_XB);
      for (int i = gt; i < T * DM / 4; i += NGT) { const f32x4 v = *(const f32x4*)(x + (size_t)i * 4); u32x2 w; w.x = pk2(v[0], v[1]); w.y = pk2(v[2], v[3]); *(u32x2*)(xb + (size_t)i * 4) = w; } }
    for (int i = gt; i < NLAYER * 4096; i += NGT) { const int l = i >> 12, gn = i & 4095, g = gn >> 6;
        const double lre = (double)FIN(7)[(size_t)l * 4096 + gn], lim = (double)FIN(8)[(size_t)l * 4096 + gn], step = exp((double)FIN(9)[l * 64 + g]);
        const double mag = exp(lre * step); double sn, cs; sincos_d(lim * step, sn, cs);
        const double are = mag * cs, aim = mag * sn, den = lre * lre + lim * lim;
        const double fre = ((are - 1.0) * lre + aim * lim) / den, fim = (aim * lre - (are - 1.0) * lim) / den;
        float* sp = (float*)(F.ws + WS_S5P + (size_t)l * MiB);
        sp[gn * 2] = (float)are; sp[gn * 2 + 1] = (float)aim;
        const float* bre = FIN(10) + ((size_t)l * 4096 + gn) * 16; const float* bim = FIN(11) + ((size_t)l * 4096 + gn) * 16;
        float* obre = sp + 16384 + (size_t)gn * 16; float* obim = sp + 16384 + 65536 + (size_t)gn * 16;
#pragma unroll
        for (int c = 0; c < 16; ++c) { const double br = bre[c], bi = bim[c]; obre[c] = (float)(fre * br - fim * bi); obim[c] = (float)(fre * bi + fim * br); } }
}

constexpr int LDP = 136;
__device__ __forceinline__ bf16x8 ldsfrag(const LAS bf16_t* base, int pitch, int row, int kk, int q) { return *(const LAS bf16x8*)(base + row * pitch + kk * 32 + 8 * q); }
__device__ __forceinline__ bf16x8 glbfrag(const bf16_t* base, int pitch, int row, int kk, int q) { return *(const bf16x8*)(base + (size_t)row * pitch + kk * 32 + 8 * q); }
#define MFMA16(a, b, c) __builtin_amdgcn_mfma_f32_16x16x32_bf16((a), (b), (c), 0, 0, 0)
__host__ __device__ __forceinline__ int fragoff(int row, int c8, int NK) { return 8 * ((((row >> 4) * NK + (c8 >> 2)) * 64) + (c8 & 3) * 16 + (row & 15)); }
#define LDS_BARRIER() do { asm volatile("s_waitcnt lgkmcnt(0)" ::: "memory"); __builtin_amdgcn_s_barrier(); asm volatile("" ::: "memory"); } while (0)

typedef float f32x16 __attribute__((ext_vector_type(16)));
__device__ __forceinline__ float gelu_tanh_(float y) { const float z = 0.7978845608028654f * (y + 0.044715f * y * y * y); const float th = 1.f - 2.f / (1.f + __expf(2.f * z)); return 0.5f * y * (1.f + th); }
__device__ __forceinline__ void s5_unit(Frame& F, int layer, int g) {
    const int tid = opaque_tid(), lane = tid & 63, w = F.wave, j = lane & 31, hh = lane >> 5, r16 = lane & 15, q = lane >> 4;
    LAS bf16_t* Xw = (LAS bf16_t*)(F.lds + w * 8704);
    LAS float* Ew = (LAS float*)(F.lds + 8 * 8704);
    LAS bf16_t* Uw = (LAS bf16_t*)(F.lds + 8 * 8704 + 4096 + w * 1024);
    const bf16_t* proj = WSP(bf16_t, WS_PROJ); bf16_t* ys = WSP(bf16_t, WS_YS5);
    const float* sp = (const float*)(F.ws + WS_S5P + (size_t)layer * MiB);
    float a1r[2], a1i[2], a2r[2], a2i[2], a3r[2], a3i[2], a4r[2], a4i[2];
#pragma unroll
    for (int s = 0; s < 2; ++s) { const int gn = g * 64 + j + 32 * s; a1r[s] = sp[gn * 2]; a1i[s] = sp[gn * 2 + 1];
        a2r[s] = a1r[s] * a1r[s] - a1i[s] * a1i[s]; a2i[s] = 2.f * a1r[s] * a1i[s];
        a3r[s] = a2r[s] * a1r[s] - a2i[s] * a1i[s]; a3i[s] = a2r[s] * a1i[s] + a2i[s] * a1r[s];
        a4r[s] = a2r[s] * a2r[s] - a2i[s] * a2i[s]; a4i[s] = 2.f * a2r[s] * a2i[s]; }
    bf16x8 bfr[4];
#pragma unroll
    for (int blk = 0; blk < 4; ++blk) { const float* src = sp + 16384 + (blk >> 1) * 65536 + (size_t)(g * 64 + j + 32 * (blk & 1)) * 16 + 8 * hh;
        const f32x4 v0 = *(const f32x4*)src, v1 = *(const f32x4*)(src + 4); u32x4 pk; pk.x = pk2(v0[0], v0[1]); pk.y = pk2(v0[2], v0[3]); pk.z = pk2(v1[0], v1[1]); pk.w = pk2(v1[2], v1[3]);
        bfr[blk] = __builtin_bit_cast(bf16x8, pk); }
    bf16x8 cfr[4];
    { const float* cre = FIN(12) + ((size_t)layer * 64 + g) * 1024 + r16 * 64; const float* cim = FIN(13) + ((size_t)layer * 64 + g) * 1024 + r16 * 64;
#pragma unroll
      for (int kk = 0; kk < 4; ++kk) { float v[8];
#pragma unroll
          for (int i = 0; i < 8; ++i) { const int ls = 8 * kk + 2 * q + (i >> 2), blk = i & 3, st = ls + 32 * (blk & 1); v[i] = (blk >> 1) ? -cim[st] : cre[st]; }
          u32x4 pk; pk.x = pk2(v[0], v[1]); pk.y = pk2(v[2], v[3]); pk.z = pk2(v[4], v[5]); pk.w = pk2(v[6], v[7]); cfr[kk] = __builtin_bit_cast(bf16x8, pk); } }
    const float dsk = FIN(14)[layer * 1024 + g * 16 + r16];
    const int t0 = w * 1024;
    float cr[2] = {0.f, 0.f}, ci[2] = {0.f, 0.f};
    const f32x16 zero16 = {0.f, 0.f, 0.f, 0.f, 0.f, 0.f, 0.f, 0.f, 0.f, 0.f, 0.f, 0.f, 0.f, 0.f, 0.f, 0.f};
#define S5_RING_LOAD(SET, tt) do { const bf16_t* p_ = proj + (size_t)(t0 + 32 * ((tt) & 31) + j) * NPP + C_SU + 16 * g + 8 * hh; asm volatile("global_load_dwordx4 %0, %1, off" : "=v"(ar[SET]) : "v"(p_) : "memory"); } while (0)
#define S5_TILE(tt, SET, LDSET, DO_Y, NWAIT) do { \
        asm volatile("s_waitcnt vmcnt(" NWAIT ")" : "+v"(ar[SET]) :: "memory"); __builtin_amdgcn_sched_barrier(0); \
        const bf16x8 afr = ar[SET]; \
        f32x16 acc[4]; \
        _Pragma("unroll") for (int blk = 0; blk < 4; ++blk) acc[blk] = __builtin_amdgcn_mfma_f32_32x32x16_bf16(afr, bfr[blk], zero16, 0, 0, 0); \
        float cjr[2][4], cji[2][4]; \
        _Pragma("unroll") for (int s = 0; s < 2; ++s) { \
            _Pragma("unroll") for (int gi = 0; gi < 4; ++gi) { float xr = 0.f, xi = 0.f; \
                _Pragma("unroll") for (int k = 0; k < 4; ++k) { const float nr = a1r[s] * xr - a1i[s] * xi + acc[s][4 * gi + k], ni = a1r[s] * xi + a1i[s] * xr + acc[2 + s][4 * gi + k]; xr = nr; xi = ni; acc[s][4 * gi + k] = xr; acc[2 + s][4 * gi + k] = xi; } } \
            float c_r = cr[s], c_i = ci[s]; \
            _Pragma("unroll") for (int gi = 0; gi < 4; ++gi) { const float er = acc[s][4 * gi + 3], ei = acc[2 + s][4 * gi + 3]; const float orr = __shfl_xor(er, 32), oi = __shfl_xor(ei, 32); \
                const float E0r = hh ? orr : er, E0i = hh ? oi : ei, E1r = hh ? er : orr, E1i = hh ? ei : oi;        \
                const float c0r = c_r, c0i = c_i; const float c1r = a4r[s] * c0r - a4i[s] * c0i + E0r, c1i = a4r[s] * c0i + a4i[s] * c0r + E0i; \
                cjr[s][gi] = hh ? c1r : c0r; cji[s][gi] = hh ? c1i : c0i; \
                c_r = a4r[s] * c1r - a4i[s] * c1i + E1r; c_i = a4r[s] * c1i + a4i[s] * c1r + E1i; } \
            cr[s] = c_r; ci[s] = c_i; } \
        if (DO_Y) { \
            _Pragma("unroll") for (int s = 0; s < 2; ++s) _Pragma("unroll") for (int gi = 0; gi < 4; ++gi) { const float kr = cjr[s][gi], ki = cji[s][gi]; \
                acc[s][4 * gi + 0] += a1r[s] * kr - a1i[s] * ki; acc[2 + s][4 * gi + 0] += a1r[s] * ki + a1i[s] * kr; \
                acc[s][4 * gi + 1] += a2r[s] * kr - a2i[s] * ki; acc[2 + s][4 * gi + 1] += a2r[s] * ki + a2i[s] * kr; \
                acc[s][4 * gi + 2] += a3r[s] * kr - a3i[s] * ki; acc[2 + s][4 * gi + 2] += a3r[s] * ki + a3i[s] * kr; \
                acc[s][4 * gi + 3] += a4r[s] * kr - a4i[s] * ki; acc[2 + s][4 * gi + 3] += a4r[s] * ki + a4i[s] * kr; } \
            _Pragma("unroll") for (int r = 0; r < 16; ++r) { const int tok = (r & 3) + 8 * (r >> 2) + 4 * hh; u32x2 o; o.x = pk2(acc[0][r], acc[1][r]); o.y = pk2(acc[2][r], acc[3][r]); *(LAS u32x2*)(Xw + tok * 136 + 4 * j) = o; } \
            *(LAS bf16x8*)(Uw + j * 16 + 8 * hh) = afr;            \
            asm volatile("s_waitcnt lgkmcnt(0)" ::: "memory"); \
            _Pragma("unroll") for (int mt = 0; mt < 2; ++mt) { f32x4 ya = {0.f, 0.f, 0.f, 0.f}; \
                _Pragma("unroll") for (int kk = 0; kk < 4; ++kk) ya = MFMA16(ldsfrag(Xw, 136, 16 * mt + r16, kk, q), cfr[kk], ya); \
                _Pragma("unroll") for (int r = 0; r < 4; ++r) { const size_t t = (size_t)(t0 + 32 * (tt) + 16 * mt + 4 * q + r); const float y = ya[r] + dsk * bf2f(Uw[(16 * mt + 4 * q + r) * 16 + r16]); \
                    ys[t * 1024 + g * 16 + r16] = (bf16_t)f2bf(gelu_tanh_(y)); } } \
            asm volatile("s_waitcnt lgkmcnt(0)" ::: "memory"); } \
        S5_RING_LOAD(LDSET, (tt) + 3); } while (0)
    bf16x8 ar[4];
    S5_RING_LOAD(0, 0); S5_RING_LOAD(1, 1); S5_RING_LOAD(2, 2);
    for (int tt = 0; tt < 32; tt += 4) { S5_TILE(tt, 0, 3, false, "2"); S5_TILE(tt + 1, 1, 0, false, "2"); S5_TILE(tt + 2, 2, 1, false, "2"); S5_TILE(tt + 3, 3, 2, false, "2"); }
    if (hh == 0) {
#pragma unroll
        for (int s = 0; s < 2; ++s) { Ew[(w * 64 + j + 32 * s) * 2] = cr[s]; Ew[(w * 64 + j + 32 * s) * 2 + 1] = ci[s]; } }
    __syncthreads();
#pragma unroll
    for (int s = 0; s < 2; ++s) { float pr = a4r[s], pi = a4i[s];
#pragma unroll
        for (int k = 0; k < 8; ++k) { const float nr = pr * pr - pi * pi, ni = 2.f * pr * pi; pr = nr; pi = ni; }
        float xr = 0.f, xi = 0.f;
        for (int v = 0; v < w; ++v) { const float er = Ew[(v * 64 + j + 32 * s) * 2], ei = Ew[(v * 64 + j + 32 * s) * 2 + 1]; const float nr = pr * xr - pi * xi + er, ni = pr * xi + pi * xr + ei; xr = nr; xi = ni; }
        cr[s] = xr; ci[s] = xi; }
    S5_TILE(0, 0, 3, true, "2"); S5_TILE(1, 1, 0, true, "10"); S5_TILE(2, 2, 1, true, "18"); S5_TILE(3, 3, 2, true, "18");
    for (int tt = 4; tt < 32; tt += 4) { S5_TILE(tt, 0, 3, true, "18"); S5_TILE(tt + 1, 1, 0, true, "18"); S5_TILE(tt + 2, 2, 1, true, "18"); S5_TILE(tt + 3, 3, 2, true, "18"); }
    asm volatile("s_waitcnt vmcnt(0)" ::: "memory");
#undef S5_RING_LOAD
#undef S5_TILE
    __syncthreads();
}

constexpr size_t RET_BLK = 3 * 16384;
__device__ __forceinline__ void ret_pre_unit(Frame& F, int n, int h) {
    const int tid = opaque_tid(), lane = tid & 63, w = F.wave, r16 = lane & 15, q = lane >> 4;
    LAS bf16_t* Qs = (LAS bf16_t*)(F.lds); LAS bf16_t* Ks = (LAS bf16_t*)(F.lds + 128 * LDP * 2);
    const bf16_t* proj = WSP(bf16_t, WS_PROJ); const float* trig = WSP(float, WS_TRIG);
    bf16_t* blk = (bf16_t*)(F.ws + WS_TMP + TM_KR) + (size_t)(n * 4 + h) * RET_BLK;
    { const int tok = tid >> 2, qt = tid & 3; const size_t t = (size_t)n * 128 + tok;
      const bf16_t* pq = proj + t * NPP + C_RQ + h * 128 + 16 * qt; const bf16_t* pk = proj + t * NPP + C_RK + h * 128 + 16 * qt;
      const float* tc = trig + t * 128 + 16 * qt;
      float cs[16], sn[16];
#pragma unroll
      for (int i = 0; i < 4; ++i) { const f32x4 c4 = *(const f32x4*)(tc + 4 * i), s4 = *(const f32x4*)(tc + 64 + 4 * i);
#pragma unroll
          for (int j = 0; j < 4; ++j) { cs[4 * i + j] = c4[j]; sn[4 * i + j] = s4[j]; } }
#pragma unroll
      for (int isk = 0; isk < 2; ++isk) {
          const bf16_t* p = isk ? pk : pq; const float sc = isk ? 0.08838834764831845f : 1.0f;
          const u32x4 a0 = *(const u32x4*)p, a1 = *(const u32x4*)(p + 8), b0 = *(const u32x4*)(p + 64), b1 = *(const u32x4*)(p + 72);
          float x1[16], x2[16];
#pragma unroll
          for (int j = 0; j < 4; ++j) { x1[2 * j] = bf_lo(a0[j]); x1[2 * j + 1] = bf_hi(a0[j]); x1[8 + 2 * j] = bf_lo(a1[j]); x1[8 + 2 * j + 1] = bf_hi(a1[j]);
              x2[2 * j] = bf_lo(b0[j]); x2[2 * j + 1] = bf_hi(b0[j]); x2[8 + 2 * j] = bf_lo(b1[j]); x2[8 + 2 * j + 1] = bf_hi(b1[j]); }
          u32x4 o1[2], o2[2];
#pragma unroll
          for (int j = 0; j < 8; ++j) { const float ya = (x1[2 * j] * cs[2 * j] - x2[2 * j] * sn[2 * j]) * sc, yb = (x1[2 * j + 1] * cs[2 * j + 1] - x2[2 * j + 1] * sn[2 * j + 1]) * sc;
              const float za = (x1[2 * j] * sn[2 * j] + x2[2 * j] * cs[2 * j]) * sc, zb = (x1[2 * j + 1] * sn[2 * j + 1] + x2[2 * j + 1] * cs[2 * j + 1]) * sc;
              o1[j >> 2][j & 3] = pk2(ya, yb); o2[j >> 2][j & 3] = pk2(za, zb); }
          LAS bf16_t* ls = (isk ? Ks : Qs) + tok * LDP + 16 * qt;
          *(LAS u32x4*)ls = o1[0]; *(LAS u32x4*)(ls + 8) = o1[1]; *(LAS u32x4*)(ls + 64) = o2[0]; *(LAS u32x4*)(ls + 72) = o2[1];
          if (!isk) { *(u32x4*)(blk + fragoff(tok, 2 * qt, 4)) = o1[0]; *(u32x4*)(blk + fragoff(tok, 2 * qt + 1, 4)) = o1[1]; *(u32x4*)(blk + fragoff(tok, 8 + 2 * qt, 4)) = o2[0]; *(u32x4*)(blk + fragoff(tok, 9 + 2 * qt, 4)) = o2[1]; } } }
    LDS_BARRIER();
    { const int d = tid >> 2, jq = tid & 3; bf16_t* g = blk + 2 * 16384;
#pragma unroll
      for (int c = 0; c < 4; ++c) { u32x4 o;
#pragma unroll
          for (int j = 0; j < 4; ++j) { const unsigned lo = Ks[(32 * jq + 8 * c + 2 * j) * LDP + d], hi = Ks[(32 * jq + 8 * c + 2 * j + 1) * LDP + d]; o[j] = lo | (hi << 16); }
          *(u32x4*)(g + fragoff(d, 4 * jq + c, 4)) = o; } }
    { const float lg = log2f(1.0f - exp2f(-5.0f - (float)h)); const int i = 16 * w + r16;
      bf16x8 bq[4];
#pragma unroll
      for (int kk = 0; kk < 4; ++kk) bq[kk] = ldsfrag(Qs, LDP, 16 * w + r16, kk, q);
      bf16_t* g = blk + 16384;
      for (int jt = 0; jt < 8; ++jt) {
          u32x2 o = {0u, 0u};
          if (jt <= w) { f32x4 acc = {0.f, 0.f, 0.f, 0.f};
#pragma unroll
              for (int kk = 0; kk < 4; ++kk) acc = MFMA16(ldsfrag(Ks, LDP, 16 * jt + r16, kk, q), bq[kk], acc);
              float v[4];
#pragma unroll
              for (int r = 0; r < 4; ++r) { const int j = 16 * jt + 4 * q + r; v[r] = (j <= i) ? acc[r] * exp2f((float)(i - j) * lg) : 0.f; }
              o.x = pk2(v[0], v[1]); o.y = pk2(v[2], v[3]); }
          *(u32x2*)(g + fragoff(i, 2 * jt + (q >> 1), 4) + 4 * (q & 1)) = o; } }
    LDS_BARRIER();
}

__device__ __forceinline__ void ret_seq_unit(Frame& F, int u) {
    const int tid = opaque_tid(), lane = tid & 63, w = F.wave, r16 = lane & 15, q = lane >> 4;
    const int h = u >> 4, e0 = (u & 15) * 16;
    LAS bf16_t* Rt = (LAS bf16_t*)(F.lds); LAS bf16_t* Vt = (LAS bf16_t*)(F.lds + 2 * 16 * LDP * 2); LAS bf16_t* Vd = (LAS bf16_t*)(F.lds + 4 * 16 * LDP * 2);
    const bf16_t* proj = WSP(bf16_t, WS_PROJ); bf16_t* O = (bf16_t*)(F.ws + WS_TMP + TM_VR);
    const bf16_t* blk0 = (const bf16_t*)(F.ws + WS_TMP + TM_KR) + (size_t)h * RET_BLK;
    const float lg = log2f(1.0f - exp2f(-5.0f - (float)h)), g128 = exp2f(128.f * lg);
    float rsc[4];
#pragma unroll
    for (int r = 0; r < 4; ++r) rsc[r] = exp2f((float)(16 * w + 4 * q + r + 1) * lg);
    const int vj = tid >> 1, vh = tid & 1; const float vdec = exp2f((float)(127 - vj) * lg);
    u32x4 vreg = {0u, 0u, 0u, 0u};
#define RET_LOADV(c) do { if (tid < 256) vreg = *(const u32x4*)(proj + (size_t)((c) * 128 + vj) * NPP + C_RV + h * 256 + e0 + 8 * vh); } while (0)
#define RET_STOREV(b) do { if (tid < 256) { LAS bf16_t* vt = Vt + (b) * 16 * LDP + (8 * vh) * LDP + vj; LAS bf16_t* vd = Vd + (b) * 16 * LDP + (8 * vh) * LDP + vj; \
        _Pragma("unroll") for (int j = 0; j < 4; ++j) { const float lo = bf_lo(vreg[j]), hi = bf_hi(vreg[j]); vt[(2 * j) * LDP] = (bf16_t)(vreg[j] & 0xffffu); vt[(2 * j + 1) * LDP] = (bf16_t)(vreg[j] >> 16); \
            vd[(2 * j) * LDP] = (bf16_t)f2bf(lo * vdec); vd[(2 * j + 1) * LDP] = (bf16_t)f2bf(hi * vdec); } } } while (0)
#define RET_LOADF(FR, c) do { const bf16_t* bk = blk0 + (size_t)(c) * 4 * RET_BLK; _Pragma("unroll") for (int kk = 0; kk < 4; ++kk) { \
        FR[kk] = *(const bf16x8*)(bk + (w * 4 + kk) * 512 + lane * 8); if (kk <= (w >> 1)) FR[4 + kk] = *(const bf16x8*)(bk + 16384 + (w * 4 + kk) * 512 + lane * 8); FR[8 + kk] = *(const bf16x8*)(bk + 32768 + (w * 4 + kk) * 512 + lane * 8); } } while (0)
    for (int i = tid; i < 16 * LDP; i += 512) Rt[i] = 0;
    RET_LOADV(0); RET_STOREV(0);
    bf16x8 fa[12], fb[12];
    RET_LOADF(fa, 0);
    f32x4 R = {0.f, 0.f, 0.f, 0.f};
    __syncthreads();
#define RET_CHUNK(c, CUR, NXT) do { const int b = (c) & 1; \
        if ((c) + 1 < T / 128) { RET_LOADF(NXT, (c) + 1); RET_LOADV((c) + 1); } \
        f32x4 a1 = {0.f, 0.f, 0.f, 0.f}, a2 = {0.f, 0.f, 0.f, 0.f}; f32x4 ra = R * g128; \
        _Pragma("unroll") for (int kk = 0; kk < 4; ++kk) { const bf16x8 bR = ldsfrag(Rt + b * 16 * LDP, LDP, r16, kk, q), bV = ldsfrag(Vt + b * 16 * LDP, LDP, r16, kk, q), bD = ldsfrag(Vd + b * 16 * LDP, LDP, r16, kk, q); \
            a1 = MFMA16(CUR[kk], bR, a1); if (kk <= (w >> 1)) a2 = MFMA16(CUR[4 + kk], bV, a2); ra = MFMA16(CUR[8 + kk], bD, ra); } \
        R = ra; \
        _Pragma("unroll") for (int r = 0; r < 4; ++r) O[(size_t)((c) * 128 + 16 * w + 4 * q + r) * 1024 + h * 256 + e0 + r16] = (bf16_t)f2bf(rsc[r] * a1[r] + a2[r]); \
        { u32x2 o; o.x = pk2(R[0], R[1]); o.y = pk2(R[2], R[3]); *(LAS u32x2*)(Rt + (b ^ 1) * 16 * LDP + r16 * LDP + 16 * w + 4 * q) = o; } \
        if ((c) + 1 < T / 128) RET_STOREV(b ^ 1); \
        LDS_BARRIER(); } while (0)
    for (int c = 0; c < T / 128; c += 2) { RET_CHUNK(c, fa, fb); RET_CHUNK(c + 1, fb, fa); }
#undef RET_CHUNK
#undef RET_LOADF
#undef RET_LOADV
#undef RET_STOREV
}


__device__ __forceinline__ void ssd_pre_unit(Frame& F, int layer, int n, int g) {
    const int tid = opaque_tid(), lane = tid & 63, w = F.wave, r16 = lane & 15, q = lane >> 4;
    LAS bf16_t* Cs = (LAS bf16_t*)(F.lds); LAS bf16_t* Bs = (LAS bf16_t*)(F.lds + 128 * LDP * 2);
    LAS float* Ac = (LAS float*)(F.lds + 2 * 128 * LDP * 2); LAS float* Dt = Ac + 8 * 128;
    const bf16_t* proj = WSP(bf16_t, WS_PROJ); const float* small = WSP(float, WS_SMALL);
    unsigned char* tm = F.ws + WS_TMP;
    float* acum = (float*)(tm + TM_SAC); bf16_t* XS = (bf16_t*)(tm + TM_SXS); bf16_t* XD = (bf16_t*)(tm + TM_SXD);
    bf16_t* cb = (bf16_t*)(tm + TM_SCB) + (size_t)(n * 2 + g) * 32768; bf16_t* sl = (bf16_t*)(tm + TM_SSL) + (size_t)(n * 16 + 8 * g) * 16384;
    const float* scw = FIN(17) + (size_t)layer * 1536 * 4; const float* scb = FIN(18) + layer * 1536; const float* sdtb = FIN(19) + layer * 16; const float* salog = FIN(20) + layer * 16;
    const int t0 = n * 128;
    { const int hh = 8 * g + w; const float a = -__expf(salog[hh]);
      const float dt0 = softplusf_(small[(size_t)(t0 + 2 * lane) * 32 + 16 + hh] + sdtb[hh]), dt1 = softplusf_(small[(size_t)(t0 + 2 * lane + 1) * 32 + 16 + hh] + sdtb[hh]);
      const float v0 = dt0 * a, v1 = dt1 * a, s = v0 + v1; float incl = s;
#pragma unroll
      for (int o = 1; o < 64; o <<= 1) { const float tmp = __shfl_up(incl, o); if (lane >= o) incl += tmp; }
      const float excl = incl - s;
      Ac[w * 128 + 2 * lane] = excl + v0; Ac[w * 128 + 2 * lane + 1] = excl + s; Dt[w * 128 + 2 * lane] = dt0; Dt[w * 128 + 2 * lane + 1] = dt1;
      acum[(size_t)(t0 + 2 * lane) * 16 + hh] = excl + v0; acum[(size_t)(t0 + 2 * lane + 1) * 16 + hh] = excl + s; }
    LDS_BARRIER();
    { const int cp = tid & 127, tq = tid >> 7; const int tb = t0 + 32 * tq;
      unsigned xa[3][35];
#pragma unroll
      for (int m = 0; m < 3; ++m) { const int ch = (m < 2) ? g * 512 + m * 256 + 2 * cp : (cp < 64 ? 1024 + g * 128 + 2 * cp : 1280 + g * 128 + 2 * (cp - 64)); const bf16_t* pc = proj + C_MX + ch;
#pragma unroll
          for (int i = 0; i < 35; ++i) xa[m][i] = (tb - 3 + i >= 0) ? *(const unsigned*)(pc + (size_t)(tb - 3 + i) * NPP) : 0u; }
#pragma unroll
      for (int m = 0; m < 3; ++m) {
          const int ch = (m < 2) ? g * 512 + m * 256 + 2 * cp : (cp < 64 ? 1024 + g * 128 + 2 * cp : 1280 + g * 128 + 2 * (cp - 64));
          const f32x4 w0 = *(const f32x4*)(scw + (size_t)ch * 4), w1 = *(const f32x4*)(scw + (size_t)ch * 4 + 4); const float b0 = scb[ch], b1 = scb[ch + 1];
          const unsigned (&xw)[35] = xa[m];
#pragma unroll
          for (int i = 0; i < 32; ++i) { const unsigned x0 = xw[i], x1 = xw[i + 1], x2 = xw[i + 2], x3 = xw[i + 3];
              const float ya = siluf_(w0[0] * bf_lo(x0) + w0[1] * bf_lo(x1) + w0[2] * bf_lo(x2) + w0[3] * bf_lo(x3) + b0);
              const float yb = siluf_(w1[0] * bf_hi(x0) + w1[1] * bf_hi(x1) + w1[2] * bf_hi(x2) + w1[3] * bf_hi(x3) + b1);
              if (m < 2) { const float dt = Dt[(m * 4 + (cp >> 5)) * 128 + 32 * tq + i]; const size_t go = (size_t)(tb + i) * 1024 + g * 512 + m * 256 + 2 * cp;
                  *(unsigned*)(XS + go) = pk2(ya, yb); *(unsigned*)(XD + go) = pk2(ya * dt, yb * dt); }
              else if (cp < 64) *(LAS unsigned*)(Bs + (32 * tq + i) * LDP + 2 * cp) = pk2(ya, yb);
              else *(LAS unsigned*)(Cs + (32 * tq + i) * LDP + 2 * (cp - 64)) = pk2(ya, yb); } } }
    LDS_BARRIER();
#pragma unroll
    for (int k = 0; k < 4; ++k) { const int idx = tid + 512 * k, row = idx >> 4, c8 = idx & 15; *(u32x4*)(cb + fragoff(row, c8, 4)) = *(const LAS u32x4*)(Cs + row * LDP + 8 * c8); }
    { const int d = tid >> 2, jq = tid & 3; bf16_t* gp = cb + 16384;
#pragma unroll
      for (int c = 0; c < 4; ++c) { u32x4 o;
#pragma unroll
          for (int j = 0; j < 4; ++j) { const unsigned lo = Bs[(32 * jq + 8 * c + 2 * j) * LDP + d], hi = Bs[(32 * jq + 8 * c + 2 * j + 1) * LDP + d]; o[j] = lo | (hi << 16); }
          *(u32x4*)(gp + fragoff(d, 4 * jq + c, 4)) = o; } }
    { const int i = 16 * w + r16; bf16x8 bq[4];
#pragma unroll
      for (int kk = 0; kk < 4; ++kk) bq[kk] = ldsfrag(Cs, LDP, i, kk, q);
      float ai[8];
#pragma unroll
      for (int hh = 0; hh < 8; ++hh) ai[hh] = Ac[hh * 128 + i];
      for (int jt = 0; jt < 8; ++jt) {
          f32x4 acc = {0.f, 0.f, 0.f, 0.f};
          if (jt <= w) {
#pragma unroll
              for (int kk = 0; kk < 4; ++kk) acc = MFMA16(ldsfrag(Bs, LDP, 16 * jt + r16, kk, q), bq[kk], acc); }
#pragma unroll
          for (int hh = 0; hh < 8; ++hh) { u32x2 o = {0u, 0u};
              if (jt <= w) { const f32x4 aj = *(const LAS f32x4*)(Ac + hh * 128 + 16 * jt + 4 * q); float v[4];
#pragma unroll
                  for (int r = 0; r < 4; ++r) { const int j = 16 * jt + 4 * q + r; v[r] = (j <= i) ? acc[r] * __expf(ai[hh] - aj[r]) : 0.f; }
                  o.x = pk2(v[0], v[1]); o.y = pk2(v[2], v[3]); }
              *(u32x2*)(sl + (size_t)hh * 16384 + fragoff(i, 2 * jt + (q >> 1), 4) + 4 * (q & 1)) = o; } } }
    LDS_BARRIER();
}

__device__ __forceinline__ void ssd_seq_unit(Frame& F, int u) {
    const int tid = opaque_tid(), lane = tid & 63, w = F.wave, r16 = lane & 15, q = lane >> 4;
    const int h = u >> 2, p0 = (u & 3) * 16, g = h >> 3;
    LAS bf16_t* St = (LAS bf16_t*)(F.lds); LAS bf16_t* Vt = (LAS bf16_t*)(F.lds + 2 * 16 * LDP * 2); LAS bf16_t* Vd = (LAS bf16_t*)(F.lds + 4 * 16 * LDP * 2);
    unsigned char* tm = F.ws + WS_TMP;
    const float* acum = (const float*)(tm + TM_SAC); const bf16_t* XD = (const bf16_t*)(tm + TM_SXD); bf16_t* O = (bf16_t*)(tm + TM_VS);
    const bf16_t* cb0 = (const bf16_t*)(tm + TM_SCB) + (size_t)g * 32768; const bf16_t* sl0 = (const bf16_t*)(tm + TM_SSL) + (size_t)h * 16384;
    const int vj = tid >> 1, vh = tid & 1;
    u32x4 vreg = {0u, 0u, 0u, 0u}; float vdl = 0.f, vdj = 0.f;
#define SSD_LOADV(c) do { if (tid < 256) { vreg = *(const u32x4*)(XD + (size_t)((c) * 128 + vj) * 1024 + h * 64 + p0 + 8 * vh); \
        vdl = acum[(size_t)((c) * 128 + 127) * 16 + h]; vdj = acum[(size_t)((c) * 128 + vj) * 16 + h]; } } while (0)
#define SSD_STOREV(b) do { if (tid < 256) { const float vdn = __expf(vdl - vdj); LAS bf16_t* vt = Vt + (b) * 16 * LDP + (8 * vh) * LDP + vj; LAS bf16_t* vd = Vd + (b) * 16 * LDP + (8 * vh) * LDP + vj; \
        _Pragma("unroll") for (int j = 0; j < 4; ++j) { const float lo = bf_lo(vreg[j]), hi = bf_hi(vreg[j]); vt[(2 * j) * LDP] = (bf16_t)(vreg[j] & 0xffffu); vt[(2 * j + 1) * LDP] = (bf16_t)(vreg[j] >> 16); \
            vd[(2 * j) * LDP] = (bf16_t)f2bf(lo * vdn); vd[(2 * j + 1) * LDP] = (bf16_t)f2bf(hi * vdn); } } } while (0)
#define SSD_LOADF(FR, AR, c) do { const bf16_t* bc = cb0 + (size_t)(c) * 2 * 32768; const bf16_t* bs = sl0 + (size_t)(c) * 16 * 16384; _Pragma("unroll") for (int kk = 0; kk < 4; ++kk) { \
        FR[kk] = *(const bf16x8*)(bc + (w * 4 + kk) * 512 + lane * 8); if (kk <= (w >> 1)) FR[4 + kk] = *(const bf16x8*)(bs + (w * 4 + kk) * 512 + lane * 8); FR[8 + kk] = *(const bf16x8*)(bc + 16384 + (w * 4 + kk) * 512 + lane * 8); } \
        _Pragma("unroll") for (int r = 0; r < 4; ++r) AR[r] = acum[(size_t)((c) * 128 + 16 * w + 4 * q + r) * 16 + h]; AR[4] = acum[(size_t)((c) * 128 + 127) * 16 + h]; } while (0)
    for (int i = tid; i < 16 * LDP; i += 512) St[i] = 0;
    SSD_LOADV(0); SSD_STOREV(0);
    bf16x8 fa[12], fb[12]; float aa[5], ab[5];
    SSD_LOADF(fa, aa, 0);
    f32x4 S = {0.f, 0.f, 0.f, 0.f};
    __syncthreads();
#define SSD_CHUNK(c, CUR, NXT, ACUR, ANXT) do { const int b = (c) & 1; \
        if ((c) + 1 < T / 128) { SSD_LOADF(NXT, ANXT, (c) + 1); SSD_LOADV((c) + 1); } \
        f32x4 a1 = {0.f, 0.f, 0.f, 0.f}, a2 = {0.f, 0.f, 0.f, 0.f}; f32x4 sa = S * __expf(ACUR[4]); \
        _Pragma("unroll") for (int kk = 0; kk < 4; ++kk) { const bf16x8 bS = ldsfrag(St + b * 16 * LDP, LDP, r16, kk, q), bV = ldsfrag(Vt + b * 16 * LDP, LDP, r16, kk, q), bD = ldsfrag(Vd + b * 16 * LDP, LDP, r16, kk, q); \
            a1 = MFMA16(CUR[kk], bS, a1); if (kk <= (w >> 1)) a2 = MFMA16(CUR[4 + kk], bV, a2); sa = MFMA16(CUR[8 + kk], bD, sa); } \
        S = sa; \
        _Pragma("unroll") for (int r = 0; r < 4; ++r) O[(size_t)((c) * 128 + 16 * w + 4 * q + r) * 1024 + h * 64 + p0 + r16] = (bf16_t)f2bf(__expf(ACUR[r]) * a1[r] + a2[r]); \
        { u32x2 o; o.x = pk2(S[0], S[1]); o.y = pk2(S[2], S[3]); *(LAS u32x2*)(St + (b ^ 1) * 16 * LDP + r16 * LDP + 16 * w + 4 * q) = o; } \
        if ((c) + 1 < T / 128) SSD_STOREV(b ^ 1); \
        LDS_BARRIER(); } while (0)
    for (int c = 0; c < T / 128; c += 2) { SSD_CHUNK(c, fa, fb, aa, ab); SSD_CHUNK(c + 1, fb, fa, ab, aa); }
#undef SSD_CHUNK
#undef SSD_LOADF
#undef SSD_LOADV
#undef SSD_STOREV
}


constexpr size_t GDN_BLK = 36864;
__device__ __forceinline__ void gdn_pre_unit(Frame& F, int layer, int n, int h) {
    const int tid = opaque_tid(), lane = tid & 63, w = F.wave, r16 = lane & 15, q = lane >> 4;
    LAS bf16_t* Qs = (LAS bf16_t*)(F.lds); LAS bf16_t* Ks = (LAS bf16_t*)(F.lds + 17408); LAS bf16_t* Kd = (LAS bf16_t*)(F.lds + 34816);
    LAS float* Mm = (LAS float*)(F.lds + 52224); LAS float* Rr = (LAS float*)(F.lds + 69632); LAS float* gc = (LAS float*)(F.lds + 135168); LAS float* be = gc + 64;
    LAS bf16_t* Xt = Qs;
    LAS bf16_t* Mb = (LAS bf16_t*)(F.lds + 135680);
    const bf16_t* proj = WSP(bf16_t, WS_PROJ); const float* small = WSP(float, WS_SMALL);
    unsigned char* tm = F.ws + WS_TMP;
    bf16_t* blk = (bf16_t*)(tm + TM_KG) + (size_t)(n * 8 + h) * GDN_BLK;
    const float* gcw = FIN(3) + (size_t)layer * 3072 * 4; const float* galog = FIN(4) + layer * 8; const float* gdtb = FIN(5) + layer * 8;
    const int t0 = n * 64;
    f32x4 wt[3][2];
#pragma unroll
      for (int p = 0; p < 3; ++p)
#pragma unroll
          for (int e = 0; e < 2; ++e) wt[p][e] = *(const f32x4*)(gcw + (size_t)(p * 1024 + h * 128 + 2 * lane + e) * 4);
    const bf16_t* pc = proj + C_DQ + h * 128 + 2 * lane; const int tb = t0 + 8 * w;
    unsigned xw[3][11];
#pragma unroll
      for (int p = 0; p < 3; ++p)
#pragma unroll
          for (int k = 0; k < 11; ++k) xw[p][k] = (tb - 3 + k >= 0) ? *(const unsigned*)(pc + (size_t)(tb - 3 + k) * NPP + p * 1024) : 0u;
    if (w == 0) { const float g = -__expf(galog[h]) * softplusf_(small[(size_t)(t0 + lane) * 32 + h] + gdtb[h]); float incl = g;
#pragma unroll
        for (int o = 1; o < 64; o <<= 1) { const float tmp = __shfl_up(incl, o); if (lane >= o) incl += tmp; }
        gc[lane] = incl; be[lane] = sigmoidf_(small[(size_t)(t0 + lane) * 32 + 8 + h]);
        if (lane == 63) ((float*)(tm + TM_SM))[n * 8 + h] = __expf(incl); }
    LDS_BARRIER();
    {
      const float gl63 = gc[63];
#pragma unroll
      for (int i = 0; i < 8; ++i) { const int tok = 8 * w + i; float v[3][2];
#pragma unroll
          for (int p = 0; p < 3; ++p) {
              v[p][0] = siluf_(wt[p][0][0] * bf_lo(xw[p][i]) + wt[p][0][1] * bf_lo(xw[p][i + 1]) + wt[p][0][2] * bf_lo(xw[p][i + 2]) + wt[p][0][3] * bf_lo(xw[p][i + 3]));
              v[p][1] = siluf_(wt[p][1][0] * bf_hi(xw[p][i]) + wt[p][1][1] * bf_hi(xw[p][i + 1]) + wt[p][1][2] * bf_hi(xw[p][i + 2]) + wt[p][1][3] * bf_hi(xw[p][i + 3])); }
          const float sq = wave_sum(v[0][0] * v[0][0] + v[0][1] * v[0][1]), sk = wave_sum(v[1][0] * v[1][0] + v[1][1] * v[1][1]);
          const float rq = rsqrtf(sq + RMS_EPS) * 0.08838834764831845f, rk = rsqrtf(sk + RMS_EPS);
          const float gci = gc[tok], bei = be[tok], eg = __expf(gci), et = __expf(gl63 - gci);
          const float q0 = v[0][0] * rq, q1 = v[0][1] * rq, k0 = v[1][0] * rk, k1 = v[1][1] * rk;
          *(LAS unsigned*)(Qs + tok * LDP + 2 * lane) = pk2(q0, q1); *(LAS unsigned*)(Ks + tok * LDP + 2 * lane) = pk2(k0, k1); *(LAS unsigned*)(Kd + tok * LDP + 2 * lane) = pk2(k0 * et, k1 * et);
          *(LAS f32x2*)(Rr + tok * 256 + 2 * lane) = (f32x2){bei * v[2][0], bei * v[2][1]}; *(LAS f32x2*)(Rr + tok * 256 + 128 + 2 * lane) = (f32x2){bei * eg * k0, bei * eg * k1};
          *(unsigned*)(blk + 16384 + fragoff(tok, lane >> 2, 4) + 2 * (lane & 3)) = pk2(q0 * eg, q1 * eg); } }
    LDS_BARRIER();
    if (w < 4) { bf16x8 aK[4];
#pragma unroll
        for (int kk = 0; kk < 4; ++kk) aK[kk] = ldsfrag(Ks, LDP, 16 * w + r16, kk, q);
        for (int jt = 0; jt <= w; ++jt) { f32x4 acc = {0.f, 0.f, 0.f, 0.f};
#pragma unroll
            for (int kk = 0; kk < 4; ++kk) acc = MFMA16(aK[kk], ldsfrag(Ks, LDP, 16 * jt + r16, kk, q), acc);
            const int j = 16 * jt + r16; const float gj = gc[j];
#pragma unroll
            for (int r = 0; r < 4; ++r) { const int i = 16 * w + 4 * q + r; const float mv = (j < i) ? be[i] * acc[r] * __expf(gc[i] - gj) : 0.f; Mm[i * 68 + j] = mv; Mb[i * 72 + j] = (bf16_t)f2bf(mv); } } }
    else { const int wq = w - 4, i = 16 * wq + r16; bf16x8 bQ[4];
#pragma unroll
        for (int kk = 0; kk < 4; ++kk) bQ[kk] = ldsfrag(Qs, LDP, i, kk, q);
        const float gi = gc[i];
        for (int jt = 0; jt < 4; ++jt) { u32x2 o = {0u, 0u};
            if (jt <= wq) { f32x4 acc = {0.f, 0.f, 0.f, 0.f};
#pragma unroll
                for (int kk = 0; kk < 4; ++kk) acc = MFMA16(ldsfrag(Ks, LDP, 16 * jt + r16, kk, q), bQ[kk], acc);
                float v[4];
#pragma unroll
                for (int r = 0; r < 4; ++r) { const int j = 16 * jt + 4 * q + r; v[r] = (j <= i) ? acc[r] * __expf(gi - gc[j]) : 0.f; }
                o.x = pk2(v[0], v[1]); o.y = pk2(v[2], v[3]); }
            *(u32x2*)(blk + 24576 + fragoff(i, 2 * jt + (q >> 1), 2) + 4 * (q & 1)) = o; } }
    { const int d = tid >> 2, jq = tid & 3; bf16_t* gp = blk + 28672;
#pragma unroll
      for (int c = 0; c < 2; ++c) { u32x4 o;
#pragma unroll
          for (int j = 0; j < 4; ++j) { const unsigned lo = Kd[(16 * jq + 8 * c + 2 * j) * LDP + d], hi = Kd[(16 * jq + 8 * c + 2 * j + 1) * LDP + d]; o[j] = lo | (hi << 16); }
          *(u32x4*)(gp + fragoff(d, 2 * jq + c, 2)) = o; } }
    LDS_BARRIER();
#pragma unroll
    for (int b = 0; b < 4; ++b) {
        if (b > 0) {
#pragma unroll
            for (int t2 = 0; t2 < 2; ++t2) { const int nt = 2 * w + t2; f32x4 acc = {0.f, 0.f, 0.f, 0.f};
#pragma unroll
                for (int ks = 0; ks < (b + 1) / 2; ++ks) { bf16x8 a = *(const LAS bf16x8*)(Mb + (16 * b + r16) * 72 + 32 * ks + 8 * q);
                    bf16x8 xb = *(const LAS bf16x8*)(Xt + (16 * nt + r16) * 72 + 32 * ks + 8 * q);
                    if (32 * ks + 8 * q >= 16 * b) { a = (bf16x8){0, 0, 0, 0, 0, 0, 0, 0}; xb = a; }
                    acc = MFMA16(a, xb, acc); }
#pragma unroll
                for (int r = 0; r < 4; ++r) Rr[(16 * b + 4 * q + r) * 256 + 16 * nt + r16] -= acc[r]; }
            LDS_BARRIER();
        }
        if (tid < 256) { float x[16];
#pragma unroll
            for (int ii = 0; ii < 16; ++ii) { float s = Rr[(16 * b + ii) * 256 + tid];
#pragma unroll
                for (int j4 = 0; j4 < (ii + 3) / 4; ++j4) { const f32x4 m4 = *(const LAS f32x4*)(Mm + (16 * b + ii) * 68 + 16 * b + 4 * j4);
#pragma unroll
                    for (int jj = 0; jj < 4; ++jj) if (4 * j4 + jj < ii) s -= m4[jj] * x[4 * j4 + jj]; }
                x[ii] = s; }
            u32x4 o0, o1; o0.x = pk2(x[0], x[1]); o0.y = pk2(x[2], x[3]); o0.z = pk2(x[4], x[5]); o0.w = pk2(x[6], x[7]); o1.x = pk2(x[8], x[9]); o1.y = pk2(x[10], x[11]); o1.z = pk2(x[12], x[13]); o1.w = pk2(x[14], x[15]);
            *(LAS u32x4*)(Xt + tid * 72 + 16 * b) = o0; *(LAS u32x4*)(Xt + tid * 72 + 16 * b + 8) = o1; }
        LDS_BARRIER();
    }
    { const int e = tid >> 2, part = tid & 3; const u32x4 a0 = *(const LAS u32x4*)(Xt + e * 72 + 16 * part), a1 = *(const LAS u32x4*)(Xt + e * 72 + 16 * part + 8);
      bf16_t* up = blk + 8192 + (((e >> 4) * 4 + part) * 64 + (e & 15)) * 4;
      *(u32x2*)(up) = (u32x2){a0[0], a0[1]}; *(u32x2*)(up + 64) = (u32x2){a0[2], a0[3]}; *(u32x2*)(up + 128) = (u32x2){a1[0], a1[1]}; *(u32x2*)(up + 192) = (u32x2){a1[2], a1[3]}; }
#pragma unroll
    for (int k = 0; k < 2; ++k) { const int idx = tid + 512 * k, row = idx >> 4, d8 = idx & 15; u32x4 o;
#pragma unroll
        for (int j = 0; j < 4; ++j) { const unsigned lo = Xt[(128 + 8 * d8 + 2 * j) * 72 + row], hi = Xt[(128 + 8 * d8 + 2 * j + 1) * 72 + row]; o[j] = lo | (hi << 16); }
        *(u32x4*)(blk + fragoff(row, d8, 4)) = o; }
    LDS_BARRIER();
}

__device__ __forceinline__ void gdn_seq_unit(Frame& F, int u) {
    const int tid = opaque_tid(), lane = tid & 63, w = F.wave, r16 = lane & 15, q = lane >> 4;
    const int h = u >> 3, e0 = (u & 7) * 16, mt = w & 3; const bool lo = w < 4;
    LAS bf16_t* St = (LAS bf16_t*)(F.lds); LAS bf16_t* Vt = (LAS bf16_t*)(F.lds + 16 * LDP * 2);
    unsigned char* tm = F.ws + WS_TMP; bf16_t* O = (bf16_t*)(tm + TM_VG);
    const bf16_t* blk0 = (const bf16_t*)(tm + TM_KG) + (size_t)h * GDN_BLK;
    const float* glp = (const float*)(tm + TM_SM) + h + (lane & 0);
    const int p0off = lo ? 0 : 16384;
#define GDN_LOADF(S, c) do { const int cc = (c) < T / 64 ? (c) : T / 64 - 1; const bf16_t* bk = blk0 + (size_t)cc * 8 * GDN_BLK + lane * 8;        \
        _Pragma("unroll") for (int kk = 0; kk < 4; ++kk) { const bf16_t* p = bk + p0off + (mt * 4 + kk) * 512; asm volatile("global_load_dwordx4 %0, %1, off" : "=v"(fr[S][kk]) : "v"(p) : "memory"); } \
        _Pragma("unroll") for (int kk = 0; kk < 2; ++kk) { const bf16_t* p = bk + 28672 + (w * 2 + kk) * 512; asm volatile("global_load_dwordx4 %0, %1, off" : "=v"(fr[S][4 + kk]) : "v"(p) : "memory"); } \
        _Pragma("unroll") for (int kk = 0; kk < 2; ++kk) { const bf16_t* p = (lo || (kk == 1 && mt < 2)) ? bk + 28672 + (w * 2) * 512 : bk + 24576 + (mt * 2 + kk) * 512;        \
            asm volatile("global_load_dwordx4 %0, %1, off" : "=v"(fr[S][6 + kk]) : "v"(p) : "memory"); } \
        { const bf16_t* p = lo ? blk0 + (size_t)cc * 8 * GDN_BLK + 8192 + (((u & 7) * 4 + mt) * 64 + lane) * 4 : bk + 28672 + (w * 2) * 512; asm volatile("global_load_dwordx2 %0, %1, off" : "=v"(uu[S]) : "v"(p) : "memory"); } \
        { const float* p = glp + cc * 8; asm volatile("global_load_dword %0, %1, off" : "=v"(gg[S]) : "v"(p) : "memory"); } } while (0)
#define GDN_WAIT(S) do { asm volatile("s_waitcnt vmcnt(30)" : "+v"(fr[S][0]), "+v"(fr[S][1]), "+v"(fr[S][2]), "+v"(fr[S][3]), "+v"(fr[S][4]), "+v"(fr[S][5]), "+v"(fr[S][6]), "+v"(fr[S][7]), "+v"(uu[S]), "+v"(gg[S]) :: "memory"); \
        __builtin_amdgcn_sched_barrier(0); } while (0)
    for (int i = tid; i < 16 * LDP; i += 512) St[i] = 0;
    bf16x8 fr[4][8]; u32x2 uu[4]; float gg[4];
    GDN_LOADF(0, 0); GDN_LOADF(1, 1); GDN_LOADF(2, 2);
    f32x4 S = {0.f, 0.f, 0.f, 0.f};
    LDS_BARRIER();
#define GDN_CHUNK(c, CS, LS) do { \
        GDN_LOADF(LS, (c) + 3); \
        const bf16x8 bs0 = ldsfrag(St, LDP, r16, 0, q), bs1 = ldsfrag(St, LDP, r16, 1, q), bs2 = ldsfrag(St, LDP, r16, 2, q), bs3 = ldsfrag(St, LDP, r16, 3, q);     \
        GDN_WAIT(CS); \
        f32x4 a0 = {0.f, 0.f, 0.f, 0.f}; \
        a0 = MFMA16(fr[CS][0], bs0, a0); a0 = MFMA16(fr[CS][1], bs1, a0); a0 = MFMA16(fr[CS][2], bs2, a0); a0 = MFMA16(fr[CS][3], bs3, a0); \
        if (lo) { u32x2 o; o.x = pk2(bf_lo(uu[CS].x) - a0[0], bf_hi(uu[CS].x) - a0[1]); o.y = pk2(bf_lo(uu[CS].y) - a0[2], bf_hi(uu[CS].y) - a0[3]); *(LAS u32x2*)(Vt + r16 * 72 + 16 * mt + 4 * q) = o; } \
        LDS_BARRIER(); \
        const bf16x8 bV0 = ldsfrag(Vt, 72, r16, 0, q), bV1 = ldsfrag(Vt, 72, r16, 1, q); \
        f32x4 sa = S * gg[CS]; sa = MFMA16(fr[CS][4], bV0, sa); sa = MFMA16(fr[CS][5], bV1, sa); S = sa; \
        { u32x2 o; o.x = pk2(S[0], S[1]); o.y = pk2(S[2], S[3]); *(LAS u32x2*)(St + r16 * LDP + 16 * w + 4 * q) = o; } \
        if (!lo) { a0 = MFMA16(fr[CS][6], bV0, a0); if (mt >= 2) a0 = MFMA16(fr[CS][7], bV1, a0);        \
            const unsigned p01 = pk2(a0[0], a0[1]), p23 = pk2(a0[2], a0[3]); bf16_t* op = O + (size_t)((c) * 64 + 16 * mt + 4 * q) * 1024 + h * 128 + e0 + r16; \
            op[0] = (bf16_t)(p01 & 0xffffu); op[1024] = (bf16_t)(p01 >> 16); op[2048] = (bf16_t)(p23 & 0xffffu); op[3072] = (bf16_t)(p23 >> 16); } \
        LDS_BARRIER(); } while (0)
    for (int c = 0; c < T / 64; c += 4) { GDN_CHUNK(c, 0, 3); GDN_CHUNK(c + 1, 1, 0); GDN_CHUNK(c + 2, 2, 1); GDN_CHUNK(c + 3, 3, 2); }
    asm volatile("s_waitcnt vmcnt(0)" ::: "memory");
#undef GDN_WAIT
#undef GDN_CHUNK
#undef GDN_LOADF
}

__device__ __forceinline__ void mixer_phase(Frame& F, int layer) {
    for (int u = F.vcu; u < 256; u += F.G) {
        if (u < 64) { gdn_seq_unit(F, u); if (MIXREP & 1) gdn_seq_unit(F, u); }
        else if (u < 128) { s5_unit(F, layer, u - 64); if (MIXREP & 2) s5_unit(F, layer, u - 64); }
        else if (u < 192) { ret_seq_unit(F, u - 128); if (MIXREP & 4) ret_seq_unit(F, u - 128); }
        else { ssd_seq_unit(F, u - 192); if (MIXREP & 8) ssd_seq_unit(F, u - 192); }
    }
}
__device__ __forceinline__ void pre_phase(Frame& F, int layer) {
    for (int u = F.vcu; u < 1280; u += F.G) {
        if (u < 1024) { gdn_pre_unit(F, layer, u >> 3, u & 7); if (MIXREP & 16) gdn_pre_unit(F, layer, u >> 3, u & 7); }
        else if (u < 1152) { ssd_pre_unit(F, layer, (u - 1024) >> 1, (u - 1024) & 1); if (MIXREP & 32) ssd_pre_unit(F, layer, (u - 1024) >> 1, (u - 1024) & 1); }
        else { const int ru = 2 * (u - 1152);
            ret_pre_unit(F, ru >> 2, ru & 3); ret_pre_unit(F, (ru + 1) >> 2, (ru + 1) & 3); if (MIXREP & 64) ret_pre_unit(F, ru >> 2, ru & 3); }
    }
}

__device__ __forceinline__ void post_phase(Frame& F, int layer) {
    const int gw = F.vcu * 8 + F.wave, NGW = F.G * 8, lane = opaque_tid() & 63;
    const bf16_t* proj = WSP(bf16_t, WS_PROJ); bf16_t* ycat = WSP(bf16_t, WS_YCAT);
    unsigned char* tm = F.ws + WS_TMP;
    const bf16_t* Or = (const bf16_t*)(tm + TM_VR); const bf16_t* Os = (const bf16_t*)(tm + TM_VS); const bf16_t* Og = (const bf16_t*)(tm + TM_VG);
    const float* gnw = FIN(6) + layer * 128; const bf16_t* XS = (const bf16_t*)(tm + TM_SXS);
    const float* sdk = FIN(21) + layer * 16; const float* snw = FIN(22) + layer * 1024;
    const bool deal = (F.G == 256); const int bx = blockIdx.x;
    const int tbeg = deal ? (bx < 128 ? (bx * 8 + F.wave) * 3 : 3072 + ((bx - 128) * 8 + F.wave) * 5) : gw;
    const int tcnt = deal ? (bx < 128 ? 3 : 5) : (T - gw + NGW - 1) / NGW, tstep = deal ? 1 : NGW;
#define UNPK8(dst, VV) do { dst[0] = bf_lo(VV[0]); dst[1] = bf_hi(VV[0]); dst[2] = bf_lo(VV[1]); dst[3] = bf_hi(VV[1]); dst[4] = bf_lo(VV[2]); dst[5] = bf_hi(VV[2]); dst[6] = bf_lo(VV[3]); dst[7] = bf_hi(VV[3]); } while (0)
#define PK8(VV, SRC) do { VV[0] = pk2(SRC[0], SRC[1]); VV[1] = pk2(SRC[2], SRC[3]); VV[2] = pk2(SRC[4], SRC[5]); VV[3] = pk2(SRC[6], SRC[7]); } while (0)
    for (int ti = 0; ti < tcnt; ++ti) { const int t = tbeg + ti * tstep;
        const bf16_t* pr = proj + (size_t)t * NPP; bf16_t* yo = ycat + (size_t)t * 4096;
        u32x4 wo[6], wg[6], wx[2];
#pragma unroll
        for (int s = 0; s < 2; ++s) { const int ch = 512 * s + 8 * lane;
            wo[s] = *(const u32x4*)(Or + (size_t)t * 1024 + ch); wg[s] = *(const u32x4*)(pr + C_RG + ch);
            wo[2 + s] = *(const u32x4*)(Og + (size_t)t * 1024 + ch); wg[2 + s] = *(const u32x4*)(pr + C_DZ + ch);
            wo[4 + s] = *(const u32x4*)(Os + (size_t)t * 1024 + ch); wg[4 + s] = *(const u32x4*)(pr + C_MZ + ch); wx[s] = *(const u32x4*)(XS + (size_t)t * 1024 + ch); }
        const f32x4 gn0 = *(const f32x4*)(gnw + 8 * (lane & 15)), gn1 = *(const f32x4*)(gnw + 8 * (lane & 15) + 4);
#pragma unroll
        for (int s = 0; s < 2; ++s) { const int ch = 512 * s + 8 * lane;
            { float y[8], gt[8]; UNPK8(y, wo[s]); UNPK8(gt, wg[s]);
              float sm = ((y[0] + y[1]) + (y[2] + y[3])) + ((y[4] + y[5]) + (y[6] + y[7])); sm = row_sum16(sm); sm += __shfl_xor(sm, 16);
              const float mu = sm * (1.f / 256.f); float s2 = 0.f;
#pragma unroll
              for (int i = 0; i < 8; ++i) { y[i] -= mu; s2 += y[i] * y[i]; }
              s2 = row_sum16(s2); s2 += __shfl_xor(s2, 16);
              const float rs = rsqrtf(s2 * (1.f / 256.f) + LN_EPS);
#pragma unroll
              for (int i = 0; i < 8; ++i) y[i] = y[i] * rs * siluf_(gt[i]);
              u32x4 ow; PK8(ow, y); *(u32x4*)(yo + ch) = ow; }
            { float y[8], gt[8]; UNPK8(y, wo[2 + s]); UNPK8(gt, wg[2 + s]);
              float s2 = 0.f;
#pragma unroll
              for (int i = 0; i < 8; ++i) s2 += y[i] * y[i];
              s2 = row_sum16(s2);
              const float rs = rsqrtf(s2 * (1.f / 128.f) + RMS_EPS);
#pragma unroll
              for (int i = 0; i < 8; ++i) y[i] = y[i] * rs * (i < 4 ? gn0[i] : gn1[i - 4]) * siluf_(gt[i]);
              u32x4 ow; PK8(ow, y); *(u32x4*)(yo + 1024 + ch) = ow; }
            { float y[8], gt[8], xh[8]; UNPK8(y, wo[4 + s]); UNPK8(gt, wg[4 + s]); UNPK8(xh, wx[s]);
              const float d = sdk[8 * s + (lane >> 3)]; float s2 = 0.f;
#pragma unroll
              for (int i = 0; i < 8; ++i) { y[i] = (y[i] + d * xh[i]) * siluf_(gt[i]); s2 += y[i] * y[i]; }
              s2 = wave_sum(s2);
              const float rs = rsqrtf(s2 * (1.f / 512.f) + RMS_EPS);
              const f32x4 n0 = *(const f32x4*)(snw + ch), n1 = *(const f32x4*)(snw + ch + 4);
#pragma unroll
              for (int i = 0; i < 8; ++i) y[i] = y[i] * rs * (i < 4 ? n0[i] : n1[i - 4]);
              u32x4 ow; PK8(ow, y); *(u32x4*)(yo + 3072 + ch) = ow; } }
    }
#undef UNPK8
#undef PK8
}

__device__ __forceinline__ void ln_phase(Frame& F, const bf16_t* in, const float* res, const float* gam, const float* bet, float* outf, bf16_t* outb) {
    const int gw = F.vcu * 8 + F.wave, NGW = F.G * 8, lane = opaque_tid() & 63;
    for (int t = gw; t < T; t += NGW) {
        const u32x2* xr = (const u32x2*)(in + (size_t)t * DM) + lane; const f32x4* rr = (const f32x4*)(res + (size_t)t * DM) + lane;
        f32x4 v[8]; float s = 0.f;
#pragma unroll
        for (int j = 0; j < 8; ++j) { const u32x2 pw = xr[64 * j]; v[j] = (f32x4){bf_lo(pw.x), bf_hi(pw.x), bf_lo(pw.y), bf_hi(pw.y)} + rr[64 * j] * ALPHA; s += (v[j][0] + v[j][1]) + (v[j][2] + v[j][3]); }
        const float mean = wave_sum(s) * (1.f / DM); float s2 = 0.f;
#pragma unroll
        for (int j = 0; j < 8; ++j) { v[j] = v[j] - mean; s2 += (v[j][0] * v[j][0] + v[j][1] * v[j][1]) + (v[j][2] * v[j][2] + v[j][3] * v[j][3]); }
        const float rstd = rsqrtf(wave_sum(s2) * (1.f / DM) + LN_EPS);
#pragma unroll
        for (int j = 0; j < 8; ++j) { const f32x4 gm = *((const f32x4*)gam + lane + 64 * j), bt = *((const f32x4*)bet + lane + 64 * j);
            const f32x4 o = v[j] * rstd * gm + bt;
            *((f32x4*)(outf + (size_t)t * DM) + lane + 64 * j) = o;
            u32x2 w; w.x = pk2(o[0], o[1]); w.y = pk2(o[2], o[3]); *((u32x2*)(outb + (size_t)t * DM) + lane + 64 * j) = w; }
    }
}

constexpr int N_PHASES = 1 + 10 * NLAYER;
__global__ void __launch_bounds__(512, 2) mega(Args args) {
    extern __shared__ __attribute__((aligned(16))) unsigned char lds_raw[];
    Frame F;
    F.lds = (LAS unsigned char*)lds_raw;
    F.tid = threadIdx.x; F.lane = F.tid & 63; F.wave = __builtin_amdgcn_readfirstlane(F.tid >> 6);
    F.G = gridDim.x; { const int bx = blockIdx.x; F.vcu = (F.G % 8 == 0) ? (bx % 8) * (F.G / 8) + bx / 8 : bx; }
    F.in = args.in; F.ws = args.ws; F.out = args.out;
    for (int u = F.tid; u < (LDS_BYTES - LDSCTL_OFF) / 4; u += 512) ((LAS unsigned*)(F.lds + LDSCTL_OFF))[u] = 0u;
    __syncthreads();
    const int lo = args.ph_lo, hi = args.ph_hi;
    unsigned* barw = (unsigned*)(args.ws + WS_CTL) + CW_BAR + args.li * XCD_BAR_WORDS;
    XcdBarrier bar; bar.bar = barw; bar.x = 0; bar.st = nullptr;
    if (hi - lo > 1) bar = xcd_barrier_post(barw, (volatile LAS unsigned*)(F.lds + MISC_OFF) + 8);
#define IN(k) (lo <= (k) && (k) < hi)
#define SEAM(k) do { if ((k) + 1 < hi) xcd_barrier(bar); } while (0)

    if (IN(0)) { p0_prologue(F); if (REPMASK & 1) { xcd_barrier(bar); p0_prologue(F); } SEAM(0); }

    for (int layer = 0; layer < NLAYER; ++layer) {
        const int pb = 1 + 10 * layer;
        unsigned char* wt = F.ws + WS_WT + (size_t)layer * WT_LAYER;
        const float* xcur = layer == 0 ? FIN(0) : WSP(float, WS_XR0);
#define B_INPROJ do { pg8::Gemm g{WSP(bf16_t, WS_XB), (const bf16_t*)(wt + WT_IN), T, NP_MAIN, DM, DM, DM, 0, 0}; pg8::StaticOrder S; S.init(T, NP_MAIN, F.G, (int)blockIdx.x); \
            pg8::EpiProj E{WSP(bf16_t, WS_PROJ), WSP(float, WS_SMALL), 0}; pg8::gemm_phase<pg8::EpiProj, pg8::StaticOrder, true, true>(F.lds, g, S, E); } while (0)
#define B_INPROJ_DEFER do { pg8::Gemm g{WSP(bf16_t, WS_XB), (const bf16_t*)(wt + WT_IN) + (size_t)NP_MAIN * DM, T, NPP - NP_MAIN, DM, DM, DM, 0, 0}; pg8::DeferOrder S; S.init(T, NPP - NP_MAIN, F.G, (F.vcu + F.G - 128 % F.G) % F.G); \
            pg8::EpiProj E{WSP(bf16_t, WS_PROJ) + NP_MAIN, WSP(float, WS_SMALL), NP_MAIN}; pg8::gemm_phase<pg8::EpiProj, pg8::DeferOrder, true, true>(F.lds, g, S, E); } while (0)
#define B_PREP pre_phase(F, layer)
#define B_MIX do { B_INPROJ_DEFER; if (MIXREP & 128) B_INPROJ_DEFER; mixer_phase(F, layer); } while (0)
#define B_GLUPOST do { pg8::Gemm g{WSP(bf16_t, WS_YS5), (const bf16_t*)(wt + WT_GLU), T, 1024, 1024, 1024, 1024, 0, 0}; pg8::StaticOrder S; S.init(T, 1024, F.G, (int)blockIdx.x); \
            pg8::EpiGlu E{WSP(bf16_t, WS_YS5), FIN(16) + layer * 1024, WSP(bf16_t, WS_YCAT)}; pg8::gemm_phase<pg8::EpiGlu, pg8::StaticOrder, true, true>(F.lds, g, S, E); post_phase(F, layer); } while (0)
#define B_MERGE do { pg8::Gemm g{WSP(bf16_t, WS_YCAT), (const bf16_t*)(wt + WT_BR), T, DM, 1024, 4096, 1024, 2048, 4 * MiB}; pg8::SegOrder<4> S; S.init(T, DM, F.G, (int)blockIdx.x); \
            pg8::EpiMerge E{WSP(bf16_t, WS_PROJ), (bf16_t*)(F.ws + WS_TMP + TM_MERGED)}; pg8::gemm_phase<pg8::EpiMerge, pg8::SegOrder<4>, true, true>(F.lds, g, S, E); } while (0)
#define B_WOUT do { pg8::Gemm g{(const bf16_t*)(F.ws + WS_TMP + TM_MERGED), (const bf16_t*)(wt + WT_OUT), T, DM, DM, DM, DM, 0, 0}; pg8::StaticOrder S; S.init(T, DM, F.G, (int)blockIdx.x); \
            pg8::EpiResid E{(bf16_t*)(F.ws + WS_TMP + TM_PRE)}; pg8::gemm_phase<pg8::EpiResid, pg8::StaticOrder, true, true>(F.lds, g, S, E); } while (0)
#define B_LN1 ln_phase(F, (const bf16_t*)(F.ws + WS_TMP + TM_PRE), xcur, FIN(28) + layer * DM, FIN(29) + layer * DM, WSP(float, WS_XR1), WSP(bf16_t, WS_XB))
#define B_UP do { pg8::Gemm g{WSP(bf16_t, WS_XB), (const bf16_t*)(wt + WT_UP), T, DFF, DM, DM, DM, 0, 0}; pg8::StaticOrder S; S.init(T, DFF, F.G, (int)blockIdx.x); \
            pg8::EpiRelu2 E{WSP(bf16_t, WS_HID)}; pg8::gemm_phase<pg8::EpiRelu2, pg8::StaticOrder, true, true>(F.lds, g, S, E); } while (0)
#define B_DOWN do { pg8::Gemm g{WSP(bf16_t, WS_HID), (const bf16_t*)(wt + WT_DOWN), T, DM, DFF, DFF, DFF, 0, 0}; pg8::StaticOrder S; S.init(T, DM, F.G, (int)blockIdx.x); \
            pg8::EpiResid E{(bf16_t*)(F.ws + WS_TMP + TM_PRE)}; pg8::gemm_phase<pg8::EpiResid, pg8::StaticOrder, true, true>(F.lds, g, S, E); } while (0)
#define B_LN2 ln_phase(F, (const bf16_t*)(F.ws + WS_TMP + TM_PRE), WSP(float, WS_XR1), FIN(32) + layer * DM, FIN(33) + layer * DM, layer == NLAYER - 1 ? F.out : WSP(float, WS_XR0), WSP(bf16_t, WS_XB))
#define PH(k, body) do { if (IN(pb + (k))) { body; if ((REPMASK >> ((k) + 1)) & 1) { xcd_barrier(bar); body; } SEAM(pb + (k)); } } while (0)
        PH(0, B_INPROJ);
        PH(1, B_PREP);
        if (IN(pb + 2)) { B_MIX; if ((REPMASK >> 3) & 1) { xcd_barrier(bar); B_PREP; xcd_barrier(bar); B_MIX; } SEAM(pb + 2); }
        PH(3, B_GLUPOST);
        PH(4, B_MERGE);
        PH(5, B_WOUT);
        PH(6, B_LN1);
        PH(7, B_UP);
        PH(8, B_DOWN);
        PH(9, B_LN2);
    }
#undef IN
#undef SEAM
}

extern "C" void kernel_launch(void* const* d_in, const int* in_sizes, int n_in, void* d_out, int out_size, void* d_ws, size_t ws_size, hipStream_t stream) {
    static int grid = 0;
    if (grid == 0) {
        if (n_in != 34 || out_size != T * DM || ws_size < WS_END) { fprintf(stderr, "kernel_launch: unexpected sizes (n_in %d, out %d, ws %zu need %zu)\n", n_in, out_size, ws_size, (size_t)WS_END); grid = -1; return; }
        int dev = 0, cus = 0, per_cu = 0;
        if (hipGetDevice(&dev) != hipSuccess || hipDeviceGetAttribute(&cus, hipDeviceAttributeMultiprocessorCount, dev) != hipSuccess) { grid = -1; return; }
        if (hipFuncSetAttribute((const void*)mega, hipFuncAttributeMaxDynamicSharedMemorySize, LDS_BYTES) != hipSuccess) { fprintf(stderr, "kernel_launch: hipFuncSetAttribute failed\n"); grid = -1; return; }
        if (hipOccupancyMaxActiveBlocksPerMultiprocessor(&per_cu, (const void*)mega, 512, LDS_BYTES) != hipSuccess || per_cu < 1) fprintf(stderr, "kernel_launch: occupancy query reports %d\n", per_cu);
        (void)hipGetLastError();
        grid = cus;
    }
    if (grid < 0) return;
    if (hipMemsetAsync((char*)d_ws + WS_CTL, 0, CTL_ZERO_BYTES, stream) != hipSuccess) return;
    Args a{};
    for (int i = 0; i < 34; ++i) a.in[i] = d_in[i];
    a.out = (float*)d_out; a.ws = (unsigned char*)d_ws;
#if MK_N_LAUNCHES == 1
    a.ph_lo = 0; a.ph_hi = N_PHASES; a.li = 0;
    hipLaunchKernelGGL(mega, dim3(grid), dim3(512), LDS_BYTES, stream, a);
#else
    for (int p = 0; p < N_PHASES; ++p) { a.ph_lo = p; a.ph_hi = p + 1; a.li = p; hipLaunchKernelGGL(mega, dim3(grid), dim3(512), LDS_BYTES, stream, a); }
#endif
}
```

```cpp
#include <hip/hip_runtime.h>
#include <cstdio>
#include <cstdint>

#ifndef MK_N_LAUNCHES
#define MK_N_LAUNCHES 1
#endif

#ifndef MIXREP
#define MIXREP 0
#endif
#ifndef REPMASK
#define REPMASK 0
#endif
#define LAS __attribute__((address_space(3)))
#define GAS __attribute__((address_space(1)))
typedef unsigned short bf16_t;
typedef short bf16x8 __attribute__((ext_vector_type(8)));
typedef float f32x4 __attribute__((ext_vector_type(4)));
typedef float f32x2 __attribute__((ext_vector_type(2)));
typedef unsigned u32x4 __attribute__((ext_vector_type(4)));
typedef unsigned u32x2 __attribute__((ext_vector_type(2)));

constexpr int T = 8192, DM = 2048, NPROJ = 18976, NPP = 19200, NP_MAIN = 18432, DFF = 8192, NLAYER = 2;
constexpr int C_RQ = 0, C_RK = 512, C_RV = 1024, C_RG = 2048, C_DQ = 3072, C_DK = 4096, C_DV = 5120, C_DZ = 6144, C_DA = 7168, C_DB = 7176,
              C_SU = 7184, C_MZ = 8208, C_MX = 9232, C_MB = 10256, C_MC = 10512, C_MDT = 10768, C_GATE = 10784;
constexpr float LN_EPS = 1e-5f, RMS_EPS = 1e-6f, ALPHA = 1.41421356237f;

constexpr size_t MiB = 1u << 20;
constexpr size_t WS_CTL = 0, CTL_ZERO_BYTES = 1 * MiB;
constexpr size_t WT_IN = 0, WT_GLU = 75 * MiB, WT_BR = 77 * MiB, WT_OUT = 93 * MiB, WT_UP = 101 * MiB, WT_DOWN = 133 * MiB, WT_LAYER = 165 * MiB;
constexpr size_t WS_WT = 1 * MiB;
constexpr size_t WS_PROJ = WS_WT + 2 * WT_LAYER;
constexpr size_t WS_HID = WS_PROJ;
constexpr size_t WS_SMALL = WS_PROJ + 300 * MiB;
constexpr size_t WS_TRIG = WS_SMALL + 1 * MiB;
constexpr size_t WS_S5P = WS_TRIG + 4 * MiB;
constexpr size_t WS_YCAT = WS_S5P + 2 * MiB;
constexpr size_t WS_YS5 = WS_YCAT + 64 * MiB;
constexpr size_t WS_XB = WS_YS5 + 16 * MiB;
constexpr size_t WS_XR0 = WS_XB + 32 * MiB;
constexpr size_t WS_XR1 = WS_XR0 + 64 * MiB;
constexpr size_t WS_TMP = WS_XR1 + 64 * MiB;
constexpr size_t TM_KR = 0, TM_VR = 32 * MiB,
                 TM_SCB = 64 * MiB, TM_SSL = 72 * MiB, TM_SXD = 104 * MiB, TM_SXS = 120 * MiB, TM_SAC = 136 * MiB, TM_VS = 138 * MiB,
                 TM_KG = 170 * MiB, TM_VG = 242 * MiB, TM_SM = 274 * MiB, TM_END = 278 * MiB;
constexpr size_t TM_MERGED = 0, TM_PRE = 32 * MiB;
constexpr size_t WS_END = WS_TMP + TM_END;
constexpr int CW_BAR = 4096;

constexpr int RING_BYTES = 131072, LDSCTL_OFF = 155648, MISC_OFF = LDSCTL_OFF + 320, LDS_BYTES = 163840;

__device__ __forceinline__ unsigned f2bf(float f) { return (unsigned)__builtin_bit_cast(unsigned short, (__bf16)f); }
__device__ __forceinline__ unsigned pk2(float lo, float hi) { typedef __bf16 bf2_t __attribute__((ext_vector_type(2))); const bf2_t v = {(__bf16)lo, (__bf16)hi}; return __builtin_bit_cast(unsigned, v); }
__device__ __forceinline__ float bf_lo(unsigned u) { return __builtin_bit_cast(float, u << 16); }
__device__ __forceinline__ float bf_hi(unsigned u) { return __builtin_bit_cast(float, u & 0xffff0000u); }
__device__ __forceinline__ float bf2f(bf16_t h) { return __builtin_bit_cast(float, (unsigned)h << 16); }
__device__ __forceinline__ float sigmoidf_(float x) { return 1.f / (1.f + __expf(-x)); }
__device__ __forceinline__ float siluf_(float x) { return x / (1.f + __expf(-x)); }
__device__ __forceinline__ float softplusf_(float x) { return x > 20.f ? x : log1pf(__expf(x)); }
template <int CTRL> __device__ __forceinline__ float dppf(float v) { return __builtin_bit_cast(float, __builtin_amdgcn_update_dpp(0, __builtin_bit_cast(int, v), CTRL, 0xF, 0xF, true)); }
__device__ __forceinline__ float row_sum16(float v) {
    v += dppf<0xB1>(v); v += dppf<0x4E>(v); v += dppf<0x141>(v); v += dppf<0x140>(v); return v;
}
__device__ __forceinline__ float wave_sum(float v) { v = row_sum16(v); v += __shfl_xor(v, 16); v += __shfl_xor(v, 32); return v; }
__device__ __forceinline__ void sincos_d(double x, double& s, double& c) {
    const double k = __builtin_rint(x * 0.63661977236758134308);
    double r = __builtin_fma(-k, 1.57079632679489655800e+00, x);
    r = __builtin_fma(-k, 6.12323399573676603587e-17, r);
    const double r2 = r * r;
    double sp = 1.58969099521155010221e-10;
    sp = __builtin_fma(sp, r2, -2.50507602534068634195e-08);
    sp = __builtin_fma(sp, r2, 2.75573137070700676789e-06);
    sp = __builtin_fma(sp, r2, -1.98412698298579493134e-04);
    sp = __builtin_fma(sp, r2, 8.33333333332248946124e-03);
    sp = __builtin_fma(sp, r2, -1.66666666666666324348e-01);
    const double sn = __builtin_fma(sp * r2, r, r);
    double cp = -1.13596475577881948265e-11;
    cp = __builtin_fma(cp, r2, 2.08757232129817482790e-09);
    cp = __builtin_fma(cp, r2, -2.75573143513906633035e-07);
    cp = __builtin_fma(cp, r2, 2.48015872894767294178e-05);
    cp = __builtin_fma(cp, r2, -1.38888888888741095749e-03);
    cp = __builtin_fma(cp, r2, 4.16666666666666019037e-02);
    const double cs = __builtin_fma(cp * r2, r2, __builtin_fma(-0.5, r2, 1.0));
    const long q = (long)k & 3;
    s = (q == 0) ? sn : (q == 1) ? cs : (q == 2) ? -sn : -cs;
    c = (q == 0) ? cs : (q == 1) ? -sn : (q == 2) ? -cs : sn;
}

namespace pg8 {
constexpr int BM = 256, BK = 64, HALF = 128, HTB = HALF * BK * 2, STAGE_BYTES = 8 * HTB, NXCD = 8, WGM = 8;
__host__ __device__ __forceinline__ int lds_byte(int r, int c) { const int st = (r >> 4) * 2 + (c >> 5), rr = r & 15, cc = c & 31, ob = rr * 64 + cc * 2; return st * 1024 + (ob ^ (((ob >> 9) & 1) << 5)); }
__host__ __device__ __forceinline__ void stage_rc(int b, int& R, int& C) { const int st = b / 1024, sb = b % 1024, swz = sb ^ (((sb >> 9) & 1) << 5); R = (st >> 1) * 16 + swz / 64; C = (st & 1) * 32 + (swz % 64) / 2; }
__host__ __device__ __forceinline__ int perm32(int rho) { const int n = rho >> 4, i = rho & 15; return 8 * (i >> 2) + 4 * n + (i & 3); }

struct Unit { int pm, pn, seg; };
struct Gemm { const bf16_t* A; const bf16_t* Bt; int M, N, K, lda, ldb; size_t segA, segB; };

__host__ __device__ __forceinline__ void tile_of(long L, int nM, int nN, int& pm, int& pn) {
    const int nwg = nM * nN; int wgid = (int)L;
    { const int q = nwg / NXCD, r = nwg % NXCD, xcd = wgid % NXCD, off = wgid / NXCD; wgid = (xcd < r ? xcd * (q + 1) : r * (q + 1) + (xcd - r) * q) + off; }
    const int nig = WGM * nN, gid = wgid / nig, fm = gid * WGM, gsz = (nM - fm) < WGM ? (nM - fm) : WGM;
    pm = fm + ((wgid % nig) % gsz); pn = (wgid % nig) / gsz;
}
struct StaticOrder {
    int nM, nN, nwg, G, c;
    __host__ __device__ void init(int M, int N, int G_, int c_) { nM = M / BM; nN = N / BM; nwg = nM * nN; G = G_; c = c_; }
    __host__ __device__ bool next(int i, Unit& u) const {
        const long L = (long)i * G + c; if (L >= nwg) return false;
        tile_of(L, nM, nN, u.pm, u.pn); u.seg = 0; return true;
    }
    __device__ __forceinline__ void a_ready(const Unit&) const {}
    __device__ __forceinline__ void done(const Unit&) const {}
};
template <int NSEG> struct SegOrder {
    int nM, nN, nwg, G, c;
    __host__ __device__ void init(int M, int N, int G_, int c_) { nM = M / BM; nN = N / BM; nwg = nM * nN; G = G_; c = c_; }
    __host__ __device__ bool next(int i, Unit& u) const {
        const long L = (long)(i / NSEG) * G + c; if (L >= nwg) return false;
        tile_of(L, nM, nN, u.pm, u.pn); u.seg = i % NSEG; return true;
    }
    __device__ __forceinline__ void a_ready(const Unit&) const {}
    __device__ __forceinline__ void done(const Unit&) const {}
};

struct DeferOrder {
    int nM, nunits, G, c;
    __host__ __device__ void init(int M, int N, int G_, int c_) { nM = M / BM; nunits = nM * (N / BM); G = G_; c = c_; }
    __host__ __device__ bool next(int i, Unit& u) const { const long L = (long)i * G + c; if (L >= nunits) return false; u.pm = (int)(L % nM); u.pn = (int)(L / nM); u.seg = 0; return true; }
    __device__ __forceinline__ void a_ready(const Unit&) const {}
    __device__ __forceinline__ void done(const Unit&) const {}
};
__device__ __forceinline__ unsigned cvt_pk_bf16(float lo, float hi) { unsigned r; asm volatile("v_cvt_pk_bf16_f32 %0, %1, %2" : "=v"(r) : "v"(lo), "v"(hi)); return r; }


template <class Epi, class Sched, bool ALIGN_EPI = false, bool SP2 = false>
__device__ __forceinline__ void gemm_phase(LAS unsigned char* lds, const Gemm g, const Sched& S, const Epi& E) {
    int tid = threadIdx.x; asm volatile("" : "+v"(tid));
    const int wid = __builtin_amdgcn_readfirstlane(tid >> 6), lane = tid & 63, wr = wid >> 2, wc = wid & 3, fr = lane & 15, fq = lane >> 4;
    const int K = g.K, nt = K / BK;
    unsigned voffA[2], voffB[2];
#pragma unroll
    for (int i = 0; i < 2; ++i) { int R, C; stage_rc(tid * 16 + i * 8192, R, C); const int Rb = Epi::PERM ? ((R & ~31) + perm32(R & 31)) : R;
        voffA[i] = (unsigned)(R * g.lda + C) * 2u; voffB[i] = (unsigned)(Rb * g.ldb + C) * 2u; }
    const size_t kstep = (size_t)(BK * 2);
    const size_t hstepA = (size_t)HALF * g.lda * 2, hstepB = (size_t)HALF * g.ldb * 2;
    const size_t tstepA = 2 * hstepA, tstepB = 2 * hstepB;
    const unsigned ldsw = (unsigned)wid * 1024u;
    const int aoff = lds_byte(wr * 64 + fr, fq * 8), boff = lds_byte(wc * 32 + fr, fq * 8);
#define PG8_SA(b, h) (((b) * 2 + (h)) * HTB)
#define PG8_SB(b, h) ((4 + (b) * 2 + (h)) * HTB)
#define PG8_STAGE(bufoff, gbase, voff) do { _Pragma("unroll") for (int _i = 0; _i < 2; ++_i) \
        __builtin_amdgcn_global_load_lds((const unsigned*)((const char*)(gbase) + (voff)[_i]), (LAS unsigned*)(lds + (bufoff) + ldsw + _i * 8192), 16, 0, 0); } while (0)
#define PG8_LDA(dst, b, h) do { _Pragma("unroll") for (int m = 0; m < 4; ++m) _Pragma("unroll") for (int k = 0; k < 2; ++k) dst[m][k] = *(const LAS bf16x8*)(lds + PG8_SA(b, h) + aoff + m * 2048 + k * 1024); } while (0)
#define PG8_LDB(dst, b, h) do { _Pragma("unroll") for (int n = 0; n < 2; ++n) _Pragma("unroll") for (int k = 0; k < 2; ++k) dst[n][k] = *(const LAS bf16x8*)(lds + PG8_SB(b, h) + boff + n * 2048 + k * 1024); } while (0)
#define PG8_MMA(ai, bj, At, Bt) do { __builtin_amdgcn_s_setprio(1); _Pragma("unroll") for (int m = 0; m < 4; ++m) _Pragma("unroll") for (int n = 0; n < 2; ++n) _Pragma("unroll") for (int k = 0; k < 2; ++k) \
        acc[ai][bj][m][n] = __builtin_amdgcn_mfma_f32_16x16x32_bf16(Bt[n][k], At[m][k], acc[ai][bj][m][n], 0, 0, 0); __builtin_amdgcn_s_setprio(0); } while (0)
#define PG8_WAIT_V(n) asm volatile("s_waitcnt vmcnt(" #n ")" ::: "memory")
#define PG8_WAIT_L(n) asm volatile("s_waitcnt lgkmcnt(" #n ")" ::: "memory")
#define PG8_BAR __builtin_amdgcn_s_barrier()
#define PG8_SCHED __builtin_amdgcn_sched_barrier(0)
    Unit cur, nxt; int ui = 0;
    if (!S.next(0, cur)) return;
    f32x4 acc[2][2][4][2];
#pragma unroll
    for (int a = 0; a < 2; ++a)
#pragma unroll
        for (int b = 0; b < 2; ++b)
#pragma unroll
            for (int m = 0; m < 4; ++m)
#pragma unroll
                for (int n = 0; n < 2; ++n) acc[a][b][m][n] = (f32x4){0.f, 0.f, 0.f, 0.f};
    bf16x8 At[4][2], B0[2][2], B1[2][2];
    const char* cA = (const char*)g.A + (size_t)cur.seg * g.segA + (size_t)cur.pm * tstepA; const char* cB = (const char*)g.Bt + (size_t)cur.seg * g.segB + (size_t)cur.pn * tstepB;
    S.a_ready(cur);
    if constexpr (SP2) {
        PG8_STAGE(PG8_SB(0, 0), cB, voffB); PG8_STAGE(PG8_SB(0, 1), cB + hstepB, voffB); PG8_STAGE(PG8_SA(0, 0), cA, voffA); PG8_STAGE(PG8_SA(0, 1), cA + hstepA, voffA);
        if (wr == 1) PG8_BAR;
        PG8_WAIT_V(2); PG8_BAR;
        PG8_STAGE(PG8_SB(1, 0), cB + kstep, voffB); PG8_STAGE(PG8_SA(1, 0), cA + kstep, voffA); PG8_STAGE(PG8_SB(1, 1), cB + hstepB + kstep, voffB);
        PG8_WAIT_V(6); PG8_BAR;
    } else {
        PG8_STAGE(PG8_SB(0, 0), cB, voffB); PG8_STAGE(PG8_SA(0, 0), cA, voffA); PG8_STAGE(PG8_SB(0, 1), cB + hstepB, voffB); PG8_STAGE(PG8_SA(0, 1), cA + hstepA, voffA);
        if (wr == 1) PG8_BAR;
        PG8_WAIT_V(4); PG8_BAR;
        PG8_STAGE(PG8_SB(1, 0), cB + kstep, voffB); PG8_STAGE(PG8_SA(1, 0), cA + kstep, voffA); PG8_STAGE(PG8_SB(1, 1), cB + hstepB + kstep, voffB);
        PG8_WAIT_V(6); PG8_BAR;
    }
    for (;;) {
        const bool has_next = S.next(ui + 1, nxt);
        const char* nA = has_next ? (const char*)g.A + (size_t)nxt.seg * g.segA + (size_t)nxt.pm * tstepA : cA;
        const char* nB = has_next ? (const char*)g.Bt + (size_t)nxt.seg * g.segB + (size_t)nxt.pn * tstepB : cB;
        for (int t = 0; t < nt; t += 2) {
            const bool last = (t == nt - 2);
            const char* a1 = cA + (size_t)(t + 1) * kstep;
            const char* a2 = last ? nA : cA + (size_t)(t + 2) * kstep; const char* b2 = last ? nB : cB + (size_t)(t + 2) * kstep;
            const char* a3 = a2 + kstep; const char* b3 = b2 + kstep;
            if (last && has_next) S.a_ready(nxt);
            if constexpr (SP2) {
            PG8_LDB(B0, 0, 0); PG8_LDB(B1, 0, 1); PG8_SCHED; PG8_LDA(At, 0, 0); PG8_STAGE(PG8_SA(1, 1), a1 + hstepA, voffA);
            PG8_WAIT_V(8); PG8_WAIT_L(0); PG8_BAR; PG8_MMA(0, 0, At, B0); PG8_MMA(0, 1, At, B1); PG8_BAR; PG8_SCHED;
            PG8_LDA(At, 0, 1); PG8_STAGE(PG8_SB(0, 0), b2, voffB); PG8_STAGE(PG8_SB(0, 1), b2 + hstepB, voffB); PG8_STAGE(PG8_SA(0, 0), a2, voffA);
            PG8_WAIT_V(8); PG8_WAIT_L(0); PG8_BAR; PG8_MMA(1, 0, At, B0); PG8_MMA(1, 1, At, B1); PG8_BAR; PG8_SCHED;
            PG8_LDB(B0, 1, 0); PG8_LDB(B1, 1, 1); PG8_SCHED; PG8_LDA(At, 1, 0); PG8_STAGE(PG8_SA(0, 1), a2 + hstepA, voffA);
            PG8_WAIT_V(8); PG8_WAIT_L(0); PG8_BAR; PG8_MMA(0, 0, At, B0); PG8_MMA(0, 1, At, B1); PG8_BAR; PG8_SCHED;
            PG8_LDA(At, 1, 1); PG8_STAGE(PG8_SB(1, 0), b3, voffB); PG8_STAGE(PG8_SB(1, 1), b3 + hstepB, voffB); PG8_STAGE(PG8_SA(1, 0), a3, voffA);
            PG8_WAIT_V(8); PG8_WAIT_L(0); PG8_BAR; PG8_MMA(1, 0, At, B0); PG8_MMA(1, 1, At, B1); PG8_BAR; PG8_SCHED;
            } else {
            PG8_LDB(B0, 0, 0); PG8_SCHED; PG8_LDA(At, 0, 0); PG8_STAGE(PG8_SA(1, 1), a1 + hstepA, voffA);
            PG8_WAIT_L(8); PG8_BAR; PG8_WAIT_L(0); PG8_MMA(0, 0, At, B0); PG8_BAR; PG8_SCHED;
            PG8_LDB(B1, 0, 1); PG8_STAGE(PG8_SB(0, 0), b2, voffB);
            PG8_BAR; PG8_WAIT_L(0); PG8_MMA(0, 1, At, B1); PG8_BAR;
            PG8_LDA(At, 0, 1); PG8_STAGE(PG8_SA(0, 0), a2, voffA);
            PG8_BAR; PG8_WAIT_L(0); PG8_MMA(1, 0, At, B0); PG8_BAR; PG8_SCHED;
            PG8_STAGE(PG8_SB(0, 1), b2 + hstepB, voffB);
            PG8_WAIT_V(6); PG8_BAR; PG8_MMA(1, 1, At, B1); PG8_BAR;
            PG8_LDB(B0, 1, 0); PG8_SCHED; PG8_LDA(At, 1, 0); PG8_STAGE(PG8_SA(0, 1), a2 + hstepA, voffA);
            PG8_WAIT_L(8); PG8_BAR; PG8_WAIT_L(0); PG8_MMA(0, 0, At, B0); PG8_BAR; PG8_SCHED;
            PG8_LDB(B1, 1, 1); PG8_STAGE(PG8_SB(1, 0), b3, voffB);
            PG8_BAR; PG8_WAIT_L(0); PG8_MMA(0, 1, At, B1); PG8_BAR;
            PG8_LDA(At, 1, 1); PG8_STAGE(PG8_SA(1, 0), a3, voffA);
            PG8_BAR; PG8_WAIT_L(0); PG8_MMA(1, 0, At, B0); PG8_BAR; PG8_SCHED;
            PG8_STAGE(PG8_SB(1, 1), b3 + hstepB, voffB);
            PG8_WAIT_V(6); PG8_BAR; PG8_MMA(1, 1, At, B1); PG8_BAR;
            }
        }
        if constexpr (ALIGN_EPI) { if (wr == 0) PG8_BAR; }
        { int tz = threadIdx.x; asm volatile("" : "+v"(tz));
          const int l2 = tz & 63; E(acc, cur, wr, wc, l2 & 15, l2 >> 4, tz); }
        S.done(cur);
        if (!has_next) break;
        if (!Epi::keep_acc(cur))
#pragma unroll
        for (int a = 0; a < 2; ++a)
#pragma unroll
            for (int b = 0; b < 2; ++b)
#pragma unroll
                for (int m = 0; m < 4; ++m)
#pragma unroll
                    for (int n = 0; n < 2; ++n) acc[a][b][m][n] = (f32x4){0.f, 0.f, 0.f, 0.f};
        cur = nxt; cA = nA; cB = nB; ++ui;
        if constexpr (ALIGN_EPI) { if (wr == 1) PG8_BAR; }
    }
    PG8_WAIT_V(0);
    if constexpr (!ALIGN_EPI) { if (wr == 0) PG8_BAR; }
    PG8_BAR;
#undef PG8_SA
#undef PG8_SB
#undef PG8_STAGE
#undef PG8_LDA
#undef PG8_LDB
#undef PG8_MMA
#undef PG8_WAIT_V
#undef PG8_WAIT_L
#undef PG8_BAR
#undef PG8_SCHED
}

struct EpiProj {
    static constexpr bool PERM = true; static __device__ __forceinline__ bool keep_acc(const Unit&) { return false; }
    bf16_t* O; float* small; int gate_from;
    __device__ __forceinline__ void operator()(const f32x4 (&acc)[2][2][4][2], const Unit& u, int wr, int wc, int fr, int fq, int tz) const {
        const int row0 = u.pm * BM + wr * 64 + fr, col0 = u.pn * BM + wc * 32 + 8 * fq;
#pragma unroll
        for (int ai = 0; ai < 2; ++ai)
#pragma unroll
            for (int m = 0; m < 4; ++m) { const int row = row0 + ai * HALF + m * 16; bf16_t* rowp = O + (size_t)row * NPP + col0;
#pragma unroll
                for (int bj = 0; bj < 2; ++bj) { f32x4 v0 = acc[ai][bj][m][0], v1 = acc[ai][bj][m][1];
                    const int col = col0 + bj * HALF;
                    if (col + gate_from >= C_GATE) {
#pragma unroll
                        for (int j = 0; j < 4; ++j) { v0[j] = fmaxf(sigmoidf_(v0[j]), 1e-30f); v1[j] = fmaxf(sigmoidf_(v1[j]), 1e-30f); } }
                    u32x4 w; w.x = cvt_pk_bf16(v0[0], v0[1]); w.y = cvt_pk_bf16(v0[2], v0[3]); w.z = cvt_pk_bf16(v1[0], v1[1]); w.w = cvt_pk_bf16(v1[2], v1[3]);
                    *(u32x4*)(rowp + bj * HALF) = w;
                    v0 = acc[ai][bj][m][0]; v1 = acc[ai][bj][m][1];
                    int si = -1; if (col == C_DA) si = 0; else if (col == C_DB) si = 8; else if (col == C_MDT) si = 16; else if (col == C_MDT + 8) si = 24;
                    if (si >= 0) { float* sp = small + (size_t)row * 32 + si; *(f32x4*)sp = v0; *(f32x4*)(sp + 4) = v1; } } }
    }
};
struct EpiGlu {
    static constexpr bool PERM = true; static __device__ __forceinline__ bool keep_acc(const Unit&) { return false; }
    const bf16_t* Y; const float* bias; bf16_t* O;
    __device__ __forceinline__ void operator()(const f32x4 (&acc)[2][2][4][2], const Unit& u, int wr, int wc, int fr, int fq, int tz) const {
        const int row0 = u.pm * BM + wr * 64 + fr, col0 = u.pn * BM + wc * 32 + 8 * fq;
#pragma unroll
        for (int ai = 0; ai < 2; ++ai)
#pragma unroll
            for (int m = 0; m < 4; ++m) { const int row = row0 + ai * HALF + m * 16;
#pragma unroll
                for (int bj = 0; bj < 2; ++bj) { const int col = col0 + bj * HALF;
                    const f32x4 b0 = *(const f32x4*)(bias + col), b1 = *(const f32x4*)(bias + col + 4);
                    const u32x4 yw = *(const u32x4*)(Y + (size_t)row * 1024 + col);
                    const f32x4 v0 = acc[ai][bj][m][0] + b0, v1 = acc[ai][bj][m][1] + b1;
                    float o[8];
                    o[0] = bf_lo(yw.x) * sigmoidf_(v0[0]); o[1] = bf_hi(yw.x) * sigmoidf_(v0[1]); o[2] = bf_lo(yw.y) * sigmoidf_(v0[2]); o[3] = bf_hi(yw.y) * sigmoidf_(v0[3]);
                    o[4] = bf_lo(yw.z) * sigmoidf_(v1[0]); o[5] = bf_hi(yw.z) * sigmoidf_(v1[1]); o[6] = bf_lo(yw.w) * sigmoidf_(v1[2]); o[7] = bf_hi(yw.w) * sigmoidf_(v1[3]);
                    u32x4 w; w.x = cvt_pk_bf16(o[0], o[1]); w.y = cvt_pk_bf16(o[2], o[3]); w.z = cvt_pk_bf16(o[4], o[5]); w.w = cvt_pk_bf16(o[6], o[7]);
                    *(u32x4*)(O + (size_t)row * 4096 + 2048 + col) = w; asm volatile("" ::: "memory"); } }
    }
};
struct EpiMerge {
    static constexpr bool PERM = true; static __device__ __forceinline__ bool keep_acc(const Unit& u) { return u.seg < 3; }
    const bf16_t* proj; bf16_t* O;
    __device__ __forceinline__ void operator()(f32x4 (&acc)[2][2][4][2], const Unit& u, int wr, int wc, int fr, int fq, int tz) const {
        const int row0 = u.pm * BM + wr * 64 + fr, col0 = u.pn * BM + wc * 32 + 8 * fq;
        const bool lastseg = (u.seg == 3);
#pragma unroll
        for (int ai = 0; ai < 2; ++ai) {
            u32x4 gw[4][2], gn[4][2];
#pragma unroll
            for (int m = 0; m < 4; ++m)
#pragma unroll
                for (int bj = 0; bj < 2; ++bj) { const bf16_t* gp = proj + (size_t)(row0 + ai * HALF + m * 16) * NPP + C_GATE + u.seg * 2048 + col0 + bj * HALF;
                    gw[m][bj] = *(const u32x4*)gp; gn[m][bj] = *(const u32x4*)(gp + (lastseg ? 0 : 2048)); }
#pragma unroll
            for (int m = 0; m < 4; ++m)
#pragma unroll
                for (int bj = 0; bj < 2; ++bj) { const int row = row0 + ai * HALF + m * 16, col = col0 + bj * HALF;
                    const u32x4 a = gw[m][bj], d4 = gn[m][bj];
                    float s[8] = {bf_lo(a.x), bf_hi(a.x), bf_lo(a.y), bf_hi(a.y), bf_lo(a.z), bf_hi(a.z), bf_lo(a.w), bf_hi(a.w)};
                    if (!lastseg) { const float d[8] = {bf_lo(d4.x), bf_hi(d4.x), bf_lo(d4.y), bf_hi(d4.y), bf_lo(d4.z), bf_hi(d4.z), bf_lo(d4.w), bf_hi(d4.w)};
#pragma unroll
                        for (int j = 0; j < 8; ++j) s[j] = s[j] * __builtin_amdgcn_rcpf(d[j]); }
                    f32x4 v0 = acc[ai][bj][m][0], v1 = acc[ai][bj][m][1];
#pragma unroll
                    for (int j = 0; j < 4; ++j) { v0[j] *= s[j]; v1[j] *= s[4 + j]; }
                    acc[ai][bj][m][0] = v0; acc[ai][bj][m][1] = v1;
                    if (lastseg) { u32x4 w; w.x = cvt_pk_bf16(v0[0], v0[1]); w.y = cvt_pk_bf16(v0[2], v0[3]); w.z = cvt_pk_bf16(v1[0], v1[1]); w.w = cvt_pk_bf16(v1[2], v1[3]);
                        *(u32x4*)(O + (size_t)row * DM + col) = w; } }
            asm volatile("" ::: "memory"); }
    }
};
struct EpiResid {
    static constexpr bool PERM = false; static __device__ __forceinline__ bool keep_acc(const Unit&) { return false; }
    const float* xres; float* O;
    __device__ __forceinline__ void operator()(const f32x4 (&acc)[2][2][4][2], const Unit& u, int wr, int wc, int fr, int fq, int tz) const {
        const int row0 = u.pm * BM + wr * 64 + fr, col0 = u.pn * BM + wc * 32 + 4 * fq;
#pragma unroll
        for (int ai = 0; ai < 2; ++ai)
#pragma unroll
            for (int m = 0; m < 4; ++m) { const size_t ro = (size_t)(row0 + ai * HALF + m * 16) * DM + col0;
#pragma unroll
                for (int bj = 0; bj < 2; ++bj)
#pragma unroll
                    for (int n = 0; n < 2; ++n) *(f32x4*)(O + ro + bj * HALF + n * 16) = acc[ai][bj][m][n]; }
    }
};
struct EpiRelu2 {
    static constexpr bool PERM = true; static __device__ __forceinline__ bool keep_acc(const Unit&) { return false; }
    bf16_t* O;
    __device__ __forceinline__ void operator()(const f32x4 (&acc)[2][2][4][2], const Unit& u, int wr, int wc, int fr, int fq, int tz) const {
        const int row0 = u.pm * BM + wr * 64 + fr, col0 = u.pn * BM + wc * 32 + 8 * fq;
#pragma unroll
        for (int ai = 0; ai < 2; ++ai)
#pragma unroll
            for (int m = 0; m < 4; ++m) { bf16_t* rowp = O + (size_t)(row0 + ai * HALF + m * 16) * DFF + col0;
#pragma unroll
                for (int bj = 0; bj < 2; ++bj) { f32x4 v0 = acc[ai][bj][m][0], v1 = acc[ai][bj][m][1];
#pragma unroll
                    for (int j = 0; j < 4; ++j) { const float a = fmaxf(v0[j], 0.f), b = fmaxf(v1[j], 0.f); v0[j] = a * a; v1[j] = b * b; }
                    u32x4 w; w.x = cvt_pk_bf16(v0[0], v0[1]); w.y = cvt_pk_bf16(v0[2], v0[3]); w.z = cvt_pk_bf16(v1[0], v1[1]); w.w = cvt_pk_bf16(v1[2], v1[3]);
                    *(u32x4*)(rowp + bj * HALF) = w; } }
    }
};
}

#define XB_TMO      128
#define XB_XCNT(j)  (256  + 64 * (j))
#define XB_XSUB(j)  (1280 + 64 * (j))
#define XB_XGEN(j)  (2304 + 64 * (j))
#define XB_TOP      3328
#define XB_TOPGEN   3392
#define XCD_BAR_WORDS 3456
#define XB_SPIN_CAP (1u << 18)
__device__ __forceinline__ unsigned xb_ld(unsigned* p)              { return __hip_atomic_load(p, __ATOMIC_RELAXED, __HIP_MEMORY_SCOPE_AGENT); }
__device__ __forceinline__ unsigned xb_add(unsigned* p, unsigned v) { return __hip_atomic_fetch_add(p, v, __ATOMIC_RELAXED, __HIP_MEMORY_SCOPE_AGENT); }
__device__ __forceinline__ unsigned xb_xcc_id() { return (unsigned)__builtin_amdgcn_s_getreg((3 << 11) | 20) & 0xFu; }
#define XB_SPIN(cond, bar) do { unsigned _sp = 0; while (cond) { __builtin_amdgcn_s_sleep(1); \
    if ((++_sp & 255u) == 0u) { if (xb_ld(&(bar)[XB_TMO])) break; if (_sp > XB_SPIN_CAP) { atomicAdd(&(bar)[XB_TMO], 1u); break; } } } } while (0)
struct XcdBarrier { unsigned* bar; unsigned x; volatile LAS unsigned* st; };
__device__ __forceinline__ XcdBarrier xcd_barrier_post(unsigned* bar, volatile LAS unsigned* st) {
    XcdBarrier b; b.bar = bar; b.x = xb_xcc_id(); b.st = st;
    if (threadIdx.x == 0) (void)xb_add(&bar[XB_XCNT(b.x)], 1u);
    return b;
}
__device__ __forceinline__ void xcd_barrier_complete(unsigned* bar, unsigned x, unsigned& nloc, unsigned& nx) {
    const unsigned G = gridDim.x * gridDim.y * gridDim.z;
    unsigned sum, cnt, mine, sp = 0u;
    for (;;) {
        sum = 0u; cnt = 0u; mine = 0u;
#pragma unroll
        for (unsigned j = 0; j < 16; ++j) { const unsigned c = xb_ld(&bar[XB_XCNT(j)]); sum += c; cnt += (c > 0u) ? 1u : 0u; mine = (j == x) ? c : mine; }
        if (sum == G) break;
        __builtin_amdgcn_s_sleep(1);
        if ((++sp & 255u) == 0u) { if (xb_ld(&bar[XB_TMO])) break; if (sp > XB_SPIN_CAP) { atomicAdd(&bar[XB_TMO], 1u); break; } }
    }
    nloc = mine > 0u ? mine : 1u; nx = cnt > 0u ? cnt : 1u;
}
__device__ __forceinline__ void xcd_barrier(const XcdBarrier& b) {
    asm volatile("s_waitcnt vmcnt(0)" ::: "memory");
    __syncthreads();
    if (threadIdx.x == 0) {
        unsigned* bar = b.bar;
        __builtin_amdgcn_s_waitcnt(0);
        unsigned nloc = b.st[0], nx = b.st[1];
        if (nloc == 0u) { xcd_barrier_complete(bar, b.x, nloc, nx); b.st[0] = nloc; b.st[1] = nx; }
        const unsigned old = xb_add(&bar[XB_XSUB(b.x)], 1u);
        const unsigned gen = old / nloc;
        if (old + 1u == (gen + 1u) * nloc) {
            __builtin_amdgcn_fence(__ATOMIC_RELEASE, "agent");
            asm volatile("s_waitcnt vmcnt(0)" ::: "memory");
            const unsigned og = xb_add(&bar[XB_TOP], 1u);
            const unsigned tg = og / nx;
            if (og + 1u == (tg + 1u) * nx) xb_add(&bar[XB_TOPGEN], 1u);
            else XB_SPIN(xb_ld(&bar[XB_TOPGEN]) == tg, bar);
            __builtin_amdgcn_fence(__ATOMIC_ACQUIRE, "agent");
            xb_add(&bar[XB_XGEN(b.x)], 1u);
            asm volatile("s_waitcnt vmcnt(0)" ::: "memory");
        } else {
            XB_SPIN(xb_ld(&bar[XB_XGEN(b.x)]) == gen, bar);
            __builtin_amdgcn_fence(__ATOMIC_ACQUIRE, "agent");
            asm volatile("s_waitcnt vmcnt(0)" ::: "memory");
        }
    }
    __syncthreads();
}

struct Args { const void* in[34]; float* out; unsigned char* ws; int ph_lo, ph_hi, li, pad; };
struct Frame {
    LAS unsigned char* lds;
    int tid, lane, wave, vcu, G;
    const void* const* in;
    unsigned char* ws;
    float* out;
};
__device__ __forceinline__ int opaque_tid() { int tz = threadIdx.x; asm volatile("" : "+v"(tz)); return tz; }
#define FIN(i) ((const float*)F.in[i])
#define WSP(type, off) ((type*)(F.ws + (off)))

constexpr int NB_IN = (NPROJ + 63) / 64;
constexpr int I_IN = (DM / 64) * NB_IN, I_GLU = (1024 / 64) * (1024 / 64), I_BR = (1024 / 64) * (DM / 64), I_OUT = (DM / 64) * (DM / 64),
              I_UP = (DM / 64) * (DFF / 64), I_DOWN = (DFF / 64) * (DM / 64), I_LAYER = I_IN + I_GLU + 4 * I_BR + I_OUT + I_UP + I_DOWN;
__device__ __forceinline__ void p0_resolve(Frame& F, int it, const float*& W, int& K, int& N, bf16_t*& WT, int& r) {
    const int l = it / I_LAYER; r = it - l * I_LAYER;
    unsigned char* wt = F.ws + WS_WT + (size_t)l * WT_LAYER;
    if (r < I_IN) { W = FIN(2) + (size_t)l * DM * NPROJ; K = DM; N = NPROJ; WT = (bf16_t*)(wt + WT_IN); return; } r -= I_IN;
    if (r < I_GLU) { W = FIN(15) + (size_t)l * 1024 * 1024; K = 1024; N = 1024; WT = (bf16_t*)(wt + WT_GLU); return; } r -= I_GLU;
    if (r < I_BR) { W = FIN(23) + (size_t)l * 1024 * DM; K = 1024; N = DM; WT = (bf16_t*)(wt + WT_BR); return; } r -= I_BR;
    if (r < I_BR) { W = FIN(24) + (size_t)l * 1024 * DM; K = 1024; N = DM; WT = (bf16_t*)(wt + WT_BR + 4 * MiB); return; } r -= I_BR;
    if (r < I_BR) { W = FIN(25) + (size_t)l * 1024 * DM; K = 1024; N = DM; WT = (bf16_t*)(wt + WT_BR + 8 * MiB); return; } r -= I_BR;
    if (r < I_BR) { W = FIN(26) + (size_t)l * 1024 * DM; K = 1024; N = DM; WT = (bf16_t*)(wt + WT_BR + 12 * MiB); return; } r -= I_BR;
    if (r < I_OUT) { W = FIN(27) + (size_t)l * DM * DM; K = DM; N = DM; WT = (bf16_t*)(wt + WT_OUT); return; } r -= I_OUT;
    if (r < I_UP) { W = FIN(30) + (size_t)l * DM * DFF; K = DM; N = DFF; WT = (bf16_t*)(wt + WT_UP); return; } r -= I_UP;
    W = FIN(31) + (size_t)l * DFF * DM; K = DFF; N = DM; WT = (bf16_t*)(wt + WT_DOWN);
}
__device__ __forceinline__ void p0_prologue(Frame& F) {
    LAS float* scr = (LAS float*)(F.lds + F.wave * 16896);
    const int gw = F.vcu * 8 + F.wave, NGW = F.G * 8; F.tid = opaque_tid(); F.lane = F.tid & 63;
    const int lane = F.lane;
    { float v[64]; const float* W; int K, N, r; bf16_t* WT;
      int it = gw;
#define P0_LOAD() do { p0_resolve(F, it, W, K, N, WT, r); const int nblk = (N + 63) / 64, kb = r / nblk, nb = r - kb * nblk; const bool ok = 64 * nb + lane < N; const float* src = W + (size_t)(64 * kb) * N + 64 * nb + (ok ? lane : 0); \
        _Pragma("unroll") for (int i = 0; i < 64; ++i) v[i] = src[(size_t)i * N]; } while (0)
      if (it < NLAYER * I_LAYER) P0_LOAD();
      while (it < NLAYER * I_LAYER) {
          const int nblk = (N + 63) / 64, kb = r / nblk, nb = r - kb * nblk, k0 = 64 * kb, n0 = 64 * nb, Kc = K, Nc = N; bf16_t* WTc = WT;
#pragma unroll
          for (int i = 0; i < 64; ++i) scr[i * 65 + lane] = v[i];
          asm volatile("s_waitcnt lgkmcnt(0)" ::: "memory");
          it += NGW;
          if (it < NLAYER * I_LAYER) P0_LOAD();
          const int c = lane & 7;
#pragma unroll
          for (int j = 0; j < 8; ++j) { const int n = (lane >> 3) + 8 * j; const LAS float* s = scr + (8 * c) * 65 + n;
              u32x4 o; o.x = pk2(s[0 * 65], s[1 * 65]); o.y = pk2(s[2 * 65], s[3 * 65]); o.z = pk2(s[4 * 65], s[5 * 65]); o.w = pk2(s[6 * 65], s[7 * 65]);
              if (n0 + n < Nc) *(u32x4*)(WTc + (size_t)(n0 + n) * Kc + k0 + 8 * c) = o; }
          asm volatile("s_waitcnt lgkmcnt(0)" ::: "memory");
      }
#undef P0_LOAD
    }
    const int gt = F.vcu * 512 + F.tid, NGT = F.G * 512;
    for (int i = gt; i < NLAYER * (NPP - NPROJ) * DM / 8; i += NGT) { const int l = i / ((NPP - NPROJ) * DM / 8), r = i % ((NPP - NPROJ) * DM / 8);
        *(u32x4*)(F.ws + WS_WT + (size_t)l * WT_LAYER + WT_IN + (size_t)NPROJ * DM * 2 + (size_t)r * 16) = (u32x4){0u, 0u, 0u, 0u}; }
    { const int* pos = (const int*)F.in[1]; float* trig = WSP(float, WS_TRIG);
      for (int i = gt; i < T * 64; i += NGT) { const int t = i >> 6, j = i & 63;
          const double inv = exp2(-(double)j * (13.287712379549449 / 64.0));
          double s, c; sincos_d((double)pos[t] * inv, s, c);
          trig[(size_t)t * 128 + j] = (float)c; trig[(size_t)t * 128 + 64 + j] = (float)s; } }
    { const float* x = FIN(0); bf16_t* xb = WSP(bf16_t, WS_XB);
      for (int i = gt; i < T * DM / 4; i += NGT) { const f32x4 v = *(const f32x4*)(x + (size_t)i * 4); u32x2 w; w.x = pk2(v[0], v[1]); w.y = pk2(v[2], v[3]); *(u32x2*)(xb + (size_t)i * 4) = w; } }
    for (int i = gt; i < NLAYER * 4096; i += NGT) { const int l = i >> 12, gn = i & 4095, g = gn >> 6;
        const double lre = (double)FIN(7)[(size_t)l * 4096 + gn], lim = (double)FIN(8)[(size_t)l * 4096 + gn], step = exp((double)FIN(9)[l * 64 + g]);
        const double mag = exp(lre * step); double sn, cs; sincos_d(lim * step, sn, cs);
        const double are = mag * cs, aim = mag * sn, den = lre * lre + lim * lim;
        const double fre = ((are - 1.0) * lre + aim * lim) / den, fim = (aim * lre - (are - 1.0) * lim) / den;
        float* sp = (float*)(F.ws + WS_S5P + (size_t)l * MiB);
        sp[gn * 2] = (float)are; sp[gn * 2 + 1] = (float)aim;
        const float* bre = FIN(10) + ((size_t)l * 4096 + gn) * 16; const float* bim = FIN(11) + ((size_t)l * 4096 + gn) * 16;
        float* obre = sp + 16384 + (size_t)gn * 16; float* obim = sp + 16384 + 65536 + (size_t)gn * 16;
#pragma unroll
        for (int c = 0; c < 16; ++c) { const double br = bre[c], bi = bim[c]; obre[c] = (float)(fre * br - fim * bi); obim[c] = (float)(fre * bi + fim * br); } }
}

constexpr int LDP = 136;
__device__ __forceinline__ bf16x8 ldsfrag(const LAS bf16_t* base, int pitch, int row, int kk, int q) { return *(const LAS bf16x8*)(base + row * pitch + kk * 32 + 8 * q); }
__device__ __forceinline__ bf16x8 glbfrag(const bf16_t* base, int pitch, int row, int kk, int q) { return *(const bf16x8*)(base + (size_t)row * pitch + kk * 32 + 8 * q); }
#define MFMA16(a, b, c) __builtin_amdgcn_mfma_f32_16x16x32_bf16((a), (b), (c), 0, 0, 0)
__host__ __device__ __forceinline__ int fragoff(int row, int c8, int NK) { return 8 * ((((row >> 4) * NK + (c8 >> 2)) * 64) + (c8 & 3) * 16 + (row & 15)); }
#define LDS_BARRIER() do { asm volatile("s_waitcnt lgkmcnt(0)" ::: "memory"); __builtin_amdgcn_s_barrier(); asm volatile("" ::: "memory"); } while (0)

typedef float f32x16 __attribute__((ext_vector_type(16)));
__device__ __forceinline__ float gelu_tanh_(float y) { const float z = 0.7978845608028654f * (y + 0.044715f * y * y * y); const float th = 1.f - 2.f / (1.f + __expf(2.f * z)); return 0.5f * y * (1.f + th); }
__device__ __forceinline__ void s5_unit(Frame& F, int layer, int g) {
    const int tid = opaque_tid(), lane = tid & 63, w = F.wave, j = lane & 31, hh = lane >> 5, r16 = lane & 15, q = lane >> 4;
    LAS bf16_t* Xw = (LAS bf16_t*)(F.lds + w * 8704);
    LAS float* Ew = (LAS float*)(F.lds + 8 * 8704);
    LAS bf16_t* Uw = (LAS bf16_t*)(F.lds + 8 * 8704 + 4096 + w * 1024);
    const bf16_t* proj = WSP(bf16_t, WS_PROJ); bf16_t* ys = WSP(bf16_t, WS_YS5);
    const float* sp = (const float*)(F.ws + WS_S5P + (size_t)layer * MiB);
    float a1r[2], a1i[2], a2r[2], a2i[2], a3r[2], a3i[2], a4r[2], a4i[2];
#pragma unroll
    for (int s = 0; s < 2; ++s) { const int gn = g * 64 + j + 32 * s; a1r[s] = sp[gn * 2]; a1i[s] = sp[gn * 2 + 1];
        a2r[s] = a1r[s] * a1r[s] - a1i[s] * a1i[s]; a2i[s] = 2.f * a1r[s] * a1i[s];
        a3r[s] = a2r[s] * a1r[s] - a2i[s] * a1i[s]; a3i[s] = a2r[s] * a1i[s] + a2i[s] * a1r[s];
        a4r[s] = a2r[s] * a2r[s] - a2i[s] * a2i[s]; a4i[s] = 2.f * a2r[s] * a2i[s]; }
    bf16x8 bfr[4];
#pragma unroll
    for (int blk = 0; blk < 4; ++blk) { const float* src = sp + 16384 + (blk >> 1) * 65536 + (size_t)(g * 64 + j + 32 * (blk & 1)) * 16 + 8 * hh;
        const f32x4 v0 = *(const f32x4*)src, v1 = *(const f32x4*)(src + 4); u32x4 pk; pk.x = pk2(v0[0], v0[1]); pk.y = pk2(v0[2], v0[3]); pk.z = pk2(v1[0], v1[1]); pk.w = pk2(v1[2], v1[3]);
        bfr[blk] = __builtin_bit_cast(bf16x8, pk); }
    bf16x8 cfr[4];
    { const float* cre = FIN(12) + ((size_t)layer * 64 + g) * 1024 + r16 * 64; const float* cim = FIN(13) + ((size_t)layer * 64 + g) * 1024 + r16 * 64;
#pragma unroll
      for (int kk = 0; kk < 4; ++kk) { float v[8];
#pragma unroll
          for (int i = 0; i < 8; ++i) { const int ls = 8 * kk + 2 * q + (i >> 2), blk = i & 3, st = ls + 32 * (blk & 1); v[i] = (blk >> 1) ? -cim[st] : cre[st]; }
          u32x4 pk; pk.x = pk2(v[0], v[1]); pk.y = pk2(v[2], v[3]); pk.z = pk2(v[4], v[5]); pk.w = pk2(v[6], v[7]); cfr[kk] = __builtin_bit_cast(bf16x8, pk); } }
    const float dsk = FIN(14)[layer * 1024 + g * 16 + r16];
    const int t0 = w * 1024;
    float cr[2] = {0.f, 0.f}, ci[2] = {0.f, 0.f};
    const f32x16 zero16 = {0.f, 0.f, 0.f, 0.f, 0.f, 0.f, 0.f, 0.f, 0.f, 0.f, 0.f, 0.f, 0.f, 0.f, 0.f, 0.f};
#define S5_RING_LOAD(SET, tt) do { const bf16_t* p_ = proj + (size_t)(t0 + 32 * ((tt) & 31) + j) * NPP + C_SU + 16 * g + 8 * hh; asm volatile("global_load_dwordx4 %0, %1, off" : "=v"(ar[SET]) : "v"(p_) : "memory"); } while (0)
#define S5_TILE(tt, SET, LDSET, DO_Y, NWAIT) do { \
        asm volatile("s_waitcnt vmcnt(" NWAIT ")" : "+v"(ar[SET]) :: "memory"); __builtin_amdgcn_sched_barrier(0); \
        const bf16x8 afr = ar[SET]; \
        f32x16 acc[4]; \
        _Pragma("unroll") for (int blk = 0; blk < 4; ++blk) acc[blk] = __builtin_amdgcn_mfma_f32_32x32x16_bf16(afr, bfr[blk], zero16, 0, 0, 0); \
        float cjr[2][4], cji[2][4]; \
        _Pragma("unroll") for (int s = 0; s < 2; ++s) { \
            _Pragma("unroll") for (int gi = 0; gi < 4; ++gi) { float xr = 0.f, xi = 0.f; \
                _Pragma("unroll") for (int k = 0; k < 4; ++k) { const float nr = a1r[s] * xr - a1i[s] * xi + acc[s][4 * gi + k], ni = a1r[s] * xi + a1i[s] * xr + acc[2 + s][4 * gi + k]; xr = nr; xi = ni; acc[s][4 * gi + k] = xr; acc[2 + s][4 * gi + k] = xi; } } \
            float c_r = cr[s], c_i = ci[s]; \
            _Pragma("unroll") for (int gi = 0; gi < 4; ++gi) { const float er = acc[s][4 * gi + 3], ei = acc[2 + s][4 * gi + 3]; const float orr = __shfl_xor(er, 32), oi = __shfl_xor(ei, 32); \
                const float E0r = hh ? orr : er, E0i = hh ? oi : ei, E1r = hh ? er : orr, E1i = hh ? ei : oi;        \
                const float c0r = c_r, c0i = c_i; const float c1r = a4r[s] * c0r - a4i[s] * c0i + E0r, c1i = a4r[s] * c0i + a4i[s] * c0r + E0i; \
                cjr[s][gi] = hh ? c1r : c0r; cji[s][gi] = hh ? c1i : c0i; \
                c_r = a4r[s] * c1r - a4i[s] * c1i + E1r; c_i = a4r[s] * c1i + a4i[s] * c1r + E1i; } \
            cr[s] = c_r; ci[s] = c_i; } \
        if (DO_Y) { \
            _Pragma("unroll") for (int s = 0; s < 2; ++s) _Pragma("unroll") for (int gi = 0; gi < 4; ++gi) { const float kr = cjr[s][gi], ki = cji[s][gi]; \
                acc[s][4 * gi + 0] += a1r[s] * kr - a1i[s] * ki; acc[2 + s][4 * gi + 0] += a1r[s] * ki + a1i[s] * kr; \
                acc[s][4 * gi + 1] += a2r[s] * kr - a2i[s] * ki; acc[2 + s][4 * gi + 1] += a2r[s] * ki + a2i[s] * kr; \
                acc[s][4 * gi + 2] += a3r[s] * kr - a3i[s] * ki; acc[2 + s][4 * gi + 2] += a3r[s] * ki + a3i[s] * kr; \
                acc[s][4 * gi + 3] += a4r[s] * kr - a4i[s] * ki; acc[2 + s][4 * gi + 3] += a4r[s] * ki + a4i[s] * kr; } \
            _Pragma("unroll") for (int r = 0; r < 16; ++r) { const int tok = (r & 3) + 8 * (r >> 2) + 4 * hh; u32x2 o; o.x = pk2(acc[0][r], acc[1][r]); o.y = pk2(acc[2][r], acc[3][r]); *(LAS u32x2*)(Xw + tok * 136 + 4 * j) = o; } \
            *(LAS bf16x8*)(Uw + j * 16 + 8 * hh) = afr;            \
            asm volatile("s_waitcnt lgkmcnt(0)" ::: "memory"); \
            _Pragma("unroll") for (int mt = 0; mt < 2; ++mt) { f32x4 ya = {0.f, 0.f, 0.f, 0.f}; \
                _Pragma("unroll") for (int kk = 0; kk < 4; ++kk) ya = MFMA16(ldsfrag(Xw, 136, 16 * mt + r16, kk, q), cfr[kk], ya); \
                _Pragma("unroll") for (int r = 0; r < 4; ++r) { const size_t t = (size_t)(t0 + 32 * (tt) + 16 * mt + 4 * q + r); const float y = ya[r] + dsk * bf2f(Uw[(16 * mt + 4 * q + r) * 16 + r16]); \
                    ys[t * 1024 + g * 16 + r16] = (bf16_t)f2bf(gelu_tanh_(y)); } } \
            asm volatile("s_waitcnt lgkmcnt(0)" ::: "memory"); } \
        S5_RING_LOAD(LDSET, (tt) + 3); } while (0)
    bf16x8 ar[4];
    S5_RING_LOAD(0, 0); S5_RING_LOAD(1, 1); S5_RING_LOAD(2, 2);
    for (int tt = 0; tt < 32; tt += 4) { S5_TILE(tt, 0, 3, false, "2"); S5_TILE(tt + 1, 1, 0, false, "2"); S5_TILE(tt + 2, 2, 1, false, "2"); S5_TILE(tt + 3, 3, 2, false, "2"); }
    if (hh == 0) {
#pragma unroll
        for (int s = 0; s < 2; ++s) { Ew[(w * 64 + j + 32 * s) * 2] = cr[s]; Ew[(w * 64 + j + 32 * s) * 2 + 1] = ci[s]; } }
    __syncthreads();
#pragma unroll
    for (int s = 0; s < 2; ++s) { float pr = a4r[s], pi = a4i[s];
#pragma unroll
        for (int k = 0; k < 8; ++k) { const float nr = pr * pr - pi * pi, ni = 2.f * pr * pi; pr = nr; pi = ni; }
        float xr = 0.f, xi = 0.f;
        for (int v = 0; v < w; ++v) { const float er = Ew[(v * 64 + j + 32 * s) * 2], ei = Ew[(v * 64 + j + 32 * s) * 2 + 1]; const float nr = pr * xr - pi * xi + er, ni = pr * xi + pi * xr + ei; xr = nr; xi = ni; }
        cr[s] = xr; ci[s] = xi; }
    S5_TILE(0, 0, 3, true, "2"); S5_TILE(1, 1, 0, true, "10"); S5_TILE(2, 2, 1, true, "18"); S5_TILE(3, 3, 2, true, "18");
    for (int tt = 4; tt < 32; tt += 4) { S5_TILE(tt, 0, 3, true, "18"); S5_TILE(tt + 1, 1, 0, true, "18"); S5_TILE(tt + 2, 2, 1, true, "18"); S5_TILE(tt + 3, 3, 2, true, "18"); }
    asm volatile("s_waitcnt vmcnt(0)" ::: "memory");
#undef S5_RING_LOAD
#undef S5_TILE
    __syncthreads();
}

constexpr size_t RET_BLK = 3 * 16384;
__device__ __forceinline__ void ret_pre_unit(Frame& F, int n, int h) {
    const int tid = opaque_tid(), lane = tid & 63, w = F.wave, r16 = lane & 15, q = lane >> 4;
    LAS bf16_t* Qs = (LAS bf16_t*)(F.lds); LAS bf16_t* Ks = (LAS bf16_t*)(F.lds + 128 * LDP * 2);
    const bf16_t* proj = WSP(bf16_t, WS_PROJ); const float* trig = WSP(float, WS_TRIG);
    bf16_t* blk = (bf16_t*)(F.ws + WS_TMP + TM_KR) + (size_t)(n * 4 + h) * RET_BLK;
    { const int tok = tid >> 2, qt = tid & 3; const size_t t = (size_t)n * 128 + tok;
      const bf16_t* pq = proj + t * NPP + C_RQ + h * 128 + 16 * qt; const bf16_t* pk = proj + t * NPP + C_RK + h * 128 + 16 * qt;
      const float* tc = trig + t * 128 + 16 * qt;
      float cs[16], sn[16];
#pragma unroll
      for (int i = 0; i < 4; ++i) { const f32x4 c4 = *(const f32x4*)(tc + 4 * i), s4 = *(const f32x4*)(tc + 64 + 4 * i);
#pragma unroll
          for (int j = 0; j < 4; ++j) { cs[4 * i + j] = c4[j]; sn[4 * i + j] = s4[j]; } }
#pragma unroll
      for (int isk = 0; isk < 2; ++isk) {
          const bf16_t* p = isk ? pk : pq; const float sc = isk ? 0.08838834764831845f : 1.0f;
          const u32x4 a0 = *(const u32x4*)p, a1 = *(const u32x4*)(p + 8), b0 = *(const u32x4*)(p + 64), b1 = *(const u32x4*)(p + 72);
          float x1[16], x2[16];
#pragma unroll
          for (int j = 0; j < 4; ++j) { x1[2 * j] = bf_lo(a0[j]); x1[2 * j + 1] = bf_hi(a0[j]); x1[8 + 2 * j] = bf_lo(a1[j]); x1[8 + 2 * j + 1] = bf_hi(a1[j]);
              x2[2 * j] = bf_lo(b0[j]); x2[2 * j + 1] = bf_hi(b0[j]); x2[8 + 2 * j] = bf_lo(b1[j]); x2[8 + 2 * j + 1] = bf_hi(b1[j]); }
          u32x4 o1[2], o2[2];
#pragma unroll
          for (int j = 0; j < 8; ++j) { const float ya = (x1[2 * j] * cs[2 * j] - x2[2 * j] * sn[2 * j]) * sc, yb = (x1[2 * j + 1] * cs[2 * j + 1] - x2[2 * j + 1] * sn[2 * j + 1]) * sc;
              const float za = (x1[2 * j] * sn[2 * j] + x2[2 * j] * cs[2 * j]) * sc, zb = (x1[2 * j + 1] * sn[2 * j + 1] + x2[2 * j + 1] * cs[2 * j + 1]) * sc;
              o1[j >> 2][j & 3] = pk2(ya, yb); o2[j >> 2][j & 3] = pk2(za, zb); }
          LAS bf16_t* ls = (isk ? Ks : Qs) + tok * LDP + 16 * qt;
          *(LAS u32x4*)ls = o1[0]; *(LAS u32x4*)(ls + 8) = o1[1]; *(LAS u32x4*)(ls + 64) = o2[0]; *(LAS u32x4*)(ls + 72) = o2[1];
          if (!isk) { *(u32x4*)(blk + fragoff(tok, 2 * qt, 4)) = o1[0]; *(u32x4*)(blk + fragoff(tok, 2 * qt + 1, 4)) = o1[1]; *(u32x4*)(blk + fragoff(tok, 8 + 2 * qt, 4)) = o2[0]; *(u32x4*)(blk + fragoff(tok, 9 + 2 * qt, 4)) = o2[1]; } } }
    LDS_BARRIER();
    { const int d = tid >> 2, jq = tid & 3; bf16_t* g = blk + 2 * 16384;
#pragma unroll
      for (int c = 0; c < 4; ++c) { u32x4 o;
#pragma unroll
          for (int j = 0; j < 4; ++j) { const unsigned lo = Ks[(32 * jq + 8 * c + 2 * j) * LDP + d], hi = Ks[(32 * jq + 8 * c + 2 * j + 1) * LDP + d]; o[j] = lo | (hi << 16); }
          *(u32x4*)(g + fragoff(d, 4 * jq + c, 4)) = o; } }
    { const float lg = log2f(1.0f - exp2f(-5.0f - (float)h)); const int i = 16 * w + r16;
      bf16x8 bq[4];
#pragma unroll
      for (int kk = 0; kk < 4; ++kk) bq[kk] = ldsfrag(Qs, LDP, 16 * w + r16, kk, q);
      bf16_t* g = blk + 16384;
      for (int jt = 0; jt < 8; ++jt) {
          u32x2 o = {0u, 0u};
          if (jt <= w) { f32x4 acc = {0.f, 0.f, 0.f, 0.f};
#pragma unroll
              for (int kk = 0; kk < 4; ++kk) acc = MFMA16(ldsfrag(Ks, LDP, 16 * jt + r16, kk, q), bq[kk], acc);
              float v[4];
#pragma unroll
              for (int r = 0; r < 4; ++r) { const int j = 16 * jt + 4 * q + r; v[r] = (j <= i) ? acc[r] * exp2f((float)(i - j) * lg) : 0.f; }
              o.x = pk2(v[0], v[1]); o.y = pk2(v[2], v[3]); }
          *(u32x2*)(g + fragoff(i, 2 * jt + (q >> 1), 4) + 4 * (q & 1)) = o; } }
    LDS_BARRIER();
}

__device__ __forceinline__ void ret_seq_unit(Frame& F, int u) {
    const int tid = opaque_tid(), lane = tid & 63, w = F.wave, r16 = lane & 15, q = lane >> 4;
    const int h = u >> 4, e0 = (u & 15) * 16;
    LAS bf16_t* Rt = (LAS bf16_t*)(F.lds); LAS bf16_t* Vt = (LAS bf16_t*)(F.lds + 2 * 16 * LDP * 2); LAS bf16_t* Vd = (LAS bf16_t*)(F.lds + 4 * 16 * LDP * 2);
    const bf16_t* proj = WSP(bf16_t, WS_PROJ); bf16_t* O = (bf16_t*)(F.ws + WS_TMP + TM_VR);
    const bf16_t* blk0 = (const bf16_t*)(F.ws + WS_TMP + TM_KR) + (size_t)h * RET_BLK;
    const float lg = log2f(1.0f - exp2f(-5.0f - (float)h)), g128 = exp2f(128.f * lg);
    float rsc[4];
#pragma unroll
    for (int r = 0; r < 4; ++r) rsc[r] = exp2f((float)(16 * w + 4 * q + r + 1) * lg);
    const int vj = tid >> 1, vh = tid & 1; const float vdec = exp2f((float)(127 - vj) * lg);
    u32x4 vreg = {0u, 0u, 0u, 0u};
#define RET_LOADV(c) do { if (tid < 256) vreg = *(const u32x4*)(proj + (size_t)((c) * 128 + vj) * NPP + C_RV + h * 256 + e0 + 8 * vh); } while (0)
#define RET_STOREV(b) do { if (tid < 256) { LAS bf16_t* vt = Vt + (b) * 16 * LDP + (8 * vh) * LDP + vj; LAS bf16_t* vd = Vd + (b) * 16 * LDP + (8 * vh) * LDP + vj; \
        _Pragma("unroll") for (int j = 0; j < 4; ++j) { const float lo = bf_lo(vreg[j]), hi = bf_hi(vreg[j]); vt[(2 * j) * LDP] = (bf16_t)(vreg[j] & 0xffffu); vt[(2 * j + 1) * LDP] = (bf16_t)(vreg[j] >> 16); \
            vd[(2 * j) * LDP] = (bf16_t)f2bf(lo * vdec); vd[(2 * j + 1) * LDP] = (bf16_t)f2bf(hi * vdec); } } } while (0)
#define RET_LOADF(FR, c) do { const bf16_t* bk = blk0 + (size_t)(c) * 4 * RET_BLK; _Pragma("unroll") for (int kk = 0; kk < 4; ++kk) { \
        FR[kk] = *(const bf16x8*)(bk + (w * 4 + kk) * 512 + lane * 8); if (kk <= (w >> 1)) FR[4 + kk] = *(const bf16x8*)(bk + 16384 + (w * 4 + kk) * 512 + lane * 8); FR[8 + kk] = *(const bf16x8*)(bk + 32768 + (w * 4 + kk) * 512 + lane * 8); } } while (0)
    for (int i = tid; i < 16 * LDP; i += 512) Rt[i] = 0;
    RET_LOADV(0); RET_STOREV(0);
    bf16x8 fa[12], fb[12];
    RET_LOADF(fa, 0);
    f32x4 R = {0.f, 0.f, 0.f, 0.f};
    __syncthreads();
#define RET_CHUNK(c, CUR, NXT) do { const int b = (c) & 1; \
        if ((c) + 1 < T / 128) { RET_LOADF(NXT, (c) + 1); RET_LOADV((c) + 1); } \
        f32x4 a1 = {0.f, 0.f, 0.f, 0.f}, a2 = {0.f, 0.f, 0.f, 0.f}; f32x4 ra = R * g128; \
        _Pragma("unroll") for (int kk = 0; kk < 4; ++kk) { const bf16x8 bR = ldsfrag(Rt + b * 16 * LDP, LDP, r16, kk, q), bV = ldsfrag(Vt + b * 16 * LDP, LDP, r16, kk, q), bD = ldsfrag(Vd + b * 16 * LDP, LDP, r16, kk, q); \
            a1 = MFMA16(CUR[kk], bR, a1); if (kk <= (w >> 1)) a2 = MFMA16(CUR[4 + kk], bV, a2); ra = MFMA16(CUR[8 + kk], bD, ra); } \
        R = ra; \
        _Pragma("unroll") for (int r = 0; r < 4; ++r) O[(size_t)((c) * 128 + 16 * w + 4 * q + r) * 1024 + h * 256 + e0 + r16] = (bf16_t)f2bf(rsc[r] * a1[r] + a2[r]); \
        { u32x2 o; o.x = pk2(R[0], R[1]); o.y = pk2(R[2], R[3]); *(LAS u32x2*)(Rt + (b ^ 1) * 16 * LDP + r16 * LDP + 16 * w + 4 * q) = o; } \
        if ((c) + 1 < T / 128) RET_STOREV(b ^ 1); \
        LDS_BARRIER(); } while (0)
    for (int c = 0; c < T / 128; c += 2) { RET_CHUNK(c, fa, fb); RET_CHUNK(c + 1, fb, fa); }
#undef RET_CHUNK
#undef RET_LOADF
#undef RET_LOADV
#undef RET_STOREV
}


__device__ __forceinline__ void ssd_pre_unit(Frame& F, int layer, int n, int g) {
    const int tid = opaque_tid(), lane = tid & 63, w = F.wave, r16 = lane & 15, q = lane >> 4;
    LAS bf16_t* Cs = (LAS bf16_t*)(F.lds); LAS bf16_t* Bs = (LAS bf16_t*)(F.lds + 128 * LDP * 2);
    LAS float* Ac = (LAS float*)(F.lds + 2 * 128 * LDP * 2); LAS float* Dt = Ac + 8 * 128;
    const bf16_t* proj = WSP(bf16_t, WS_PROJ); const float* small = WSP(float, WS_SMALL);
    unsigned char* tm = F.ws + WS_TMP;
    float* acum = (float*)(tm + TM_SAC); bf16_t* XS = (bf16_t*)(tm + TM_SXS); bf16_t* XD = (bf16_t*)(tm + TM_SXD);
    bf16_t* cb = (bf16_t*)(tm + TM_SCB) + (size_t)(n * 2 + g) * 32768; bf16_t* sl = (bf16_t*)(tm + TM_SSL) + (size_t)(n * 16 + 8 * g) * 16384;
    const float* scw = FIN(17) + (size_t)layer * 1536 * 4; const float* scb = FIN(18) + layer * 1536; const float* sdtb = FIN(19) + layer * 16; const float* salog = FIN(20) + layer * 16;
    const int t0 = n * 128;
    { const int hh = 8 * g + w; const float a = -__expf(salog[hh]);
      const float dt0 = softplusf_(small[(size_t)(t0 + 2 * lane) * 32 + 16 + hh] + sdtb[hh]), dt1 = softplusf_(small[(size_t)(t0 + 2 * lane + 1) * 32 + 16 + hh] + sdtb[hh]);
      const float v0 = dt0 * a, v1 = dt1 * a, s = v0 + v1; float incl = s;
#pragma unroll
      for (int o = 1; o < 64; o <<= 1) { const float tmp = __shfl_up(incl, o); if (lane >= o) incl += tmp; }
      const float excl = incl - s;
      Ac[w * 128 + 2 * lane] = excl + v0; Ac[w * 128 + 2 * lane + 1] = excl + s; Dt[w * 128 + 2 * lane] = dt0; Dt[w * 128 + 2 * lane + 1] = dt1;
      acum[(size_t)(t0 + 2 * lane) * 16 + hh] = excl + v0; acum[(size_t)(t0 + 2 * lane + 1) * 16 + hh] = excl + s; }
    LDS_BARRIER();
    { const int cp = tid & 127, tq = tid >> 7; const int tb = t0 + 32 * tq;
      unsigned xa[3][35];
#pragma unroll
      for (int m = 0; m < 3; ++m) { const int ch = (m < 2) ? g * 512 + m * 256 + 2 * cp : (cp < 64 ? 1024 + g * 128 + 2 * cp : 1280 + g * 128 + 2 * (cp - 64)); const bf16_t* pc = proj + C_MX + ch;
#pragma unroll
          for (int i = 0; i < 35; ++i) xa[m][i] = (tb - 3 + i >= 0) ? *(const unsigned*)(pc + (size_t)(tb - 3 + i) * NPP) : 0u; }
#pragma unroll
      for (int m = 0; m < 3; ++m) {
          const int ch = (m < 2) ? g * 512 + m * 256 + 2 * cp : (cp < 64 ? 1024 + g * 128 + 2 * cp : 1280 + g * 128 + 2 * (cp - 64));
          const f32x4 w0 = *(const f32x4*)(scw + (size_t)ch * 4), w1 = *(const f32x4*)(scw + (size_t)ch * 4 + 4); const float b0 = scb[ch], b1 = scb[ch + 1];
          const unsigned (&xw)[35] = xa[m];
#pragma unroll
          for (int i = 0; i < 32; ++i) { const unsigned x0 = xw[i], x1 = xw[i + 1], x2 = xw[i + 2], x3 = xw[i + 3];
              const float ya = siluf_(w0[0] * bf_lo(x0) + w0[1] * bf_lo(x1) + w0[2] * bf_lo(x2) + w0[3] * bf_lo(x3) + b0);
              const float yb = siluf_(w1[0] * bf_hi(x0) + w1[1] * bf_hi(x1) + w1[2] * bf_hi(x2) + w1[3] * bf_hi(x3) + b1);
              if (m < 2) { const float dt = Dt[(m * 4 + (cp >> 5)) * 128 + 32 * tq + i]; const size_t go = (size_t)(tb + i) * 1024 + g * 512 + m * 256 + 2 * cp;
                  *(unsigned*)(XS + go) = pk2(ya, yb); *(unsigned*)(XD + go) = pk2(ya * dt, yb * dt); }
              else if (cp < 64) *(LAS unsigned*)(Bs + (32 * tq + i) * LDP + 2 * cp) = pk2(ya, yb);
              else *(LAS unsigned*)(Cs + (32 * tq + i) * LDP + 2 * (cp - 64)) = pk2(ya, yb); } } }
    LDS_BARRIER();
#pragma unroll
    for (int k = 0; k < 4; ++k) { const int idx = tid + 512 * k, row = idx >> 4, c8 = idx & 15; *(u32x4*)(cb + fragoff(row, c8, 4)) = *(const LAS u32x4*)(Cs + row * LDP + 8 * c8); }
    { const int d = tid >> 2, jq = tid & 3; bf16_t* gp = cb + 16384;
#pragma unroll
      for (int c = 0; c < 4; ++c) { u32x4 o;
#pragma unroll
          for (int j = 0; j < 4; ++j) { const unsigned lo = Bs[(32 * jq + 8 * c + 2 * j) * LDP + d], hi = Bs[(32 * jq + 8 * c + 2 * j + 1) * LDP + d]; o[j] = lo | (hi << 16); }
          *(u32x4*)(gp + fragoff(d, 4 * jq + c, 4)) = o; } }
    { const int i = 16 * w + r16; bf16x8 bq[4];
#pragma unroll
      for (int kk = 0; kk < 4; ++kk) bq[kk] = ldsfrag(Cs, LDP, i, kk, q);
      float ai[8];
#pragma unroll
      for (int hh = 0; hh < 8; ++hh) ai[hh] = Ac[hh * 128 + i];
      for (int jt = 0; jt < 8; ++jt) {
          f32x4 acc = {0.f, 0.f, 0.f, 0.f};
          if (jt <= w) {
#pragma unroll
              for (int kk = 0; kk < 4; ++kk) acc = MFMA16(ldsfrag(Bs, LDP, 16 * jt + r16, kk, q), bq[kk], acc); }
#pragma unroll
          for (int hh = 0; hh < 8; ++hh) { u32x2 o = {0u, 0u};
              if (jt <= w) { const f32x4 aj = *(const LAS f32x4*)(Ac + hh * 128 + 16 * jt + 4 * q); float v[4];
#pragma unroll
                  for (int r = 0; r < 4; ++r) { const int j = 16 * jt + 4 * q + r; v[r] = (j <= i) ? acc[r] * __expf(ai[hh] - aj[r]) : 0.f; }
                  o.x = pk2(v[0], v[1]); o.y = pk2(v[2], v[3]); }
              *(u32x2*)(sl + (size_t)hh * 16384 + fragoff(i, 2 * jt + (q >> 1), 4) + 4 * (q & 1)) = o; } } }
    LDS_BARRIER();
}

__device__ __forceinline__ void ssd_seq_unit(Frame& F, int u) {
    const int tid = opaque_tid(), lane = tid & 63, w = F.wave, r16 = lane & 15, q = lane >> 4;
    const int h = u >> 2, p0 = (u & 3) * 16, g = h >> 3;
    LAS bf16_t* St = (LAS bf16_t*)(F.lds); LAS bf16_t* Vt = (LAS bf16_t*)(F.lds + 2 * 16 * LDP * 2); LAS bf16_t* Vd = (LAS bf16_t*)(F.lds + 4 * 16 * LDP * 2);
    unsigned char* tm = F.ws + WS_TMP;
    const float* acum = (const float*)(tm + TM_SAC); const bf16_t* XD = (const bf16_t*)(tm + TM_SXD); bf16_t* O = (bf16_t*)(tm + TM_VS);
    const bf16_t* cb0 = (const bf16_t*)(tm + TM_SCB) + (size_t)g * 32768; const bf16_t* sl0 = (const bf16_t*)(tm + TM_SSL) + (size_t)h * 16384;
    const int vj = tid >> 1, vh = tid & 1;
    u32x4 vreg = {0u, 0u, 0u, 0u}; float vdl = 0.f, vdj = 0.f;
#define SSD_LOADV(c) do { if (tid < 256) { vreg = *(const u32x4*)(XD + (size_t)((c) * 128 + vj) * 1024 + h * 64 + p0 + 8 * vh); \
        vdl = acum[(size_t)((c) * 128 + 127) * 16 + h]; vdj = acum[(size_t)((c) * 128 + vj) * 16 + h]; } } while (0)
#define SSD_STOREV(b) do { if (tid < 256) { const float vdn = __expf(vdl - vdj); LAS bf16_t* vt = Vt + (b) * 16 * LDP + (8 * vh) * LDP + vj; LAS bf16_t* vd = Vd + (b) * 16 * LDP + (8 * vh) * LDP + vj; \
        _Pragma("unroll") for (int j = 0; j < 4; ++j) { const float lo = bf_lo(vreg[j]), hi = bf_hi(vreg[j]); vt[(2 * j) * LDP] = (bf16_t)(vreg[j] & 0xffffu); vt[(2 * j + 1) * LDP] = (bf16_t)(vreg[j] >> 16); \
            vd[(2 * j) * LDP] = (bf16_t)f2bf(lo * vdn); vd[(2 * j + 1) * LDP] = (bf16_t)f2bf(hi * vdn); } } } while (0)
#define SSD_LOADF(FR, AR, c) do { const bf16_t* bc = cb0 + (size_t)(c) * 2 * 32768; const bf16_t* bs = sl0 + (size_t)(c) * 16 * 16384; _Pragma("unroll") for (int kk = 0; kk < 4; ++kk) { \
        FR[kk] = *(const bf16x8*)(bc + (w * 4 + kk) * 512 + lane * 8); if (kk <= (w >> 1)) FR[4 + kk] = *(const bf16x8*)(bs + (w * 4 + kk) * 512 + lane * 8); FR[8 + kk] = *(const bf16x8*)(bc + 16384 + (w * 4 + kk) * 512 + lane * 8); } \
        _Pragma("unroll") for (int r = 0; r < 4; ++r) AR[r] = acum[(size_t)((c) * 128 + 16 * w + 4 * q + r) * 16 + h]; AR[4] = acum[(size_t)((c) * 128 + 127) * 16 + h]; } while (0)
    for (int i = tid; i < 16 * LDP; i += 512) St[i] = 0;
    SSD_LOADV(0); SSD_STOREV(0);
    bf16x8 fa[12], fb[12]; float aa[5], ab[5];
    SSD_LOADF(fa, aa, 0);
    f32x4 S = {0.f, 0.f, 0.f, 0.f};
    __syncthreads();
#define SSD_CHUNK(c, CUR, NXT, ACUR, ANXT) do { const int b = (c) & 1; \
        if ((c) + 1 < T / 128) { SSD_LOADF(NXT, ANXT, (c) + 1); SSD_LOADV((c) + 1); } \
        f32x4 a1 = {0.f, 0.f, 0.f, 0.f}, a2 = {0.f, 0.f, 0.f, 0.f}; f32x4 sa = S * __expf(ACUR[4]); \
        _Pragma("unroll") for (int kk = 0; kk < 4; ++kk) { const bf16x8 bS = ldsfrag(St + b * 16 * LDP, LDP, r16, kk, q), bV = ldsfrag(Vt + b * 16 * LDP, LDP, r16, kk, q), bD = ldsfrag(Vd + b * 16 * LDP, LDP, r16, kk, q); \
            a1 = MFMA16(CUR[kk], bS, a1); if (kk <= (w >> 1)) a2 = MFMA16(CUR[4 + kk], bV, a2); sa = MFMA16(CUR[8 + kk], bD, sa); } \
        S = sa; \
        _Pragma("unroll") for (int r = 0; r < 4; ++r) O[(size_t)((c) * 128 + 16 * w + 4 * q + r) * 1024 + h * 64 + p0 + r16] = (bf16_t)f2bf(__expf(ACUR[r]) * a1[r] + a2[r]); \
        { u32x2 o; o.x = pk2(S[0], S[1]); o.y = pk2(S[2], S[3]); *(LAS u32x2*)(St + (b ^ 1) * 16 * LDP + r16 * LDP + 16 * w + 4 * q) = o; } \
        if ((c) + 1 < T / 128) SSD_STOREV(b ^ 1); \
        LDS_BARRIER(); } while (0)
    for (int c = 0; c < T / 128; c += 2) { SSD_CHUNK(c, fa, fb, aa, ab); SSD_CHUNK(c + 1, fb, fa, ab, aa); }
#undef SSD_CHUNK
#undef SSD_LOADF
#undef SSD_LOADV
#undef SSD_STOREV
}


constexpr size_t GDN_BLK = 36864;
__device__ __forceinline__ void gdn_pre_unit(Frame& F, int layer, int n, int h) {
    const int tid = opaque_tid(), lane = tid & 63, w = F.wave, r16 = lane & 15, q = lane >> 4;
    LAS bf16_t* Qs = (LAS bf16_t*)(F.lds); LAS bf16_t* Ks = (LAS bf16_t*)(F.lds + 17408); LAS bf16_t* Kd = (LAS bf16_t*)(F.lds + 34816);
    LAS float* Mm = (LAS float*)(F.lds + 52224); LAS float* Rr = (LAS float*)(F.lds + 69632); LAS float* gc = (LAS float*)(F.lds + 135168); LAS float* be = gc + 64;
    LAS bf16_t* Xt = Qs;
    LAS bf16_t* Mb = (LAS bf16_t*)(F.lds + 135680);
    const bf16_t* proj = WSP(bf16_t, WS_PROJ); const float* small = WSP(float, WS_SMALL);
    unsigned char* tm = F.ws + WS_TMP;
    bf16_t* blk = (bf16_t*)(tm + TM_KG) + (size_t)(n * 8 + h) * GDN_BLK;
    const float* gcw = FIN(3) + (size_t)layer * 3072 * 4; const float* galog = FIN(4) + layer * 8; const float* gdtb = FIN(5) + layer * 8;
    const int t0 = n * 64;
    f32x4 wt[3][2];
#pragma unroll
      for (int p = 0; p < 3; ++p)
#pragma unroll
          for (int e = 0; e < 2; ++e) wt[p][e] = *(const f32x4*)(gcw + (size_t)(p * 1024 + h * 128 + 2 * lane + e) * 4);
    const bf16_t* pc = proj + C_DQ + h * 128 + 2 * lane; const int tb = t0 + 8 * w;
    unsigned xw[3][11];
#pragma unroll
      for (int p = 0; p < 3; ++p)
#pragma unroll
          for (int k = 0; k < 11; ++k) xw[p][k] = (tb - 3 + k >= 0) ? *(const unsigned*)(pc + (size_t)(tb - 3 + k) * NPP + p * 1024) : 0u;
    if (w == 0) { const float g = -__expf(galog[h]) * softplusf_(small[(size_t)(t0 + lane) * 32 + h] + gdtb[h]); float incl = g;
#pragma unroll
        for (int o = 1; o < 64; o <<= 1) { const float tmp = __shfl_up(incl, o); if (lane >= o) incl += tmp; }
        gc[lane] = incl; be[lane] = sigmoidf_(small[(size_t)(t0 + lane) * 32 + 8 + h]);
        if (lane == 63) ((float*)(tm + TM_SM))[n * 8 + h] = __expf(incl); }
    LDS_BARRIER();
    {
      const float gl63 = gc[63];
#pragma unroll
      for (int i = 0; i < 8; ++i) { const int tok = 8 * w + i; float v[3][2];
#pragma unroll
          for (int p = 0; p < 3; ++p) {
              v[p][0] = siluf_(wt[p][0][0] * bf_lo(xw[p][i]) + wt[p][0][1] * bf_lo(xw[p][i + 1]) + wt[p][0][2] * bf_lo(xw[p][i + 2]) + wt[p][0][3] * bf_lo(xw[p][i + 3]));
              v[p][1] = siluf_(wt[p][1][0] * bf_hi(xw[p][i]) + wt[p][1][1] * bf_hi(xw[p][i + 1]) + wt[p][1][2] * bf_hi(xw[p][i + 2]) + wt[p][1][3] * bf_hi(xw[p][i + 3])); }
          const float sq = wave_sum(v[0][0] * v[0][0] + v[0][1] * v[0][1]), sk = wave_sum(v[1][0] * v[1][0] + v[1][1] * v[1][1]);
          const float rq = rsqrtf(sq + RMS_EPS) * 0.08838834764831845f, rk = rsqrtf(sk + RMS_EPS);
          const float gci = gc[tok], bei = be[tok], eg = __expf(gci), et = __expf(gl63 - gci);
          const float q0 = v[0][0] * rq, q1 = v[0][1] * rq, k0 = v[1][0] * rk, k1 = v[1][1] * rk;
          *(LAS unsigned*)(Qs + tok * LDP + 2 * lane) = pk2(q0, q1); *(LAS unsigned*)(Ks + tok * LDP + 2 * lane) = pk2(k0, k1); *(LAS unsigned*)(Kd + tok * LDP + 2 * lane) = pk2(k0 * et, k1 * et);
          *(LAS f32x2*)(Rr + tok * 256 + 2 * lane) = (f32x2){bei * v[2][0], bei * v[2][1]}; *(LAS f32x2*)(Rr + tok * 256 + 128 + 2 * lane) = (f32x2){bei * eg * k0, bei * eg * k1};
          *(unsigned*)(blk + 16384 + fragoff(tok, lane >> 2, 4) + 2 * (lane & 3)) = pk2(q0 * eg, q1 * eg); } }
    LDS_BARRIER();
    if (w < 4) { bf16x8 aK[4];
#pragma unroll
        for (int kk = 0; kk < 4; ++kk) aK[kk] = ldsfrag(Ks, LDP, 16 * w + r16, kk, q);
        for (int jt = 0; jt <= w; ++jt) { f32x4 acc = {0.f, 0.f, 0.f, 0.f};
#pragma unroll
            for (int kk = 0; kk < 4; ++kk) acc = MFMA16(aK[kk], ldsfrag(Ks, LDP, 16 * jt + r16, kk, q), acc);
            const int j = 16 * jt + r16; const float gj = gc[j];
#pragma unroll
            for (int r = 0; r < 4; ++r) { const int i = 16 * w + 4 * q + r; const float mv = (j < i) ? be[i] * acc[r] * __expf(gc[i] - gj) : 0.f; Mm[i * 68 + j] = mv; Mb[i * 72 + j] = (bf16_t)f2bf(mv); } } }
    else { const int wq = w - 4, i = 16 * wq + r16; bf16x8 bQ[4];
#pragma unroll
        for (int kk = 0; kk < 4; ++kk) bQ[kk] = ldsfrag(Qs, LDP, i, kk, q);
        const float gi = gc[i];
        for (int jt = 0; jt < 4; ++jt) { u32x2 o = {0u, 0u};
            if (jt <= wq) { f32x4 acc = {0.f, 0.f, 0.f, 0.f};
#pragma unroll
                for (int kk = 0; kk < 4; ++kk) acc = MFMA16(ldsfrag(Ks, LDP, 16 * jt + r16, kk, q), bQ[kk], acc);
                float v[4];
#pragma unroll
                for (int r = 0; r < 4; ++r) { const int j = 16 * jt + 4 * q + r; v[r] = (j <= i) ? acc[r] * __expf(gi - gc[j]) : 0.f; }
                o.x = pk2(v[0], v[1]); o.y = pk2(v[2], v[3]); }
            *(u32x2*)(blk + 24576 + fragoff(i, 2 * jt + (q >> 1), 2) + 4 * (q & 1)) = o; } }
    { const int d = tid >> 2, jq = tid & 3; bf16_t* gp = blk + 28672;
#pragma unroll
      for (int c = 0; c < 2; ++c) { u32x4 o;
#pragma unroll
          for (int j = 0; j < 4; ++j) { const unsigned lo = Kd[(16 * jq + 8 * c + 2 * j) * LDP + d], hi = Kd[(16 * jq + 8 * c + 2 * j + 1) * LDP + d]; o[j] = lo | (hi << 16); }
          *(u32x4*)(gp + fragoff(d, 2 * jq + c, 2)) = o; } }
    LDS_BARRIER();
#pragma unroll
    for (int b = 0; b < 4; ++b) {
        if (b > 0) {
#pragma unroll
            for (int t2 = 0; t2 < 2; ++t2) { const int nt = 2 * w + t2; f32x4 acc = {0.f, 0.f, 0.f, 0.f};
#pragma unroll
                for (int ks = 0; ks < (b + 1) / 2; ++ks) { bf16x8 a = *(const LAS bf16x8*)(Mb + (16 * b + r16) * 72 + 32 * ks + 8 * q);
                    bf16x8 xb = *(const LAS bf16x8*)(Xt + (16 * nt + r16) * 72 + 32 * ks + 8 * q);
                    if (32 * ks + 8 * q >= 16 * b) { a = (bf16x8){0, 0, 0, 0, 0, 0, 0, 0}; xb = a; }
                    acc = MFMA16(a, xb, acc); }
#pragma unroll
                for (int r = 0; r < 4; ++r) Rr[(16 * b + 4 * q + r) * 256 + 16 * nt + r16] -= acc[r]; }
            LDS_BARRIER();
        }
        if (tid < 256) { float x[16];
#pragma unroll
            for (int ii = 0; ii < 16; ++ii) { float s = Rr[(16 * b + ii) * 256 + tid];
#pragma unroll
                for (int j4 = 0; j4 < (ii + 3) / 4; ++j4) { const f32x4 m4 = *(const LAS f32x4*)(Mm + (16 * b + ii) * 68 + 16 * b + 4 * j4);
#pragma unroll
                    for (int jj = 0; jj < 4; ++jj) if (4 * j4 + jj < ii) s -= m4[jj] * x[4 * j4 + jj]; }
                x[ii] = s; }
            u32x4 o0, o1; o0.x = pk2(x[0], x[1]); o0.y = pk2(x[2], x[3]); o0.z = pk2(x[4], x[5]); o0.w = pk2(x[6], x[7]); o1.x = pk2(x[8], x[9]); o1.y = pk2(x[10], x[11]); o1.z = pk2(x[12], x[13]); o1.w = pk2(x[14], x[15]);
            *(LAS u32x4*)(Xt + tid * 72 + 16 * b) = o0; *(LAS u32x4*)(Xt + tid * 72 + 16 * b + 8) = o1; }
        LDS_BARRIER();
    }
    { const int e = tid >> 2, part = tid & 3; const u32x4 a0 = *(const LAS u32x4*)(Xt + e * 72 + 16 * part), a1 = *(const LAS u32x4*)(Xt + e * 72 + 16 * part + 8);
      bf16_t* up = blk + 8192 + (((e >> 4) * 4 + part) * 64 + (e & 15)) * 4;
      *(u32x2*)(up) = (u32x2){a0[0], a0[1]}; *(u32x2*)(up + 64) = (u32x2){a0[2], a0[3]}; *(u32x2*)(up + 128) = (u32x2){a1[0], a1[1]}; *(u32x2*)(up + 192) = (u32x2){a1[2], a1[3]}; }
#pragma unroll
    for (int k = 0; k < 2; ++k) { const int idx = tid + 512 * k, row = idx >> 4, d8 = idx & 15; u32x4 o;
#pragma unroll
        for (int j = 0; j < 4; ++j) { const unsigned lo = Xt[(128 + 8 * d8 + 2 * j) * 72 + row], hi = Xt[(128 + 8 * d8 + 2 * j + 1) * 72 + row]; o[j] = lo | (hi << 16); }
        *(u32x4*)(blk + fragoff(row, d8, 4)) = o; }
    LDS_BARRIER();
}

__device__ __forceinline__ void gdn_seq_unit(Frame& F, int u) {
    const int tid = opaque_tid(), lane = tid & 63, w = F.wave, r16 = lane & 15, q = lane >> 4;
    const int h = u >> 3, e0 = (u & 7) * 16, mt = w & 3; const bool lo = w < 4;
    LAS bf16_t* St = (LAS bf16_t*)(F.lds); LAS bf16_t* Vt = (LAS bf16_t*)(F.lds + 16 * LDP * 2);
    unsigned char* tm = F.ws + WS_TMP; bf16_t* O = (bf16_t*)(tm + TM_VG);
    const bf16_t* blk0 = (const bf16_t*)(tm + TM_KG) + (size_t)h * GDN_BLK;
    const float* glp = (const float*)(tm + TM_SM) + h + (lane & 0);
    const int p0off = lo ? 0 : 16384;
#define GDN_LOADF(S, c) do { const int cc = (c) < T / 64 ? (c) : T / 64 - 1; const bf16_t* bk = blk0 + (size_t)cc * 8 * GDN_BLK + lane * 8;        \
        _Pragma("unroll") for (int kk = 0; kk < 4; ++kk) { const bf16_t* p = bk + p0off + (mt * 4 + kk) * 512; asm volatile("global_load_dwordx4 %0, %1, off" : "=v"(fr[S][kk]) : "v"(p) : "memory"); } \
        _Pragma("unroll") for (int kk = 0; kk < 2; ++kk) { const bf16_t* p = bk + 28672 + (w * 2 + kk) * 512; asm volatile("global_load_dwordx4 %0, %1, off" : "=v"(fr[S][4 + kk]) : "v"(p) : "memory"); } \
        _Pragma("unroll") for (int kk = 0; kk < 2; ++kk) { const bf16_t* p = (lo || (kk == 1 && mt < 2)) ? bk + 28672 + (w * 2) * 512 : bk + 24576 + (mt * 2 + kk) * 512;        \
            asm volatile("global_load_dwordx4 %0, %1, off" : "=v"(fr[S][6 + kk]) : "v"(p) : "memory"); } \
        { const bf16_t* p = lo ? blk0 + (size_t)cc * 8 * GDN_BLK + 8192 + (((u & 7) * 4 + mt) * 64 + lane) * 4 : bk + 28672 + (w * 2) * 512; asm volatile("global_load_dwordx2 %0, %1, off" : "=v"(uu[S]) : "v"(p) : "memory"); } \
        { const float* p = glp + cc * 8; asm volatile("global_load_dword %0, %1, off" : "=v"(gg[S]) : "v"(p) : "memory"); } } while (0)
#define GDN_WAIT(S) do { asm volatile("s_waitcnt vmcnt(30)" : "+v"(fr[S][0]), "+v"(fr[S][1]), "+v"(fr[S][2]), "+v"(fr[S][3]), "+v"(fr[S][4]), "+v"(fr[S][5]), "+v"(fr[S][6]), "+v"(fr[S][7]), "+v"(uu[S]), "+v"(gg[S]) :: "memory"); \
        __builtin_amdgcn_sched_barrier(0); } while (0)
    for (int i = tid; i < 16 * LDP; i += 512) St[i] = 0;
    bf16x8 fr[4][8]; u32x2 uu[4]; float gg[4];
    GDN_LOADF(0, 0); GDN_LOADF(1, 1); GDN_LOADF(2, 2);
    f32x4 S = {0.f, 0.f, 0.f, 0.f};
    LDS_BARRIER();
#define GDN_CHUNK(c, CS, LS) do { \
        GDN_LOADF(LS, (c) + 3); \
        const bf16x8 bs0 = ldsfrag(St, LDP, r16, 0, q), bs1 = ldsfrag(St, LDP, r16, 1, q), bs2 = ldsfrag(St, LDP, r16, 2, q), bs3 = ldsfrag(St, LDP, r16, 3, q);     \
        GDN_WAIT(CS); \
        f32x4 a0 = {0.f, 0.f, 0.f, 0.f}; \
        a0 = MFMA16(fr[CS][0], bs0, a0); a0 = MFMA16(fr[CS][1], bs1, a0); a0 = MFMA16(fr[CS][2], bs2, a0); a0 = MFMA16(fr[CS][3], bs3, a0); \
        if (lo) { u32x2 o; o.x = pk2(bf_lo(uu[CS].x) - a0[0], bf_hi(uu[CS].x) - a0[1]); o.y = pk2(bf_lo(uu[CS].y) - a0[2], bf_hi(uu[CS].y) - a0[3]); *(LAS u32x2*)(Vt + r16 * 72 + 16 * mt + 4 * q) = o; } \
        LDS_BARRIER(); \
        const bf16x8 bV0 = ldsfrag(Vt, 72, r16, 0, q), bV1 = ldsfrag(Vt, 72, r16, 1, q); \
        f32x4 sa = S * gg[CS]; sa = MFMA16(fr[CS][4], bV0, sa); sa = MFMA16(fr[CS][5], bV1, sa); S = sa; \
        { u32x2 o; o.x = pk2(S[0], S[1]); o.y = pk2(S[2], S[3]); *(LAS u32x2*)(St + r16 * LDP + 16 * w + 4 * q) = o; } \
        if (!lo) { a0 = MFMA16(fr[CS][6], bV0, a0); if (mt >= 2) a0 = MFMA16(fr[CS][7], bV1, a0);        \
            const unsigned p01 = pk2(a0[0], a0[1]), p23 = pk2(a0[2], a0[3]); bf16_t* op = O + (size_t)((c) * 64 + 16 * mt + 4 * q) * 1024 + h * 128 + e0 + r16; \
            op[0] = (bf16_t)(p01 & 0xffffu); op[1024] = (bf16_t)(p01 >> 16); op[2048] = (bf16_t)(p23 & 0xffffu); op[3072] = (bf16_t)(p23 >> 16); } \
        LDS_BARRIER(); } while (0)
    for (int c = 0; c < T / 64; c += 4) { GDN_CHUNK(c, 0, 3); GDN_CHUNK(c + 1, 1, 0); GDN_CHUNK(c + 2, 2, 1); GDN_CHUNK(c + 3, 3, 2); }
    asm volatile("s_waitcnt vmcnt(0)" ::: "memory");
#undef GDN_WAIT
#undef GDN_CHUNK
#undef GDN_LOADF
}

__device__ __forceinline__ void mixer_phase(Frame& F, int layer) {
    for (int u = F.vcu; u < 256; u += F.G) {
        if (u < 64) { gdn_seq_unit(F, u); if (MIXREP & 1) gdn_seq_unit(F, u); }
        else if (u < 128) { s5_unit(F, layer, u - 64); if (MIXREP & 2) s5_unit(F, layer, u - 64); }
        else if (u < 192) { ret_seq_unit(F, u - 128); if (MIXREP & 4) ret_seq_unit(F, u - 128); }
        else { ssd_seq_unit(F, u - 192); if (MIXREP & 8) ssd_seq_unit(F, u - 192); }
    }
}
__device__ __forceinline__ void pre_phase(Frame& F, int layer) {
    for (int u = F.vcu; u < 1280; u += F.G) {
        if (u < 1024) { gdn_pre_unit(F, layer, u >> 3, u & 7); if (MIXREP & 16) gdn_pre_unit(F, layer, u >> 3, u & 7); }
        else if (u < 1152) { ssd_pre_unit(F, layer, (u - 1024) >> 1, (u - 1024) & 1); if (MIXREP & 32) ssd_pre_unit(F, layer, (u - 1024) >> 1, (u - 1024) & 1); }
        else { const int ru = 2 * (u - 1152);
            ret_pre_unit(F, ru >> 2, ru & 3); ret_pre_unit(F, (ru + 1) >> 2, (ru + 1) & 3); if (MIXREP & 64) ret_pre_unit(F, ru >> 2, ru & 3); }
    }
}

__device__ __forceinline__ void post_phase(Frame& F, int layer) {
    const int gw = F.vcu * 8 + F.wave, NGW = F.G * 8, lane = opaque_tid() & 63;
    const bf16_t* proj = WSP(bf16_t, WS_PROJ); bf16_t* ycat = WSP(bf16_t, WS_YCAT);
    unsigned char* tm = F.ws + WS_TMP;
    const bf16_t* Or = (const bf16_t*)(tm + TM_VR); const bf16_t* Os = (const bf16_t*)(tm + TM_VS); const bf16_t* Og = (const bf16_t*)(tm + TM_VG);
    const float* gnw = FIN(6) + layer * 128; const bf16_t* XS = (const bf16_t*)(tm + TM_SXS);
    const float* sdk = FIN(21) + layer * 16; const float* snw = FIN(22) + layer * 1024;
    const bool deal = (F.G == 256); const int bx = blockIdx.x;
    const int tbeg = deal ? (bx < 128 ? (bx * 8 + F.wave) * 3 : 3072 + ((bx - 128) * 8 + F.wave) * 5) : gw;
    const int tcnt = deal ? (bx < 128 ? 3 : 5) : (T - gw + NGW - 1) / NGW, tstep = deal ? 1 : NGW;
#define UNPK8(dst, VV) do { dst[0] = bf_lo(VV[0]); dst[1] = bf_hi(VV[0]); dst[2] = bf_lo(VV[1]); dst[3] = bf_hi(VV[1]); dst[4] = bf_lo(VV[2]); dst[5] = bf_hi(VV[2]); dst[6] = bf_lo(VV[3]); dst[7] = bf_hi(VV[3]); } while (0)
#define PK8(VV, SRC) do { VV[0] = pk2(SRC[0], SRC[1]); VV[1] = pk2(SRC[2], SRC[3]); VV[2] = pk2(SRC[4], SRC[5]); VV[3] = pk2(SRC[6], SRC[7]); } while (0)
    for (int ti = 0; ti < tcnt; ++ti) { const int t = tbeg + ti * tstep;
        const bf16_t* pr = proj + (size_t)t * NPP; bf16_t* yo = ycat + (size_t)t * 4096;
        u32x4 wo[6], wg[6], wx[2];
#pragma unroll
        for (int s = 0; s < 2; ++s) { const int ch = 512 * s + 8 * lane;
            wo[s] = *(const u32x4*)(Or + (size_t)t * 1024 + ch); wg[s] = *(const u32x4*)(pr + C_RG + ch);
            wo[2 + s] = *(const u32x4*)(Og + (size_t)t * 1024 + ch); wg[2 + s] = *(const u32x4*)(pr + C_DZ + ch);
            wo[4 + s] = *(const u32x4*)(Os + (size_t)t * 1024 + ch); wg[4 + s] = *(const u32x4*)(pr + C_MZ + ch); wx[s] = *(const u32x4*)(XS + (size_t)t * 1024 + ch); }
        const f32x4 gn0 = *(const f32x4*)(gnw + 8 * (lane & 15)), gn1 = *(const f32x4*)(gnw + 8 * (lane & 15) + 4);
#pragma unroll
        for (int s = 0; s < 2; ++s) { const int ch = 512 * s + 8 * lane;
            { float y[8], gt[8]; UNPK8(y, wo[s]); UNPK8(gt, wg[s]);
              float sm = ((y[0] + y[1]) + (y[2] + y[3])) + ((y[4] + y[5]) + (y[6] + y[7])); sm = row_sum16(sm); sm += __shfl_xor(sm, 16);
              const float mu = sm * (1.f / 256.f); float s2 = 0.f;
#pragma unroll
              for (int i = 0; i < 8; ++i) { y[i] -= mu; s2 += y[i] * y[i]; }
              s2 = row_sum16(s2); s2 += __shfl_xor(s2, 16);
              const float rs = rsqrtf(s2 * (1.f / 256.f) + LN_EPS);
#pragma unroll
              for (int i = 0; i < 8; ++i) y[i] = y[i] * rs * siluf_(gt[i]);
              u32x4 ow; PK8(ow, y); *(u32x4*)(yo + ch) = ow; }
            { float y[8], gt[8]; UNPK8(y, wo[2 + s]); UNPK8(gt, wg[2 + s]);
              float s2 = 0.f;
#pragma unroll
              for (int i = 0; i < 8; ++i) s2 += y[i] * y[i];
              s2 = row_sum16(s2);
              const float rs = rsqrtf(s2 * (1.f / 128.f) + RMS_EPS);
#pragma unroll
              for (int i = 0; i < 8; ++i) y[i] = y[i] * rs * (i < 4 ? gn0[i] : gn1[i - 4]) * siluf_(gt[i]);
              u32x4 ow; PK8(ow, y); *(u32x4*)(yo + 1024 + ch) = ow; }
            { float y[8], gt[8], xh[8]; UNPK8(y, wo[4 + s]); UNPK8(gt, wg[4 + s]); UNPK8(xh, wx[s]);
              const float d = sdk[8 * s + (lane >> 3)]; float s2 = 0.f;
#pragma unroll
              for (int i = 0; i < 8; ++i) { y[i] = (y[i] + d * xh[i]) * siluf_(gt[i]); s2 += y[i] * y[i]; }
              s2 = wave_sum(s2);
              const float rs = rsqrtf(s2 * (1.f / 512.f) + RMS_EPS);
              const f32x4 n0 = *(const f32x4*)(snw + ch), n1 = *(const f32x4*)(snw + ch + 4);
#pragma unroll
              for (int i = 0; i < 8; ++i) y[i] = y[i] * rs * (i < 4 ? n0[i] : n1[i - 4]);
              u32x4 ow; PK8(ow, y); *(u32x4*)(yo + 3072 + ch) = ow; } }
    }
#undef UNPK8
#undef PK8
}

__device__ __forceinline__ void ln_phase(Frame& F, const float* in, const float* res, const float* gam, const float* bet, float* outf, bf16_t* outb) {
    const int gw = F.vcu * 8 + F.wave, NGW = F.G * 8, lane = opaque_tid() & 63;
    for (int t = gw; t < T; t += NGW) {
        const f32x4* xr = (const f32x4*)(in + (size_t)t * DM) + lane; const f32x4* rr = (const f32x4*)(res + (size_t)t * DM) + lane;
        f32x4 v[8]; float s = 0.f;
#pragma unroll
        for (int j = 0; j < 8; ++j) { v[j] = xr[64 * j] + rr[64 * j] * ALPHA; s += (v[j][0] + v[j][1]) + (v[j][2] + v[j][3]); }
        const float mean = wave_sum(s) * (1.f / DM); float s2 = 0.f;
#pragma unroll
        for (int j = 0; j < 8; ++j) { v[j] = v[j] - mean; s2 += (v[j][0] * v[j][0] + v[j][1] * v[j][1]) + (v[j][2] * v[j][2] + v[j][3] * v[j][3]); }
        const float rstd = rsqrtf(wave_sum(s2) * (1.f / DM) + LN_EPS);
#pragma unroll
        for (int j = 0; j < 8; ++j) { const f32x4 gm = *((const f32x4*)gam + lane + 64 * j), bt = *((const f32x4*)bet + lane + 64 * j);
            const f32x4 o = v[j] * rstd * gm + bt;
            *((f32x4*)(outf + (size_t)t * DM) + lane + 64 * j) = o;
            u32x2 w; w.x = pk2(o[0], o[1]); w.y = pk2(o[2], o[3]); *((u32x2*)(outb + (size_t)t * DM) + lane + 64 * j) = w; }
    }
}

constexpr int N_PHASES = 1 + 10 * NLAYER;
__global__ void __launch_bounds__(512, 2) mega(Args args) {
    extern __shared__ __attribute__((aligned(16))) unsigned char lds_raw[];
    Frame F;
    F.lds = (LAS unsigned char*)lds_raw;
    F.tid = threadIdx.x; F.lane = F.tid & 63; F.wave = __builtin_amdgcn_readfirstlane(F.tid >> 6);
    F.G = gridDim.x; { const int bx = blockIdx.x; F.vcu = (F.G % 8 == 0) ? (bx % 8) * (F.G / 8) + bx / 8 : bx; }
    F.in = args.in; F.ws = args.ws; F.out = args.out;
    for (int u = F.tid; u < (LDS_BYTES - LDSCTL_OFF) / 4; u += 512) ((LAS unsigned*)(F.lds + LDSCTL_OFF))[u] = 0u;
    __syncthreads();
    const int lo = args.ph_lo, hi = args.ph_hi;
    unsigned* barw = (unsigned*)(args.ws + WS_CTL) + CW_BAR + args.li * XCD_BAR_WORDS;
    XcdBarrier bar; bar.bar = barw; bar.x = 0; bar.st = nullptr;
    if (hi - lo > 1) bar = xcd_barrier_post(barw, (volatile LAS unsigned*)(F.lds + MISC_OFF) + 8);
#define IN(k) (lo <= (k) && (k) < hi)
#define SEAM(k) do { if ((k) + 1 < hi) xcd_barrier(bar); } while (0)

    if (IN(0)) { p0_prologue(F); if (REPMASK & 1) { xcd_barrier(bar); p0_prologue(F); } SEAM(0); }

    for (int layer = 0; layer < NLAYER; ++layer) {
        const int pb = 1 + 10 * layer;
        unsigned char* wt = F.ws + WS_WT + (size_t)layer * WT_LAYER;
        const float* xcur = layer == 0 ? FIN(0) : WSP(float, WS_XR0);
#define B_INPROJ do { pg8::Gemm g{WSP(bf16_t, WS_XB), (const bf16_t*)(wt + WT_IN), T, NP_MAIN, DM, DM, DM, 0, 0}; pg8::StaticOrder S; S.init(T, NP_MAIN, F.G, (int)blockIdx.x); \
            pg8::EpiProj E{WSP(bf16_t, WS_PROJ), WSP(float, WS_SMALL), 0}; pg8::gemm_phase<pg8::EpiProj, pg8::StaticOrder, true, true>(F.lds, g, S, E); } while (0)
#define B_INPROJ_DEFER do { pg8::Gemm g{WSP(bf16_t, WS_XB), (const bf16_t*)(wt + WT_IN) + (size_t)NP_MAIN * DM, T, NPP - NP_MAIN, DM, DM, DM, 0, 0}; pg8::DeferOrder S; S.init(T, NPP - NP_MAIN, F.G, (F.vcu + F.G - 128 % F.G) % F.G); \
            pg8::EpiProj E{WSP(bf16_t, WS_PROJ) + NP_MAIN, WSP(float, WS_SMALL), NP_MAIN}; pg8::gemm_phase<pg8::EpiProj, pg8::DeferOrder, true, true>(F.lds, g, S, E); } while (0)
#define B_PREP pre_phase(F, layer)
#define B_MIX do { B_INPROJ_DEFER; if (MIXREP & 128) B_INPROJ_DEFER; mixer_phase(F, layer); } while (0)
#define B_GLUPOST do { pg8::Gemm g{WSP(bf16_t, WS_YS5), (const bf16_t*)(wt + WT_GLU), T, 1024, 1024, 1024, 1024, 0, 0}; pg8::StaticOrder S; S.init(T, 1024, F.G, (int)blockIdx.x); \
            pg8::EpiGlu E{WSP(bf16_t, WS_YS5), FIN(16) + layer * 1024, WSP(bf16_t, WS_YCAT)}; pg8::gemm_phase<pg8::EpiGlu, pg8::StaticOrder, true, true>(F.lds, g, S, E); post_phase(F, layer); } while (0)
#define B_MERGE do { pg8::Gemm g{WSP(bf16_t, WS_YCAT), (const bf16_t*)(wt + WT_BR), T, DM, 1024, 4096, 1024, 2048, 4 * MiB}; pg8::SegOrder<4> S; S.init(T, DM, F.G, (int)blockIdx.x); \
            pg8::EpiMerge E{WSP(bf16_t, WS_PROJ), (bf16_t*)(F.ws + WS_TMP + TM_MERGED)}; pg8::gemm_phase<pg8::EpiMerge, pg8::SegOrder<4>, true, true>(F.lds, g, S, E); } while (0)
#define B_WOUT do { pg8::Gemm g{(const bf16_t*)(F.ws + WS_TMP + TM_MERGED), (const bf16_t*)(wt + WT_OUT), T, DM, DM, DM, DM, 0, 0}; pg8::StaticOrder S; S.init(T, DM, F.G, (int)blockIdx.x); \
            pg8::EpiResid E{xcur, (float*)(F.ws + WS_TMP + TM_PRE)}; pg8::gemm_phase<pg8::EpiResid, pg8::StaticOrder, true, true>(F.lds, g, S, E); } while (0)
#define B_LN1 ln_phase(F, (const float*)(F.ws + WS_TMP + TM_PRE), xcur, FIN(28) + layer * DM, FIN(29) + layer * DM, WSP(float, WS_XR1), WSP(bf16_t, WS_XB))
#define B_UP do { pg8::Gemm g{WSP(bf16_t, WS_XB), (const bf16_t*)(wt + WT_UP), T, DFF, DM, DM, DM, 0, 0}; pg8::StaticOrder S; S.init(T, DFF, F.G, (int)blockIdx.x); \
            pg8::EpiRelu2 E{WSP(bf16_t, WS_HID)}; pg8::gemm_phase<pg8::EpiRelu2, pg8::StaticOrder, true, true>(F.lds, g, S, E); } while (0)
#define B_DOWN do { pg8::Gemm g{WSP(bf16_t, WS_HID), (const bf16_t*)(wt + WT_DOWN), T, DM, DFF, DFF, DFF, 0, 0}; pg8::StaticOrder S; S.init(T, DM, F.G, (int)blockIdx.x); \
            pg8::EpiResid E{WSP(float, WS_XR1), (float*)(F.ws + WS_TMP + TM_PRE)}; pg8::gemm_phase<pg8::EpiResid, pg8::StaticOrder, true, true>(F.lds, g, S, E); } while (0)
#define B_LN2 ln_phase(F, (const float*)(F.ws + WS_TMP + TM_PRE), WSP(float, WS_XR1), FIN(32) + layer * DM, FIN(33) + layer * DM, layer == NLAYER - 1 ? F.out : WSP(float, WS_XR0), WSP(bf16_t, WS_XB))
#define PH(k, body) do { if (IN(pb + (k))) { body; if ((REPMASK >> ((k) + 1)) & 1) { xcd_barrier(bar); body; } SEAM(pb + (k)); } } while (0)
        PH(0, B_INPROJ);
        PH(1, B_PREP);
        if (IN(pb + 2)) { B_MIX; if ((REPMASK >> 3) & 1) { xcd_barrier(bar); B_PREP; xcd_barrier(bar); B_MIX; } SEAM(pb + 2); }
        PH(3, B_GLUPOST);
        PH(4, B_MERGE);
        PH(5, B_WOUT);
        PH(6, B_LN1);
        PH(7, B_UP);
        PH(8, B_DOWN);
        PH(9, B_LN2);
    }
#undef IN
#undef SEAM
}

extern "C" void kernel_launch(void* const* d_in, const int* in_sizes, int n_in, void* d_out, int out_size, void* d_ws, size_t ws_size, hipStream_t stream) {
    static int grid = 0;
    if (grid == 0) {
        if (n_in != 34 || out_size != T * DM || ws_size < WS_END) { fprintf(stderr, "kernel_launch: unexpected sizes (n_in %d, out %d, ws %zu need %zu)\n", n_in, out_size, ws_size, (size_t)WS_END); grid = -1; return; }
        int dev = 0, cus = 0, per_cu = 0;
        if (hipGetDevice(&dev) != hipSuccess || hipDeviceGetAttribute(&cus, hipDeviceAttributeMultiprocessorCount, dev) != hipSuccess) { grid = -1; return; }
        if (hipFuncSetAttribute((const void*)mega, hipFuncAttributeMaxDynamicSharedMemorySize, LDS_BYTES) != hipSuccess) { fprintf(stderr, "kernel_launch: hipFuncSetAttribute failed\n"); grid = -1; return; }
        if (hipOccupancyMaxActiveBlocksPerMultiprocessor(&per_cu, (const void*)mega, 512, LDS_BYTES) != hipSuccess || per_cu < 1) fprintf(stderr, "kernel_launch: occupancy query reports %d\n", per_cu);
        (void)hipGetLastError();
        grid = cus;
    }
    if (grid < 0) return;
    if (hipMemsetAsync((char*)d_ws + WS_CTL, 0, CTL_ZERO_BYTES, stream) != hipSuccess) return;
    Args a{};
    for (int i = 0; i < 34; ++i) a.in[i] = d_in[i];
    a.out = (float*)d_out; a.ws = (unsigned char*)d_ws;
#if MK_N_LAUNCHES == 1
    a.ph_lo = 0; a.ph_hi = N_PHASES; a.li = 0;
    hipLaunchKernelGGL(mega, dim3(grid), dim3(512), LDS_BYTES, stream, a);
#else
    for (int p = 0; p < N_PHASES; ++p) { a.ph_lo = p; a.ph_hi = p + 1; a.li = p; hipLaunchKernelGGL(mega, dim3(grid), dim3(512), LDS_BYTES, stream, a); }
#endif
}
```

```cpp
#include <hip/hip_runtime.h>
#include <cstdio>
#include <cstdint>

#ifndef MK_N_LAUNCHES
#define MK_N_LAUNCHES 1
#endif

#ifndef WGM_INPROJ
#define WGM_INPROJ 2
#endif
#ifndef WGM_UP
#define WGM_UP 2
#endif
#ifndef WGM_N8
#define WGM_N8 2
#endif
#ifndef MIXREP
#define MIXREP 0
#endif
#ifndef REPMASK
#define REPMASK 0
#endif
#define LAS __attribute__((address_space(3)))
#define GAS __attribute__((address_space(1)))
typedef unsigned short bf16_t;
typedef short bf16x8 __attribute__((ext_vector_type(8)));
typedef float f32x4 __attribute__((ext_vector_type(4)));
typedef float f32x2 __attribute__((ext_vector_type(2)));
typedef unsigned u32x4 __attribute__((ext_vector_type(4)));
typedef unsigned u32x2 __attribute__((ext_vector_type(2)));

constexpr int T = 8192, DM = 2048, NPROJ = 18976, NPP = 19200, NP_MAIN = 18432, DFF = 8192, NLAYER = 2;
constexpr int C_RQ = 0, C_RK = 512, C_RV = 1024, C_RG = 2048, C_DQ = 3072, C_DK = 4096, C_DV = 5120, C_DZ = 6144, C_DA = 7168, C_DB = 7176,
              C_SU = 7184, C_MZ = 8208, C_MX = 9232, C_MB = 10256, C_MC = 10512, C_MDT = 10768, C_GATE = 10784;
constexpr float LN_EPS = 1e-5f, RMS_EPS = 1e-6f, ALPHA = 1.41421356237f;

constexpr size_t MiB = 1u << 20;
constexpr size_t WS_CTL = 0, CTL_ZERO_BYTES = 1 * MiB;
constexpr size_t WT_IN = 0, WT_GLU = 75 * MiB, WT_BR = 77 * MiB, WT_OUT = 93 * MiB, WT_UP = 101 * MiB, WT_DOWN = 133 * MiB, WT_LAYER = 165 * MiB;
constexpr size_t WS_WT = 1 * MiB;
constexpr size_t WS_PROJ = WS_WT + 2 * WT_LAYER;
constexpr size_t WS_HID = WS_PROJ;
constexpr size_t WS_SMALL = WS_PROJ + 300 * MiB;
constexpr size_t WS_TRIG = WS_SMALL + 1 * MiB;
constexpr size_t WS_S5P = WS_TRIG + 4 * MiB;
constexpr size_t WS_YCAT = WS_S5P + 2 * MiB;
constexpr size_t WS_YS5 = WS_YCAT + 64 * MiB;
constexpr size_t WS_XB = WS_YS5 + 16 * MiB;
constexpr size_t WS_XR0 = WS_XB + 32 * MiB;
constexpr size_t WS_XR1 = WS_XR0 + 64 * MiB;
constexpr size_t WS_TMP = WS_XR1 + 64 * MiB;
constexpr size_t TM_KR = 0, TM_VR = 32 * MiB,
                 TM_SCB = 64 * MiB, TM_SSL = 72 * MiB, TM_SXD = 104 * MiB, TM_SXS = 120 * MiB, TM_SAC = 136 * MiB, TM_VS = 138 * MiB,
                 TM_KG = 170 * MiB, TM_VG = 242 * MiB, TM_SM = 274 * MiB, TM_END = 278 * MiB;
constexpr size_t TM_MERGED = 0, TM_PRE = 32 * MiB;
constexpr size_t WS_END = WS_TMP + TM_END;
constexpr int CW_BAR = 4096;

constexpr int RING_BYTES = 131072, LDSCTL_OFF = 155648, MISC_OFF = LDSCTL_OFF + 320, LDS_BYTES = 163840;

__device__ __forceinline__ unsigned f2bf(float f) { return (unsigned)__builtin_bit_cast(unsigned short, (__bf16)f); }
__device__ __forceinline__ unsigned pk2(float lo, float hi) { typedef __bf16 bf2_t __attribute__((ext_vector_type(2))); const bf2_t v = {(__bf16)lo, (__bf16)hi}; return __builtin_bit_cast(unsigned, v); }
__device__ __forceinline__ float bf_lo(unsigned u) { return __builtin_bit_cast(float, u << 16); }
__device__ __forceinline__ float bf_hi(unsigned u) { return __builtin_bit_cast(float, u & 0xffff0000u); }
__device__ __forceinline__ float bf2f(bf16_t h) { return __builtin_bit_cast(float, (unsigned)h << 16); }
__device__ __forceinline__ float sigmoidf_(float x) { return 1.f / (1.f + __expf(-x)); }
__device__ __forceinline__ float siluf_(float x) { return x / (1.f + __expf(-x)); }
__device__ __forceinline__ float softplusf_(float x) { return x > 20.f ? x : log1pf(__expf(x)); }
template <int CTRL> __device__ __forceinline__ float dppf(float v) { return __builtin_bit_cast(float, __builtin_amdgcn_update_dpp(0, __builtin_bit_cast(int, v), CTRL, 0xF, 0xF, true)); }
__device__ __forceinline__ float row_sum16(float v) {
    v += dppf<0xB1>(v); v += dppf<0x4E>(v); v += dppf<0x141>(v); v += dppf<0x140>(v); return v;
}
__device__ __forceinline__ float wave_sum(float v) { v = row_sum16(v); v += __shfl_xor(v, 16); v += __shfl_xor(v, 32); return v; }
__device__ __forceinline__ void sincos_d(double x, double& s, double& c) {
    const double k = __builtin_rint(x * 0.63661977236758134308);
    double r = __builtin_fma(-k, 1.57079632679489655800e+00, x);
    r = __builtin_fma(-k, 6.12323399573676603587e-17, r);
    const double r2 = r * r;
    double sp = 1.58969099521155010221e-10;
    sp = __builtin_fma(sp, r2, -2.50507602534068634195e-08);
    sp = __builtin_fma(sp, r2, 2.75573137070700676789e-06);
    sp = __builtin_fma(sp, r2, -1.98412698298579493134e-04);
    sp = __builtin_fma(sp, r2, 8.33333333332248946124e-03);
    sp = __builtin_fma(sp, r2, -1.66666666666666324348e-01);
    const double sn = __builtin_fma(sp * r2, r, r);
    double cp = -1.13596475577881948265e-11;
    cp = __builtin_fma(cp, r2, 2.08757232129817482790e-09);
    cp = __builtin_fma(cp, r2, -2.75573143513906633035e-07);
    cp = __builtin_fma(cp, r2, 2.48015872894767294178e-05);
    cp = __builtin_fma(cp, r2, -1.38888888888741095749e-03);
    cp = __builtin_fma(cp, r2, 4.16666666666666019037e-02);
    const double cs = __builtin_fma(cp * r2, r2, __builtin_fma(-0.5, r2, 1.0));
    const long q = (long)k & 3;
    s = (q == 0) ? sn : (q == 1) ? cs : (q == 2) ? -sn : -cs;
    c = (q == 0) ? cs : (q == 1) ? -sn : (q == 2) ? -cs : sn;
}

namespace pg8 {
constexpr int BM = 256, BK = 64, HALF = 128, HTB = HALF * BK * 2, STAGE_BYTES = 8 * HTB, NXCD = 8, WGM = 8;
__host__ __device__ __forceinline__ int lds_byte(int r, int c) { const int st = (r >> 4) * 2 + (c >> 5), rr = r & 15, cc = c & 31, ob = rr * 64 + cc * 2; return st * 1024 + (ob ^ (((ob >> 9) & 1) << 5)); }
__host__ __device__ __forceinline__ void stage_rc(int b, int& R, int& C) { const int st = b / 1024, sb = b % 1024, swz = sb ^ (((sb >> 9) & 1) << 5); R = (st >> 1) * 16 + swz / 64; C = (st & 1) * 32 + (swz % 64) / 2; }
__host__ __device__ __forceinline__ int perm32(int rho) { const int n = rho >> 4, i = rho & 15; return 8 * (i >> 2) + 4 * n + (i & 3); }

struct Unit { int pm, pn, seg; };
struct Gemm { const bf16_t* A; const bf16_t* Bt; int M, N, K, lda, ldb; size_t segA, segB; };

__host__ __device__ __forceinline__ void tile_of(long L, int nM, int nN, int wgm, int& pm, int& pn) {
    const int nwg = nM * nN; int wgid = (int)L;
    { const int q = nwg / NXCD, r = nwg % NXCD, xcd = wgid % NXCD, off = wgid / NXCD; wgid = (xcd < r ? xcd * (q + 1) : r * (q + 1) + (xcd - r) * q) + off; }
    const int nig = wgm * nN, gid = wgid / nig, fm = gid * wgm, gsz = (nM - fm) < wgm ? (nM - fm) : wgm;
    pm = fm + ((wgid % nig) % gsz); pn = (wgid % nig) / gsz;
}
struct StaticOrder {
    int nM, nN, nwg, G, c, wgm = 2;
    __host__ __device__ void init(int M, int N, int G_, int c_) { nM = M / BM; nN = N / BM; nwg = nM * nN; G = G_; c = c_; }
    __host__ __device__ bool next(int i, Unit& u) const {
        const long L = (long)i * G + c; if (L >= nwg) return false;
        tile_of(L, nM, nN, wgm, u.pm, u.pn); u.seg = 0; return true;
    }
    __device__ __forceinline__ void a_ready(const Unit&) const {}
    __device__ __forceinline__ void done(const Unit&) const {}
};
template <int NSEG> struct SegOrder {
    int nM, nN, nwg, G, c, wgm = 2;
    __host__ __device__ void init(int M, int N, int G_, int c_) { nM = M / BM; nN = N / BM; nwg = nM * nN; G = G_; c = c_; }
    __host__ __device__ bool next(int i, Unit& u) const {
        const long L = (long)(i / NSEG) * G + c; if (L >= nwg) return false;
        tile_of(L, nM, nN, wgm, u.pm, u.pn); u.seg = i % NSEG; return true;
    }
    __device__ __forceinline__ void a_ready(const Unit&) const {}
    __device__ __forceinline__ void done(const Unit&) const {}
};

struct DeferOrder {
    int nM, nunits, G, c;
    __host__ __device__ void init(int M, int N, int G_, int c_) { nM = M / BM; nunits = nM * (N / BM); G = G_; c = c_; }
    __host__ __device__ bool next(int i, Unit& u) const { const long L = (long)i * G + c; if (L >= nunits) return false; u.pm = (int)(L % nM); u.pn = (int)(L / nM); u.seg = 0; return true; }
    __device__ __forceinline__ void a_ready(const Unit&) const {}
    __device__ __forceinline__ void done(const Unit&) const {}
};
__device__ __forceinline__ unsigned cvt_pk_bf16(float lo, float hi) { unsigned r; asm volatile("v_cvt_pk_bf16_f32 %0, %1, %2" : "=v"(r) : "v"(lo), "v"(hi)); return r; }


template <class Epi, class Sched, bool ALIGN_EPI = false, bool SP2 = false>
__device__ __forceinline__ void gemm_phase(LAS unsigned char* lds, const Gemm g, const Sched& S, const Epi& E) {
    int tid = threadIdx.x; asm volatile("" : "+v"(tid));
    const int wid = __builtin_amdgcn_readfirstlane(tid >> 6), lane = tid & 63, wr = wid >> 2, wc = wid & 3, fr = lane & 15, fq = lane >> 4;
    const int K = g.K, nt = K / BK;
    unsigned voffA[2], voffB[2];
#pragma unroll
    for (int i = 0; i < 2; ++i) { int R, C; stage_rc(tid * 16 + i * 8192, R, C); const int Rb = Epi::PERM ? ((R & ~31) + perm32(R & 31)) : R;
        voffA[i] = (unsigned)(R * g.lda + C) * 2u; voffB[i] = (unsigned)(Rb * g.ldb + C) * 2u; }
    const size_t kstep = (size_t)(BK * 2);
    const size_t hstepA = (size_t)HALF * g.lda * 2, hstepB = (size_t)HALF * g.ldb * 2;
    const size_t tstepA = 2 * hstepA, tstepB = 2 * hstepB;
    const unsigned ldsw = (unsigned)wid * 1024u;
    const int aoff = lds_byte(wr * 64 + fr, fq * 8), boff = lds_byte(wc * 32 + fr, fq * 8);
#define PG8_SA(b, h) (((b) * 2 + (h)) * HTB)
#define PG8_SB(b, h) ((4 + (b) * 2 + (h)) * HTB)
#define PG8_STAGE(bufoff, gbase, voff) do { _Pragma("unroll") for (int _i = 0; _i < 2; ++_i) \
        __builtin_amdgcn_global_load_lds((const unsigned*)((const char*)(gbase) + (voff)[_i]), (LAS unsigned*)(lds + (bufoff) + ldsw + _i * 8192), 16, 0, 0); } while (0)
#define PG8_LDA(dst, b, h) do { _Pragma("unroll") for (int m = 0; m < 4; ++m) _Pragma("unroll") for (int k = 0; k < 2; ++k) dst[m][k] = *(const LAS bf16x8*)(lds + PG8_SA(b, h) + aoff + m * 2048 + k * 1024); } while (0)
#define PG8_LDB(dst, b, h) do { _Pragma("unroll") for (int n = 0; n < 2; ++n) _Pragma("unroll") for (int k = 0; k < 2; ++k) dst[n][k] = *(const LAS bf16x8*)(lds + PG8_SB(b, h) + boff + n * 2048 + k * 1024); } while (0)
#define PG8_MMA(ai, bj, At, Bt) do { __builtin_amdgcn_s_setprio(1); _Pragma("unroll") for (int m = 0; m < 4; ++m) _Pragma("unroll") for (int n = 0; n < 2; ++n) _Pragma("unroll") for (int k = 0; k < 2; ++k) \
        acc[ai][bj][m][n] = __builtin_amdgcn_mfma_f32_16x16x32_bf16(Bt[n][k], At[m][k], acc[ai][bj][m][n], 0, 0, 0); __builtin_amdgcn_s_setprio(0); } while (0)
#define PG8_WAIT_V(n) asm volatile("s_waitcnt vmcnt(" #n ")" ::: "memory")
#define PG8_WAIT_L(n) asm volatile("s_waitcnt lgkmcnt(" #n ")" ::: "memory")
#define PG8_BAR __builtin_amdgcn_s_barrier()
#define PG8_SCHED __builtin_amdgcn_sched_barrier(0)
    Unit cur, nxt; int ui = 0;
    if (!S.next(0, cur)) return;
    f32x4 acc[2][2][4][2];
#pragma unroll
    for (int a = 0; a < 2; ++a)
#pragma unroll
        for (int b = 0; b < 2; ++b)
#pragma unroll
            for (int m = 0; m < 4; ++m)
#pragma unroll
                for (int n = 0; n < 2; ++n) acc[a][b][m][n] = (f32x4){0.f, 0.f, 0.f, 0.f};
    bf16x8 At[4][2], B0[2][2], B1[2][2];
    const char* cA = (const char*)g.A + (size_t)cur.seg * g.segA + (size_t)cur.pm * tstepA; const char* cB = (const char*)g.Bt + (size_t)cur.seg * g.segB + (size_t)cur.pn * tstepB;
    S.a_ready(cur);
    if constexpr (SP2) {
        PG8_STAGE(PG8_SB(0, 0), cB, voffB); PG8_STAGE(PG8_SB(0, 1), cB + hstepB, voffB); PG8_STAGE(PG8_SA(0, 0), cA, voffA); PG8_STAGE(PG8_SA(0, 1), cA + hstepA, voffA);
        if (wr == 1) PG8_BAR;
        PG8_WAIT_V(2); PG8_BAR;
        PG8_STAGE(PG8_SB(1, 0), cB + kstep, voffB); PG8_STAGE(PG8_SA(1, 0), cA + kstep, voffA); PG8_STAGE(PG8_SB(1, 1), cB + hstepB + kstep, voffB);
        PG8_WAIT_V(6); PG8_BAR;
    } else {
        PG8_STAGE(PG8_SB(0, 0), cB, voffB); PG8_STAGE(PG8_SA(0, 0), cA, voffA); PG8_STAGE(PG8_SB(0, 1), cB + hstepB, voffB); PG8_STAGE(PG8_SA(0, 1), cA + hstepA, voffA);
        if (wr == 1) PG8_BAR;
        PG8_WAIT_V(4); PG8_BAR;
        PG8_STAGE(PG8_SB(1, 0), cB + kstep, voffB); PG8_STAGE(PG8_SA(1, 0), cA + kstep, voffA); PG8_STAGE(PG8_SB(1, 1), cB + hstepB + kstep, voffB);
        PG8_WAIT_V(6); PG8_BAR;
    }
    for (;;) {
        const bool has_next = S.next(ui + 1, nxt);
        const char* nA = has_next ? (const char*)g.A + (size_t)nxt.seg * g.segA + (size_t)nxt.pm * tstepA : cA;
        const char* nB = has_next ? (const char*)g.Bt + (size_t)nxt.seg * g.segB + (size_t)nxt.pn * tstepB : cB;
        for (int t = 0; t < nt; t += 2) {
            const bool last = (t == nt - 2);
            const char* a1 = cA + (size_t)(t + 1) * kstep;
            const char* a2 = last ? nA : cA + (size_t)(t + 2) * kstep; const char* b2 = last ? nB : cB + (size_t)(t + 2) * kstep;
            const char* a3 = a2 + kstep; const char* b3 = b2 + kstep;
            if (last && has_next) S.a_ready(nxt);
            if constexpr (SP2) {
            PG8_LDB(B0, 0, 0); PG8_LDB(B1, 0, 1); PG8_SCHED; PG8_LDA(At, 0, 0); PG8_STAGE(PG8_SA(1, 1), a1 + hstepA, voffA);
            PG8_WAIT_V(8); PG8_WAIT_L(0); PG8_BAR; PG8_MMA(0, 0, At, B0); PG8_MMA(0, 1, At, B1); PG8_BAR; PG8_SCHED;
            PG8_LDA(At, 0, 1); PG8_STAGE(PG8_SB(0, 0), b2, voffB); PG8_STAGE(PG8_SB(0, 1), b2 + hstepB, voffB); PG8_STAGE(PG8_SA(0, 0), a2, voffA);
            PG8_WAIT_V(8); PG8_WAIT_L(0); PG8_BAR; PG8_MMA(1, 0, At, B0); PG8_MMA(1, 1, At, B1); PG8_BAR; PG8_SCHED;
            PG8_LDB(B0, 1, 0); PG8_LDB(B1, 1, 1); PG8_SCHED; PG8_LDA(At, 1, 0); PG8_STAGE(PG8_SA(0, 1), a2 + hstepA, voffA);
            PG8_WAIT_V(8); PG8_WAIT_L(0); PG8_BAR; PG8_MMA(0, 0, At, B0); PG8_MMA(0, 1, At, B1); PG8_BAR; PG8_SCHED;
            PG8_LDA(At, 1, 1); PG8_STAGE(PG8_SB(1, 0), b3, voffB); PG8_STAGE(PG8_SB(1, 1), b3 + hstepB, voffB); PG8_STAGE(PG8_SA(1, 0), a3, voffA);
            PG8_WAIT_V(8); PG8_WAIT_L(0); PG8_BAR; PG8_MMA(1, 0, At, B0); PG8_MMA(1, 1, At, B1); PG8_BAR; PG8_SCHED;
            } else {
            PG8_LDB(B0, 0, 0); PG8_SCHED; PG8_LDA(At, 0, 0); PG8_STAGE(PG8_SA(1, 1), a1 + hstepA, voffA);
            PG8_WAIT_L(8); PG8_BAR; PG8_WAIT_L(0); PG8_MMA(0, 0, At, B0); PG8_BAR; PG8_SCHED;
            PG8_LDB(B1, 0, 1); PG8_STAGE(PG8_SB(0, 0), b2, voffB);
            PG8_BAR; PG8_WAIT_L(0); PG8_MMA(0, 1, At, B1); PG8_BAR;
            PG8_LDA(At, 0, 1); PG8_STAGE(PG8_SA(0, 0), a2, voffA);
            PG8_BAR; PG8_WAIT_L(0); PG8_MMA(1, 0, At, B0); PG8_BAR; PG8_SCHED;
            PG8_STAGE(PG8_SB(0, 1), b2 + hstepB, voffB);
            PG8_WAIT_V(6); PG8_BAR; PG8_MMA(1, 1, At, B1); PG8_BAR;
            PG8_LDB(B0, 1, 0); PG8_SCHED; PG8_LDA(At, 1, 0); PG8_STAGE(PG8_SA(0, 1), a2 + hstepA, voffA);
            PG8_WAIT_L(8); PG8_BAR; PG8_WAIT_L(0); PG8_MMA(0, 0, At, B0); PG8_BAR; PG8_SCHED;
            PG8_LDB(B1, 1, 1); PG8_STAGE(PG8_SB(1, 0), b3, voffB);
            PG8_BAR; PG8_WAIT_L(0); PG8_MMA(0, 1, At, B1); PG8_BAR;
            PG8_LDA(At, 1, 1); PG8_STAGE(PG8_SA(1, 0), a3, voffA);
            PG8_BAR; PG8_WAIT_L(0); PG8_MMA(1, 0, At, B0); PG8_BAR; PG8_SCHED;
            PG8_STAGE(PG8_SB(1, 1), b3 + hstepB, voffB);
            PG8_WAIT_V(6); PG8_BAR; PG8_MMA(1, 1, At, B1); PG8_BAR;
            }
        }
        if constexpr (ALIGN_EPI) { if (wr == 0) PG8_BAR; }
        { int tz = threadIdx.x; asm volatile("" : "+v"(tz));
          const int l2 = tz & 63; E(acc, cur, wr, wc, l2 & 15, l2 >> 4, tz); }
        S.done(cur);
        if (!has_next) break;
        if (!Epi::keep_acc(cur))
#pragma unroll
        for (int a = 0; a < 2; ++a)
#pragma unroll
            for (int b = 0; b < 2; ++b)
#pragma unroll
                for (int m = 0; m < 4; ++m)
#pragma unroll
                    for (int n = 0; n < 2; ++n) acc[a][b][m][n] = (f32x4){0.f, 0.f, 0.f, 0.f};
        cur = nxt; cA = nA; cB = nB; ++ui;
        if constexpr (ALIGN_EPI) { if (wr == 1) PG8_BAR; }
    }
    PG8_WAIT_V(0);
    if constexpr (!ALIGN_EPI) { if (wr == 0) PG8_BAR; }
    PG8_BAR;
#undef PG8_SA
#undef PG8_SB
#undef PG8_STAGE
#undef PG8_LDA
#undef PG8_LDB
#undef PG8_MMA
#undef PG8_WAIT_V
#undef PG8_WAIT_L
#undef PG8_BAR
#undef PG8_SCHED
}

struct EpiProj {
    static constexpr bool PERM = true; static __device__ __forceinline__ bool keep_acc(const Unit&) { return false; }
    bf16_t* O; float* small; int gate_from;
    __device__ __forceinline__ void operator()(const f32x4 (&acc)[2][2][4][2], const Unit& u, int wr, int wc, int fr, int fq, int tz) const {
        const int row0 = u.pm * BM + wr * 64 + fr, col0 = u.pn * BM + wc * 32 + 8 * fq;
#pragma unroll
        for (int ai = 0; ai < 2; ++ai)
#pragma unroll
            for (int m = 0; m < 4; ++m) { const int row = row0 + ai * HALF + m * 16; bf16_t* rowp = O + (size_t)row * NPP + col0;
#pragma unroll
                for (int bj = 0; bj < 2; ++bj) { f32x4 v0 = acc[ai][bj][m][0], v1 = acc[ai][bj][m][1];
                    const int col = col0 + bj * HALF;
                    if (col + gate_from >= C_GATE) {
#pragma unroll
                        for (int j = 0; j < 4; ++j) { v0[j] = fmaxf(sigmoidf_(v0[j]), 1e-30f); v1[j] = fmaxf(sigmoidf_(v1[j]), 1e-30f); } }
                    u32x4 w; w.x = cvt_pk_bf16(v0[0], v0[1]); w.y = cvt_pk_bf16(v0[2], v0[3]); w.z = cvt_pk_bf16(v1[0], v1[1]); w.w = cvt_pk_bf16(v1[2], v1[3]);
                    *(u32x4*)(rowp + bj * HALF) = w;
                    v0 = acc[ai][bj][m][0]; v1 = acc[ai][bj][m][1];
                    int si = -1; if (col == C_DA) si = 0; else if (col == C_DB) si = 8; else if (col == C_MDT) si = 16; else if (col == C_MDT + 8) si = 24;
                    if (si >= 0) { float* sp = small + (size_t)row * 32 + si; *(f32x4*)sp = v0; *(f32x4*)(sp + 4) = v1; } } }
    }
};
struct EpiGlu {
    static constexpr bool PERM = true; static __device__ __forceinline__ bool keep_acc(const Unit&) { return false; }
    const bf16_t* Y; const float* bias; bf16_t* O;
    __device__ __forceinline__ void operator()(const f32x4 (&acc)[2][2][4][2], const Unit& u, int wr, int wc, int fr, int fq, int tz) const {
        const int row0 = u.pm * BM + wr * 64 + fr, col0 = u.pn * BM + wc * 32 + 8 * fq;
#pragma unroll
        for (int ai = 0; ai < 2; ++ai)
#pragma unroll
            for (int m = 0; m < 4; ++m) { const int row = row0 + ai * HALF + m * 16;
#pragma unroll
                for (int bj = 0; bj < 2; ++bj) { const int col = col0 + bj * HALF;
                    const f32x4 b0 = *(const f32x4*)(bias + col), b1 = *(const f32x4*)(bias + col + 4);
                    const u32x4 yw = *(const u32x4*)(Y + (size_t)row * 1024 + col);
                    const f32x4 v0 = acc[ai][bj][m][0] + b0, v1 = acc[ai][bj][m][1] + b1;
                    float o[8];
                    o[0] = bf_lo(yw.x) * sigmoidf_(v0[0]); o[1] = bf_hi(yw.x) * sigmoidf_(v0[1]); o[2] = bf_lo(yw.y) * sigmoidf_(v0[2]); o[3] = bf_hi(yw.y) * sigmoidf_(v0[3]);
                    o[4] = bf_lo(yw.z) * sigmoidf_(v1[0]); o[5] = bf_hi(yw.z) * sigmoidf_(v1[1]); o[6] = bf_lo(yw.w) * sigmoidf_(v1[2]); o[7] = bf_hi(yw.w) * sigmoidf_(v1[3]);
                    u32x4 w; w.x = cvt_pk_bf16(o[0], o[1]); w.y = cvt_pk_bf16(o[2], o[3]); w.z = cvt_pk_bf16(o[4], o[5]); w.w = cvt_pk_bf16(o[6], o[7]);
                    *(u32x4*)(O + (size_t)row * 4096 + 2048 + col) = w; asm volatile("" ::: "memory"); } }
    }
};
struct EpiMerge {
    static constexpr bool PERM = true; static __device__ __forceinline__ bool keep_acc(const Unit& u) { return u.seg < 3; }
    const bf16_t* proj; bf16_t* O;
    __device__ __forceinline__ void operator()(f32x4 (&acc)[2][2][4][2], const Unit& u, int wr, int wc, int fr, int fq, int tz) const {
        const int row0 = u.pm * BM + wr * 64 + fr, col0 = u.pn * BM + wc * 32 + 8 * fq;
        const bool lastseg = (u.seg == 3);
#pragma unroll
        for (int ai = 0; ai < 2; ++ai) {
            u32x4 gw[4][2], gn[4][2];
#pragma unroll
            for (int m = 0; m < 4; ++m)
#pragma unroll
                for (int bj = 0; bj < 2; ++bj) { const bf16_t* gp = proj + (size_t)(row0 + ai * HALF + m * 16) * NPP + C_GATE + u.seg * 2048 + col0 + bj * HALF;
                    gw[m][bj] = *(const u32x4*)gp; gn[m][bj] = *(const u32x4*)(gp + (lastseg ? 0 : 2048)); }
#pragma unroll
            for (int m = 0; m < 4; ++m)
#pragma unroll
                for (int bj = 0; bj < 2; ++bj) { const int row = row0 + ai * HALF + m * 16, col = col0 + bj * HALF;
                    const u32x4 a = gw[m][bj], d4 = gn[m][bj];
                    float s[8] = {bf_lo(a.x), bf_hi(a.x), bf_lo(a.y), bf_hi(a.y), bf_lo(a.z), bf_hi(a.z), bf_lo(a.w), bf_hi(a.w)};
                    if (!lastseg) { const float d[8] = {bf_lo(d4.x), bf_hi(d4.x), bf_lo(d4.y), bf_hi(d4.y), bf_lo(d4.z), bf_hi(d4.z), bf_lo(d4.w), bf_hi(d4.w)};
#pragma unroll
                        for (int j = 0; j < 8; ++j) s[j] = s[j] * __builtin_amdgcn_rcpf(d[j]); }
                    f32x4 v0 = acc[ai][bj][m][0], v1 = acc[ai][bj][m][1];
#pragma unroll
                    for (int j = 0; j < 4; ++j) { v0[j] *= s[j]; v1[j] *= s[4 + j]; }
                    acc[ai][bj][m][0] = v0; acc[ai][bj][m][1] = v1;
                    if (lastseg) { u32x4 w; w.x = cvt_pk_bf16(v0[0], v0[1]); w.y = cvt_pk_bf16(v0[2], v0[3]); w.z = cvt_pk_bf16(v1[0], v1[1]); w.w = cvt_pk_bf16(v1[2], v1[3]);
                        *(u32x4*)(O + (size_t)row * DM + col) = w; } }
            asm volatile("" ::: "memory"); }
    }
};
struct EpiResid {
    static constexpr bool PERM = false; static __device__ __forceinline__ bool keep_acc(const Unit&) { return false; }
    const float* xres; float* O;
    __device__ __forceinline__ void operator()(const f32x4 (&acc)[2][2][4][2], const Unit& u, int wr, int wc, int fr, int fq, int tz) const {
        const int row0 = u.pm * BM + wr * 64 + fr, col0 = u.pn * BM + wc * 32 + 4 * fq;
#pragma unroll
        for (int ai = 0; ai < 2; ++ai)
#pragma unroll
            for (int m = 0; m < 4; ++m) { const size_t ro = (size_t)(row0 + ai * HALF + m * 16) * DM + col0;
#pragma unroll
                for (int bj = 0; bj < 2; ++bj)
#pragma unroll
                    for (int n = 0; n < 2; ++n) *(f32x4*)(O + ro + bj * HALF + n * 16) = acc[ai][bj][m][n]; }
    }
};
struct EpiRelu2 {
    static constexpr bool PERM = true; static __device__ __forceinline__ bool keep_acc(const Unit&) { return false; }
    bf16_t* O;
    __device__ __forceinline__ void operator()(const f32x4 (&acc)[2][2][4][2], const Unit& u, int wr, int wc, int fr, int fq, int tz) const {
        const int row0 = u.pm * BM + wr * 64 + fr, col0 = u.pn * BM + wc * 32 + 8 * fq;
#pragma unroll
        for (int ai = 0; ai < 2; ++ai)
#pragma unroll
            for (int m = 0; m < 4; ++m) { bf16_t* rowp = O + (size_t)(row0 + ai * HALF + m * 16) * DFF + col0;
#pragma unroll
                for (int bj = 0; bj < 2; ++bj) { f32x4 v0 = acc[ai][bj][m][0], v1 = acc[ai][bj][m][1];
#pragma unroll
                    for (int j = 0; j < 4; ++j) { const float a = fmaxf(v0[j], 0.f), b = fmaxf(v1[j], 0.f); v0[j] = a * a; v1[j] = b * b; }
                    u32x4 w; w.x = cvt_pk_bf16(v0[0], v0[1]); w.y = cvt_pk_bf16(v0[2], v0[3]); w.z = cvt_pk_bf16(v1[0], v1[1]); w.w = cvt_pk_bf16(v1[2], v1[3]);
                    *(u32x4*)(rowp + bj * HALF) = w; } }
    }
};
}

#define XB_TMO      128
#define XB_XCNT(j)  (256  + 64 * (j))
#define XB_XSUB(j)  (1280 + 64 * (j))
#define XB_XGEN(j)  (2304 + 64 * (j))
#define XB_TOP      3328
#define XB_TOPGEN   3392
#define XCD_BAR_WORDS 3456
#define XB_SPIN_CAP (1u << 18)
__device__ __forceinline__ unsigned xb_ld(unsigned* p)              { return __hip_atomic_load(p, __ATOMIC_RELAXED, __HIP_MEMORY_SCOPE_AGENT); }
__device__ __forceinline__ unsigned xb_add(unsigned* p, unsigned v) { return __hip_atomic_fetch_add(p, v, __ATOMIC_RELAXED, __HIP_MEMORY_SCOPE_AGENT); }
__device__ __forceinline__ unsigned xb_xcc_id() { return (unsigned)__builtin_amdgcn_s_getreg((3 << 11) | 20) & 0xFu; }
#define XB_SPIN(cond, bar) do { unsigned _sp = 0; while (cond) { __builtin_amdgcn_s_sleep(1); \
    if ((++_sp & 255u) == 0u) { if (xb_ld(&(bar)[XB_TMO])) break; if (_sp > XB_SPIN_CAP) { atomicAdd(&(bar)[XB_TMO], 1u); break; } } } } while (0)
struct XcdBarrier { unsigned* bar; unsigned x; volatile LAS unsigned* st; };
__device__ __forceinline__ XcdBarrier xcd_barrier_post(unsigned* bar, volatile LAS unsigned* st) {
    XcdBarrier b; b.bar = bar; b.x = xb_xcc_id(); b.st = st;
    if (threadIdx.x == 0) (void)xb_add(&bar[XB_XCNT(b.x)], 1u);
    return b;
}
__device__ __forceinline__ void xcd_barrier_complete(unsigned* bar, unsigned x, unsigned& nloc, unsigned& nx) {
    const unsigned G = gridDim.x * gridDim.y * gridDim.z;
    unsigned sum, cnt, mine, sp = 0u;
    for (;;) {
        sum = 0u; cnt = 0u; mine = 0u;
#pragma unroll
        for (unsigned j = 0; j < 16; ++j) { const unsigned c = xb_ld(&bar[XB_XCNT(j)]); sum += c; cnt += (c > 0u) ? 1u : 0u; mine = (j == x) ? c : mine; }
        if (sum == G) break;
        __builtin_amdgcn_s_sleep(1);
        if ((++sp & 255u) == 0u) { if (xb_ld(&bar[XB_TMO])) break; if (sp > XB_SPIN_CAP) { atomicAdd(&bar[XB_TMO], 1u); break; } }
    }
    nloc = mine > 0u ? mine : 1u; nx = cnt > 0u ? cnt : 1u;
}
__device__ __forceinline__ void xcd_barrier(const XcdBarrier& b) {
    asm volatile("s_waitcnt vmcnt(0)" ::: "memory");
    __syncthreads();
    if (threadIdx.x == 0) {
        unsigned* bar = b.bar;
        __builtin_amdgcn_s_waitcnt(0);
        unsigned nloc = b.st[0], nx = b.st[1];
        if (nloc == 0u) { xcd_barrier_complete(bar, b.x, nloc, nx); b.st[0] = nloc; b.st[1] = nx; }
        const unsigned old = xb_add(&bar[XB_XSUB(b.x)], 1u);
        const unsigned gen = old / nloc;
        if (old + 1u == (gen + 1u) * nloc) {
            __builtin_amdgcn_fence(__ATOMIC_RELEASE, "agent");
            asm volatile("s_waitcnt vmcnt(0)" ::: "memory");
            const unsigned og = xb_add(&bar[XB_TOP], 1u);
            const unsigned tg = og / nx;
            if (og + 1u == (tg + 1u) * nx) xb_add(&bar[XB_TOPGEN], 1u);
            else XB_SPIN(xb_ld(&bar[XB_TOPGEN]) == tg, bar);
            __builtin_amdgcn_fence(__ATOMIC_ACQUIRE, "agent");
            xb_add(&bar[XB_XGEN(b.x)], 1u);
            asm volatile("s_waitcnt vmcnt(0)" ::: "memory");
        } else {
            XB_SPIN(xb_ld(&bar[XB_XGEN(b.x)]) == gen, bar);
            __builtin_amdgcn_fence(__ATOMIC_ACQUIRE, "agent");
            asm volatile("s_waitcnt vmcnt(0)" ::: "memory");
        }
    }
    __syncthreads();
}

struct Args { const void* in[34]; float* out; unsigned char* ws; int ph_lo, ph_hi, li, pad; };
struct Frame {
    LAS unsigned char* lds;
    int tid, lane, wave, vcu, G;
    const void* const* in;
    unsigned char* ws;
    float* out;
};
__device__ __forceinline__ int opaque_tid() { int tz = threadIdx.x; asm volatile("" : "+v"(tz)); return tz; }
#define FIN(i) ((const float*)F.in[i])
#define WSP(type, off) ((type*)(F.ws + (off)))

constexpr int NB_IN = (NPROJ + 63) / 64;
constexpr int I_IN = (DM / 64) * NB_IN, I_GLU = (1024 / 64) * (1024 / 64), I_BR = (1024 / 64) * (DM / 64), I_OUT = (DM / 64) * (DM / 64),
              I_UP = (DM / 64) * (DFF / 64), I_DOWN = (DFF / 64) * (DM / 64), I_LAYER = I_IN + I_GLU + 4 * I_BR + I_OUT + I_UP + I_DOWN;
__device__ __forceinline__ void p0_resolve(Frame& F, int it, const float*& W, int& K, int& N, bf16_t*& WT, int& r) {
    const int l = it / I_LAYER; r = it - l * I_LAYER;
    unsigned char* wt = F.ws + WS_WT + (size_t)l * WT_LAYER;
    if (r < I_IN) { W = FIN(2) + (size_t)l * DM * NPROJ; K = DM; N = NPROJ; WT = (bf16_t*)(wt + WT_IN); return; } r -= I_IN;
    if (r < I_GLU) { W = FIN(15) + (size_t)l * 1024 * 1024; K = 1024; N = 1024; WT = (bf16_t*)(wt + WT_GLU); return; } r -= I_GLU;
    if (r < I_BR) { W = FIN(23) + (size_t)l * 1024 * DM; K = 1024; N = DM; WT = (bf16_t*)(wt + WT_BR); return; } r -= I_BR;
    if (r < I_BR) { W = FIN(24) + (size_t)l * 1024 * DM; K = 1024; N = DM; WT = (bf16_t*)(wt + WT_BR + 4 * MiB); return; } r -= I_BR;
    if (r < I_BR) { W = FIN(25) + (size_t)l * 1024 * DM; K = 1024; N = DM; WT = (bf16_t*)(wt + WT_BR + 8 * MiB); return; } r -= I_BR;
    if (r < I_BR) { W = FIN(26) + (size_t)l * 1024 * DM; K = 1024; N = DM; WT = (bf16_t*)(wt + WT_BR + 12 * MiB); return; } r -= I_BR;
    if (r < I_OUT) { W = FIN(27) + (size_t)l * DM * DM; K = DM; N = DM; WT = (bf16_t*)(wt + WT_OUT); return; } r -= I_OUT;
    if (r < I_UP) { W = FIN(30) + (size_t)l * DM * DFF; K = DM; N = DFF; WT = (bf16_t*)(wt + WT_UP); return; } r -= I_UP;
    W = FIN(31) + (size_t)l * DFF * DM; K = DFF; N = DM; WT = (bf16_t*)(wt + WT_DOWN);
}
__device__ __forceinline__ void p0_prologue(Frame& F) {
    LAS float* scr = (LAS float*)(F.lds + F.wave * 16896);
    const int gw = F.vcu * 8 + F.wave, NGW = F.G * 8; F.tid = opaque_tid(); F.lane = F.tid & 63;
    const int lane = F.lane;
    { float v[64]; const float* W; int K, N, r; bf16_t* WT;
      int it = gw;
#define P0_LOAD() do { p0_resolve(F, it, W, K, N, WT, r); const int nblk = (N + 63) / 64, kb = r / nblk, nb = r - kb * nblk; const bool ok = 64 * nb + lane < N; const float* src = W + (size_t)(64 * kb) * N + 64 * nb + (ok ? lane : 0); \
        _Pragma("unroll") for (int i = 0; i < 64; ++i) v[i] = src[(size_t)i * N]; } while (0)
      if (it < NLAYER * I_LAYER) P0_LOAD();
      while (it < NLAYER * I_LAYER) {
          const int nblk = (N + 63) / 64, kb = r / nblk, nb = r - kb * nblk, k0 = 64 * kb, n0 = 64 * nb, Kc = K, Nc = N; bf16_t* WTc = WT;
#pragma unroll
          for (int i = 0; i < 64; ++i) scr[i * 65 + lane] = v[i];
          asm volatile("s_waitcnt lgkmcnt(0)" ::: "memory");
          it += NGW;
          if (it < NLAYER * I_LAYER) P0_LOAD();
          const int c = lane & 7;
#pragma unroll
          for (int j = 0; j < 8; ++j) { const int n = (lane >> 3) + 8 * j; const LAS float* s = scr + (8 * c) * 65 + n;
              u32x4 o; o.x = pk2(s[0 * 65], s[1 * 65]); o.y = pk2(s[2 * 65], s[3 * 65]); o.z = pk2(s[4 * 65], s[5 * 65]); o.w = pk2(s[6 * 65], s[7 * 65]);
              if (n0 + n < Nc) *(u32x4*)(WTc + (size_t)(n0 + n) * Kc + k0 + 8 * c) = o; }
          asm volatile("s_waitcnt lgkmcnt(0)" ::: "memory");
      }
#undef P0_LOAD
    }
    const int gt = F.vcu * 512 + F.tid, NGT = F.G * 512;
    for (int i = gt; i < NLAYER * (NPP - NPROJ) * DM / 8; i += NGT) { const int l = i / ((NPP - NPROJ) * DM / 8), r = i % ((NPP - NPROJ) * DM / 8);
        *(u32x4*)(F.ws + WS_WT + (size_t)l * WT_LAYER + WT_IN + (size_t)NPROJ * DM * 2 + (size_t)r * 16) = (u32x4){0u, 0u, 0u, 0u}; }
    { const int* pos = (const int*)F.in[1]; float* trig = WSP(float, WS_TRIG);
      for (int i = gt; i < T * 64; i += NGT) { const int t = i >> 6, j = i & 63;
          const double inv = exp2(-(double)j * (13.287712379549449 / 64.0));
          double s, c; sincos_d((double)pos[t] * inv, s, c);
          trig[(size_t)t * 128 + j] = (float)c; trig[(size_t)t * 128 + 64 + j] = (float)s; } }
    { const float* x = FIN(0); bf16_t* xb = WSP(bf16_t, WS_XB);
      for (int i = gt; i < T * DM / 4; i += NGT) { const f32x4 v = *(const f32x4*)(x + (size_t)i * 4); u32x2 w; w.x = pk2(v[0], v[1]); w.y = pk2(v[2], v[3]); *(u32x2*)(xb + (size_t)i * 4) = w; } }
    for (int i = gt; i < NLAYER * 4096; i += NGT) { const int l = i >> 12, gn = i & 4095, g = gn >> 6;
        const double lre = (double)FIN(7)[(size_t)l * 4096 + gn], lim = (double)FIN(8)[(size_t)l * 4096 + gn], step = exp((double)FIN(9)[l * 64 + g]);
        const double mag = exp(lre * step); double sn, cs; sincos_d(lim * step, sn, cs);
        const double are = mag * cs, aim = mag * sn, den = lre * lre + lim * lim;
        const double fre = ((are - 1.0) * lre + aim * lim) / den, fim = (aim * lre - (are - 1.0) * lim) / den;
        float* sp = (float*)(F.ws + WS_S5P + (size_t)l * MiB);
        sp[gn * 2] = (float)are; sp[gn * 2 + 1] = (float)aim;
        const float* bre = FIN(10) + ((size_t)l * 4096 + gn) * 16; const float* bim = FIN(11) + ((size_t)l * 4096 + gn) * 16;
        float* obre = sp + 16384 + (size_t)gn * 16; float* obim = sp + 16384 + 65536 + (size_t)gn * 16;
#pragma unroll
        for (int c = 0; c < 16; ++c) { const double br = bre[c], bi = bim[c]; obre[c] = (float)(fre * br - fim * bi); obim[c] = (float)(fre * bi + fim * br); } }
}

constexpr int LDP = 136;
__device__ __forceinline__ bf16x8 ldsfrag(const LAS bf16_t* base, int pitch, int row, int kk, int q) { return *(const LAS bf16x8*)(base + row * pitch + kk * 32 + 8 * q); }
__device__ __forceinline__ bf16x8 glbfrag(const bf16_t* base, int pitch, int row, int kk, int q) { return *(const bf16x8*)(base + (size_t)row * pitch + kk * 32 + 8 * q); }
#define MFMA16(a, b, c) __builtin_amdgcn_mfma_f32_16x16x32_bf16((a), (b), (c), 0, 0, 0)
__host__ __device__ __forceinline__ int fragoff(int row, int c8, int NK) { return 8 * ((((row >> 4) * NK + (c8 >> 2)) * 64) + (c8 & 3) * 16 + (row & 15)); }
#define LDS_BARRIER() do { asm volatile("s_waitcnt lgkmcnt(0)" ::: "memory"); __builtin_amdgcn_s_barrier(); asm volatile("" ::: "memory"); } while (0)

typedef float f32x16 __attribute__((ext_vector_type(16)));
__device__ __forceinline__ float gelu_tanh_(float y) { const float z = 0.7978845608028654f * (y + 0.044715f * y * y * y); const float th = 1.f - 2.f / (1.f + __expf(2.f * z)); return 0.5f * y * (1.f + th); }
__device__ __forceinline__ void s5_unit(Frame& F, int layer, int g) {
    const int tid = opaque_tid(), lane = tid & 63, w = F.wave, j = lane & 31, hh = lane >> 5, r16 = lane & 15, q = lane >> 4;
    LAS bf16_t* Xw = (LAS bf16_t*)(F.lds + w * 8704);
    LAS float* Ew = (LAS float*)(F.lds + 8 * 8704);
    LAS bf16_t* Uw = (LAS bf16_t*)(F.lds + 8 * 8704 + 4096 + w * 1024);
    const bf16_t* proj = WSP(bf16_t, WS_PROJ); bf16_t* ys = WSP(bf16_t, WS_YS5);
    const float* sp = (const float*)(F.ws + WS_S5P + (size_t)layer * MiB);
    float a1r[2], a1i[2], a2r[2], a2i[2], a3r[2], a3i[2], a4r[2], a4i[2];
#pragma unroll
    for (int s = 0; s < 2; ++s) { const int gn = g * 64 + j + 32 * s; a1r[s] = sp[gn * 2]; a1i[s] = sp[gn * 2 + 1];
        a2r[s] = a1r[s] * a1r[s] - a1i[s] * a1i[s]; a2i[s] = 2.f * a1r[s] * a1i[s];
        a3r[s] = a2r[s] * a1r[s] - a2i[s] * a1i[s]; a3i[s] = a2r[s] * a1i[s] + a2i[s] * a1r[s];
        a4r[s] = a2r[s] * a2r[s] - a2i[s] * a2i[s]; a4i[s] = 2.f * a2r[s] * a2i[s]; }
    bf16x8 bfr[4];
#pragma unroll
    for (int blk = 0; blk < 4; ++blk) { const float* src = sp + 16384 + (blk >> 1) * 65536 + (size_t)(g * 64 + j + 32 * (blk & 1)) * 16 + 8 * hh;
        const f32x4 v0 = *(const f32x4*)src, v1 = *(const f32x4*)(src + 4); u32x4 pk; pk.x = pk2(v0[0], v0[1]); pk.y = pk2(v0[2], v0[3]); pk.z = pk2(v1[0], v1[1]); pk.w = pk2(v1[2], v1[3]);
        bfr[blk] = __builtin_bit_cast(bf16x8, pk); }
    bf16x8 cfr[4];
    { const float* cre = FIN(12) + ((size_t)layer * 64 + g) * 1024 + r16 * 64; const float* cim = FIN(13) + ((size_t)layer * 64 + g) * 1024 + r16 * 64;
#pragma unroll
      for (int kk = 0; kk < 4; ++kk) { float v[8];
#pragma unroll
          for (int i = 0; i < 8; ++i) { const int ls = 8 * kk + 2 * q + (i >> 2), blk = i & 3, st = ls + 32 * (blk & 1); v[i] = (blk >> 1) ? -cim[st] : cre[st]; }
          u32x4 pk; pk.x = pk2(v[0], v[1]); pk.y = pk2(v[2], v[3]); pk.z = pk2(v[4], v[5]); pk.w = pk2(v[6], v[7]); cfr[kk] = __builtin_bit_cast(bf16x8, pk); } }
    const float dsk = FIN(14)[layer * 1024 + g * 16 + r16];
    const int t0 = w * 1024;
    float cr[2] = {0.f, 0.f}, ci[2] = {0.f, 0.f};
    const f32x16 zero16 = {0.f, 0.f, 0.f, 0.f, 0.f, 0.f, 0.f, 0.f, 0.f, 0.f, 0.f, 0.f, 0.f, 0.f, 0.f, 0.f};
#define S5_RING_LOAD(SET, tt) do { const bf16_t* p_ = proj + (size_t)(t0 + 32 * ((tt) & 31) + j) * NPP + C_SU + 16 * g + 8 * hh; asm volatile("global_load_dwordx4 %0, %1, off" : "=v"(ar[SET]) : "v"(p_) : "memory"); } while (0)
#define S5_TILE(tt, SET, LDSET, DO_Y, NWAIT) do { \
        asm volatile("s_waitcnt vmcnt(" NWAIT ")" : "+v"(ar[SET]) :: "memory"); __builtin_amdgcn_sched_barrier(0); \
        const bf16x8 afr = ar[SET]; \
        f32x16 acc[4]; \
        _Pragma("unroll") for (int blk = 0; blk < 4; ++blk) acc[blk] = __builtin_amdgcn_mfma_f32_32x32x16_bf16(afr, bfr[blk], zero16, 0, 0, 0); \
        float cjr[2][4], cji[2][4]; \
        _Pragma("unroll") for (int s = 0; s < 2; ++s) { \
            _Pragma("unroll") for (int gi = 0; gi < 4; ++gi) { float xr = 0.f, xi = 0.f; \
                _Pragma("unroll") for (int k = 0; k < 4; ++k) { const float nr = a1r[s] * xr - a1i[s] * xi + acc[s][4 * gi + k], ni = a1r[s] * xi + a1i[s] * xr + acc[2 + s][4 * gi + k]; xr = nr; xi = ni; acc[s][4 * gi + k] = xr; acc[2 + s][4 * gi + k] = xi; } } \
            float c_r = cr[s], c_i = ci[s]; \
            _Pragma("unroll") for (int gi = 0; gi < 4; ++gi) { const float er = acc[s][4 * gi + 3], ei = acc[2 + s][4 * gi + 3]; const float orr = __shfl_xor(er, 32), oi = __shfl_xor(ei, 32); \
                const float E0r = hh ? orr : er, E0i = hh ? oi : ei, E1r = hh ? er : orr, E1i = hh ? ei : oi;        \
                const float c0r = c_r, c0i = c_i; const float c1r = a4r[s] * c0r - a4i[s] * c0i + E0r, c1i = a4r[s] * c0i + a4i[s] * c0r + E0i; \
                cjr[s][gi] = hh ? c1r : c0r; cji[s][gi] = hh ? c1i : c0i; \
                c_r = a4r[s] * c1r - a4i[s] * c1i + E1r; c_i = a4r[s] * c1i + a4i[s] * c1r + E1i; } \
            cr[s] = c_r; ci[s] = c_i; } \
        if (DO_Y) { \
            _Pragma("unroll") for (int s = 0; s < 2; ++s) _Pragma("unroll") for (int gi = 0; gi < 4; ++gi) { const float kr = cjr[s][gi], ki = cji[s][gi]; \
                acc[s][4 * gi + 0] += a1r[s] * kr - a1i[s] * ki; acc[2 + s][4 * gi + 0] += a1r[s] * ki + a1i[s] * kr; \
                acc[s][4 * gi + 1] += a2r[s] * kr - a2i[s] * ki; acc[2 + s][4 * gi + 1] += a2r[s] * ki + a2i[s] * kr; \
                acc[s][4 * gi + 2] += a3r[s] * kr - a3i[s] * ki; acc[2 + s][4 * gi + 2] += a3r[s] * ki + a3i[s] * kr; \
                acc[s][4 * gi + 3] += a4r[s] * kr - a4i[s] * ki; acc[2 + s][4 * gi + 3] += a4r[s] * ki + a4i[s] * kr; } \
            _Pragma("unroll") for (int r = 0; r < 16; ++r) { const int tok = (r & 3) + 8 * (r >> 2) + 4 * hh; u32x2 o; o.x = pk2(acc[0][r], acc[1][r]); o.y = pk2(acc[2][r], acc[3][r]); *(LAS u32x2*)(Xw + tok * 136 + 4 * j) = o; } \
            *(LAS bf16x8*)(Uw + j * 16 + 8 * hh) = afr;            \
            asm volatile("s_waitcnt lgkmcnt(0)" ::: "memory"); \
            _Pragma("unroll") for (int mt = 0; mt < 2; ++mt) { f32x4 ya = {0.f, 0.f, 0.f, 0.f}; \
                _Pragma("unroll") for (int kk = 0; kk < 4; ++kk) ya = MFMA16(ldsfrag(Xw, 136, 16 * mt + r16, kk, q), cfr[kk], ya); \
                _Pragma("unroll") for (int r = 0; r < 4; ++r) { const size_t t = (size_t)(t0 + 32 * (tt) + 16 * mt + 4 * q + r); const float y = ya[r] + dsk * bf2f(Uw[(16 * mt + 4 * q + r) * 16 + r16]); \
                    ys[t * 1024 + g * 16 + r16] = (bf16_t)f2bf(gelu_tanh_(y)); } } \
            asm volatile("s_waitcnt lgkmcnt(0)" ::: "memory"); } \
        S5_RING_LOAD(LDSET, (tt) + 3); } while (0)
    bf16x8 ar[4];
    S5_RING_LOAD(0, 0); S5_RING_LOAD(1, 1); S5_RING_LOAD(2, 2);
    for (int tt = 0; tt < 32; tt += 4) { S5_TILE(tt, 0, 3, false, "2"); S5_TILE(tt + 1, 1, 0, false, "2"); S5_TILE(tt + 2, 2, 1, false, "2"); S5_TILE(tt + 3, 3, 2, false, "2"); }
    if (hh == 0) {
#pragma unroll
        for (int s = 0; s < 2; ++s) { Ew[(w * 64 + j + 32 * s) * 2] = cr[s]; Ew[(w * 64 + j + 32 * s) * 2 + 1] = ci[s]; } }
    __syncthreads();
#pragma unroll
    for (int s = 0; s < 2; ++s) { float pr = a4r[s], pi = a4i[s];
#pragma unroll
        for (int k = 0; k < 8; ++k) { const float nr = pr * pr - pi * pi, ni = 2.f * pr * pi; pr = nr; pi = ni; }
        float xr = 0.f, xi = 0.f;
        for (int v = 0; v < w; ++v) { const float er = Ew[(v * 64 + j + 32 * s) * 2], ei = Ew[(v * 64 + j + 32 * s) * 2 + 1]; const float nr = pr * xr - pi * xi + er, ni = pr * xi + pi * xr + ei; xr = nr; xi = ni; }
        cr[s] = xr; ci[s] = xi; }
    S5_TILE(0, 0, 3, true, "2"); S5_TILE(1, 1, 0, true, "10"); S5_TILE(2, 2, 1, true, "18"); S5_TILE(3, 3, 2, true, "18");
    for (int tt = 4; tt < 32; tt += 4) { S5_TILE(tt, 0, 3, true, "18"); S5_TILE(tt + 1, 1, 0, true, "18"); S5_TILE(tt + 2, 2, 1, true, "18"); S5_TILE(tt + 3, 3, 2, true, "18"); }
    asm volatile("s_waitcnt vmcnt(0)" ::: "memory");
#undef S5_RING_LOAD
#undef S5_TILE
    __syncthreads();
}

constexpr size_t RET_BLK = 3 * 16384;
__device__ __forceinline__ void ret_pre_unit(Frame& F, int n, int h) {
    const int tid = opaque_tid(), lane = tid & 63, w = F.wave, r16 = lane & 15, q = lane >> 4;
    LAS bf16_t* Qs = (LAS bf16_t*)(F.lds); LAS bf16_t* Ks = (LAS bf16_t*)(F.lds + 128 * LDP * 2);
    const bf16_t* proj = WSP(bf16_t, WS_PROJ); const float* trig = WSP(float, WS_TRIG);
    bf16_t* blk = (bf16_t*)(F.ws + WS_TMP + TM_KR) + (size_t)(n * 4 + h) * RET_BLK;
    { const int tok = tid >> 2, qt = tid & 3; const size_t t = (size_t)n * 128 + tok;
      const bf16_t* pq = proj + t * NPP + C_RQ + h * 128 + 16 * qt; const bf16_t* pk = proj + t * NPP + C_RK + h * 128 + 16 * qt;
      const float* tc = trig + t * 128 + 16 * qt;
      float cs[16], sn[16];
#pragma unroll
      for (int i = 0; i < 4; ++i) { const f32x4 c4 = *(const f32x4*)(tc + 4 * i), s4 = *(const f32x4*)(tc + 64 + 4 * i);
#pragma unroll
          for (int j = 0; j < 4; ++j) { cs[4 * i + j] = c4[j]; sn[4 * i + j] = s4[j]; } }
#pragma unroll
      for (int isk = 0; isk < 2; ++isk) {
          const bf16_t* p = isk ? pk : pq; const float sc = isk ? 0.08838834764831845f : 1.0f;
          const u32x4 a0 = *(const u32x4*)p, a1 = *(const u32x4*)(p + 8), b0 = *(const u32x4*)(p + 64), b1 = *(const u32x4*)(p + 72);
          float x1[16], x2[16];
#pragma unroll
          for (int j = 0; j < 4; ++j) { x1[2 * j] = bf_lo(a0[j]); x1[2 * j + 1] = bf_hi(a0[j]); x1[8 + 2 * j] = bf_lo(a1[j]); x1[8 + 2 * j + 1] = bf_hi(a1[j]);
              x2[2 * j] = bf_lo(b0[j]); x2[2 * j + 1] = bf_hi(b0[j]); x2[8 + 2 * j] = bf_lo(b1[j]); x2[8 + 2 * j + 1] = bf_hi(b1[j]); }
          u32x4 o1[2], o2[2];
#pragma unroll
          for (int j = 0; j < 8; ++j) { const float ya = (x1[2 * j] * cs[2 * j] - x2[2 * j] * sn[2 * j]) * sc, yb = (x1[2 * j + 1] * cs[2 * j + 1] - x2[2 * j + 1] * sn[2 * j + 1]) * sc;
              const float za = (x1[2 * j] * sn[2 * j] + x2[2 * j] * cs[2 * j]) * sc, zb = (x1[2 * j + 1] * sn[2 * j + 1] + x2[2 * j + 1] * cs[2 * j + 1]) * sc;
              o1[j >> 2][j & 3] = pk2(ya, yb); o2[j >> 2][j & 3] = pk2(za, zb); }
          LAS bf16_t* ls = (isk ? Ks : Qs) + tok * LDP + 16 * qt;
          *(LAS u32x4*)ls = o1[0]; *(LAS u32x4*)(ls + 8) = o1[1]; *(LAS u32x4*)(ls + 64) = o2[0]; *(LAS u32x4*)(ls + 72) = o2[1];
          if (!isk) { *(u32x4*)(blk + fragoff(tok, 2 * qt, 4)) = o1[0]; *(u32x4*)(blk + fragoff(tok, 2 * qt + 1, 4)) = o1[1]; *(u32x4*)(blk + fragoff(tok, 8 + 2 * qt, 4)) = o2[0]; *(u32x4*)(blk + fragoff(tok, 9 + 2 * qt, 4)) = o2[1]; } } }
    LDS_BARRIER();
    { const int d = tid >> 2, jq = tid & 3; bf16_t* g = blk + 2 * 16384;
#pragma unroll
      for (int c = 0; c < 4; ++c) { u32x4 o;
#pragma unroll
          for (int j = 0; j < 4; ++j) { const unsigned lo = Ks[(32 * jq + 8 * c + 2 * j) * LDP + d], hi = Ks[(32 * jq + 8 * c + 2 * j + 1) * LDP + d]; o[j] = lo | (hi << 16); }
          *(u32x4*)(g + fragoff(d, 4 * jq + c, 4)) = o; } }
    { const float lg = log2f(1.0f - exp2f(-5.0f - (float)h)); const int i = 16 * w + r16;
      bf16x8 bq[4];
#pragma unroll
      for (int kk = 0; kk < 4; ++kk) bq[kk] = ldsfrag(Qs, LDP, 16 * w + r16, kk, q);
      bf16_t* g = blk + 16384;
      for (int jt = 0; jt < 8; ++jt) {
          u32x2 o = {0u, 0u};
          if (jt <= w) { f32x4 acc = {0.f, 0.f, 0.f, 0.f};
#pragma unroll
              for (int kk = 0; kk < 4; ++kk) acc = MFMA16(ldsfrag(Ks, LDP, 16 * jt + r16, kk, q), bq[kk], acc);
              float v[4];
#pragma unroll
              for (int r = 0; r < 4; ++r) { const int j = 16 * jt + 4 * q + r; v[r] = (j <= i) ? acc[r] * exp2f((float)(i - j) * lg) : 0.f; }
              o.x = pk2(v[0], v[1]); o.y = pk2(v[2], v[3]); }
          *(u32x2*)(g + fragoff(i, 2 * jt + (q >> 1), 4) + 4 * (q & 1)) = o; } }
    LDS_BARRIER();
}

__device__ __forceinline__ void ret_seq_unit(Frame& F, int u) {
    const int tid = opaque_tid(), lane = tid & 63, w = F.wave, r16 = lane & 15, q = lane >> 4;
    const int h = u >> 4, e0 = (u & 15) * 16;
    LAS bf16_t* Rt = (LAS bf16_t*)(F.lds); LAS bf16_t* Vt = (LAS bf16_t*)(F.lds + 2 * 16 * LDP * 2); LAS bf16_t* Vd = (LAS bf16_t*)(F.lds + 4 * 16 * LDP * 2);
    const bf16_t* proj = WSP(bf16_t, WS_PROJ); bf16_t* O = (bf16_t*)(F.ws + WS_TMP + TM_VR);
    const bf16_t* blk0 = (const bf16_t*)(F.ws + WS_TMP + TM_KR) + (size_t)h * RET_BLK;
    const float lg = log2f(1.0f - exp2f(-5.0f - (float)h)), g128 = exp2f(128.f * lg);
    float rsc[4];
#pragma unroll
    for (int r = 0; r < 4; ++r) rsc[r] = exp2f((float)(16 * w + 4 * q + r + 1) * lg);
    const int vj = tid >> 1, vh = tid & 1; const float vdec = exp2f((float)(127 - vj) * lg);
    u32x4 vreg = {0u, 0u, 0u, 0u};
#define RET_LOADV(c) do { if (tid < 256) vreg = *(const u32x4*)(proj + (size_t)((c) * 128 + vj) * NPP + C_RV + h * 256 + e0 + 8 * vh); } while (0)
#define RET_STOREV(b) do { if (tid < 256) { LAS bf16_t* vt = Vt + (b) * 16 * LDP + (8 * vh) * LDP + vj; LAS bf16_t* vd = Vd + (b) * 16 * LDP + (8 * vh) * LDP + vj; \
        _Pragma("unroll") for (int j = 0; j < 4; ++j) { const float lo = bf_lo(vreg[j]), hi = bf_hi(vreg[j]); vt[(2 * j) * LDP] = (bf16_t)(vreg[j] & 0xffffu); vt[(2 * j + 1) * LDP] = (bf16_t)(vreg[j] >> 16); \
            vd[(2 * j) * LDP] = (bf16_t)f2bf(lo * vdec); vd[(2 * j + 1) * LDP] = (bf16_t)f2bf(hi * vdec); } } } while (0)
#define RET_LOADF(FR, c) do { const bf16_t* bk = blk0 + (size_t)(c) * 4 * RET_BLK; _Pragma("unroll") for (int kk = 0; kk < 4; ++kk) { \
        FR[kk] = *(const bf16x8*)(bk + (w * 4 + kk) * 512 + lane * 8); if (kk <= (w >> 1)) FR[4 + kk] = *(const bf16x8*)(bk + 16384 + (w * 4 + kk) * 512 + lane * 8); FR[8 + kk] = *(const bf16x8*)(bk + 32768 + (w * 4 + kk) * 512 + lane * 8); } } while (0)
    for (int i = tid; i < 16 * LDP; i += 512) Rt[i] = 0;
    RET_LOADV(0); RET_STOREV(0);
    bf16x8 fa[12], fb[12];
    RET_LOADF(fa, 0);
    f32x4 R = {0.f, 0.f, 0.f, 0.f};
    __syncthreads();
#define RET_CHUNK(c, CUR, NXT) do { const int b = (c) & 1; \
        if ((c) + 1 < T / 128) { RET_LOADF(NXT, (c) + 1); RET_LOADV((c) + 1); } \
        f32x4 a1 = {0.f, 0.f, 0.f, 0.f}, a2 = {0.f, 0.f, 0.f, 0.f}; f32x4 ra = R * g128; \
        _Pragma("unroll") for (int kk = 0; kk < 4; ++kk) { const bf16x8 bR = ldsfrag(Rt + b * 16 * LDP, LDP, r16, kk, q), bV = ldsfrag(Vt + b * 16 * LDP, LDP, r16, kk, q), bD = ldsfrag(Vd + b * 16 * LDP, LDP, r16, kk, q); \
            a1 = MFMA16(CUR[kk], bR, a1); if (kk <= (w >> 1)) a2 = MFMA16(CUR[4 + kk], bV, a2); ra = MFMA16(CUR[8 + kk], bD, ra); } \
        R = ra; \
        _Pragma("unroll") for (int r = 0; r < 4; ++r) O[(size_t)((c) * 128 + 16 * w + 4 * q + r) * 1024 + h * 256 + e0 + r16] = (bf16_t)f2bf(rsc[r] * a1[r] + a2[r]); \
        { u32x2 o; o.x = pk2(R[0], R[1]); o.y = pk2(R[2], R[3]); *(LAS u32x2*)(Rt + (b ^ 1) * 16 * LDP + r16 * LDP + 16 * w + 4 * q) = o; } \
        if ((c) + 1 < T / 128) RET_STOREV(b ^ 1); \
        LDS_BARRIER(); } while (0)
    for (int c = 0; c < T / 128; c += 2) { RET_CHUNK(c, fa, fb); RET_CHUNK(c + 1, fb, fa); }
#undef RET_CHUNK
#undef RET_LOADF
#undef RET_LOADV
#undef RET_STOREV
}


__device__ __forceinline__ void ssd_pre_unit(Frame& F, int layer, int n, int g) {
    const int tid = opaque_tid(), lane = tid & 63, w = F.wave, r16 = lane & 15, q = lane >> 4;
    LAS bf16_t* Cs = (LAS bf16_t*)(F.lds); LAS bf16_t* Bs = (LAS bf16_t*)(F.lds + 128 * LDP * 2);
    LAS float* Ac = (LAS float*)(F.lds + 2 * 128 * LDP * 2); LAS float* Dt = Ac + 8 * 128;
    const bf16_t* proj = WSP(bf16_t, WS_PROJ); const float* small = WSP(float, WS_SMALL);
    unsigned char* tm = F.ws + WS_TMP;
    float* acum = (float*)(tm + TM_SAC); bf16_t* XS = (bf16_t*)(tm + TM_SXS); bf16_t* XD = (bf16_t*)(tm + TM_SXD);
    bf16_t* cb = (bf16_t*)(tm + TM_SCB) + (size_t)(n * 2 + g) * 32768; bf16_t* sl = (bf16_t*)(tm + TM_SSL) + (size_t)(n * 16 + 8 * g) * 16384;
    const float* scw = FIN(17) + (size_t)layer * 1536 * 4; const float* scb = FIN(18) + layer * 1536; const float* sdtb = FIN(19) + layer * 16; const float* salog = FIN(20) + layer * 16;
    const int t0 = n * 128;
    { const int hh = 8 * g + w; const float a = -__expf(salog[hh]);
      const float dt0 = softplusf_(small[(size_t)(t0 + 2 * lane) * 32 + 16 + hh] + sdtb[hh]), dt1 = softplusf_(small[(size_t)(t0 + 2 * lane + 1) * 32 + 16 + hh] + sdtb[hh]);
      const float v0 = dt0 * a, v1 = dt1 * a, s = v0 + v1; float incl = s;
#pragma unroll
      for (int o = 1; o < 64; o <<= 1) { const float tmp = __shfl_up(incl, o); if (lane >= o) incl += tmp; }
      const float excl = incl - s;
      Ac[w * 128 + 2 * lane] = excl + v0; Ac[w * 128 + 2 * lane + 1] = excl + s; Dt[w * 128 + 2 * lane] = dt0; Dt[w * 128 + 2 * lane + 1] = dt1;
      acum[(size_t)(t0 + 2 * lane) * 16 + hh] = excl + v0; acum[(size_t)(t0 + 2 * lane + 1) * 16 + hh] = excl + s; }
    LDS_BARRIER();
    { const int cp = tid & 127, tq = tid >> 7; const int tb = t0 + 32 * tq;
      unsigned xa[3][35];
#pragma unroll
      for (int m = 0; m < 3; ++m) { const int ch = (m < 2) ? g * 512 + m * 256 + 2 * cp : (cp < 64 ? 1024 + g * 128 + 2 * cp : 1280 + g * 128 + 2 * (cp - 64)); const bf16_t* pc = proj + C_MX + ch;
#pragma unroll
          for (int i = 0; i < 35; ++i) xa[m][i] = (tb - 3 + i >= 0) ? *(const unsigned*)(pc + (size_t)(tb - 3 + i) * NPP) : 0u; }
#pragma unroll
      for (int m = 0; m < 3; ++m) {
          const int ch = (m < 2) ? g * 512 + m * 256 + 2 * cp : (cp < 64 ? 1024 + g * 128 + 2 * cp : 1280 + g * 128 + 2 * (cp - 64));
          const f32x4 w0 = *(const f32x4*)(scw + (size_t)ch * 4), w1 = *(const f32x4*)(scw + (size_t)ch * 4 + 4); const float b0 = scb[ch], b1 = scb[ch + 1];
          const unsigned (&xw)[35] = xa[m];
#pragma unroll
          for (int i = 0; i < 32; ++i) { const unsigned x0 = xw[i], x1 = xw[i + 1], x2 = xw[i + 2], x3 = xw[i + 3];
              const float ya = siluf_(w0[0] * bf_lo(x0) + w0[1] * bf_lo(x1) + w0[2] * bf_lo(x2) + w0[3] * bf_lo(x3) + b0);
              const float yb = siluf_(w1[0] * bf_hi(x0) + w1[1] * bf_hi(x1) + w1[2] * bf_hi(x2) + w1[3] * bf_hi(x3) + b1);
              if (m < 2) { const float dt = Dt[(m * 4 + (cp >> 5)) * 128 + 32 * tq + i]; const size_t go = (size_t)(tb + i) * 1024 + g * 512 + m * 256 + 2 * cp;
                  *(unsigned*)(XS + go) = pk2(ya, yb); *(unsigned*)(XD + go) = pk2(ya * dt, yb * dt); }
              else if (cp < 64) *(LAS unsigned*)(Bs + (32 * tq + i) * LDP + 2 * cp) = pk2(ya, yb);
              else *(LAS unsigned*)(Cs + (32 * tq + i) * LDP + 2 * (cp - 64)) = pk2(ya, yb); } } }
    LDS_BARRIER();
#pragma unroll
    for (int k = 0; k < 4; ++k) { const int idx = tid + 512 * k, row = idx >> 4, c8 = idx & 15; *(u32x4*)(cb + fragoff(row, c8, 4)) = *(const LAS u32x4*)(Cs + row * LDP + 8 * c8); }
    { const int d = tid >> 2, jq = tid & 3; bf16_t* gp = cb + 16384;
#pragma unroll
      for (int c = 0; c < 4; ++c) { u32x4 o;
#pragma unroll
          for (int j = 0; j < 4; ++j) { const unsigned lo = Bs[(32 * jq + 8 * c + 2 * j) * LDP + d], hi = Bs[(32 * jq + 8 * c + 2 * j + 1) * LDP + d]; o[j] = lo | (hi << 16); }
          *(u32x4*)(gp + fragoff(d, 4 * jq + c, 4)) = o; } }
    { const int i = 16 * w + r16; bf16x8 bq[4];
#pragma unroll
      for (int kk = 0; kk < 4; ++kk) bq[kk] = ldsfrag(Cs, LDP, i, kk, q);
      float ai[8];
#pragma unroll
      for (int hh = 0; hh < 8; ++hh) ai[hh] = Ac[hh * 128 + i];
      for (int jt = 0; jt < 8; ++jt) {
          f32x4 acc = {0.f, 0.f, 0.f, 0.f};
          if (jt <= w) {
#pragma unroll
              for (int kk = 0; kk < 4; ++kk) acc = MFMA16(ldsfrag(Bs, LDP, 16 * jt + r16, kk, q), bq[kk], acc); }
#pragma unroll
          for (int hh = 0; hh < 8; ++hh) { u32x2 o = {0u, 0u};
              if (jt <= w) { const f32x4 aj = *(const LAS f32x4*)(Ac + hh * 128 + 16 * jt + 4 * q); float v[4];
#pragma unroll
                  for (int r = 0; r < 4; ++r) { const int j = 16 * jt + 4 * q + r; v[r] = (j <= i) ? acc[r] * __expf(ai[hh] - aj[r]) : 0.f; }
                  o.x = pk2(v[0], v[1]); o.y = pk2(v[2], v[3]); }
              *(u32x2*)(sl + (size_t)hh * 16384 + fragoff(i, 2 * jt + (q >> 1), 4) + 4 * (q & 1)) = o; } } }
    LDS_BARRIER();
}

__device__ __forceinline__ void ssd_seq_unit(Frame& F, int u) {
    const int tid = opaque_tid(), lane = tid & 63, w = F.wave, r16 = lane & 15, q = lane >> 4;
    const int h = u >> 2, p0 = (u & 3) * 16, g = h >> 3;
    LAS bf16_t* St = (LAS bf16_t*)(F.lds); LAS bf16_t* Vt = (LAS bf16_t*)(F.lds + 2 * 16 * LDP * 2); LAS bf16_t* Vd = (LAS bf16_t*)(F.lds + 4 * 16 * LDP * 2);
    unsigned char* tm = F.ws + WS_TMP;
    const float* acum = (const float*)(tm + TM_SAC); const bf16_t* XD = (const bf16_t*)(tm + TM_SXD); bf16_t* O = (bf16_t*)(tm + TM_VS);
    const bf16_t* cb0 = (const bf16_t*)(tm + TM_SCB) + (size_t)g * 32768; const bf16_t* sl0 = (const bf16_t*)(tm + TM_SSL) + (size_t)h * 16384;
    const int vj = tid >> 1, vh = tid & 1;
    u32x4 vreg = {0u, 0u, 0u, 0u}; float vdl = 0.f, vdj = 0.f;
#define SSD_LOADV(c) do { if (tid < 256) { vreg = *(const u32x4*)(XD + (size_t)((c) * 128 + vj) * 1024 + h * 64 + p0 + 8 * vh); \
        vdl = acum[(size_t)((c) * 128 + 127) * 16 + h]; vdj = acum[(size_t)((c) * 128 + vj) * 16 + h]; } } while (0)
#define SSD_STOREV(b) do { if (tid < 256) { const float vdn = __expf(vdl - vdj); LAS bf16_t* vt = Vt + (b) * 16 * LDP + (8 * vh) * LDP + vj; LAS bf16_t* vd = Vd + (b) * 16 * LDP + (8 * vh) * LDP + vj; \
        _Pragma("unroll") for (int j = 0; j < 4; ++j) { const float lo = bf_lo(vreg[j]), hi = bf_hi(vreg[j]); vt[(2 * j) * LDP] = (bf16_t)(vreg[j] & 0xffffu); vt[(2 * j + 1) * LDP] = (bf16_t)(vreg[j] >> 16); \
            vd[(2 * j) * LDP] = (bf16_t)f2bf(lo * vdn); vd[(2 * j + 1) * LDP] = (bf16_t)f2bf(hi * vdn); } } } while (0)
#define SSD_LOADF(FR, AR, c) do { const bf16_t* bc = cb0 + (size_t)(c) * 2 * 32768; const bf16_t* bs = sl0 + (size_t)(c) * 16 * 16384; _Pragma("unroll") for (int kk = 0; kk < 4; ++kk) { \
        FR[kk] = *(const bf16x8*)(bc + (w * 4 + kk) * 512 + lane * 8); if (kk <= (w >> 1)) FR[4 + kk] = *(const bf16x8*)(bs + (w * 4 + kk) * 512 + lane * 8); FR[8 + kk] = *(const bf16x8*)(bc + 16384 + (w * 4 + kk) * 512 + lane * 8); } \
        _Pragma("unroll") for (int r = 0; r < 4; ++r) AR[r] = acum[(size_t)((c) * 128 + 16 * w + 4 * q + r) * 16 + h]; AR[4] = acum[(size_t)((c) * 128 + 127) * 16 + h]; } while (0)
    for (int i = tid; i < 16 * LDP; i += 512) St[i] = 0;
    SSD_LOADV(0); SSD_STOREV(0);
    bf16x8 fa[12], fb[12]; float aa[5], ab[5];
    SSD_LOADF(fa, aa, 0);
    f32x4 S = {0.f, 0.f, 0.f, 0.f};
    __syncthreads();
#define SSD_CHUNK(c, CUR, NXT, ACUR, ANXT) do { const int b = (c) & 1; \
        if ((c) + 1 < T / 128) { SSD_LOADF(NXT, ANXT, (c) + 1); SSD_LOADV((c) + 1); } \
        f32x4 a1 = {0.f, 0.f, 0.f, 0.f}, a2 = {0.f, 0.f, 0.f, 0.f}; f32x4 sa = S * __expf(ACUR[4]); \
        _Pragma("unroll") for (int kk = 0; kk < 4; ++kk) { const bf16x8 bS = ldsfrag(St + b * 16 * LDP, LDP, r16, kk, q), bV = ldsfrag(Vt + b * 16 * LDP, LDP, r16, kk, q), bD = ldsfrag(Vd + b * 16 * LDP, LDP, r16, kk, q); \
            a1 = MFMA16(CUR[kk], bS, a1); if (kk <= (w >> 1)) a2 = MFMA16(CUR[4 + kk], bV, a2); sa = MFMA16(CUR[8 + kk], bD, sa); } \
        S = sa; \
        _Pragma("unroll") for (int r = 0; r < 4; ++r) O[(size_t)((c) * 128 + 16 * w + 4 * q + r) * 1024 + h * 64 + p0 + r16] = (bf16_t)f2bf(__expf(ACUR[r]) * a1[r] + a2[r]); \
        { u32x2 o; o.x = pk2(S[0], S[1]); o.y = pk2(S[2], S[3]); *(LAS u32x2*)(St + (b ^ 1) * 16 * LDP + r16 * LDP + 16 * w + 4 * q) = o; } \
        if ((c) + 1 < T / 128) SSD_STOREV(b ^ 1); \
        LDS_BARRIER(); } while (0)
    for (int c = 0; c < T / 128; c += 2) { SSD_CHUNK(c, fa, fb, aa, ab); SSD_CHUNK(c + 1, fb, fa, ab, aa); }
#undef SSD_CHUNK
#undef SSD_LOADF
#undef SSD_LOADV
#undef SSD_STOREV
}


constexpr size_t GDN_BLK = 36864;
__device__ __forceinline__ void gdn_pre_unit(Frame& F, int layer, int n, int h) {
    const int tid = opaque_tid(), lane = tid & 63, w = F.wave, r16 = lane & 15, q = lane >> 4;
    LAS bf16_t* Qs = (LAS bf16_t*)(F.lds); LAS bf16_t* Ks = (LAS bf16_t*)(F.lds + 17408); LAS bf16_t* Kd = (LAS bf16_t*)(F.lds + 34816);
    LAS float* Mm = (LAS float*)(F.lds + 52224); LAS float* Rr = (LAS float*)(F.lds + 69632); LAS float* gc = (LAS float*)(F.lds + 135168); LAS float* be = gc + 64;
    LAS bf16_t* Xt = Qs;
    LAS bf16_t* Mb = (LAS bf16_t*)(F.lds + 135680);
    const bf16_t* proj = WSP(bf16_t, WS_PROJ); const float* small = WSP(float, WS_SMALL);
    unsigned char* tm = F.ws + WS_TMP;
    bf16_t* blk = (bf16_t*)(tm + TM_KG) + (size_t)(n * 8 + h) * GDN_BLK;
    const float* gcw = FIN(3) + (size_t)layer * 3072 * 4; const float* galog = FIN(4) + layer * 8; const float* gdtb = FIN(5) + layer * 8;
    const int t0 = n * 64;
    f32x4 wt[3][2];
#pragma unroll
      for (int p = 0; p < 3; ++p)
#pragma unroll
          for (int e = 0; e < 2; ++e) wt[p][e] = *(const f32x4*)(gcw + (size_t)(p * 1024 + h * 128 + 2 * lane + e) * 4);
    const bf16_t* pc = proj + C_DQ + h * 128 + 2 * lane; const int tb = t0 + 8 * w;
    unsigned xw[3][11];
#pragma unroll
      for (int p = 0; p < 3; ++p)
#pragma unroll
          for (int k = 0; k < 11; ++k) xw[p][k] = (tb - 3 + k >= 0) ? *(const unsigned*)(pc + (size_t)(tb - 3 + k) * NPP + p * 1024) : 0u;
    if (w == 0) { const float g = -__expf(galog[h]) * softplusf_(small[(size_t)(t0 + lane) * 32 + h] + gdtb[h]); float incl = g;
#pragma unroll
        for (int o = 1; o < 64; o <<= 1) { const float tmp = __shfl_up(incl, o); if (lane >= o) incl += tmp; }
        gc[lane] = incl; be[lane] = sigmoidf_(small[(size_t)(t0 + lane) * 32 + 8 + h]);
        if (lane == 63) ((float*)(tm + TM_SM))[n * 8 + h] = __expf(incl); }
    LDS_BARRIER();
    {
      const float gl63 = gc[63];
#pragma unroll
      for (int i = 0; i < 8; ++i) { const int tok = 8 * w + i; float v[3][2];
#pragma unroll
          for (int p = 0; p < 3; ++p) {
              v[p][0] = siluf_(wt[p][0][0] * bf_lo(xw[p][i]) + wt[p][0][1] * bf_lo(xw[p][i + 1]) + wt[p][0][2] * bf_lo(xw[p][i + 2]) + wt[p][0][3] * bf_lo(xw[p][i + 3]));
              v[p][1] = siluf_(wt[p][1][0] * bf_hi(xw[p][i]) + wt[p][1][1] * bf_hi(xw[p][i + 1]) + wt[p][1][2] * bf_hi(xw[p][i + 2]) + wt[p][1][3] * bf_hi(xw[p][i + 3])); }
          const float sq = wave_sum(v[0][0] * v[0][0] + v[0][1] * v[0][1]), sk = wave_sum(v[1][0] * v[1][0] + v[1][1] * v[1][1]);
          const float rq = rsqrtf(sq + RMS_EPS) * 0.08838834764831845f, rk = rsqrtf(sk + RMS_EPS);
          const float gci = gc[tok], bei = be[tok], eg = __expf(gci), et = __expf(gl63 - gci);
          const float q0 = v[0][0] * rq, q1 = v[0][1] * rq, k0 = v[1][0] * rk, k1 = v[1][1] * rk;
          *(LAS unsigned*)(Qs + tok * LDP + 2 * lane) = pk2(q0, q1); *(LAS unsigned*)(Ks + tok * LDP + 2 * lane) = pk2(k0, k1); *(LAS unsigned*)(Kd + tok * LDP + 2 * lane) = pk2(k0 * et, k1 * et);
          *(LAS f32x2*)(Rr + tok * 256 + 2 * lane) = (f32x2){bei * v[2][0], bei * v[2][1]}; *(LAS f32x2*)(Rr + tok * 256 + 128 + 2 * lane) = (f32x2){bei * eg * k0, bei * eg * k1};
          *(unsigned*)(blk + 16384 + fragoff(tok, lane >> 2, 4) + 2 * (lane & 3)) = pk2(q0 * eg, q1 * eg); } }
    LDS_BARRIER();
    if (w < 4) { bf16x8 aK[4];
#pragma unroll
        for (int kk = 0; kk < 4; ++kk) aK[kk] = ldsfrag(Ks, LDP, 16 * w + r16, kk, q);
        for (int jt = 0; jt <= w; ++jt) { f32x4 acc = {0.f, 0.f, 0.f, 0.f};
#pragma unroll
            for (int kk = 0; kk < 4; ++kk) acc = MFMA16(aK[kk], ldsfrag(Ks, LDP, 16 * jt + r16, kk, q), acc);
            const int j = 16 * jt + r16; const float gj = gc[j];
#pragma unroll
            for (int r = 0; r < 4; ++r) { const int i = 16 * w + 4 * q + r; const float mv = (j < i) ? be[i] * acc[r] * __expf(gc[i] - gj) : 0.f; Mm[i * 68 + j] = mv; Mb[i * 72 + j] = (bf16_t)f2bf(mv); } } }
    else { const int wq = w - 4, i = 16 * wq + r16; bf16x8 bQ[4];
#pragma unroll
        for (int kk = 0; kk < 4; ++kk) bQ[kk] = ldsfrag(Qs, LDP, i, kk, q);
        const float gi = gc[i];
        for (int jt = 0; jt < 4; ++jt) { u32x2 o = {0u, 0u};
            if (jt <= wq) { f32x4 acc = {0.f, 0.f, 0.f, 0.f};
#pragma unroll
                for (int kk = 0; kk < 4; ++kk) acc = MFMA16(ldsfrag(Ks, LDP, 16 * jt + r16, kk, q), bQ[kk], acc);
                float v[4];
#pragma unroll
                for (int r = 0; r < 4; ++r) { const int j = 16 * jt + 4 * q + r; v[r] = (j <= i) ? acc[r] * __expf(gi - gc[j]) : 0.f; }
                o.x = pk2(v[0], v[1]); o.y = pk2(v[2], v[3]); }
            *(u32x2*)(blk + 24576 + fragoff(i, 2 * jt + (q >> 1), 2) + 4 * (q & 1)) = o; } }
    { const int d = tid >> 2, jq = tid & 3; bf16_t* gp = blk + 28672;
#pragma unroll
      for (int c = 0; c < 2; ++c) { u32x4 o;
#pragma unroll
          for (int j = 0; j < 4; ++j) { const unsigned lo = Kd[(16 * jq + 8 * c + 2 * j) * LDP + d], hi = Kd[(16 * jq + 8 * c + 2 * j + 1) * LDP + d]; o[j] = lo | (hi << 16); }
          *(u32x4*)(gp + fragoff(d, 2 * jq + c, 2)) = o; } }
    LDS_BARRIER();
#pragma unroll
    for (int b = 0; b < 4; ++b) {
        if (b > 0) {
#pragma unroll
            for (int t2 = 0; t2 < 2; ++t2) { const int nt = 2 * w + t2; f32x4 acc = {0.f, 0.f, 0.f, 0.f};
#pragma unroll
                for (int ks = 0; ks < (b + 1) / 2; ++ks) { bf16x8 a = *(const LAS bf16x8*)(Mb + (16 * b + r16) * 72 + 32 * ks + 8 * q);
                    bf16x8 xb = *(const LAS bf16x8*)(Xt + (16 * nt + r16) * 72 + 32 * ks + 8 * q);
                    if (32 * ks + 8 * q >= 16 * b) { a = (bf16x8){0, 0, 0, 0, 0, 0, 0, 0}; xb = a; }
                    acc = MFMA16(a, xb, acc); }
#pragma unroll
                for (int r = 0; r < 4; ++r) Rr[(16 * b + 4 * q + r) * 256 + 16 * nt + r16] -= acc[r]; }
            LDS_BARRIER();
        }
        if (tid < 256) { float x[16];
#pragma unroll
            for (int ii = 0; ii < 16; ++ii) { float s = Rr[(16 * b + ii) * 256 + tid];
#pragma unroll
                for (int j4 = 0; j4 < (ii + 3) / 4; ++j4) { const f32x4 m4 = *(const LAS f32x4*)(Mm + (16 * b + ii) * 68 + 16 * b + 4 * j4);
#pragma unroll
                    for (int jj = 0; jj < 4; ++jj) if (4 * j4 + jj < ii) s -= m4[jj] * x[4 * j4 + jj]; }
                x[ii] = s; }
            u32x4 o0, o1; o0.x = pk2(x[0], x[1]); o0.y = pk2(x[2], x[3]); o0.z = pk2(x[4], x[5]); o0.w = pk2(x[6], x[7]); o1.x = pk2(x[8], x[9]); o1.y = pk2(x[10], x[11]); o1.z = pk2(x[12], x[13]); o1.w = pk2(x[14], x[15]);
            *(LAS u32x4*)(Xt + tid * 72 + 16 * b) = o0; *(LAS u32x4*)(Xt + tid * 72 + 16 * b + 8) = o1; }
        LDS_BARRIER();
    }
    { const int e = tid >> 2, part = tid & 3; const u32x4 a0 = *(const LAS u32x4*)(Xt + e * 72 + 16 * part), a1 = *(const LAS u32x4*)(Xt + e * 72 + 16 * part + 8);
      bf16_t* up = blk + 8192 + (((e >> 4) * 4 + part) * 64 + (e & 15)) * 4;
      *(u32x2*)(up) = (u32x2){a0[0], a0[1]}; *(u32x2*)(up + 64) = (u32x2){a0[2], a0[3]}; *(u32x2*)(up + 128) = (u32x2){a1[0], a1[1]}; *(u32x2*)(up + 192) = (u32x2){a1[2], a1[3]}; }
#pragma unroll
    for (int k = 0; k < 2; ++k) { const int idx = tid + 512 * k, row = idx >> 4, d8 = idx & 15; u32x4 o;
#pragma unroll
        for (int j = 0; j < 4; ++j) { const unsigned lo = Xt[(128 + 8 * d8 + 2 * j) * 72 + row], hi = Xt[(128 + 8 * d8 + 2 * j + 1) * 72 + row]; o[j] = lo | (hi << 16); }
        *(u32x4*)(blk + fragoff(row, d8, 4)) = o; }
    LDS_BARRIER();
}

__device__ __forceinline__ void gdn_seq_unit(Frame& F, int u) {
    const int tid = opaque_tid(), lane = tid & 63, w = F.wave, r16 = lane & 15, q = lane >> 4;
    const int h = u >> 3, e0 = (u & 7) * 16, mt = w & 3; const bool lo = w < 4;
    LAS bf16_t* St = (LAS bf16_t*)(F.lds); LAS bf16_t* Vt = (LAS bf16_t*)(F.lds + 16 * LDP * 2);
    unsigned char* tm = F.ws + WS_TMP; bf16_t* O = (bf16_t*)(tm + TM_VG);
    const bf16_t* blk0 = (const bf16_t*)(tm + TM_KG) + (size_t)h * GDN_BLK;
    const float* glp = (const float*)(tm + TM_SM) + h + (lane & 0);
    const int p0off = lo ? 0 : 16384;
#define GDN_LOADF(S, c) do { const int cc = (c) < T / 64 ? (c) : T / 64 - 1; const bf16_t* bk = blk0 + (size_t)cc * 8 * GDN_BLK + lane * 8;        \
        _Pragma("unroll") for (int kk = 0; kk < 4; ++kk) { const bf16_t* p = bk + p0off + (mt * 4 + kk) * 512; asm volatile("global_load_dwordx4 %0, %1, off" : "=v"(fr[S][kk]) : "v"(p) : "memory"); } \
        _Pragma("unroll") for (int kk = 0; kk < 2; ++kk) { const bf16_t* p = bk + 28672 + (w * 2 + kk) * 512; asm volatile("global_load_dwordx4 %0, %1, off" : "=v"(fr[S][4 + kk]) : "v"(p) : "memory"); } \
        _Pragma("unroll") for (int kk = 0; kk < 2; ++kk) { const bf16_t* p = (lo || (kk == 1 && mt < 2)) ? bk + 28672 + (w * 2) * 512 : bk + 24576 + (mt * 2 + kk) * 512;        \
            asm volatile("global_load_dwordx4 %0, %1, off" : "=v"(fr[S][6 + kk]) : "v"(p) : "memory"); } \
        { const bf16_t* p = lo ? blk0 + (size_t)cc * 8 * GDN_BLK + 8192 + (((u & 7) * 4 + mt) * 64 + lane) * 4 : bk + 28672 + (w * 2) * 512; asm volatile("global_load_dwordx2 %0, %1, off" : "=v"(uu[S]) : "v"(p) : "memory"); } \
        { const float* p = glp + cc * 8; asm volatile("global_load_dword %0, %1, off" : "=v"(gg[S]) : "v"(p) : "memory"); } } while (0)
#define GDN_WAIT(S) do { asm volatile("s_waitcnt vmcnt(30)" : "+v"(fr[S][0]), "+v"(fr[S][1]), "+v"(fr[S][2]), "+v"(fr[S][3]), "+v"(fr[S][4]), "+v"(fr[S][5]), "+v"(fr[S][6]), "+v"(fr[S][7]), "+v"(uu[S]), "+v"(gg[S]) :: "memory"); \
        __builtin_amdgcn_sched_barrier(0); } while (0)
    for (int i = tid; i < 16 * LDP; i += 512) St[i] = 0;
    bf16x8 fr[4][8]; u32x2 uu[4]; float gg[4];
    GDN_LOADF(0, 0); GDN_LOADF(1, 1); GDN_LOADF(2, 2);
    f32x4 S = {0.f, 0.f, 0.f, 0.f};
    LDS_BARRIER();
#define GDN_CHUNK(c, CS, LS) do { \
        GDN_LOADF(LS, (c) + 3); \
        const bf16x8 bs0 = ldsfrag(St, LDP, r16, 0, q), bs1 = ldsfrag(St, LDP, r16, 1, q), bs2 = ldsfrag(St, LDP, r16, 2, q), bs3 = ldsfrag(St, LDP, r16, 3, q);     \
        GDN_WAIT(CS); \
        f32x4 a0 = {0.f, 0.f, 0.f, 0.f}; \
        a0 = MFMA16(fr[CS][0], bs0, a0); a0 = MFMA16(fr[CS][1], bs1, a0); a0 = MFMA16(fr[CS][2], bs2, a0); a0 = MFMA16(fr[CS][3], bs3, a0); \
        if (lo) { u32x2 o; o.x = pk2(bf_lo(uu[CS].x) - a0[0], bf_hi(uu[CS].x) - a0[1]); o.y = pk2(bf_lo(uu[CS].y) - a0[2], bf_hi(uu[CS].y) - a0[3]); *(LAS u32x2*)(Vt + r16 * 72 + 16 * mt + 4 * q) = o; } \
        LDS_BARRIER(); \
        const bf16x8 bV0 = ldsfrag(Vt, 72, r16, 0, q), bV1 = ldsfrag(Vt, 72, r16, 1, q); \
        f32x4 sa = S * gg[CS]; sa = MFMA16(fr[CS][4], bV0, sa); sa = MFMA16(fr[CS][5], bV1, sa); S = sa; \
        { u32x2 o; o.x = pk2(S[0], S[1]); o.y = pk2(S[2], S[3]); *(LAS u32x2*)(St + r16 * LDP + 16 * w + 4 * q) = o; } \
        if (!lo) { a0 = MFMA16(fr[CS][6], bV0, a0); if (mt >= 2) a0 = MFMA16(fr[CS][7], bV1, a0);        \
            const unsigned p01 = pk2(a0[0], a0[1]), p23 = pk2(a0[2], a0[3]); bf16_t* op = O + (size_t)((c) * 64 + 16 * mt + 4 * q) * 1024 + h * 128 + e0 + r16; \
            op[0] = (bf16_t)(p01 & 0xffffu); op[1024] = (bf16_t)(p01 >> 16); op[2048] = (bf16_t)(p23 & 0xffffu); op[3072] = (bf16_t)(p23 >> 16); } \
        LDS_BARRIER(); } while (0)
    for (int c = 0; c < T / 64; c += 4) { GDN_CHUNK(c, 0, 3); GDN_CHUNK(c + 1, 1, 0); GDN_CHUNK(c + 2, 2, 1); GDN_CHUNK(c + 3, 3, 2); }
    asm volatile("s_waitcnt vmcnt(0)" ::: "memory");
#undef GDN_WAIT
#undef GDN_CHUNK
#undef GDN_LOADF
}

__device__ __forceinline__ void mixer_phase(Frame& F, int layer) {
    for (int u = F.vcu; u < 256; u += F.G) {
        if (u < 64) { gdn_seq_unit(F, u); if (MIXREP & 1) gdn_seq_unit(F, u); }
        else if (u < 128) { s5_unit(F, layer, u - 64); if (MIXREP & 2) s5_unit(F, layer, u - 64); }
        else if (u < 192) { ret_seq_unit(F, u - 128); if (MIXREP & 4) ret_seq_unit(F, u - 128); }
        else { ssd_seq_unit(F, u - 192); if (MIXREP & 8) ssd_seq_unit(F, u - 192); }
    }
}
__device__ __forceinline__ void pre_phase(Frame& F, int layer) {
    for (int u = F.vcu; u < 1280; u += F.G) {
        if (u < 1024) { gdn_pre_unit(F, layer, u >> 3, u & 7); if (MIXREP & 16) gdn_pre_unit(F, layer, u >> 3, u & 7); }
        else if (u < 1152) { ssd_pre_unit(F, layer, (u - 1024) >> 1, (u - 1024) & 1); if (MIXREP & 32) ssd_pre_unit(F, layer, (u - 1024) >> 1, (u - 1024) & 1); }
        else { const int ru = 2 * (u - 1152);
            ret_pre_unit(F, ru >> 2, ru & 3); ret_pre_unit(F, (ru + 1) >> 2, (ru + 1) & 3); if (MIXREP & 64) ret_pre_unit(F, ru >> 2, ru & 3); }
    }
}

__device__ __forceinline__ void post_phase(Frame& F, int layer) {
    const int gw = F.vcu * 8 + F.wave, NGW = F.G * 8, lane = opaque_tid() & 63;
    const bf16_t* proj = WSP(bf16_t, WS_PROJ); bf16_t* ycat = WSP(bf16_t, WS_YCAT);
    unsigned char* tm = F.ws + WS_TMP;
    const bf16_t* Or = (const bf16_t*)(tm + TM_VR); const bf16_t* Os = (const bf16_t*)(tm + TM_VS); const bf16_t* Og = (const bf16_t*)(tm + TM_VG);
    const float* gnw = FIN(6) + layer * 128; const bf16_t* XS = (const bf16_t*)(tm + TM_SXS);
    const float* sdk = FIN(21) + layer * 16; const float* snw = FIN(22) + layer * 1024;
    const bool deal = (F.G == 256); const int bx = blockIdx.x;
    const int tbeg = deal ? (bx < 128 ? (bx * 8 + F.wave) * 3 : 3072 + ((bx - 128) * 8 + F.wave) * 5) : gw;
    const int tcnt = deal ? (bx < 128 ? 3 : 5) : (T - gw + NGW - 1) / NGW, tstep = deal ? 1 : NGW;
#define UNPK8(dst, VV) do { dst[0] = bf_lo(VV[0]); dst[1] = bf_hi(VV[0]); dst[2] = bf_lo(VV[1]); dst[3] = bf_hi(VV[1]); dst[4] = bf_lo(VV[2]); dst[5] = bf_hi(VV[2]); dst[6] = bf_lo(VV[3]); dst[7] = bf_hi(VV[3]); } while (0)
#define PK8(VV, SRC) do { VV[0] = pk2(SRC[0], SRC[1]); VV[1] = pk2(SRC[2], SRC[3]); VV[2] = pk2(SRC[4], SRC[5]); VV[3] = pk2(SRC[6], SRC[7]); } while (0)
    for (int ti = 0; ti < tcnt; ++ti) { const int t = tbeg + ti * tstep;
        const bf16_t* pr = proj + (size_t)t * NPP; bf16_t* yo = ycat + (size_t)t * 4096;
        u32x4 wo[6], wg[6], wx[2];
#pragma unroll
        for (int s = 0; s < 2; ++s) { const int ch = 512 * s + 8 * lane;
            wo[s] = *(const u32x4*)(Or + (size_t)t * 1024 + ch); wg[s] = *(const u32x4*)(pr + C_RG + ch);
            wo[2 + s] = *(const u32x4*)(Og + (size_t)t * 1024 + ch); wg[2 + s] = *(const u32x4*)(pr + C_DZ + ch);
            wo[4 + s] = *(const u32x4*)(Os + (size_t)t * 1024 + ch); wg[4 + s] = *(const u32x4*)(pr + C_MZ + ch); wx[s] = *(const u32x4*)(XS + (size_t)t * 1024 + ch); }
        const f32x4 gn0 = *(const f32x4*)(gnw + 8 * (lane & 15)), gn1 = *(const f32x4*)(gnw + 8 * (lane & 15) + 4);
#pragma unroll
        for (int s = 0; s < 2; ++s) { const int ch = 512 * s + 8 * lane;
            { float y[8], gt[8]; UNPK8(y, wo[s]); UNPK8(gt, wg[s]);
              float sm = ((y[0] + y[1]) + (y[2] + y[3])) + ((y[4] + y[5]) + (y[6] + y[7])); sm = row_sum16(sm); sm += __shfl_xor(sm, 16);
              const float mu = sm * (1.f / 256.f); float s2 = 0.f;
#pragma unroll
              for (int i = 0; i < 8; ++i) { y[i] -= mu; s2 += y[i] * y[i]; }
              s2 = row_sum16(s2); s2 += __shfl_xor(s2, 16);
              const float rs = rsqrtf(s2 * (1.f / 256.f) + LN_EPS);
#pragma unroll
              for (int i = 0; i < 8; ++i) y[i] = y[i] * rs * siluf_(gt[i]);
              u32x4 ow; PK8(ow, y); *(u32x4*)(yo + ch) = ow; }
            { float y[8], gt[8]; UNPK8(y, wo[2 + s]); UNPK8(gt, wg[2 + s]);
              float s2 = 0.f;
#pragma unroll
              for (int i = 0; i < 8; ++i) s2 += y[i] * y[i];
              s2 = row_sum16(s2);
              const float rs = rsqrtf(s2 * (1.f / 128.f) + RMS_EPS);
#pragma unroll
              for (int i = 0; i < 8; ++i) y[i] = y[i] * rs * (i < 4 ? gn0[i] : gn1[i - 4]) * siluf_(gt[i]);
              u32x4 ow; PK8(ow, y); *(u32x4*)(yo + 1024 + ch) = ow; }
            { float y[8], gt[8], xh[8]; UNPK8(y, wo[4 + s]); UNPK8(gt, wg[4 + s]); UNPK8(xh, wx[s]);
              const float d = sdk[8 * s + (lane >> 3)]; float s2 = 0.f;
#pragma unroll
              for (int i = 0; i < 8; ++i) { y[i] = (y[i] + d * xh[i]) * siluf_(gt[i]); s2 += y[i] * y[i]; }
              s2 = wave_sum(s2);
              const float rs = rsqrtf(s2 * (1.f / 512.f) + RMS_EPS);
              const f32x4 n0 = *(const f32x4*)(snw + ch), n1 = *(const f32x4*)(snw + ch + 4);
#pragma unroll
              for (int i = 0; i < 8; ++i) y[i] = y[i] * rs * (i < 4 ? n0[i] : n1[i - 4]);
              u32x4 ow; PK8(ow, y); *(u32x4*)(yo + 3072 + ch) = ow; } }
    }
#undef UNPK8
#undef PK8
}

__device__ __forceinline__ void ln_phase(Frame& F, const float* in, const float* res, const float* gam, const float* bet, float* outf, bf16_t* outb) {
    const int gw = F.vcu * 8 + F.wave, NGW = F.G * 8, lane = opaque_tid() & 63;
    for (int t = gw; t < T; t += NGW) {
        const f32x4* xr = (const f32x4*)(in + (size_t)t * DM) + lane; const f32x4* rr = (const f32x4*)(res + (size_t)t * DM) + lane;
        f32x4 v[8]; float s = 0.f;
#pragma unroll
        for (int j = 0; j < 8; ++j) { v[j] = xr[64 * j] + rr[64 * j] * ALPHA; s += (v[j][0] + v[j][1]) + (v[j][2] + v[j][3]); }
        const float mean = wave_sum(s) * (1.f / DM); float s2 = 0.f;
#pragma unroll
        for (int j = 0; j < 8; ++j) { v[j] = v[j] - mean; s2 += (v[j][0] * v[j][0] + v[j][1] * v[j][1]) + (v[j][2] * v[j][2] + v[j][3] * v[j][3]); }
        const float rstd = rsqrtf(wave_sum(s2) * (1.f / DM) + LN_EPS);
#pragma unroll
        for (int j = 0; j < 8; ++j) { const f32x4 gm = *((const f32x4*)gam + lane + 64 * j), bt = *((const f32x4*)bet + lane + 64 * j);
            const f32x4 o = v[j] * rstd * gm + bt;
            *((f32x4*)(outf + (size_t)t * DM) + lane + 64 * j) = o;
            u32x2 w; w.x = pk2(o[0], o[1]); w.y = pk2(o[2], o[3]); *((u32x2*)(outb + (size_t)t * DM) + lane + 64 * j) = w; }
    }
}

constexpr int N_PHASES = 1 + 10 * NLAYER;
__global__ void __launch_bounds__(512, 2) mega(Args args) {
    extern __shared__ __attribute__((aligned(16))) unsigned char lds_raw[];
    Frame F;
    F.lds = (LAS unsigned char*)lds_raw;
    F.tid = threadIdx.x; F.lane = F.tid & 63; F.wave = __builtin_amdgcn_readfirstlane(F.tid >> 6);
    F.G = gridDim.x; { const int bx = blockIdx.x; F.vcu = (F.G % 8 == 0) ? (bx % 8) * (F.G / 8) + bx / 8 : bx; }
    F.in = args.in; F.ws = args.ws; F.out = args.out;
    for (int u = F.tid; u < (LDS_BYTES - LDSCTL_OFF) / 4; u += 512) ((LAS unsigned*)(F.lds + LDSCTL_OFF))[u] = 0u;
    __syncthreads();
    const int lo = args.ph_lo, hi = args.ph_hi;
    unsigned* barw = (unsigned*)(args.ws + WS_CTL) + CW_BAR + args.li * XCD_BAR_WORDS;
    XcdBarrier bar; bar.bar = barw; bar.x = 0; bar.st = nullptr;
    if (hi - lo > 1) bar = xcd_barrier_post(barw, (volatile LAS unsigned*)(F.lds + MISC_OFF) + 8);
#define IN(k) (lo <= (k) && (k) < hi)
#define SEAM(k) do { if ((k) + 1 < hi) xcd_barrier(bar); } while (0)

    if (IN(0)) { p0_prologue(F); if (REPMASK & 1) { xcd_barrier(bar); p0_prologue(F); } SEAM(0); }

    for (int layer = 0; layer < NLAYER; ++layer) {
        const int pb = 1 + 10 * layer;
        unsigned char* wt = F.ws + WS_WT + (size_t)layer * WT_LAYER;
        const float* xcur = layer == 0 ? FIN(0) : WSP(float, WS_XR0);
#define B_INPROJ do { pg8::Gemm g{WSP(bf16_t, WS_XB), (const bf16_t*)(wt + WT_IN), T, NP_MAIN, DM, DM, DM, 0, 0}; pg8::StaticOrder S; S.init(T, NP_MAIN, F.G, (int)blockIdx.x); S.wgm = WGM_INPROJ; \
            pg8::EpiProj E{WSP(bf16_t, WS_PROJ), WSP(float, WS_SMALL), 0}; pg8::gemm_phase<pg8::EpiProj, pg8::StaticOrder, true, true>(F.lds, g, S, E); } while (0)
#define B_INPROJ_DEFER do { pg8::Gemm g{WSP(bf16_t, WS_XB), (const bf16_t*)(wt + WT_IN) + (size_t)NP_MAIN * DM, T, NPP - NP_MAIN, DM, DM, DM, 0, 0}; pg8::DeferOrder S; S.init(T, NPP - NP_MAIN, F.G, (F.vcu + F.G - 128 % F.G) % F.G); \
            pg8::EpiProj E{WSP(bf16_t, WS_PROJ) + NP_MAIN, WSP(float, WS_SMALL), NP_MAIN}; pg8::gemm_phase<pg8::EpiProj, pg8::DeferOrder, true, true>(F.lds, g, S, E); } while (0)
#define B_PREP pre_phase(F, layer)
#define B_MIX do { B_INPROJ_DEFER; if (MIXREP & 128) B_INPROJ_DEFER; mixer_phase(F, layer); } while (0)
#define B_GLUPOST do { pg8::Gemm g{WSP(bf16_t, WS_YS5), (const bf16_t*)(wt + WT_GLU), T, 1024, 1024, 1024, 1024, 0, 0}; pg8::StaticOrder S; S.init(T, 1024, F.G, (int)blockIdx.x); \
            pg8::EpiGlu E{WSP(bf16_t, WS_YS5), FIN(16) + layer * 1024, WSP(bf16_t, WS_YCAT)}; pg8::gemm_phase<pg8::EpiGlu, pg8::StaticOrder, true, true>(F.lds, g, S, E); post_phase(F, layer); } while (0)
#define B_MERGE do { pg8::Gemm g{WSP(bf16_t, WS_YCAT), (const bf16_t*)(wt + WT_BR), T, DM, 1024, 4096, 1024, 2048, 4 * MiB}; pg8::SegOrder<4> S; S.init(T, DM, F.G, (int)blockIdx.x); S.wgm = WGM_N8; \
            pg8::EpiMerge E{WSP(bf16_t, WS_PROJ), (bf16_t*)(F.ws + WS_TMP + TM_MERGED)}; pg8::gemm_phase<pg8::EpiMerge, pg8::SegOrder<4>, true, true>(F.lds, g, S, E); } while (0)
#define B_WOUT do { pg8::Gemm g{(const bf16_t*)(F.ws + WS_TMP + TM_MERGED), (const bf16_t*)(wt + WT_OUT), T, DM, DM, DM, DM, 0, 0}; pg8::StaticOrder S; S.init(T, DM, F.G, (int)blockIdx.x); S.wgm = WGM_N8; \
            pg8::EpiResid E{xcur, (float*)(F.ws + WS_TMP + TM_PRE)}; pg8::gemm_phase<pg8::EpiResid, pg8::StaticOrder, true, true>(F.lds, g, S, E); } while (0)
#define B_LN1 ln_phase(F, (const float*)(F.ws + WS_TMP + TM_PRE), xcur, FIN(28) + layer * DM, FIN(29) + layer * DM, WSP(float, WS_XR1), WSP(bf16_t, WS_XB))
#define B_UP do { pg8::Gemm g{WSP(bf16_t, WS_XB), (const bf16_t*)(wt + WT_UP), T, DFF, DM, DM, DM, 0, 0}; pg8::StaticOrder S; S.init(T, DFF, F.G, (int)blockIdx.x); S.wgm = WGM_UP; \
            pg8::EpiRelu2 E{WSP(bf16_t, WS_HID)}; pg8::gemm_phase<pg8::EpiRelu2, pg8::StaticOrder, true, true>(F.lds, g, S, E); } while (0)
#define B_DOWN do { pg8::Gemm g{WSP(bf16_t, WS_HID), (const bf16_t*)(wt + WT_DOWN), T, DM, DFF, DFF, DFF, 0, 0}; pg8::StaticOrder S; S.init(T, DM, F.G, (int)blockIdx.x); S.wgm = WGM_N8; \
            pg8::EpiResid E{WSP(float, WS_XR1), (float*)(F.ws + WS_TMP + TM_PRE)}; pg8::gemm_phase<pg8::EpiResid, pg8::StaticOrder, true, true>(F.lds, g, S, E); } while (0)
#define B_LN2 ln_phase(F, (const float*)(F.ws + WS_TMP + TM_PRE), WSP(float, WS_XR1), FIN(32) + layer * DM, FIN(33) + layer * DM, layer == NLAYER - 1 ? F.out : WSP(float, WS_XR0), WSP(bf16_t, WS_XB))
#define PH(k, body) do { if (IN(pb + (k))) { body; if ((REPMASK >> ((k) + 1)) & 1) { xcd_barrier(bar); body; } SEAM(pb + (k)); } } while (0)
        PH(0, B_INPROJ);
        PH(1, B_PREP);
        if (IN(pb + 2)) { B_MIX; if ((REPMASK >> 3) & 1) { xcd_barrier(bar); B_PREP; xcd_barrier(bar); B_MIX; } SEAM(pb + 2); }
        PH(3, B_GLUPOST);
        PH(4, B_MERGE);
        PH(5, B_WOUT);
        PH(6, B_LN1);
        PH(7, B_UP);
        PH(8, B_DOWN);
        PH(9, B_LN2);
    }
#undef IN
#undef SEAM
}

extern "C" void kernel_launch(void* const* d_in, const int* in_sizes, int n_in, void* d_out, int out_size, void* d_ws, size_t ws_size, hipStream_t stream) {
    static int grid = 0;
    if (grid == 0) {
        if (n_in != 34 || out_size != T * DM || ws_size < WS_END) { fprintf(stderr, "kernel_launch: unexpected sizes (n_in %d, out %d, ws %zu need %zu)\n", n_in, out_size, ws_size, (size_t)WS_END); grid = -1; return; }
        int dev = 0, cus = 0, per_cu = 0;
        if (hipGetDevice(&dev) != hipSuccess || hipDeviceGetAttribute(&cus, hipDeviceAttributeMultiprocessorCount, dev) != hipSuccess) { grid = -1; return; }
        if (hipFuncSetAttribute((const void*)mega, hipFuncAttributeMaxDynamicSharedMemorySize, LDS_BYTES) != hipSuccess) { fprintf(stderr, "kernel_launch: hipFuncSetAttribute failed\n"); grid = -1; return; }
        if (hipOccupancyMaxActiveBlocksPerMultiprocessor(&per_cu, (const void*)mega, 512, LDS_BYTES) != hipSuccess || per_cu < 1) fprintf(stderr, "kernel_launch: occupancy query reports %d\n", per_cu);
        (void)hipGetLastError();
        grid = cus;
    }
    if (grid < 0) return;
    if (hipMemsetAsync((char*)d_ws + WS_CTL, 0, CTL_ZERO_BYTES, stream) != hipSuccess) return;
    Args a{};
    for (int i = 0; i < 34; ++i) a.in[i] = d_in[i];
    a.out = (float*)d_out; a.ws = (unsigned char*)d_ws;
#if MK_N_LAUNCHES == 1
    a.ph_lo = 0; a.ph_hi = N_PHASES; a.li = 0;
    hipLaunchKernelGGL(mega, dim3(grid), dim3(512), LDS_BYTES, stream, a);
#else
    for (int p = 0; p < N_PHASES; ++p) { a.ph_lo = p; a.ph_hi = p + 1; a.li = p; hipLaunchKernelGGL(mega, dim3(grid), dim3(512), LDS_BYTES, stream, a); }
#endif
}
```
